# Optimizing an MI355X kernel written in HIP

```python
import math
import jax, jax.numpy as jnp
from jax import lax
import numpy as np

D_MODEL = 2048
BATCH = 16
SEQ = 2048
DEPTH = 2

F32 = jnp.float32

GROUP_WIDTH = D_MODEL // 4
MLA_HEADS = 4
MLA_NOPE = 128
MLA_ROPE = 64
MLA_V = GROUP_WIDTH // MLA_HEADS
MLA_Q_LORA = 384
MLA_KV_LORA = 256
ATTN_BLOCK = 128
RET_HEADS = 4
RET_DV = GROUP_WIDTH // RET_HEADS
RET_DK = RET_DV // 2
RET_CHUNK = 128
RET_DECAY_EXP_FWD = 5.0
RET_DECAY_EXP_BWD = 5.5
SSD_HEADDIM = 64
SSD_HEADS = GROUP_WIDTH // SSD_HEADDIM
SSD_GROUPS = 2
SSD_STATE = 128
SSD_CONV = 5
SSD_CHUNK = 128
SSD_CONV_CH = GROUP_WIDTH + 2 * SSD_GROUPS * SSD_STATE
HY_ORDER = 2
HY_WIDTH = GROUP_WIDTH
HY_SHORT = 3
HY_EMB = 33
HY_FILTER_HIDDEN = 64
HY_TARGET = 1e-2
HY_FAST_PCT = 0.3
HY_SLOW_PCT = 1.5
HY_MIN_DECAY = math.log(HY_TARGET) / HY_SLOW_PCT
HY_MAX_DECAY = math.log(HY_TARGET) / HY_FAST_PCT
D_FF = 5632
N_EXPERTS = 8
TOP_K = 2
D_FF_EXPERT = 7168
MOE_BLOCK = 256
ROPE_BASE = 10000.0
ALPHA = (2 * DEPTH) ** 0.25
BETA = (8 * DEPTH) ** -0.25
N_DENSE = (DEPTH + 1) // 2
N_MOE = DEPTH // 2

IN_SPLITS = (MLA_Q_LORA, MLA_KV_LORA, MLA_ROPE,
             RET_HEADS * RET_DK, RET_HEADS * RET_DK, GROUP_WIDTH, GROUP_WIDTH,
             GROUP_WIDTH, SSD_CONV_CH, 2 * SSD_HEADS,
             (HY_ORDER + 1) * HY_WIDTH)
IN_COLS = sum(IN_SPLITS)

kernel_name = 'hymba_style_mla_retnet_ssd_hyena_deepnorm_moe'


def rms_norm(x, w, eps=1e-6):
    xf = x.astype(F32)
    y = xf * lax.rsqrt(jnp.mean(xf * xf, axis=-1, keepdims=True) + eps)
    return (y * w.astype(F32)).astype(x.dtype)


def layer_norm(x, g, b, eps=1e-5):
    xf = x.astype(F32)
    mu = jnp.mean(xf, axis=-1, keepdims=True)
    var = jnp.mean(jnp.square(xf - mu), axis=-1, keepdims=True)
    return ((xf - mu) * lax.rsqrt(var + eps) * g.astype(F32) + b.astype(F32)).astype(x.dtype)


def rotary(x):
    s, d = x.shape[1], x.shape[-1]
    half = d // 2
    inv_freq = ROPE_BASE ** (-jnp.arange(half, dtype=F32) * 2.0 / d)
    ang = jnp.arange(s, dtype=F32)[:, None] * inv_freq[None, :]
    cos = jnp.cos(ang)[None, :, None, :]
    sin = jnp.sin(ang)[None, :, None, :]
    xf = x.astype(F32)
    x1, x2 = xf[..., :half], xf[..., half:]
    return jnp.concatenate([x1 * cos - x2 * sin, x2 * cos + x1 * sin], axis=-1).astype(x.dtype)


def depthwise_conv(x, w, b):
    k = w.shape[0]
    y = lax.conv_general_dilated(x, w[:, None, :].astype(x.dtype), window_strides=(1,),
                                 padding=[(k // 2, k // 2)],
                                 dimension_numbers=('NWC', 'WIO', 'NWC'),
                                 feature_group_count=x.shape[-1])
    return y + b.astype(x.dtype)


def mla_attention(q_nope, q_pe, k_nope, k_pe, v):
    bsz, s, h, _ = q_nope.shape
    nq = s // ATTN_BLOCK
    scale = (MLA_NOPE + MLA_ROPE) ** -0.5

    def to_blocks(t):
        return jnp.moveaxis(t.reshape(bsz, nq, ATTN_BLOCK, h, t.shape[-1]), 1, 0)

    def attend(blk):
        qn, qp = blk
        sc = (jnp.einsum('bqhd,bkhd->bhqk', qn, k_nope)
              + jnp.einsum('bqhr,bkr->bhqk', qp, k_pe))
        p = jax.nn.softmax(sc.astype(F32) * scale, axis=-1)
        return jnp.einsum('bhqk,bkhe->bqhe', p.astype(v.dtype), v)

    out = lax.map(attend, (to_blocks(q_nope), to_blocks(q_pe)))
    return jnp.moveaxis(out, 0, 1).reshape(bsz, s, h * v.shape[-1])


def retention_one_direction(q, k, v, log_gamma, include_diag):
    bsz, s, h, dk = q.shape
    dv = v.shape[-1]
    n = RET_CHUNK
    c = s // n
    qc = q.reshape(bsz, c, n, h, dk)
    kc = k.reshape(bsz, c, n, h, dk)
    vc = v.reshape(bsz, c, n, h, dv)
    idx = jnp.arange(n, dtype=F32)
    diff = idx[:, None] - idx[None, :]
    mask = (diff >= 0) if include_diag else (diff > 0)
    decay = jnp.where(mask[..., None], jnp.exp(jnp.where(mask, diff, 0.0)[..., None] * log_gamma), 0.0)
    scores = jnp.einsum('bcihd,bcjhd->bchij', qc, kc) * jnp.moveaxis(decay, -1, 0)
    inner = jnp.einsum('bchij,bcjhe->bcihe', scores, vc)
    k_decay = jnp.exp((n - 1.0 - idx)[:, None] * log_gamma)
    states = jnp.einsum('bcjhd,jh,bcjhe->bchde', kc, k_decay, vc)
    chunk_decay = jnp.exp(n * log_gamma)[:, None, None]

    def step(carry, st):
        return carry * chunk_decay + st, carry

    _, prev = lax.scan(step, jnp.zeros((bsz, h, dk, dv), F32), jnp.moveaxis(states, 1, 0))
    prev = jnp.moveaxis(prev, 0, 1)
    q_decay = jnp.exp((idx + 1.0)[:, None] * log_gamma)
    cross = jnp.einsum('bcihd,ih,bchde->bcihe', qc, q_decay, prev)
    return (inner + cross).reshape(bsz, s, h, dv)


def bidirectional_retention(q, k, v):
    q, k, v = (t.astype(F32) for t in (q, k, v))
    bsz, s, h, dv = v.shape
    heads = jnp.arange(RET_HEADS, dtype=F32)
    lg_fwd = jnp.log1p(-jnp.exp2(-RET_DECAY_EXP_FWD - heads))
    lg_bwd = jnp.log1p(-jnp.exp2(-RET_DECAY_EXP_BWD - heads))
    y = (retention_one_direction(q, k, v, lg_fwd, True)
         + jnp.flip(retention_one_direction(jnp.flip(q, 1), jnp.flip(k, 1), jnp.flip(v, 1), lg_bwd, False), 1))
    mu = jnp.mean(y, axis=-1, keepdims=True)
    var = jnp.mean(jnp.square(y - mu), axis=-1, keepdims=True)
    y = (y - mu) * lax.rsqrt(var + 1e-6)
    return y.reshape(bsz, s, h * dv)


def ssd_chunked(x, dt, a, bm, cm, include_diag):
    bsz, s, h, p = x.shape
    g, n = bm.shape[2], bm.shape[3]
    e = h // g
    q = SSD_CHUNK
    c = s // q
    xc = (x * dt[..., None]).reshape(bsz, c, q, g, e, p)
    la = (dt * a).reshape(bsz, c, q, g, e)
    bc = bm.reshape(bsz, c, q, g, n)
    cc = cm.reshape(bsz, c, q, g, n)
    cs = jnp.cumsum(la, axis=2)
    idx = jnp.arange(q)
    mask = (idx[:, None] >= idx[None, :]) if include_diag else (idx[:, None] > idx[None, :])
    mask6 = mask[:, :, None, None]
    seg = cs[:, :, :, None] - cs[:, :, None, :]
    lmat = jnp.where(mask6, jnp.exp(jnp.where(mask6, seg, 0.0)), 0.0)
    cb = jnp.einsum('bcign,bcjgn->bcijg', cc, bc)
    y_diag = jnp.einsum('bcijg,bcijge,bcjgep->bcigep', cb, lmat, xc)
    to_end = jnp.exp(cs[:, :, -1:] - cs)
    states = jnp.einsum('bcjgn,bcjge,bcjgep->bcgepn', bc, to_end, xc)
    chunk_decay = jnp.exp(cs[:, :, -1])

    def step(carry, inp):
        st, dec = inp
        return carry * dec[..., None, None] + st, carry

    init = jnp.zeros((bsz, g, e, p, n), F32)
    _, prev = lax.scan(step, init, (jnp.moveaxis(states, 1, 0), jnp.moveaxis(chunk_decay, 1, 0)))
    prev = jnp.moveaxis(prev, 0, 1)
    y_off = jnp.einsum('bcign,bcige,bcgepn->bcigep', cc, jnp.exp(cs), prev)
    return (y_diag + y_off).reshape(bsz, s, h, p)


def hyena_filter_spectrum(seq_len, w1, b1, w2, b2, w3, freq):
    t = jnp.linspace(0.0, 1.0, seq_len, dtype=F32)[:, None]
    bands = (HY_EMB - 1) // 2
    ang = 2.0 * math.pi * jnp.arange(seq_len, dtype=F32)[:, None] / seq_len
    f = jnp.linspace(1e-4, bands - 1, bands, dtype=F32)[None, :]
    z = jnp.concatenate([t, jnp.cos(f * ang), -jnp.sin(f * ang)], axis=-1)
    freq = freq.astype(F32)
    hid = jnp.sin(freq[0] * (z @ w1.astype(F32) + b1.astype(F32)))
    hid = jnp.sin(freq[1] * (hid @ w2.astype(F32) + b2.astype(F32)))
    filt = (hid @ w3.astype(F32)).reshape(seq_len, HY_ORDER, 2, HY_WIDTH)
    deltas = jnp.abs(jnp.linspace(HY_MIN_DECAY, HY_MAX_DECAY, HY_WIDTH, dtype=F32))
    filt = filt * jnp.exp(-t * deltas)[:, None, None, :]
    h_fwd, h_bwd = filt[:, :, 0], filt[:, :, 1]
    h_full = jnp.concatenate([h_fwd, jnp.zeros((1, HY_ORDER, HY_WIDTH), F32), jnp.flip(h_bwd[1:], 0)], axis=0)
    return jnp.fft.rfft(h_full, axis=0)


def fft_long_conv(u, h_freq, bias):
    seq_len = u.shape[1]
    spec = jnp.fft.rfft(u, n=2 * seq_len, axis=1) * h_freq[None]
    return jnp.fft.irfft(spec, n=2 * seq_len, axis=1)[:, :seq_len] + u * bias.astype(F32)


def hybrid_mixer(x, w_in, mla_q_norm, mla_w_uq, mla_kv_norm, mla_w_ukv, mla_out_norm,
                 ssd_conv_w, ssd_conv_b, ssd_dt_bias, ssd_a_log, ssd_d, ssd_norm,
                 hy_conv_w, hy_conv_b, hy_w1, hy_b1, hy_w2, hy_b2, hy_w3, hy_freq, hy_bias, hy_out_norm,
                 w_out):
    bsz, s, _ = x.shape
    dtype = x.dtype
    proj = jnp.einsum('bsd,de->bse', x, w_in)
    split_idx = np.cumsum(IN_SPLITS)[:-1].tolist()
    (q_c, kv_c, k_pe, r_q, r_k, r_v, r_g, m_z, m_xbc, m_dt, h_u) = jnp.split(proj, split_idx, axis=-1)

    q = jnp.einsum('bsr,re->bse', rms_norm(q_c, mla_q_norm), mla_w_uq).reshape(bsz, s, MLA_HEADS, MLA_NOPE + MLA_ROPE)
    q_nope, q_pe = q[..., :MLA_NOPE], rotary(q[..., MLA_NOPE:])
    kv = jnp.einsum('bsr,re->bse', rms_norm(kv_c, mla_kv_norm), mla_w_ukv).reshape(bsz, s, MLA_HEADS, MLA_NOPE + MLA_V)
    k_nope, v = kv[..., :MLA_NOPE], kv[..., MLA_NOPE:]
    k_pe = rotary(k_pe[:, :, None, :])[:, :, 0]
    out_a = rms_norm(mla_attention(q_nope, q_pe, k_nope, k_pe, v), mla_out_norm).astype(dtype)

    rq = rotary(r_q.reshape(bsz, s, RET_HEADS, RET_DK))
    rk = rotary(r_k.reshape(bsz, s, RET_HEADS, RET_DK)) * (RET_DK ** -0.5)
    rv = r_v.reshape(bsz, s, RET_HEADS, RET_DV)
    out_b = (bidirectional_retention(rq, rk, rv) * jax.nn.silu(r_g.astype(F32))).astype(dtype)

    gn = SSD_GROUPS * SSD_STATE
    xbc = jax.nn.silu(depthwise_conv(m_xbc, ssd_conv_w, ssd_conv_b)).astype(F32)
    xs = xbc[..., :GROUP_WIDTH].reshape(bsz, s, SSD_HEADS, SSD_HEADDIM)
    bm = xbc[..., GROUP_WIDTH:GROUP_WIDTH + gn].reshape(bsz, s, SSD_GROUPS, SSD_STATE)
    cm = xbc[..., GROUP_WIDTH + gn:].reshape(bsz, s, SSD_GROUPS, SSD_STATE)
    dt = jax.nn.softplus(m_dt.astype(F32).reshape(bsz, s, 2, SSD_HEADS) + ssd_dt_bias.astype(F32))
    a = -jnp.exp(ssd_a_log.astype(F32))
    y_f = ssd_chunked(xs, dt[:, :, 0], a[0], bm, cm, True)
    y_b = jnp.flip(ssd_chunked(jnp.flip(xs, 1), jnp.flip(dt[:, :, 1], 1), a[1],
                               jnp.flip(bm, 1), jnp.flip(cm, 1), False), 1)
    y_c = (y_f + y_b + xs * ssd_d.astype(F32)[:, None]).reshape(bsz, s, GROUP_WIDTH)
    out_c = rms_norm(y_c * jax.nn.silu(m_z.astype(F32)), ssd_norm).astype(dtype)

    u = depthwise_conv(h_u, hy_conv_w, hy_conv_b).astype(F32)
    hy_parts = jnp.split(u, HY_ORDER + 1, axis=-1)
    h_freq = hyena_filter_spectrum(s, hy_w1, hy_b1, hy_w2, hy_b2, hy_w3, hy_freq)
    z = hy_parts[0]
    for o in range(HY_ORDER):
        z = hy_parts[o + 1] * fft_long_conv(z, h_freq[:, o], hy_bias[o])
    out_d = rms_norm(z, hy_out_norm).astype(dtype)

    mixed = jnp.concatenate([out_a, out_b, out_c, out_d], axis=-1)
    return jnp.einsum('bse,ed->bsd', mixed, w_out)


def swiglu(x, w_gate, w_up, w_down):
    return (jax.nn.silu(x @ w_gate) * (x @ w_up)) @ w_down


def moe_swiglu(x, w_router, w_gate, w_up, w_down):
    bsz, s, d = x.shape
    xf = x.reshape(-1, d)
    n_tok = xf.shape[0]
    n_asg = n_tok * TOP_K
    logits = (xf @ w_router).astype(F32)
    top_val, top_idx = lax.top_k(logits, TOP_K)
    gates = jax.nn.softmax(top_val, axis=-1)
    e_flat = top_idx.reshape(-1)
    g_flat = gates.reshape(-1)
    tok_flat = jnp.repeat(jnp.arange(n_tok, dtype=jnp.int32), TOP_K)
    order = jnp.argsort(e_flat)
    e_sorted, tok_sorted, g_sorted = e_flat[order], tok_flat[order], g_flat[order]
    counts = jnp.bincount(e_flat, length=N_EXPERTS)
    padded = (counts + MOE_BLOCK - 1) // MOE_BLOCK * MOE_BLOCK
    start = jnp.cumsum(counts) - counts
    pend = jnp.cumsum(padded)
    pstart = pend - padded
    dest = pstart[e_sorted] + (jnp.arange(n_asg, dtype=jnp.int32) - start[e_sorted])
    cap = n_asg + N_EXPERTS * MOE_BLOCK
    n_blocks = cap // MOE_BLOCK
    slot_tok = jnp.full((cap,), n_tok, jnp.int32).at[dest].set(tok_sorted)
    slot_gate = jnp.zeros((cap,), F32).at[dest].set(g_sorted)
    block_expert = jnp.minimum(
        jnp.searchsorted(pend, jnp.arange(n_blocks, dtype=pend.dtype) * MOE_BLOCK, side='right'),
        N_EXPERTS - 1)
    x_pad = jnp.concatenate([xf, jnp.zeros((1, d), xf.dtype)], axis=0)
    x_slots = x_pad[slot_tok].reshape(n_blocks, MOE_BLOCK, d)

    def expert_block(args):
        xb, e = args
        return swiglu(xb, w_gate[e], w_up[e], w_down[e])

    y_slots = lax.map(expert_block, (x_slots, block_expert)).reshape(cap, d)
    y = jnp.zeros((n_tok + 1, d), y_slots.dtype).at[slot_tok].add(y_slots * slot_gate[:, None].astype(y_slots.dtype))
    return y[:n_tok].reshape(bsz, s, d).astype(x.dtype)


def setup_inputs(seed: int = 0) -> dict:
    key = jax.random.key(seed)
    ks = jax.random.split(key, 40)

    def nrm(i, shape, scale):
        return jax.random.normal(ks[i], shape, F32) * scale

    L = DEPTH
    D = D_MODEL
    W = GROUP_WIDTH
    HID = HY_FILTER_HIDDEN
    dt0 = jnp.exp(jax.random.uniform(ks[9], (L, 2, SSD_HEADS), F32, minval=math.log(1e-3), maxval=math.log(1e-1)))
    return {
        'x': nrm(0, (BATCH, SEQ, D), 1.0),
        'w_in': nrm(1, (L, D, IN_COLS), D ** -0.5),
        'mla_q_norm': 1.0 + nrm(2, (L, MLA_Q_LORA), 0.02),
        'mla_w_uq': nrm(3, (L, MLA_Q_LORA, MLA_HEADS * (MLA_NOPE + MLA_ROPE)), MLA_Q_LORA ** -0.5),
        'mla_kv_norm': 1.0 + nrm(4, (L, MLA_KV_LORA), 0.02),
        'mla_w_ukv': nrm(5, (L, MLA_KV_LORA, MLA_HEADS * (MLA_NOPE + MLA_V)), MLA_KV_LORA ** -0.5),
        'mla_out_norm': 1.0 + nrm(6, (L, W), 0.02),
        'ssd_conv_w': nrm(7, (L, SSD_CONV, SSD_CONV_CH), SSD_CONV ** -0.5),
        'ssd_conv_b': nrm(8, (L, SSD_CONV_CH), 0.02),
        'ssd_dt_bias': dt0 + jnp.log(-jnp.expm1(-dt0)),
        'ssd_a_log': jnp.log(jax.random.uniform(ks[10], (L, 2, SSD_HEADS), F32, minval=1.0, maxval=16.0)),
        'ssd_d': 1.0 + nrm(11, (L, SSD_HEADS), 0.02),
        'ssd_norm': 1.0 + nrm(12, (L, W), 0.02),
        'hy_conv_w': nrm(13, (L, HY_SHORT, (HY_ORDER + 1) * W), HY_SHORT ** -0.5),
        'hy_conv_b': nrm(14, (L, (HY_ORDER + 1) * W), 0.02),
        'hy_w1': nrm(15, (L, HY_EMB, HID), HY_EMB ** -0.5),
        'hy_b1': nrm(16, (L, HID), 0.1),
        'hy_w2': nrm(17, (L, HID, HID), HID ** -0.5),
        'hy_b2': nrm(18, (L, HID), 0.1),
        'hy_w3': nrm(19, (L, HID, HY_ORDER * 2 * W), HID ** -0.5),
        'hy_freq': 1.0 + nrm(20, (L, 2, HID), 0.02),
        'hy_bias': nrm(21, (L, HY_ORDER, W), 1.0),
        'hy_out_norm': 1.0 + nrm(22, (L, W), 0.02),
        'w_out': nrm(23, (L, D, D), BETA * D ** -0.5),
        'ln1_g': 1.0 + nrm(24, (L, D), 0.02),
        'ln1_b': nrm(25, (L, D), 0.02),
        'ln2_g': 1.0 + nrm(26, (L, D), 0.02),
        'ln2_b': nrm(27, (L, D), 0.02),
        'ffn_w_gate': nrm(28, (N_DENSE, D, D_FF), D ** -0.5),
        'ffn_w_up': nrm(29, (N_DENSE, D, D_FF), D ** -0.5),
        'ffn_w_down': nrm(30, (N_DENSE, D_FF, D), BETA * D_FF ** -0.5),
        'moe_router': nrm(31, (N_MOE, D, N_EXPERTS), D ** -0.5),
        'moe_w_gate': nrm(32, (N_MOE, N_EXPERTS, D, D_FF_EXPERT), D ** -0.5),
        'moe_w_up': nrm(33, (N_MOE, N_EXPERTS, D, D_FF_EXPERT), D ** -0.5),
        'moe_w_down': nrm(34, (N_MOE, N_EXPERTS, D_FF_EXPERT, D), BETA * D_FF_EXPERT ** -0.5),
    }


def reference(x, w_in, mla_q_norm, mla_w_uq, mla_kv_norm, mla_w_ukv, mla_out_norm,
              ssd_conv_w, ssd_conv_b, ssd_dt_bias, ssd_a_log, ssd_d, ssd_norm,
              hy_conv_w, hy_conv_b, hy_w1, hy_b1, hy_w2, hy_b2, hy_w3, hy_freq, hy_bias, hy_out_norm,
              w_out, ln1_g, ln1_b, ln2_g, ln2_b,
              ffn_w_gate, ffn_w_up, ffn_w_down,
              moe_router, moe_w_gate, moe_w_up, moe_w_down):
    for layer in range(DEPTH):
        h = hybrid_mixer(x, w_in[layer], mla_q_norm[layer], mla_w_uq[layer], mla_kv_norm[layer],
                         mla_w_ukv[layer], mla_out_norm[layer],
                         ssd_conv_w[layer], ssd_conv_b[layer], ssd_dt_bias[layer], ssd_a_log[layer],
                         ssd_d[layer], ssd_norm[layer],
                         hy_conv_w[layer], hy_conv_b[layer], hy_w1[layer], hy_b1[layer], hy_w2[layer],
                         hy_b2[layer], hy_w3[layer], hy_freq[layer], hy_bias[layer], hy_out_norm[layer],
                         w_out[layer])
        x = layer_norm(ALPHA * x + h, ln1_g[layer], ln1_b[layer])
        j = layer // 2
        if layer % 2 == 0:
            f = swiglu(x, ffn_w_gate[j], ffn_w_up[j], ffn_w_down[j])
        else:
            f = moe_swiglu(x, moe_router[j], moe_w_gate[j], moe_w_up[j], moe_w_down[j])
        x = layer_norm(ALPHA * x + f, ln2_g[layer], ln2_b[layer])
    return x
```

```cpp
#include <hip/hip_runtime.h>
#include <cstdio>
#include <cstdint>
namespace pg8 {
#define PG8_LAS __attribute__((address_space(3)))
typedef unsigned short bf16_t;
typedef short bf16x8 __attribute__((ext_vector_type(8)));
typedef float f32x4 __attribute__((ext_vector_type(4)));
typedef unsigned u32x4 __attribute__((ext_vector_type(4)));
constexpr int BM = 256, BK = 64, HALF = 128, HTB = HALF * BK * 2  , STAGE_BYTES = 8 * HTB, NXCD = 8, WGM = 8;

__host__ __device__ __forceinline__ int lds_byte(int r, int c) { const int st = (r >> 4) * 2 + (c >> 5), rr = r & 15, cc = c & 31, ob = rr * 64 + cc * 2; return st * 1024 + (ob ^ (((ob >> 9) & 1) << 5)); }
__host__ __device__ __forceinline__ void stage_rc(int b, int& R, int& C) { const int st = b / 1024, sb = b % 1024, swz = sb ^ (((sb >> 9) & 1) << 5); R = (st >> 1) * 16 + swz / 64; C = (st & 1) * 32 + (swz % 64) / 2; }
__host__ __device__ __forceinline__ int perm32(int rho) { const int n = rho >> 4, i = rho & 15; return 8 * (i >> 2) + 4 * n + (i & 3); }

struct Unit { int pm, pn; long aoff, boff; int aux; };
struct Gemm { const bf16_t* A; const bf16_t* Bt; int M, N, K; };

struct StaticOrder {
    int nM, nN, nwg, G, c;
    __host__ __device__ void init(int M, int N, int G_, int c_) { nM = M / BM; nN = N / BM; nwg = nM * nN; G = G_; c = c_; }
    __host__ __device__ bool next(int i, Unit& u) const {
        const long L = (long)i * G + c; if (L >= nwg) return false;
        int wgid = (int)L; { const int q = nwg / NXCD, r = nwg % NXCD, xcd = wgid % NXCD, off = wgid / NXCD; wgid = (xcd < r ? xcd * (q + 1) : r * (q + 1) + (xcd - r) * q) + off; }
        const int nig = WGM * nN, gid = wgid / nig, fm = gid * WGM, gsz = (nM - fm) < WGM ? (nM - fm) : WGM;
        u.pm = fm + ((wgid % nig) % gsz); u.pn = (wgid % nig) / gsz; u.aoff = 0; u.boff = 0; u.aux = 0; return true;
    }
    __device__ __forceinline__ void a_ready(const Unit&) const {}
    __device__ __forceinline__ void done(const Unit&) const {}
};
struct MoeOrder {
    StaticOrder so; int rb0; int pend[8]; long bstride;
    __device__ bool next(int i, Unit& u) const {
        if (!so.next(i, u)) return false;
        const int row = (rb0 + u.pm) * BM; int e = 0;
#pragma unroll
        for (int j = 0; j < 7; ++j) e += (row >= pend[j]) ? 1 : 0;
        u.boff = (long)e * bstride; u.aux = rb0 + u.pm; return true;
    }
    __device__ __forceinline__ void a_ready(const Unit&) const {}
    __device__ __forceinline__ void done(const Unit&) const {}
};

__device__ __forceinline__ unsigned cvt_pk_bf16(float lo, float hi) { unsigned r; asm volatile("v_cvt_pk_bf16_f32 %0, %1, %2" : "=v"(r) : "v"(lo), "v"(hi)); return r; }
__device__ __forceinline__ float silu_f(float v) { return v * __builtin_amdgcn_rcpf(1.0f + __builtin_amdgcn_exp2f(-1.4426950408889634f * v)); }

struct EpiBf16 {
    static constexpr bool PERM = true, AFTER_DRAIN = false;
    bf16_t* O; int ldc; float* F; int fcol0;
    __device__ __forceinline__ void operator()(const f32x4 (&acc)[2][2][4][2], const Unit& u, int wr, int wc, int fr, int fq) const {
        const int row0 = u.pm * BM + wr * 64 + fr; const int col0 = u.pn * BM + wc * 32 + 8 * fq;
#pragma unroll
        for (int ai = 0; ai < 2; ++ai)
#pragma unroll
            for (int m = 0; m < 4; ++m) { bf16_t* rowp = O + (size_t)(row0 + ai * HALF + m * 16) * ldc + col0;
#pragma unroll
                for (int bj = 0; bj < 2; ++bj) { const f32x4 v0 = acc[ai][bj][m][0], v1 = acc[ai][bj][m][1];
                    u32x4 w; w.x = cvt_pk_bf16(v0[0], v0[1]); w.y = cvt_pk_bf16(v0[2], v0[3]); w.z = cvt_pk_bf16(v1[0], v1[1]); w.w = cvt_pk_bf16(v1[2], v1[3]);
                    *(u32x4*)(rowp + bj * HALF) = w;
                    if (F) { const int c = col0 + bj * HALF - fcol0; if (c >= 0 && c < 16) { float* fp = F + (size_t)(row0 + ai * HALF + m * 16) * 16 + c; *(f32x4*)fp = v0; *(f32x4*)(fp + 4) = v1; } }
                } }
    }
};
struct EpiResF32 {
    static constexpr bool PERM = false, AFTER_DRAIN = false;
    float* X; int ldc; float alpha; float bscale;
    __device__ __forceinline__ void operator()(const f32x4 (&acc)[2][2][4][2], const Unit& u, int wr, int wc, int fr, int fq) const {
        const int row0 = u.pm * BM + wr * 64 + fr, col0 = u.pn * BM + wc * 32 + 4 * fq;
#pragma unroll
        for (int ai = 0; ai < 2; ++ai)
#pragma unroll
            for (int m = 0; m < 4; ++m) { float* rowp = X + (size_t)(row0 + ai * HALF + m * 16) * ldc + col0;
#pragma unroll
                for (int bj = 0; bj < 2; ++bj)
#pragma unroll
                    for (int n = 0; n < 2; ++n) { f32x4* p = (f32x4*)(rowp + bj * HALF + n * 16); const f32x4 x = *p; *p = x * alpha + acc[ai][bj][m][n] * bscale; } }
    }
};
struct EpiSwiglu {
    static constexpr bool PERM = true, AFTER_DRAIN = false;
    bf16_t* H; int ldc;
    __device__ __forceinline__ void operator()(const f32x4 (&acc)[2][2][4][2], const Unit& u, int wr, int wc, int fr, int fq) const {
        const int row0 = u.pm * BM + wr * 64 + fr; const int col0 = u.pn * HALF + wc * 32 + 8 * fq;
#pragma unroll
        for (int ai = 0; ai < 2; ++ai)
#pragma unroll
            for (int m = 0; m < 4; ++m) { bf16_t* rowp = H + (size_t)(row0 + ai * HALF + m * 16) * ldc + col0;
                const f32x4 g0 = acc[ai][0][m][0], g1 = acc[ai][0][m][1], u0 = acc[ai][1][m][0], u1 = acc[ai][1][m][1];
                f32x4 h0, h1;
#pragma unroll
                for (int j = 0; j < 4; ++j) { h0[j] = silu_f(g0[j]) * u0[j]; h1[j] = silu_f(g1[j]) * u1[j]; }
                u32x4 w; w.x = cvt_pk_bf16(h0[0], h0[1]); w.y = cvt_pk_bf16(h0[2], h0[3]); w.z = cvt_pk_bf16(h1[0], h1[1]); w.w = cvt_pk_bf16(h1[2], h1[3]);
                *(u32x4*)rowp = w; }
    }
};
struct EpiMoeDown {
    static constexpr bool PERM = true, AFTER_DRAIN = false;
    bf16_t* Y0; long ystride; int ldc; const int* slot_tok2; const float* slot_gate; int rbase;
    __device__ __forceinline__ void operator()(const f32x4 (&acc)[2][2][4][2], const Unit& u, int wr, int wc, int fr, int fq) const {
        const int row0 = rbase + u.pm * BM + wr * 64 + fr; const int col0 = u.pn * BM + wc * 32 + 8 * fq;
#pragma unroll
        for (int ai = 0; ai < 2; ++ai)
#pragma unroll
            for (int m = 0; m < 4; ++m) { const int slot = row0 + ai * HALF + m * 16; const int t2 = slot_tok2[slot]; const float gt = slot_gate[slot];
                if (t2 >= 0) { bf16_t* rowp = Y0 + (size_t)(t2 & 1) * ystride + (size_t)(t2 >> 1) * ldc + col0;
#pragma unroll
                    for (int bj = 0; bj < 2; ++bj) { const f32x4 v0 = acc[ai][bj][m][0] * gt, v1 = acc[ai][bj][m][1] * gt;
                        u32x4 w; w.x = cvt_pk_bf16(v0[0], v0[1]); w.y = cvt_pk_bf16(v0[2], v0[3]); w.z = cvt_pk_bf16(v1[0], v1[1]); w.w = cvt_pk_bf16(v1[2], v1[3]);
                        *(u32x4*)(rowp + bj * HALF) = w; } } }
    }
};

template <class Epi, class Sched, bool ALIGN_EPI = false, bool SP2 = false>
__device__ __forceinline__ void gemm_phase(PG8_LAS unsigned char* lds, const Gemm g, const Sched& S, const Epi& E, int tid) {
    asm volatile("" : "+v"(tid));
    const int wid = __builtin_amdgcn_readfirstlane(tid >> 6), lane = tid & 63, wr = wid >> 2, wc = wid & 3, fr = lane & 15, fq = lane >> 4;
    const int K = g.K, nt = K / BK;
    unsigned voffA[2], voffB[2];
#pragma unroll
    for (int i = 0; i < 2; ++i) { int R, C; stage_rc(tid * 16 + i * 8192, R, C); const int Rb = Epi::PERM ? ((R & ~31) + perm32(R & 31)) : R;
        voffA[i] = (unsigned)(R * K + C) * 2u; voffB[i] = (unsigned)(Rb * K + C) * 2u; }
    const size_t kstep = (size_t)(BK * 2);
    const size_t hstep = (size_t)HALF * K * 2;
    const size_t tstep = 2 * hstep;
    const unsigned ldsw = (unsigned)wid * 1024u;
    const int aoff = lds_byte(wr * 64 + fr, fq * 8), boff = lds_byte(wc * 32 + fr, fq * 8);
#define PG8_SA(b, h) (((b) * 2 + (h)) * HTB)
#define PG8_SB(b, h) ((4 + (b) * 2 + (h)) * HTB)
#define PG8_STAGE(bufoff, gbase, voff) do { _Pragma("unroll") for (int _i = 0; _i < 2; ++_i) \
        __builtin_amdgcn_global_load_lds((const unsigned*)((const char*)(gbase) + (voff)[_i]), (PG8_LAS unsigned*)(lds + (bufoff) + ldsw + _i * 8192), 16, 0, 0); } while (0)
#define PG8_LDA(dst, b, h) do { _Pragma("unroll") for (int m = 0; m < 4; ++m) _Pragma("unroll") for (int k = 0; k < 2; ++k) dst[m][k] = *(const PG8_LAS bf16x8*)(lds + PG8_SA(b, h) + aoff + m * 2048 + k * 1024); } while (0)
#define PG8_LDB(dst, b, h) do { _Pragma("unroll") for (int n = 0; n < 2; ++n) _Pragma("unroll") for (int k = 0; k < 2; ++k) dst[n][k] = *(const PG8_LAS bf16x8*)(lds + PG8_SB(b, h) + boff + n * 2048 + k * 1024); } while (0)
#define PG8_MMA(ai, bj, At, Bt) do { __builtin_amdgcn_s_setprio(1); _Pragma("unroll") for (int m = 0; m < 4; ++m) _Pragma("unroll") for (int n = 0; n < 2; ++n) _Pragma("unroll") for (int k = 0; k < 2; ++k) \
        acc[ai][bj][m][n] = __builtin_amdgcn_mfma_f32_16x16x32_bf16(Bt[n][k], At[m][k], acc[ai][bj][m][n], 0, 0, 0); __builtin_amdgcn_s_setprio(0); } while (0)
#define PG8_WAIT_V(n) asm volatile("s_waitcnt vmcnt(" #n ")" ::: "memory")
#define PG8_WAIT_L(n) asm volatile("s_waitcnt lgkmcnt(" #n ")" ::: "memory")
#define PG8_BAR __builtin_amdgcn_s_barrier()
#define PG8_SCHED __builtin_amdgcn_sched_barrier(0)
    Unit cur, nxt; int ui = 0;
    if (!S.next(0, cur)) return;
    f32x4 acc[2][2][4][2];
#pragma unroll
    for (int a = 0; a < 2; ++a)
#pragma unroll
        for (int b = 0; b < 2; ++b)
#pragma unroll
            for (int m = 0; m < 4; ++m)
#pragma unroll
                for (int n = 0; n < 2; ++n) acc[a][b][m][n] = (f32x4){0.f, 0.f, 0.f, 0.f};
    bf16x8 At[4][2], B0[2][2], B1[2][2];
    const char* cA = (const char*)g.A + cur.aoff + (size_t)cur.pm * tstep; const char* cB = (const char*)g.Bt + cur.boff + (size_t)cur.pn * tstep;
    S.a_ready(cur);
    if constexpr (SP2) {
        PG8_STAGE(PG8_SB(0, 0), cB, voffB); PG8_STAGE(PG8_SB(0, 1), cB + hstep, voffB); PG8_STAGE(PG8_SA(0, 0), cA, voffA); PG8_STAGE(PG8_SA(0, 1), cA + hstep, voffA);
        if (wr == 1) PG8_BAR;
        PG8_WAIT_V(2); PG8_BAR;
        PG8_STAGE(PG8_SB(1, 0), cB + kstep, voffB); PG8_STAGE(PG8_SA(1, 0), cA + kstep, voffA); PG8_STAGE(PG8_SB(1, 1), cB + hstep + kstep, voffB);
        PG8_WAIT_V(6); PG8_BAR;
    } else {
        PG8_STAGE(PG8_SB(0, 0), cB, voffB); PG8_STAGE(PG8_SA(0, 0), cA, voffA); PG8_STAGE(PG8_SB(0, 1), cB + hstep, voffB); PG8_STAGE(PG8_SA(0, 1), cA + hstep, voffA);
        if (wr == 1) PG8_BAR;
        PG8_WAIT_V(4); PG8_BAR;
        PG8_STAGE(PG8_SB(1, 0), cB + kstep, voffB); PG8_STAGE(PG8_SA(1, 0), cA + kstep, voffA); PG8_STAGE(PG8_SB(1, 1), cB + hstep + kstep, voffB);
        PG8_WAIT_V(6); PG8_BAR;
    }
    for (;;) {
        const bool has_next = S.next(ui + 1, nxt);
        const char* nA = has_next ? (const char*)g.A + nxt.aoff + (size_t)nxt.pm * tstep : cA; const char* nB = has_next ? (const char*)g.Bt + nxt.boff + (size_t)nxt.pn * tstep : cB;
        for (int t = 0; t < nt; t += 2) {
            const bool last = (t == nt - 2);
            const char* a1 = cA + (size_t)(t + 1) * kstep;
            const char* a2 = last ? nA : cA + (size_t)(t + 2) * kstep; const char* b2 = last ? nB : cB + (size_t)(t + 2) * kstep;
            const char* a3 = a2 + kstep; const char* b3 = b2 + kstep;
            if (last && has_next) S.a_ready(nxt);
            if constexpr (SP2) {
            PG8_LDB(B0, 0, 0); PG8_LDB(B1, 0, 1); PG8_SCHED; PG8_LDA(At, 0, 0); PG8_STAGE(PG8_SA(1, 1), a1 + hstep, voffA);
            PG8_WAIT_V(8); PG8_WAIT_L(0); PG8_BAR; PG8_MMA(0, 0, At, B0); PG8_MMA(0, 1, At, B1); PG8_BAR; PG8_SCHED;
            PG8_LDA(At, 0, 1); PG8_STAGE(PG8_SB(0, 0), b2, voffB); PG8_STAGE(PG8_SB(0, 1), b2 + hstep, voffB); PG8_STAGE(PG8_SA(0, 0), a2, voffA);
            PG8_WAIT_V(8); PG8_WAIT_L(0); PG8_BAR; PG8_MMA(1, 0, At, B0); PG8_MMA(1, 1, At, B1); PG8_BAR; PG8_SCHED;
            PG8_LDB(B0, 1, 0); PG8_LDB(B1, 1, 1); PG8_SCHED; PG8_LDA(At, 1, 0); PG8_STAGE(PG8_SA(0, 1), a2 + hstep, voffA);
            PG8_WAIT_V(8); PG8_WAIT_L(0); PG8_BAR; PG8_MMA(0, 0, At, B0); PG8_MMA(0, 1, At, B1); PG8_BAR; PG8_SCHED;
            PG8_LDA(At, 1, 1); PG8_STAGE(PG8_SB(1, 0), b3, voffB); PG8_STAGE(PG8_SB(1, 1), b3 + hstep, voffB); PG8_STAGE(PG8_SA(1, 0), a3, voffA);
            PG8_WAIT_V(8); PG8_WAIT_L(0); PG8_BAR; PG8_MMA(1, 0, At, B0); PG8_MMA(1, 1, At, B1); PG8_BAR; PG8_SCHED;
            } else {
            PG8_LDB(B0, 0, 0); PG8_SCHED; PG8_LDA(At, 0, 0); PG8_STAGE(PG8_SA(1, 1), a1 + hstep, voffA);
            PG8_WAIT_L(8); PG8_BAR; PG8_WAIT_L(0); PG8_MMA(0, 0, At, B0); PG8_BAR; PG8_SCHED;
            PG8_LDB(B1, 0, 1); PG8_STAGE(PG8_SB(0, 0), b2, voffB);
            PG8_BAR; PG8_WAIT_L(0); PG8_MMA(0, 1, At, B1); PG8_BAR;
            PG8_LDA(At, 0, 1); PG8_STAGE(PG8_SA(0, 0), a2, voffA);
            PG8_BAR; PG8_WAIT_L(0); PG8_MMA(1, 0, At, B0); PG8_BAR; PG8_SCHED;
            PG8_STAGE(PG8_SB(0, 1), b2 + hstep, voffB);
            PG8_WAIT_V(6); PG8_BAR; PG8_MMA(1, 1, At, B1); PG8_BAR;
            PG8_LDB(B0, 1, 0); PG8_SCHED; PG8_LDA(At, 1, 0); PG8_STAGE(PG8_SA(0, 1), a2 + hstep, voffA);
            PG8_WAIT_L(8); PG8_BAR; PG8_WAIT_L(0); PG8_MMA(0, 0, At, B0); PG8_BAR; PG8_SCHED;
            PG8_LDB(B1, 1, 1); PG8_STAGE(PG8_SB(1, 0), b3, voffB);
            PG8_BAR; PG8_WAIT_L(0); PG8_MMA(0, 1, At, B1); PG8_BAR;
            PG8_LDA(At, 1, 1); PG8_STAGE(PG8_SA(1, 0), a3, voffA);
            PG8_BAR; PG8_WAIT_L(0); PG8_MMA(1, 0, At, B0); PG8_BAR; PG8_SCHED;
            PG8_STAGE(PG8_SB(1, 1), b3 + hstep, voffB);
            PG8_WAIT_V(6); PG8_BAR; PG8_MMA(1, 1, At, B1); PG8_BAR;
            }
        }
        if constexpr (ALIGN_EPI) { if (wr == 0) PG8_BAR; }
        if constexpr (!Epi::AFTER_DRAIN) { E(acc, cur, wr, wc, fr, fq); S.done(cur); }
        if (!has_next) break;
#pragma unroll
        for (int a = 0; a < 2; ++a)
#pragma unroll
            for (int b = 0; b < 2; ++b)
#pragma unroll
                for (int m = 0; m < 4; ++m)
#pragma unroll
                    for (int n = 0; n < 2; ++n) acc[a][b][m][n] = (f32x4){0.f, 0.f, 0.f, 0.f};
        cur = nxt; cA = nA; cB = nB; ++ui;
        if constexpr (ALIGN_EPI) { if (wr == 1) PG8_BAR; }
    }
    PG8_WAIT_V(0);
    if constexpr (!ALIGN_EPI) { if (wr == 0) PG8_BAR; }
    PG8_BAR;
#undef PG8_SA
#undef PG8_SB
#undef PG8_STAGE
#undef PG8_LDA
#undef PG8_LDB
#undef PG8_MMA
#undef PG8_WAIT_V
#undef PG8_WAIT_L
#undef PG8_BAR
#undef PG8_SCHED
}
}

#ifndef ZERO_MOE
#define ZERO_MOE 0
#endif
#ifndef ZERO_FFN
#define ZERO_FFN 0
#endif
#ifndef ZERO_A
#define ZERO_A 0
#endif
#ifndef ZERO_B
#define ZERO_B 0
#endif
#ifndef ZERO_C
#define ZERO_C 0
#endif
#ifndef ZERO_D
#define ZERO_D 0
#endif
constexpr int NWAVES = 8;
constexpr int NB = 16, SEQ = 2048, DM = 2048, M = NB * SEQ;
constexpr int NIN = 5328, NINP = 5376;
constexpr int C_QC = 0, C_KVC = 384, C_KPE = 640, C_RQ = 704, C_RK = 960, C_RV = 1216, C_RG = 1728, C_MZ = 2240, C_XBC = 2752, C_DT = 3776, C_HU = 3792;
constexpr int DFF = 5632, DFFE = 7168, NEXP = 8;
constexpr int CAP_ROWS = 2 * M + NEXP * 256, CAP_RB = CAP_ROWS / 256;
constexpr int MOE_CH = 3, MOE_CH_RB = CAP_RB / MOE_CH;
constexpr float ALPHA = 1.4142135623730951f;
constexpr int HY_OFF = 2055, HY_GLEN = 4112;

constexpr size_t al256(size_t x) { return (x + 255) / 256 * 256; }
constexpr size_t WS_CTL = 0, CTL_ZERO_BYTES = 1u << 20;
constexpr size_t SZ_WIN = (size_t)NINP * DM * 2, SZ_WUQ = (size_t)768 * 384 * 2, SZ_WUKV = (size_t)1024 * 256 * 2, SZ_WOUT = (size_t)DM * DM * 2;
constexpr size_t WS_WIN = CTL_ZERO_BYTES;
constexpr size_t WS_WUQ = WS_WIN + 2 * SZ_WIN;
constexpr size_t WS_WUKV = WS_WUQ + 2 * SZ_WUQ;
constexpr size_t WS_WOUT = WS_WUKV + 2 * SZ_WUKV;
constexpr size_t WS_WGU = WS_WOUT + 2 * SZ_WOUT;
constexpr size_t WS_WDN = WS_WGU + (size_t)2 * DFF * DM * 2;
constexpr size_t WS_HYG = WS_WDN + (size_t)DM * DFF * 2;
constexpr size_t WS_XB = al256(WS_HYG + (size_t)2 * 2 * 512 * HY_GLEN * 2);
constexpr size_t WS_RT = WS_XB + (size_t)M * DM * 2;
constexpr size_t WS_RTG = WS_RT + (size_t)M * 16;
constexpr size_t WS_SLOT = WS_RTG + (size_t)M * 8;
constexpr size_t WS_SLOTG = WS_SLOT + (size_t)CAP_ROWS * 4;
constexpr size_t WS_SCR = al256(WS_SLOTG + (size_t)CAP_ROWS * 4);
constexpr size_t WS_PROJ = WS_SCR;
constexpr size_t WS_DTF = WS_PROJ + (size_t)M * NINP * 2;
constexpr size_t WS_QN = WS_DTF + (size_t)M * 16 * 4;
constexpr size_t WS_KVN = WS_QN + (size_t)M * 384 * 2;
constexpr size_t WS_KPE = WS_KVN + (size_t)M * 256 * 2;
constexpr size_t WS_RQ = WS_KPE + (size_t)M * 64 * 2;
constexpr size_t WS_RK = WS_RQ + (size_t)M * 256 * 2;
constexpr size_t WS_XBC = WS_RK + (size_t)M * 256 * 2;
constexpr size_t WS_SSDP = WS_XBC + (size_t)M * 1024 * 2;
constexpr size_t WS_UT = WS_SSDP + (size_t)M * 8 * 16;
constexpr size_t WS_QB = WS_UT + (size_t)3 * 512 * M * 2;
constexpr size_t WS_KVB = WS_QB + (size_t)M * 768 * 2;
constexpr size_t WS_ATT = WS_KVB + (size_t)M * 1024 * 2;
constexpr size_t WS_YC = WS_ATT + (size_t)M * 512 * 2;
constexpr size_t WS_ZT = WS_YC + (size_t)M * 512 * 2;
constexpr size_t WS_MIX = WS_ZT + (size_t)512 * M * 2;
constexpr size_t WS_MIX_END = WS_MIX + (size_t)M * DM * 2;
constexpr size_t WS_HID = WS_SCR;
constexpr size_t WS_MGU = WS_SCR;
constexpr size_t WS_MDN = WS_MGU + (size_t)NEXP * 2 * DFFE * DM * 2;
constexpr size_t WS_XS = WS_MDN + (size_t)NEXP * DM * DFFE * 2;
constexpr size_t WS_HIDS = WS_XS + (size_t)CAP_ROWS * DM * 2;
constexpr size_t WS_Y0 = WS_HIDS + (size_t)MOE_CH_RB * 256 * DFFE * 2;
constexpr size_t WS_Y1 = WS_Y0 + (size_t)M * DM * 2;
constexpr size_t WS_END = WS_Y1 + (size_t)M * DM * 2;
static_assert(WS_MIX_END <= WS_END && WS_HID + (size_t)M * DFF * 2 <= WS_END, "d_ws map");
static_assert(WS_END <= 1942000000ull, "d_ws map exceeds the guaranteed workspace");
constexpr int CW_TMO = 0, CW_CODE = 1;
constexpr int CW_CNT = 64;
constexpr int CW_BAR = 4096;

constexpr int RING_OFF = 0, RING_BYTES = 131072;
constexpr int LDSCTL_OFF = RING_BYTES, MISC_OFF = LDSCTL_OFF + 320;
constexpr int LDS_BYTES = 147456;

#define GAS __attribute__((address_space(1)))
#define LAS __attribute__((address_space(3)))
typedef unsigned short bf16;
typedef unsigned v4u __attribute__((ext_vector_type(4)));
typedef unsigned v2u __attribute__((ext_vector_type(2)));
typedef float f32x4 __attribute__((ext_vector_type(4)));
typedef float f32x2 __attribute__((ext_vector_type(2)));
typedef float f32x16 __attribute__((ext_vector_type(16)));
typedef short bf16x8 __attribute__((ext_vector_type(8)));
typedef short s16x4 __attribute__((ext_vector_type(4)));
typedef GAS unsigned gu32;
#define RLX_AGENT __ATOMIC_RELAXED, __HIP_MEMORY_SCOPE_AGENT
#define LDS_WAIT() asm volatile("s_waitcnt lgkmcnt(0)" ::: "memory")
#define VM_WAIT() asm volatile("s_waitcnt vmcnt(0)" ::: "memory")
__device__ __forceinline__ unsigned f2bf(float f) { unsigned u = __builtin_bit_cast(unsigned, f); return (u + 0x7fffu + ((u >> 16) & 1u)) >> 16; }
__device__ __forceinline__ unsigned pk2(float lo, float hi) { return f2bf(lo) | (f2bf(hi) << 16); }
__device__ __forceinline__ float bf2f(unsigned b) { return __builtin_bit_cast(float, b << 16); }
__device__ __forceinline__ float bflo(unsigned w) { return __builtin_bit_cast(float, w << 16); }
__device__ __forceinline__ float bfhi(unsigned w) { return __builtin_bit_cast(float, w & 0xffff0000u); }
__device__ __forceinline__ float silu(float v) { return v / (1.0f + __expf(-v)); }
template <int K> __device__ __forceinline__ float swz_xor(float v) { return __builtin_bit_cast(float, __builtin_amdgcn_ds_swizzle(__builtin_bit_cast(int, v), (K << 10) | 0x1f)); }
__device__ __forceinline__ float half_sum(float v) { v += swz_xor<1>(v); v += swz_xor<2>(v); v += swz_xor<4>(v); v += swz_xor<8>(v); v += swz_xor<16>(v); return v; }
__device__ __forceinline__ float wave_sum(float v) { v = half_sum(v);
    auto rr = __builtin_amdgcn_permlane32_swap(__builtin_bit_cast(unsigned, v), __builtin_bit_cast(unsigned, v), false, false);
    const unsigned r0 = rr[0], r1 = rr[1];
    return __uint_as_float(r0) + __uint_as_float(r1); }

#define XB_TMO      128
#define XB_XCNT(j)  (256  + 64 * (j))
#define XB_XSUB(j)  (1280 + 64 * (j))
#define XB_XGEN(j)  (2304 + 64 * (j))
#define XB_TOP      3328
#define XB_TOPGEN   3392
#define XCD_BAR_WORDS 3456
#define XB_SPIN_CAP (1u << 18)
__device__ __forceinline__ unsigned xb_ld(unsigned* p)              { return __hip_atomic_load(p, __ATOMIC_RELAXED, __HIP_MEMORY_SCOPE_AGENT); }
__device__ __forceinline__ unsigned xb_add(unsigned* p, unsigned v) { return __hip_atomic_fetch_add(p, v, __ATOMIC_RELAXED, __HIP_MEMORY_SCOPE_AGENT); }
__device__ __forceinline__ unsigned xb_xcc_id() { return (unsigned)__builtin_amdgcn_s_getreg((3 << 11) | 20) & 0xFu; }
#define XB_SPIN(cond, bar) do { unsigned _sp = 0; while (cond) { __builtin_amdgcn_s_sleep(1); \
    if ((++_sp & 255u) == 0u) { if (xb_ld(&(bar)[XB_TMO])) break; if (_sp > XB_SPIN_CAP) { atomicAdd(&(bar)[XB_TMO], 1u); break; } } } } while (0)
struct XcdBarrier { unsigned* bar; unsigned x; volatile LAS unsigned* st; };
__device__ __forceinline__ XcdBarrier xcd_barrier_post(unsigned* bar, volatile LAS unsigned* st) {
    XcdBarrier b; b.bar = bar; b.x = xb_xcc_id(); b.st = st;
    if (threadIdx.x == 0) (void)xb_add(&bar[XB_XCNT(b.x)], 1u);
    return b;
}
__device__ __forceinline__ void xcd_barrier_complete(unsigned* bar, unsigned x, unsigned& nloc, unsigned& nx) {
    const unsigned G = gridDim.x * gridDim.y * gridDim.z;
    unsigned sum, cnt, mine, sp = 0u;
    for (;;) {
        sum = 0u; cnt = 0u; mine = 0u;
#pragma unroll
        for (unsigned j = 0; j < 16; ++j) { const unsigned c = xb_ld(&bar[XB_XCNT(j)]); sum += c; cnt += (c > 0u) ? 1u : 0u; mine = (j == x) ? c : mine; }
        if (sum == G) break;
        __builtin_amdgcn_s_sleep(1);
        if ((++sp & 255u) == 0u) { if (xb_ld(&bar[XB_TMO])) break; if (sp > XB_SPIN_CAP) { atomicAdd(&bar[XB_TMO], 1u); break; } }
    }
    nloc = mine > 0u ? mine : 1u; nx = cnt > 0u ? cnt : 1u;
}
__device__ __forceinline__ void xcd_barrier(const XcdBarrier& b) {
    asm volatile("s_waitcnt vmcnt(0)" ::: "memory");
    __syncthreads();
    if (threadIdx.x == 0) {
        unsigned* bar = b.bar;
        __builtin_amdgcn_s_waitcnt(0);
        unsigned nloc = b.st[0], nx = b.st[1];
        if (nloc == 0u) { xcd_barrier_complete(bar, b.x, nloc, nx); b.st[0] = nloc; b.st[1] = nx; }
        const unsigned old = xb_add(&bar[XB_XSUB(b.x)], 1u);
        const unsigned gen = old / nloc;
        if (old + 1u == (gen + 1u) * nloc) {
            __builtin_amdgcn_fence(__ATOMIC_RELEASE, "agent");
            asm volatile("s_waitcnt vmcnt(0)" ::: "memory");
            const unsigned og = xb_add(&bar[XB_TOP], 1u);
            const unsigned tg = og / nx;
            if (og + 1u == (tg + 1u) * nx) xb_add(&bar[XB_TOPGEN], 1u);
            else XB_SPIN(xb_ld(&bar[XB_TOPGEN]) == tg, bar);
            __builtin_amdgcn_fence(__ATOMIC_ACQUIRE, "agent");
            xb_add(&bar[XB_XGEN(b.x)], 1u);
            asm volatile("s_waitcnt vmcnt(0)" ::: "memory");
        } else {
            XB_SPIN(xb_ld(&bar[XB_XGEN(b.x)]) == gen, bar);
            __builtin_amdgcn_fence(__ATOMIC_ACQUIRE, "agent");
            asm volatile("s_waitcnt vmcnt(0)" ::: "memory");
        }
    }
    __syncthreads();
}

struct Args {
    const float* in[35]; float* out; unsigned char* ws; int ph_lo, ph_hi;
};
enum { I_X = 0, I_WIN, I_QNORM, I_WUQ, I_KVNORM, I_WUKV, I_OUTNORM, I_CONVW, I_CONVB, I_DTBIAS, I_ALOG, I_SSDD, I_SSDNORM, I_HYCW, I_HYCB, I_HYW1, I_HYB1, I_HYW2, I_HYB2, I_HYW3, I_HYFREQ, I_HYBIAS, I_HYNORM,
       I_WOUT, I_LN1G, I_LN1B, I_LN2G, I_LN2B, I_FFG, I_FFU, I_FFD, I_ROUTER, I_MOEG, I_MOEU, I_MOED };

typedef __attribute__((address_space(4))) const Args CArgs;
struct AP { const CArgs* p;
    __device__ __forceinline__ const float* in(int i) const { return p->in[i]; }
    __device__ __forceinline__ float* out() const { return p->out; }
    __device__ __forceinline__ unsigned char* ws() const { return p->ws; } };
__device__ __forceinline__ AP kargs() { const CArgs* p = (const CArgs*)__builtin_amdgcn_kernarg_segment_ptr(); asm volatile("" : "+s"(p)); AP a; a.p = p; return a; }

__device__ __forceinline__ void transpose_item(const float* W, int K, int N, int nblk, bf16* WT, int GR, int GS, int off, LAS float* scr, int item, int lane) {
    const int kb = item / nblk, nb = item % nblk, k0 = 64 * kb, n0 = 32 * nb;
    const int nr = n0 + (lane & 31); const bool ok = nr < N;
#pragma unroll 8
    for (int i = 0; i < 32; ++i) { const int kk = 2 * i + (lane >> 5); scr[kk * 33 + (lane & 31)] = ok ? W[(size_t)(k0 + kk) * N + nr] : 0.f; }
    LDS_WAIT(); asm volatile("" ::: "memory");
    const int c = lane & 7;
#pragma unroll
    for (int j = 0; j < 4; ++j) { const int nl = (lane >> 3) + 8 * j; const int n = n0 + nl; const LAS float* s = scr + (8 * c) * 33 + nl;
        v4u o; o.x = pk2(s[0 * 33], s[1 * 33]); o.y = pk2(s[2 * 33], s[3 * 33]); o.z = pk2(s[4 * 33], s[5 * 33]); o.w = pk2(s[6 * 33], s[7 * 33]);
        const int dest = (n / GR) * GS + (n % GR) + off;
        *(GAS v4u*)(WT + (size_t)dest * K + k0 + 8 * c) = o; }
    LDS_WAIT(); asm volatile("" ::: "memory");
}
struct TrJob { const float* W; int K, N, nblk; bf16* WT; int GR, GS, off; int items; };
__device__ __forceinline__ TrJob mk_job(const float* W, int K, int N, int Npad, bf16* WT, int GR, int GS, int off) { TrJob j; j.W = W; j.K = K; j.N = N; j.nblk = Npad / 32; j.WT = WT; j.GR = GR; j.GS = GS; j.off = off; j.items = (K / 64) * (Npad / 32); return j; }

__device__ __forceinline__ void hyena_filter_item(const AP& a, int layer, int pos, bf16* HYG, LAS float* scr, int lane) {
    const float* w1 = a.in(I_HYW1) + layer * 33 * 64; const float* b1 = a.in(I_HYB1) + layer * 64;
    const float* w2 = a.in(I_HYW2) + layer * 64 * 64; const float* b2 = a.in(I_HYB2) + layer * 64;
    const float* w3 = a.in(I_HYW3) + (size_t)layer * 64 * 2048; const float* fr = a.in(I_HYFREQ) + layer * 128;
    const float t = (float)pos / 2047.0f; const float ang = 6.283185307179586f * (float)pos / 2048.0f;
    if (lane < 33) { float z;
        if (lane == 0) z = t;
        else { const int k = (lane - 1) & 15; const float f = 1e-4f + (float)k * ((15.0f - 1e-4f) / 15.0f); z = (lane <= 16) ? cosf(f * ang) : -sinf(f * ang); }
        scr[lane] = z; }
    LDS_WAIT(); asm volatile("" ::: "memory");
    float s = b1[lane];
    for (int i = 0; i < 33; ++i) s += scr[i] * w1[i * 64 + lane];
    const float h1 = sinf(fr[lane] * s);
    scr[64 + lane] = h1;
    LDS_WAIT(); asm volatile("" ::: "memory");
    float s2 = b2[lane];
    for (int i = 0; i < 64; ++i) s2 += scr[64 + i] * w2[i * 64 + lane];
    const float h2 = sinf(fr[64 + lane] * s2);
    scr[128 + lane] = h2;
    LDS_WAIT(); asm volatile("" ::: "memory");
    for (int m = 0; m < 32; ++m) { const int col = lane + 64 * m; float v = 0.f;
        for (int i = 0; i < 64; ++i) v += scr[128 + i] * w3[(size_t)i * 2048 + col];
        const int o = col >> 10, dir = (col >> 9) & 1, c = col & 511;
        const float delta = fabsf(-3.0701134573253945f + (float)c * ((-15.350567286626973f + 3.0701134573253945f) / 511.0f));
        v *= expf(-t * delta);
        if (dir == 0 || pos > 0) { const int n = dir == 0 ? HY_OFF - pos : HY_OFF + pos;
            HYG[(((size_t)layer * 2 + o) * 512 + c) * HY_GLEN + n] = (bf16)f2bf(v); } }
    LDS_WAIT(); asm volatile("" ::: "memory");
}

__device__ __forceinline__ void ln_row(float* xrow, bf16* brow, const float* g, const float* b, int lane, f32x4 (&v)[8], const bf16* y0, const bf16* y1, float* orow) {
    const GAS f32x4* xr = (const GAS f32x4*)xrow + lane; float s = 0.f;
#pragma unroll
    for (int j = 0; j < 8; ++j) { v[j] = xr[64 * j];
        if (y0) { v2u a0 = *((const GAS v2u*)y0 + lane + 64 * j), a1 = *((const GAS v2u*)y1 + lane + 64 * j); if (ZERO_MOE) { a0.x = a0.y = a1.x = a1.y = 0u; }
            v[j].x = ALPHA * v[j].x + bflo(a0.x) + bflo(a1.x); v[j].y = ALPHA * v[j].y + bfhi(a0.x) + bfhi(a1.x); v[j].z = ALPHA * v[j].z + bflo(a0.y) + bflo(a1.y); v[j].w = ALPHA * v[j].w + bfhi(a0.y) + bfhi(a1.y); }
        s += (v[j].x + v[j].y) + (v[j].z + v[j].w); }
    const float mean = wave_sum(s) * (1.f / DM); float s2 = 0.f;
#pragma unroll
    for (int j = 0; j < 8; ++j) { v[j] = v[j] - mean; s2 += (v[j].x * v[j].x + v[j].y * v[j].y) + (v[j].z * v[j].z + v[j].w * v[j].w); }
    const float rstd = 1.f / sqrtf(wave_sum(s2) * (1.f / DM) + 1e-5f);
    GAS f32x4* xo = (GAS f32x4*)orow + lane;
#pragma unroll
    for (int j = 0; j < 8; ++j) { const f32x4 gg = *((const GAS f32x4*)g + lane + 64 * j), bb = *((const GAS f32x4*)b + lane + 64 * j);
        v[j] = v[j] * rstd * gg + bb; xo[64 * j] = v[j];
        if (brow) { v2u w; w.x = pk2(v[j].x, v[j].y); w.y = pk2(v[j].z, v[j].w); *((GAS v2u*)brow + lane + 64 * j) = w; } }
}

__device__ __forceinline__ void ld8bf(const bf16* p, float (&f)[8]) { const v4u w = *(const GAS v4u*)p; f[0] = bflo(w.x); f[1] = bfhi(w.x); f[2] = bflo(w.y); f[3] = bfhi(w.y); f[4] = bflo(w.z); f[5] = bfhi(w.z); f[6] = bflo(w.w); f[7] = bfhi(w.w); }
__device__ __forceinline__ void st8bf(bf16* p, const float (&f)[8]) { v4u w; w.x = pk2(f[0], f[1]); w.y = pk2(f[2], f[3]); w.z = pk2(f[4], f[5]); w.w = pk2(f[6], f[7]); *(GAS v4u*)p = w; }

__device__ __forceinline__ void prep_row(const AP& a, int layer, int row, int lane, unsigned char* ws) {
    const bf16* PROJ = (const bf16*)(ws + WS_PROJ); const bf16* pr = PROJ + (size_t)row * NINP;
    const int t = row & (SEQ - 1);
    { float f[8]; float ss = 0.f;
      if (lane < 48) { ld8bf(pr + C_QC + lane * 8, f);
#pragma unroll
          for (int j = 0; j < 8; ++j) ss += f[j] * f[j]; }
      const float rs = 1.0f / sqrtf(wave_sum(ss) * (1.f / 384.f) + 1e-6f);
      if (lane < 48) { const float* w = a.in(I_QNORM) + layer * 384 + lane * 8;
#pragma unroll
          for (int j = 0; j < 8; ++j) f[j] = f[j] * rs * w[j];
          st8bf((bf16*)(ws + WS_QN) + (size_t)row * 384 + lane * 8, f); } }
    { float f[8]; float ss = 0.f;
      if (lane < 32) { ld8bf(pr + C_KVC + lane * 8, f);
#pragma unroll
          for (int j = 0; j < 8; ++j) ss += f[j] * f[j]; }
      const float rs = 1.0f / sqrtf(wave_sum(ss) * (1.f / 256.f) + 1e-6f);
      if (lane < 32) { const float* w = a.in(I_KVNORM) + layer * 256 + lane * 8;
#pragma unroll
          for (int j = 0; j < 8; ++j) f[j] = f[j] * rs * w[j];
          st8bf((bf16*)(ws + WS_KVN) + (size_t)row * 256 + lane * 8, f); } }
    { const int i = lane & 31, gsel = lane >> 5;
      const float inv = exp2f(-(float)i * (13.287712379549449f / 32.0f));
      float sn, cs; sincosf((float)t * inv, &sn, &cs);
#pragma unroll
      for (int gg = 0; gg < 5; ++gg) { const int g = 2 * gg + gsel;
          if (g < 9) { int src; bf16* dst; float sc = 1.f;
              if (g == 0) { src = C_KPE; dst = (bf16*)(ws + WS_KPE) + (size_t)row * 64; }
              else if (g < 5) { src = C_RQ + (g - 1) * 64; dst = (bf16*)(ws + WS_RQ) + (size_t)row * 256 + (g - 1) * 64; }
              else { src = C_RK + (g - 5) * 64; dst = (bf16*)(ws + WS_RK) + (size_t)row * 256 + (g - 5) * 64; sc = 0.125f; }
              const float x1 = bf2f(pr[src + i]), x2 = bf2f(pr[src + 32 + i]);
              dst[i] = (bf16)f2bf((x1 * cs - x2 * sn) * sc); dst[32 + i] = (bf16)f2bf((x2 * cs + x1 * sn) * sc); } } }
    { const float* cw = a.in(I_CONVW) + layer * 5 * 1024; const float* cb = a.in(I_CONVB) + layer * 1024;
#pragma unroll
      for (int h = 0; h < 2; ++h) { const int c0 = h * 512 + lane * 8; float acc[8];
#pragma unroll
          for (int j = 0; j < 8; ++j) acc[j] = cb[c0 + j];
#pragma unroll
          for (int k = 0; k < 5; ++k) { const int tt = t + k - 2;
              if (tt >= 0 && tt < SEQ) { float f[8]; ld8bf(pr + (long)(k - 2) * NINP + C_XBC + c0, f);
#pragma unroll
                  for (int j = 0; j < 8; ++j) acc[j] += cw[k * 1024 + c0 + j] * f[j]; } }
#pragma unroll
          for (int j = 0; j < 8; ++j) acc[j] = silu(acc[j]);
          st8bf((bf16*)(ws + WS_XBC) + (size_t)row * 1024 + c0, acc); } }
}
__device__ __forceinline__ void prep_scan(const AP& a, int layer, int item, int lane, unsigned char* ws, LAS float* scr) {
    const int b = item >> 4, dir = (item >> 3) & 1, hh = item & 7;
    const float* DTF = (const float*)(ws + WS_DTF); float* SSDP = (float*)(ws + WS_SSDP);
    const float bias = a.in(I_DTBIAS)[layer * 16 + dir * 8 + hh]; const float av = -expf(a.in(I_ALOG)[layer * 16 + dir * 8 + hh]);
    float dt[32]; float tot = 0.f;
#pragma unroll
    for (int j = 0; j < 32; ++j) { const int row = b * SEQ + lane * 32 + j; const float x = DTF[(size_t)row * 16 + dir * 8 + hh] + bias;
        dt[j] = x > 20.f ? x : log1pf(expf(x)); tot += dt[j] * av; }
    scr[lane] = tot; LDS_WAIT(); asm volatile("" ::: "memory");
    float excl = 0.f, T = 0.f;
#pragma unroll 2
    for (int l = 0; l < 64; ++l) { const float v = scr[l]; T += v; excl += (l < lane) ? v : 0.f; }
    LDS_WAIT(); asm volatile("" ::: "memory");
    float run = excl;
#pragma unroll
    for (int j = 0; j < 32; ++j) { const int row = b * SEQ + lane * 32 + j; const float la = dt[j] * av; float c;
        if (dir == 0) { run += la; c = run; } else { c = T - run; run += la; }
        f32x2 o; o.x = c * 1.4426950408889634f; o.y = log2f(dt[j]) - o.x;
        *(GAS f32x2*)(SSDP + ((size_t)row * 8 + hh) * 4 + dir * 2) = o; }
}
__device__ __forceinline__ void prep_hyconv(const AP& a, int layer, int item, int lane, unsigned char* ws) {
    const int cg = item % 24, tt = (item / 24) & 31, b = item / (24 * 32);
    const int ch = cg * 64 + lane, part = ch >> 9, c = ch & 511, t0 = tt * 64;
    const bf16* PROJ = (const bf16*)(ws + WS_PROJ); const bf16* col = PROJ + (size_t)(b * SEQ) * NINP + C_HU + ch;
    const float* cw = a.in(I_HYCW) + layer * 3 * 1536; const float w0 = cw[ch], w1 = cw[1536 + ch], w2 = cw[3072 + ch], bs = a.in(I_HYCB)[layer * 1536 + ch];
    float xm = (t0 > 0) ? bf2f(col[(size_t)(t0 - 1) * NINP]) : 0.f, x0 = bf2f(col[(size_t)t0 * NINP]);
    bf16* dst = (bf16*)(ws + WS_UT) + (((size_t)part * 512 + c) * NB + b) * SEQ + t0;
#pragma unroll
    for (int q = 0; q < 8; ++q) { float u[8];
#pragma unroll
        for (int j = 0; j < 8; ++j) { const int t = t0 + q * 8 + j; const float xp = (t + 1 < SEQ) ? bf2f(col[(size_t)(t + 1) * NINP]) : 0.f;
            u[j] = bs + w0 * xm + w1 * x0 + w2 * xp; xm = x0; x0 = xp; }
        st8bf(dst + q * 8, u); }
}

__device__ __forceinline__ void post_row(const AP& a, int layer, int row, int lane, unsigned char* ws) {
    bf16* MIX = (bf16*)(ws + WS_MIX) + (size_t)row * DM;
    { float f[8]; ld8bf((const bf16*)(ws + WS_ATT) + (size_t)row * 512 + lane * 8, f); float ss = 0.f;
#pragma unroll
      for (int j = 0; j < 8; ++j) ss += f[j] * f[j];
      const float rs = 1.0f / sqrtf(wave_sum(ss) * (1.f / 512.f) + 1e-6f); const float* w = a.in(I_OUTNORM) + layer * 512 + lane * 8;
#pragma unroll
      for (int j = 0; j < 8; ++j) f[j] = ZERO_A ? 0.f : f[j] * rs * w[j];
      st8bf(MIX + lane * 8, f); }
    { float f[8], z[8]; ld8bf((const bf16*)(ws + WS_YC) + (size_t)row * 512 + lane * 8, f); ld8bf((const bf16*)(ws + WS_PROJ) + (size_t)row * NINP + C_MZ + lane * 8, z); float ss = 0.f;
#pragma unroll
      for (int j = 0; j < 8; ++j) { f[j] = f[j] * silu(z[j]); ss += f[j] * f[j]; }
      const float rs = 1.0f / sqrtf(wave_sum(ss) * (1.f / 512.f) + 1e-6f); const float* w = a.in(I_SSDNORM) + layer * 512 + lane * 8;
#pragma unroll
      for (int j = 0; j < 8; ++j) f[j] = ZERO_C ? 0.f : f[j] * rs * w[j];
      st8bf(MIX + 1024 + lane * 8, f); }
}
__device__ __forceinline__ void post_hy(const AP& a, int layer, int item, int lane, unsigned char* ws, LAS bf16* scr) {
    const int b = item >> 5, t0 = (item & 31) * 64;
    const bf16* ZT = (const bf16*)(ws + WS_ZT) + (size_t)b * SEQ + t0 + lane; const float* w = a.in(I_HYNORM) + layer * 512;
    float ss = 0.f;
#pragma unroll 8
    for (int c = 0; c < 512; ++c) { const float v = bf2f(ZT[(size_t)c * M]); ss += v * v; }
    const float rs = 1.0f / sqrtf(ss * (1.f / 512.f) + 1e-6f);
    for (int cg = 0; cg < 8; ++cg) {
#pragma unroll 8
        for (int j = 0; j < 64; ++j) { const int c = cg * 64 + j; scr[lane * 72 + j] = (bf16)f2bf(ZERO_D ? 0.f : bf2f(ZT[(size_t)c * M]) * rs * w[c]); }
        LDS_WAIT(); asm volatile("" ::: "memory");
#pragma unroll
        for (int i = 0; i < 8; ++i) { const int tl = (lane >> 3) + 8 * i, c8 = lane & 7; const v4u v = *(const LAS v4u*)(scr + tl * 72 + c8 * 8);
            *(GAS v4u*)((bf16*)(ws + WS_MIX) + (size_t)(b * SEQ + t0 + tl) * DM + 1536 + cg * 64 + c8 * 8) = v; }
        LDS_WAIT(); asm volatile("" ::: "memory");
    }
}

namespace mixb {
#define SBAR() __builtin_amdgcn_sched_barrier(0)
__device__ __forceinline__ int crow(int r, int hi) { return (r & 3) + 8 * (r >> 2) + 4 * hi; }
__device__ __forceinline__ unsigned cvtpk(float lo, float hi) { unsigned r; asm volatile("v_cvt_pk_bf16_f32 %0, %1, %2" : "=v"(r) : "v"(lo), "v"(hi)); return r; }
__device__ __forceinline__ int v_st(int k, int c) { const int kk = (k & ~0xC) | ((k & 4) << 1) | ((k & 8) >> 1); return ((kk >> 3) * 4 + (c >> 5)) * 512 + ((kk & 7) * 32 + (c & 31)) * 2; }
__device__ __forceinline__ int v_rd_base(int lane) { return ((lane & 3) << 3) | (((lane >> 2) & 3) << 6) | (((lane >> 4) & 1) << 5) | (((lane >> 5) & 1) << 8); }
constexpr int v_rd_off(int d0, int ks, int half) { return d0 * 512 + ks * 4096 + half * 2048; }
template <int OFF> __device__ __forceinline__ s16x4 tr_read(int vb) { s16x4 r; asm volatile("ds_read_b64_tr_b16 %0, %1 offset:%2" : "=&v"(r) : "v"(vb), "i"(OFF) : "memory"); return r; }
template <int D0> __device__ __forceinline__ void pv_one(f32x16& od, int vb, bf16x8 pa0, bf16x8 pa1, bf16x8 pa2, bf16x8 pa3) {
    const s16x4 l0 = tr_read<v_rd_off(D0, 0, 0)>(vb), h0 = tr_read<v_rd_off(D0, 0, 1)>(vb), l1 = tr_read<v_rd_off(D0, 1, 0)>(vb), h1 = tr_read<v_rd_off(D0, 1, 1)>(vb);
    const s16x4 l2 = tr_read<v_rd_off(D0, 2, 0)>(vb), h2 = tr_read<v_rd_off(D0, 2, 1)>(vb), l3 = tr_read<v_rd_off(D0, 3, 0)>(vb), h3 = tr_read<v_rd_off(D0, 3, 1)>(vb);
    asm volatile("s_waitcnt lgkmcnt(0)" ::: "memory"); SBAR();
#define PKV(L, H) (bf16x8){L[0], L[1], L[2], L[3], H[0], H[1], H[2], H[3]}
    od = __builtin_amdgcn_mfma_f32_32x32x16_bf16(pa0, PKV(l0, h0), od, 0, 0, 0);
    od = __builtin_amdgcn_mfma_f32_32x32x16_bf16(pa1, PKV(l1, h1), od, 0, 0, 0);
    od = __builtin_amdgcn_mfma_f32_32x32x16_bf16(pa2, PKV(l2, h2), od, 0, 0, 0);
    od = __builtin_amdgcn_mfma_f32_32x32x16_bf16(pa3, PKV(l3, h3), od, 0, 0, 0);
#undef PKV
}
__device__ __forceinline__ void fast_sincos(float x, float& s, float& c) { float r = x * 0.15915494309189535f; r = r - floorf(r); s = __builtin_amdgcn_sinf(r); c = __builtin_amdgcn_cosf(r); }

struct MixP {
    const bf16* q; int ldq;
    const bf16* k0; int ldk0; const bf16* k1; int ldk1;
    const bf16* v; int ldv;
    bf16* o; int ldo;
    float lf, lb;
    const float* ssdp;
    const bf16* aux; int ldaux; float dh;
};
constexpr int V_BYTES = 16384, V_OFF = 0, K_OFF = 2 * V_BYTES;
template <int DQK> struct KL { static constexpr int PITCH = DQK * 2, BYTES = 64 * PITCH, WK_OFF = K_OFF + 2 * BYTES, SCR_OFF = WK_OFF + 1024, END = SCR_OFF + NWAVES * 256; };

template <int MODE, int DQK, int DV>
__device__ __forceinline__ void mix_unit(const MixP& P, int q0, LAS unsigned char* lds, int tid) {
    typedef KL<DQK> L;
    constexpr int ND = DQK / 16, NV = DV / 32, CPR = DQK / 8, KCH = 64 * CPR / 512, VPR = DV / 8, VCH = (64 * VPR + 511) / 512;
    constexpr float SCALE = 0.07216878364870322f;
    constexpr float C = SCALE * 1.4426950408889634f, THR = 8.f;
    asm volatile("" : "+v"(tid));
    const int wid = tid >> 6, lane = tid & 63, r32 = lane & 31, hi = lane >> 5;
    const int qrow = q0 + wid * 32 + r32;
    LAS unsigned char* Vl = lds + V_OFF; LAS unsigned char* Kl = lds + K_OFF;
    LAS float* wsc = (LAS float*)(lds + L::SCR_OFF) + wid * 64; LAS float* li_l = wsc; LAS float* al_l = wsc + 32;
    LAS f32x2* wk_l = (LAS f32x2*)(lds + L::WK_OFF);
    bf16x8 qr[ND];
    { const bf16* Qw = P.q + (long)qrow * P.ldq + hi * 8;
#pragma unroll
      for (int d0 = 0; d0 < ND; ++d0) qr[d0] = *(const GAS bf16x8*)(Qw + d0 * 16); }
    if constexpr (MODE == 0) {
#pragma unroll
        for (int dd = 0; dd < 2; ++dd)
#pragma unroll
            for (int j = 0; j < 8; ++j) { const int i = dd * 16 + hi * 8 + j; const float inv = exp2f(-(float)i * (13.287712379549449f / 32.0f)); float sn, cs; fast_sincos((float)qrow * inv, sn, cs);
                const float x1 = bf2f((unsigned short)qr[8 + dd][j]), x2 = bf2f((unsigned short)qr[10 + dd][j]);
                qr[8 + dd][j] = (short)f2bf(x1 * cs - x2 * sn); qr[10 + dd][j] = (short)f2bf(x2 * cs + x1 * sn); }
    }
    float cf_i = 0.f, rb_i = 0.f;
    if constexpr (MODE == 2) { const f32x4 w = *(const GAS f32x4*)(P.ssdp + (size_t)qrow * 32); cf_i = w.x; rb_i = w.z; }
    bf16x8 ks[KCH], vs[VCH]; f32x4 wkreg = {0.f, 0.f, 0.f, 0.f};
#define MX_SLOAD(kr0) do { \
    _Pragma("unroll") for (int i = 0; i < KCH; ++i) { const int cid = tid + 512 * i, row = cid / CPR, c8 = cid % CPR; \
        const bf16* src = (MODE == 0 && c8 >= 16) ? P.k1 + (long)((kr0) + row) * P.ldk1 + (c8 - 16) * 8 : P.k0 + (long)((kr0) + row) * P.ldk0 + c8 * 8; \
        ks[i] = *(const GAS bf16x8*)src; } \
    _Pragma("unroll") for (int i = 0; i < VCH; ++i) { const int cid = tid + 512 * i, row = cid / VPR, c8 = cid % VPR; \
        if (VCH * 512 == 64 * VPR || cid < 64 * VPR) vs[i] = *(const GAS bf16x8*)(P.v + (long)((kr0) + row) * P.ldv + c8 * 8); } \
    if (MODE == 2) { if (tid < 64) wkreg = *(const GAS f32x4*)(P.ssdp + (size_t)((kr0) + tid) * 32); } } while (0)
#define MX_SWRITE(b) do { \
    _Pragma("unroll") for (int i = 0; i < KCH; ++i) { const int cid = tid + 512 * i, row = cid / CPR, c8 = cid % CPR; \
        *(LAS bf16x8*)(Kl + (b) * L::BYTES + row * L::PITCH + ((c8 * 16) ^ ((row & 7) << 4))) = ks[i]; } \
    _Pragma("unroll") for (int i = 0; i < VCH; ++i) { const int cid = tid + 512 * i, row = cid / VPR, c8 = cid % VPR; \
        if (VCH * 512 == 64 * VPR || cid < 64 * VPR) *(LAS bf16x8*)(Vl + (b) * V_BYTES + v_st(row, c8 * 8)) = vs[i]; } \
    if (MODE == 2) { if (tid < 64) wk_l[(b) * 64 + tid] = (f32x2){wkreg.y, wkreg.w}; } } while (0)
    float m_reg = -1e30f, l_reg = 0.f; f32x16 o[NV];
#pragma unroll
    for (int d = 0; d < NV; ++d) o[d] = f32x16{};
    const int vb0 = (int)(uintptr_t)(Vl) + v_rd_base(lane);
    constexpr int NT = SEQ / 64;
    MX_SLOAD(0); VM_WAIT(); MX_SWRITE(0); __syncthreads();
    for (int j = 0; j < NT; ++j) {
        const int buf = j & 1; const int kr0 = j * 64;
        if (j + 1 < NT) MX_SLOAD(kr0 + 64);
        SBAR();
        f32x16 p0 = f32x16{}, p1 = f32x16{};
        { LAS unsigned char* Kb = Kl + buf * L::BYTES;
#pragma unroll
          for (int dg = 0; dg < ND / 4; ++dg) { bf16x8 kb0[4], kb1[4];
#pragma unroll
              for (int dd = 0; dd < 4; ++dd) { const int cb = ((dg * 4 + dd) * 16 + hi * 8) * 2;
                  kb0[dd] = *(const LAS bf16x8*)(Kb + r32 * L::PITCH + (cb ^ ((r32 & 7) << 4)));
                  kb1[dd] = *(const LAS bf16x8*)(Kb + (32 + r32) * L::PITCH + (cb ^ ((r32 & 7) << 4))); }
              LDS_WAIT(); SBAR();
#pragma unroll
              for (int dd = 0; dd < 4; ++dd) { p0 = __builtin_amdgcn_mfma_f32_32x32x16_bf16(kb0[dd], qr[dg * 4 + dd], p0, 0, 0, 0);
                  p1 = __builtin_amdgcn_mfma_f32_32x32x16_bf16(kb1[dd], qr[dg * 4 + dd], p1, 0, 0, 0); }
              SBAR(); } }
        SBAR();
        if constexpr (MODE == 0) {
            float pmax = p0[0];
#pragma unroll
            for (int r = 1; r < 16; ++r) pmax = fmaxf(pmax, p0[r]);
#pragma unroll
            for (int r = 0; r < 16; ++r) pmax = fmaxf(pmax, p1[r]);
            { auto rr = __builtin_amdgcn_permlane32_swap(__float_as_uint(pmax), __float_as_uint(pmax), false, false); pmax = fmaxf(__uint_as_float(rr[0]), __uint_as_float(rr[1])); }
            float mn, alpha;
            if (__all(pmax - m_reg <= THR / SCALE)) { mn = m_reg; alpha = 1.f; }
            else { mn = fmaxf(m_reg, pmax); alpha = __builtin_amdgcn_exp2f((m_reg - mn) * C); m_reg = mn; }
            const float mnC = -mn * C;
#pragma unroll
            for (int r = 0; r < 16; ++r) { p0[r] = __builtin_amdgcn_exp2f(fmaf(p0[r], C, mnC)); p1[r] = __builtin_amdgcn_exp2f(fmaf(p1[r], C, mnC)); }
            if (__any(alpha < 1.f)) { if (hi == 0) al_l[r32] = alpha; LDS_WAIT();
#pragma unroll
                for (int r = 0; r < 16; ++r) { const float av = al_l[crow(r, hi)];
#pragma unroll
                    for (int d = 0; d < NV; ++d) o[d][r] *= av; } }
            float ps = 0.f;
#pragma unroll
            for (int r = 0; r < 16; ++r) ps += p0[r] + p1[r];
            { auto rr = __builtin_amdgcn_permlane32_swap(__float_as_uint(ps), __float_as_uint(ps), false, false); ps = __uint_as_float(rr[0]) + __uint_as_float(rr[1]); }
            l_reg = l_reg * alpha + ps;
        } else if constexpr (MODE == 1) {
#pragma unroll
            for (int r = 0; r < 16; ++r) { const int k0 = kr0 + crow(r, hi), k1 = k0 + 32;
                const float e0 = (k0 <= qrow) ? (float)(qrow - k0) * P.lf : (float)(k0 - qrow) * P.lb;
                const float e1 = (k1 <= qrow) ? (float)(qrow - k1) * P.lf : (float)(k1 - qrow) * P.lb;
                p0[r] *= __builtin_amdgcn_exp2f(e0); p1[r] *= __builtin_amdgcn_exp2f(e1); }
        } else {
#pragma unroll
            for (int r = 0; r < 16; ++r) { const int kk = crow(r, hi); const f32x2 w0 = wk_l[buf * 64 + kk], w1 = wk_l[buf * 64 + 32 + kk];
                const int k0 = kr0 + kk, k1 = k0 + 32;
                const float e0 = (k0 <= qrow) ? cf_i + w0.x : rb_i + w0.y;
                const float e1 = (k1 <= qrow) ? cf_i + w1.x : rb_i + w1.y;
                p0[r] *= __builtin_amdgcn_exp2f(e0); p1[r] *= __builtin_amdgcn_exp2f(e1); }
        }
        SBAR();
        bf16x8 pa0, pa1, pa2, pa3;
#define MX_PK4(PP, BASE, OUT) do { const unsigned a0 = cvtpk(PP[BASE + 0], PP[BASE + 1]), a1 = cvtpk(PP[BASE + 2], PP[BASE + 3]); \
    const unsigned b0 = cvtpk(PP[BASE + 4], PP[BASE + 5]), b1 = cvtpk(PP[BASE + 6], PP[BASE + 7]); \
    auto r0 = __builtin_amdgcn_permlane32_swap(a0, b0, false, false); auto r1 = __builtin_amdgcn_permlane32_swap(a1, b1, false, false); \
    v4u w = {r0[0], r1[0], r0[1], r1[1]}; OUT = __builtin_bit_cast(bf16x8, w); } while (0)
        MX_PK4(p0, 0, pa0); MX_PK4(p0, 8, pa1); MX_PK4(p1, 0, pa2); MX_PK4(p1, 8, pa3);
#undef MX_PK4
        SBAR();
        { const int vb = vb0 + buf * V_BYTES;
          pv_one<0>(o[0], vb, pa0, pa1, pa2, pa3); pv_one<1>(o[1], vb, pa0, pa1, pa2, pa3);
          if constexpr (NV == 4) { pv_one<2>(o[2], vb, pa0, pa1, pa2, pa3); pv_one<3>(o[3], vb, pa0, pa1, pa2, pa3); } }
        SBAR();
        if (j + 1 < NT) { VM_WAIT(); MX_SWRITE(buf ^ 1); }
        __syncthreads();
    }
#undef MX_SLOAD
#undef MX_SWRITE
    const int orow0 = q0 + wid * 32;
    if constexpr (MODE == 0) {
        if (hi == 0) li_l[r32] = l_reg; LDS_WAIT();
#pragma unroll
        for (int r = 0; r < 16; ++r) { const int rr = crow(r, hi); const float rl = __builtin_amdgcn_rcpf(li_l[rr]);
#pragma unroll
            for (int d0 = 0; d0 < NV; ++d0) P.o[(long)(orow0 + rr) * P.ldo + d0 * 32 + r32] = (bf16)f2bf(o[d0][r] * rl); }
    } else if constexpr (MODE == 1) {
#pragma unroll
        for (int r = 0; r < 16; ++r) { const int rr = crow(r, hi);
            float s = 0.f;
#pragma unroll
            for (int d0 = 0; d0 < NV; ++d0) s += o[d0][r];
            s = half_sum(s);
            const float mean = s * (1.f / 128.f); float qv = 0.f;
#pragma unroll
            for (int d0 = 0; d0 < NV; ++d0) { const float dlt = o[d0][r] - mean; qv += dlt * dlt; }
            qv = half_sum(qv);
            const float rs = 1.0f / sqrtf(qv * (1.f / 128.f) + 1e-6f);
#pragma unroll
            for (int d0 = 0; d0 < NV; ++d0) { const float gt = bf2f(P.aux[(long)(orow0 + rr) * P.ldaux + d0 * 32 + r32]);
                P.o[(long)(orow0 + rr) * P.ldo + d0 * 32 + r32] = (bf16)f2bf(ZERO_B ? 0.f : (o[d0][r] - mean) * rs * silu(gt)); } }
    } else {
#pragma unroll
        for (int r = 0; r < 16; ++r) { const int rr = crow(r, hi);
#pragma unroll
            for (int d0 = 0; d0 < NV; ++d0) { const float xv = bf2f(P.aux[(long)(orow0 + rr) * P.ldaux + d0 * 32 + r32]);
                P.o[(long)(orow0 + rr) * P.ldo + d0 * 32 + r32] = (bf16)f2bf(o[d0][r] + xv * P.dh); } }
    }
    __syncthreads();
}
#undef SBAR
}

namespace hyb {
constexpr int U_PITCH = 4112, U_BYTES = 16 * U_PITCH, FC_OFF = U_BYTES, FC_PITCH = 8256;
typedef float f32x4v __attribute__((ext_vector_type(4)));
__device__ __forceinline__ void hyena_unit(const AP& a, int layer, int c, unsigned char* ws, LAS unsigned char* lds, int tid) {
    asm volatile("" : "+v"(tid));
    const int wid = tid >> 6, lane = tid & 63, fr = lane & 15, fq = lane >> 4;
    const bf16* UT = (const bf16*)(ws + WS_UT); bf16* ZT = (bf16*)(ws + WS_ZT);
    LAS unsigned char* Ul = lds; LAS unsigned char* FC = lds + FC_OFF;
    const int ksh = (3 - fr) & 3;
    for (int o = 0; o < 2; ++o) {
        const bf16* G = (const bf16*)(ws + WS_HYG) + (((size_t)layer * 2 + o) * 512 + c) * HY_GLEN;
        for (int idx = tid; idx < 4104; idx += 512) {
#pragma unroll
            for (int k = 0; k < 4; ++k) *(LAS bf16*)(FC + k * FC_PITCH + idx * 2) = G[idx + k]; }
        if (o == 0) {
#pragma unroll
            for (int i = 0; i < 8; ++i) { const int id = tid + 512 * i, b = id >> 8, t8 = id & 255;
                *(LAS v4u*)(Ul + b * U_PITCH + t8 * 16) = *(const GAS v4u*)(UT + ((size_t)c * NB + b) * SEQ + t8 * 8); } }
        __syncthreads();
        f32x4v acc[16];
#pragma unroll
        for (int i = 0; i < 16; ++i) acc[i] = (f32x4v){0.f, 0.f, 0.f, 0.f};
        for (int kb = 0; kb < 8; ++kb) {
            bf16x8 bfr[8];
#pragma unroll
            for (int kl = 0; kl < 8; ++kl) bfr[kl] = *(const LAS bf16x8*)(Ul + fr * U_PITCH + ((kb * 8 + kl) * 32 + fq * 8) * 2);
            const int n0 = HY_OFF - 16 * (16 * wid - 16 * kb + 15) - fr + 8 * fq;
            const LAS unsigned char* ab = FC + ksh * FC_PITCH + (n0 - ksh) * 2;
#pragma unroll
            for (int ddrel = -14; ddrel <= 15; ++ddrel) {
                const v2u lo = *(const LAS v2u*)(ab + (15 - ddrel) * 32), hi2 = *(const LAS v2u*)(ab + (15 - ddrel) * 32 + 8);
                const v4u w = {lo.x, lo.y, hi2.x, hi2.y}; const bf16x8 af = __builtin_bit_cast(bf16x8, w);
#pragma unroll
                for (int kl = 0; kl < 8; ++kl) { const int al = ddrel + 2 * kl; if (al >= 0 && al < 16) acc[al] = __builtin_amdgcn_mfma_f32_16x16x32_bf16(af, bfr[kl], acc[al], 0, 0, 0); }
            }
        }
        __syncthreads();
        const float bias = a.in(I_HYBIAS)[(layer * 2 + o) * 512 + c];
        const bf16* X = UT + (((size_t)(1 + o) * 512 + c) * NB + fr) * SEQ;
#pragma unroll
        for (int al = 0; al < 16; ++al) { const int t = 16 * (16 * wid + al) + 4 * fq;
            const v2u uu = *(const LAS v2u*)(Ul + fr * U_PITCH + t * 2); const v2u xx = *(const GAS v2u*)(X + t);
            const float r0 = bflo(xx.x) * (acc[al][0] + bflo(uu.x) * bias), r1 = bfhi(xx.x) * (acc[al][1] + bfhi(uu.x) * bias);
            const float r2 = bflo(xx.y) * (acc[al][2] + bflo(uu.y) * bias), r3 = bfhi(xx.y) * (acc[al][3] + bfhi(uu.y) * bias);
            v2u z; z.x = pk2(r0, r1); z.y = pk2(r2, r3);
            if (o == 0) *(LAS v2u*)(Ul + fr * U_PITCH + t * 2) = z;
            else *(GAS v2u*)(ZT + ((size_t)c * NB + fr) * SEQ + t) = z; }
        __syncthreads();
    }
}
}

constexpr int N_PHASES = 26;
#ifndef MK_CUTS
#define MK_CUTS 0
#endif
#ifndef MOE_CHECK
#define MOE_CHECK 0
#endif
#ifndef ONLYKIND
#define ONLYKIND -1
#endif
#define KSEL(kind) (ONLYKIND < 0 || ONLYKIND == (kind))
#define IN(k) (LO <= (k) && (k) < HI)
#define INK(k, kind) (KSEL(kind) && LO <= (k) && (k) < HI)
struct Ids { int wave0, G0, bx0, vcu0; };
#define PH_LOCALS int wave = ids.wave0, G = ids.G0, bx = ids.bx0, vcu = ids.vcu0; asm volatile("" : "+s"(wave), "+s"(G), "+s"(bx), "+s"(vcu)); \
    int tid; asm volatile("v_mbcnt_lo_u32_b32 %0, -1, 0\n\tv_mbcnt_hi_u32_b32 %0, -1, %0" : "=v"(tid)); tid += wave * 64; \
    const int lane = tid & 63, gw = wave * G + vcu, NGW = G * NWAVES; LAS float* wscr = (LAS float*)(lds + RING_OFF + wave * 16384); (void)lane; (void)gw; (void)NGW; (void)wscr; (void)bx; \
    const AP args = kargs(); unsigned char* ws = args.ws(); float* XRES = args.out(); bf16* XB = (bf16*)(ws + WS_XB); gu32* ctl = (gu32*)(ws + WS_CTL); (void)XRES; (void)XB; (void)ctl;
#define SEAM(k) do { if constexpr (IN(k) && IN((k) + 1)) { XcdBarrier bb_ = bar; asm volatile("" : "+s"(bb_.bar), "+s"(bb_.x)); xcd_barrier(bb_); } } while (0)

template <int LAYER, int LO, int HI>
__device__ __forceinline__ void layer_phases(LAS unsigned char* lds, const XcdBarrier& bar, const Ids& ids) {
    constexpr int layer = LAYER, pb = 1 + LAYER * 10;
    if constexpr (INK(pb + 0, 1)) { PH_LOCALS
        pg8::Gemm g{XB, (const bf16*)(ws + WS_WIN + layer * SZ_WIN), M, NINP, DM}; pg8::StaticOrder S; S.init(M, NINP, G, bx);
        pg8::EpiBf16 E{(bf16*)(ws + WS_PROJ), NINP, (float*)(ws + WS_DTF), C_DT};
        pg8::gemm_phase<pg8::EpiBf16, pg8::StaticOrder, true, true>(lds + RING_OFF, g, S, E, tid);
    }
    SEAM(pb + 0);
    if constexpr (INK(pb + 1, 2)) { PH_LOCALS
        for (int m = gw; m < M; m += NGW) prep_row(args, layer, m, lane, ws);
        for (int it = gw; it < 256; it += NGW) prep_scan(args, layer, it, lane, ws, wscr);
        for (int it = gw; it < NB * 32 * 24; it += NGW) prep_hyconv(args, layer, it, lane, ws);
    }
    SEAM(pb + 1);
    if constexpr (INK(pb + 2, 3)) {
        { PH_LOCALS pg8::Gemm g{(const bf16*)(ws + WS_QN), (const bf16*)(ws + WS_WUQ + layer * SZ_WUQ), M, 768, 384}; pg8::StaticOrder S; S.init(M, 768, G, bx);
          pg8::EpiBf16 E{(bf16*)(ws + WS_QB), 768, nullptr, 0};
          pg8::gemm_phase<pg8::EpiBf16, pg8::StaticOrder, true, true>(lds + RING_OFF, g, S, E, tid); }
        { PH_LOCALS pg8::Gemm g{(const bf16*)(ws + WS_KVN), (const bf16*)(ws + WS_WUKV + layer * SZ_WUKV), M, 1024, 256}; pg8::StaticOrder S; S.init(M, 1024, G, bx);
          pg8::EpiBf16 E{(bf16*)(ws + WS_KVB), 1024, nullptr, 0};
          pg8::gemm_phase<pg8::EpiBf16, pg8::StaticOrder, true, true>(lds + RING_OFF, g, S, E, tid); }
    }
    SEAM(pb + 2);
    if constexpr (IN(pb + 3)) {
        if constexpr (KSEL(40)) { PH_LOCALS for (int u = vcu; u < NB * 4 * 8; u += G) { const int b = u >> 5, h = (u >> 3) & 3, qb = u & 7; const size_t r0 = (size_t)b * SEQ;
            mixb::MixP P{}; P.q = (const bf16*)(ws + WS_QB) + r0 * 768 + h * 192; P.ldq = 768; P.k0 = (const bf16*)(ws + WS_KVB) + r0 * 1024 + h * 256; P.ldk0 = 1024;
            P.k1 = (const bf16*)(ws + WS_KPE) + r0 * 64; P.ldk1 = 64; P.v = (const bf16*)(ws + WS_KVB) + r0 * 1024 + h * 256 + 128; P.ldv = 1024;
            P.o = (bf16*)(ws + WS_ATT) + r0 * 512 + h * 128; P.ldo = 512;
            mixb::mix_unit<0, 192, 128>(P, qb * 256, lds + RING_OFF, tid); } }
        if constexpr (KSEL(41)) { PH_LOCALS for (int u = vcu; u < NB * 4 * 8; u += G) { const int b = u >> 5, h = (u >> 3) & 3, qb = u & 7; const size_t r0 = (size_t)b * SEQ;
            mixb::MixP P{}; P.q = (const bf16*)(ws + WS_RQ) + r0 * 256 + h * 64; P.ldq = 256; P.k0 = (const bf16*)(ws + WS_RK) + r0 * 256 + h * 64; P.ldk0 = 256; P.k1 = P.k0; P.ldk1 = 256;
            P.v = (const bf16*)(ws + WS_PROJ) + r0 * NINP + C_RV + h * 128; P.ldv = NINP; P.aux = (const bf16*)(ws + WS_PROJ) + r0 * NINP + C_RG + h * 128; P.ldaux = NINP;
            P.o = (bf16*)(ws + WS_MIX) + r0 * DM + 512 + h * 128; P.ldo = DM;
            P.lf = log2f(1.0f - exp2f(-5.0f - (float)h)); P.lb = log2f(1.0f - exp2f(-5.5f - (float)h));
            mixb::mix_unit<1, 64, 128>(P, qb * 256, lds + RING_OFF, tid); } }
        if constexpr (KSEL(42)) { PH_LOCALS for (int u = vcu; u < NB * 8 * 8; u += G) { const int b = u >> 6, hh = (u >> 3) & 7, qb = u & 7, gq = hh >> 2; const size_t r0 = (size_t)b * SEQ;
            mixb::MixP P{}; const bf16* XBC = (const bf16*)(ws + WS_XBC) + r0 * 1024;
            P.q = XBC + 768 + gq * 128; P.ldq = 1024; P.k0 = XBC + 512 + gq * 128; P.ldk0 = 1024; P.k1 = P.k0; P.ldk1 = 1024; P.v = XBC + hh * 64; P.ldv = 1024; P.aux = P.v; P.ldaux = 1024;
            P.ssdp = (const float*)(ws + WS_SSDP) + r0 * 32 + hh * 4; P.dh = args.in(I_SSDD)[layer * 8 + hh];
            P.o = (bf16*)(ws + WS_YC) + r0 * 512 + hh * 64; P.ldo = 512;
            mixb::mix_unit<2, 128, 64>(P, qb * 256, lds + RING_OFF, tid); } }
        if constexpr (KSEL(43)) { PH_LOCALS for (int u = vcu; u < 512; u += G) hyb::hyena_unit(args, layer, u, ws, lds + RING_OFF, tid); }
    }
    SEAM(pb + 3);
    if constexpr (INK(pb + 4, 5)) { PH_LOCALS
        for (int m = gw; m < M; m += NGW) post_row(args, layer, m, lane, ws);
        for (int it = gw; it < NB * 32; it += NGW) post_hy(args, layer, it, lane, ws, (LAS bf16*)wscr);
    }
    SEAM(pb + 4);
    if constexpr (INK(pb + 5, 6)) { PH_LOCALS
        pg8::Gemm g{(const bf16*)(ws + WS_MIX), (const bf16*)(ws + WS_WOUT + layer * SZ_WOUT), M, DM, DM}; pg8::StaticOrder S; S.init(M, DM, G, bx);
        pg8::EpiResF32 E{XRES, DM, ALPHA, 1.f};
        pg8::gemm_phase<pg8::EpiResF32, pg8::StaticOrder, true, true>(lds + RING_OFF, g, S, E, tid);
    }
    SEAM(pb + 5);
    if constexpr (INK(pb + 6, 7)) { PH_LOCALS
        const float* gG = args.in(I_LN1G) + layer * DM; const float* gB = args.in(I_LN1B) + layer * DM;
        if constexpr (LAYER == 1) {
            LAS float* WrT = (LAS float*)(lds + RING_OFF);
            for (int i = tid; i < DM * NEXP; i += NWAVES * 64) WrT[(i & 7) * DM + (i >> 3)] = args.in(I_ROUTER)[i];
            for (int i = bx * NWAVES * 64 + tid; i < CAP_ROWS; i += G * NWAVES * 64) ((int*)(ws + WS_SLOT))[i] = -1;
            __syncthreads();
            for (int m = gw; m < M; m += NGW) { f32x4 v[8]; ln_row(XRES + (size_t)m * DM, XB + (size_t)m * DM, gG, gB, lane, v, nullptr, nullptr, XRES + (size_t)m * DM);
                float lg[8];
#pragma unroll
                for (int e = 0; e < 8; ++e) { float s = 0.f;
#pragma unroll
                    for (int j = 0; j < 8; ++j) { const f32x4 w = *((const LAS f32x4*)(WrT + e * DM) + lane + 64 * j); s += (v[j].x * w.x + v[j].y * w.y) + (v[j].z * w.z + v[j].w * w.w); }
                    lg[e] = wave_sum(s); __builtin_amdgcn_sched_barrier(0); }
                int e0 = 0; float v0 = lg[0];
#pragma unroll
                for (int e = 1; e < 8; ++e) if (lg[e] > v0) { v0 = lg[e]; e0 = e; }
                int e1 = -1; float v1 = -3.0e38f;
#pragma unroll
                for (int e = 0; e < 8; ++e) if (e != e0 && lg[e] > v1) { v1 = lg[e]; e1 = e; }
                if (lane == 0) { const float ex = __expf(v1 - v0); const float g0 = 1.0f / (1.0f + ex), g1 = ex / (1.0f + ex);
                    const int p0 = (int)atomicAdd((unsigned*)(ctl + CW_CNT + e0), 1u), p1 = (int)atomicAdd((unsigned*)(ctl + CW_CNT + e1), 1u);
                    int* rt = (int*)(ws + WS_RT) + (size_t)m * 4; rt[0] = e0; rt[1] = e1; rt[2] = p0; rt[3] = p1;
                    float* rg = (float*)(ws + WS_RTG) + (size_t)m * 2; rg[0] = g0; rg[1] = g1; } }
            __syncthreads();
        } else {
            for (int m = gw; m < M; m += NGW) { f32x4 v[8]; ln_row(XRES + (size_t)m * DM, XB + (size_t)m * DM, gG, gB, lane, v, nullptr, nullptr, XRES + (size_t)m * DM); }
        }
    }
    SEAM(pb + 6);
    if constexpr (LAYER == 0) {
        if constexpr (INK(8, 8)) { PH_LOCALS
            pg8::Gemm g{XB, (const bf16*)(ws + WS_WGU), M, 2 * DFF, DM}; pg8::StaticOrder S; S.init(M, 2 * DFF, G, bx);
            pg8::EpiSwiglu E{(bf16*)(ws + WS_HID), DFF};
            pg8::gemm_phase<pg8::EpiSwiglu, pg8::StaticOrder, true, true>(lds + RING_OFF, g, S, E, tid);
        }
        SEAM(8);
        if constexpr (INK(9, 9)) { PH_LOCALS
            pg8::Gemm g{(const bf16*)(ws + WS_HID), (const bf16*)(ws + WS_WDN), M, DM, DFF}; pg8::StaticOrder S; S.init(M, DM, G, bx);
            pg8::EpiResF32 E{XRES, DM, ALPHA, ZERO_FFN ? 0.f : 1.f};
            pg8::gemm_phase<pg8::EpiResF32, pg8::StaticOrder, true, true>(lds + RING_OFF, g, S, E, tid);
        }
        SEAM(9);
        if constexpr (INK(10, 10)) { PH_LOCALS
            const float* gG = args.in(I_LN2G); const float* gB = args.in(I_LN2B);
            for (int m = gw; m < M; m += NGW) { f32x4 v[8]; ln_row(XRES + (size_t)m * DM, XB + (size_t)m * DM, gG, gB, lane, v, nullptr, nullptr, XRES + (size_t)m * DM); }
        }
        SEAM(10);
    }
}

template <int CH, int LO, int HI>
__device__ __forceinline__ void moe_chunk(LAS unsigned char* lds, const XcdBarrier& bar, const Ids& ids) {
    if constexpr (INK(19 + 2 * CH, 19)) { PH_LOCALS
        pg8::MoeOrder S; int acc = 0;
#pragma unroll
        for (int e = 0; e < 8; ++e) { const int c = (int)__hip_atomic_load(ctl + CW_CNT + e, RLX_AGENT); acc += (c + 255) / 256 * 256; S.pend[e] = acc; }
        const int nrb = acc / 256; const int rb0 = CH * MOE_CH_RB; int nrbc = nrb - rb0; nrbc = nrbc < 0 ? 0 : (nrbc > MOE_CH_RB ? MOE_CH_RB : nrbc);
        pg8::Gemm g{(const bf16*)(ws + WS_XS) + (size_t)rb0 * 256 * DM, (const bf16*)(ws + WS_MGU), nrbc * 256, 2 * DFFE, DM};
        S.so.init(nrbc * 256, 2 * DFFE, G, bx); S.rb0 = rb0; S.bstride = (long)2 * DFFE * DM * 2;
        pg8::EpiSwiglu E{(bf16*)(ws + WS_HIDS), DFFE};
        pg8::gemm_phase<pg8::EpiSwiglu, pg8::MoeOrder, true, true>(lds + RING_OFF, g, S, E, tid);
    }
    SEAM(19 + 2 * CH);
    if constexpr (INK(20 + 2 * CH, 20)) { PH_LOCALS
        pg8::MoeOrder S; int acc = 0;
#pragma unroll
        for (int e = 0; e < 8; ++e) { const int c = (int)__hip_atomic_load(ctl + CW_CNT + e, RLX_AGENT); acc += (c + 255) / 256 * 256; S.pend[e] = acc; }
        const int nrb = acc / 256; const int rb0 = CH * MOE_CH_RB; int nrbc = nrb - rb0; nrbc = nrbc < 0 ? 0 : (nrbc > MOE_CH_RB ? MOE_CH_RB : nrbc);
        pg8::Gemm g{(const bf16*)(ws + WS_HIDS), (const bf16*)(ws + WS_MDN), nrbc * 256, DM, DFFE};
        S.so.init(nrbc * 256, DM, G, bx); S.rb0 = rb0; S.bstride = (long)DM * DFFE * 2;
        pg8::EpiMoeDown E{(bf16*)(ws + WS_Y0), (long)((WS_Y1 - WS_Y0) / 2), DM, (const int*)(ws + WS_SLOT), (const float*)(ws + WS_SLOTG), rb0 * 256};
        pg8::gemm_phase<pg8::EpiMoeDown, pg8::MoeOrder, true, true>(lds + RING_OFF, g, S, E, tid);
    }
    SEAM(20 + 2 * CH);
}

template <int LO, int HI>
__global__ void __launch_bounds__(NWAVES * 64, 2) mk_fwd(Args args_unused, int li) {
    extern __shared__ __attribute__((aligned(16))) unsigned char lds_raw[];
    LAS unsigned char* lds = (LAS unsigned char*)lds_raw;
    volatile LAS unsigned* MISC = (volatile LAS unsigned*)(lds + MISC_OFF);
    Ids ids; { const int tid0 = threadIdx.x; ids.wave0 = __builtin_amdgcn_readfirstlane(tid0 >> 6); ids.G0 = gridDim.x; ids.bx0 = blockIdx.x;
        ids.vcu0 = (ids.G0 % 8 == 0) ? (ids.bx0 % 8) * (ids.G0 / 8) + ids.bx0 / 8 : ids.bx0;
        for (int u = tid0; u < (LDS_BYTES - LDSCTL_OFF) / 4; u += NWAVES * 64) ((LAS unsigned*)(lds + LDSCTL_OFF))[u] = 0u; }
    __syncthreads();
    XcdBarrier bar; bar.bar = nullptr; bar.x = 0; bar.st = nullptr;
    if constexpr (HI - LO > 1) { const AP a0 = kargs(); bar = xcd_barrier_post((unsigned*)((gu32*)(a0.ws() + WS_CTL) + CW_BAR) + li * XCD_BAR_WORDS, MISC + 8); }

    if constexpr (INK(0, 0)) { PH_LOCALS
        constexpr int I_WIN_ = 32 * (NINP / 32), I_UQ = 6 * 24, I_UKV = 4 * 32, I_OUT = 32 * 64, I_GU = 32 * (DFF / 32), I_DN = (DFF / 64) * 64;
        constexpr int NIT = 2 * I_WIN_ + 2 * I_UQ + 2 * I_UKV + 2 * I_OUT + 2 * I_GU + I_DN;
        for (int it = gw; it < NIT; it += NGW) { int r = it;
#define TRJ(n, W, K, N, NP, WT, GR, GS, OFF) if (r < (n)) { transpose_item((W), (K), (N), (NP) / 32, (bf16*)(WT), (GR), (GS), (OFF), wscr, r, lane); continue; } r -= (n);
            TRJ(I_WIN_, args.in(I_WIN), DM, NIN, NINP, ws + WS_WIN, 1 << 30, 0, 0)
            TRJ(I_WIN_, args.in(I_WIN) + (size_t)DM * NIN, DM, NIN, NINP, ws + WS_WIN + SZ_WIN, 1 << 30, 0, 0)
            TRJ(I_UQ, args.in(I_WUQ), 384, 768, 768, ws + WS_WUQ, 1 << 30, 0, 0)
            TRJ(I_UQ, args.in(I_WUQ) + 384 * 768, 384, 768, 768, ws + WS_WUQ + SZ_WUQ, 1 << 30, 0, 0)
            TRJ(I_UKV, args.in(I_WUKV), 256, 1024, 1024, ws + WS_WUKV, 1 << 30, 0, 0)
            TRJ(I_UKV, args.in(I_WUKV) + 256 * 1024, 256, 1024, 1024, ws + WS_WUKV + SZ_WUKV, 1 << 30, 0, 0)
            TRJ(I_OUT, args.in(I_WOUT), DM, DM, DM, ws + WS_WOUT, 1 << 30, 0, 0)
            TRJ(I_OUT, args.in(I_WOUT) + (size_t)DM * DM, DM, DM, DM, ws + WS_WOUT + SZ_WOUT, 1 << 30, 0, 0)
            TRJ(I_GU, args.in(I_FFG), DM, DFF, DFF, ws + WS_WGU, 128, 256, 0)
            TRJ(I_GU, args.in(I_FFU), DM, DFF, DFF, ws + WS_WGU, 128, 256, 128)
            transpose_item(args.in(I_FFD), DFF, DM, DM / 32, (bf16*)(ws + WS_WDN), 1 << 30, 0, 0, wscr, r, lane);
#undef TRJ
        }
        for (int m = gw; m < M; m += NGW) { const GAS f32x4* xr = (const GAS f32x4*)(args.in(I_X) + (size_t)m * DM) + lane; GAS f32x4* xo = (GAS f32x4*)(XRES + (size_t)m * DM) + lane; GAS v2u* xb = (GAS v2u*)(XB + (size_t)m * DM) + lane;
#pragma unroll
            for (int j = 0; j < 8; ++j) { const f32x4 v = xr[64 * j]; xo[64 * j] = v; v2u w; w.x = pk2(v.x, v.y); w.y = pk2(v.z, v.w); xb[64 * j] = w; } }
        for (int it = gw; it < 2 * SEQ; it += NGW) hyena_filter_item(args, it >> 11, it & (SEQ - 1), (bf16*)(ws + WS_HYG), wscr, lane);
    }
    SEAM(0);
    layer_phases<0, LO, HI>(lds, bar, ids);
    layer_phases<1, LO, HI>(lds, bar, ids);
    if constexpr (INK(18, 18)) { PH_LOCALS
        for (int it = gw; it < 24 * 7168; it += NGW) { const int job = it / 7168, r = it - job * 7168, e = job / 3, kind = job - e * 3;
            if (kind < 2) transpose_item(args.in(kind == 0 ? I_MOEG : I_MOEU) + (size_t)e * DM * DFFE, DM, DFFE, DFFE / 32, (bf16*)(ws + WS_MGU) + (size_t)e * 2 * DFFE * DM, 128, 256, kind * 128, wscr, r, lane);
            else transpose_item(args.in(I_MOED) + (size_t)e * DFFE * DM, DFFE, DM, DM / 32, (bf16*)(ws + WS_MDN) + (size_t)e * DM * DFFE, 1 << 30, 0, 0, wscr, r, lane); }
        int pst[8]; { int acc = 0;
#pragma unroll
            for (int e = 0; e < 8; ++e) { pst[e] = acc; const int c = (int)__hip_atomic_load(ctl + CW_CNT + e, RLX_AGENT); acc += (c + 255) / 256 * 256; } }
        for (int it = gw; it < 2 * M; it += NGW) { const int tok = it >> 1, k = it & 1; const int* rt = (const int*)(ws + WS_RT) + (size_t)tok * 4; const int e = rt[k], pos = rt[2 + k];
            int base = 0;
#pragma unroll
            for (int j = 0; j < 8; ++j) base = (e == j) ? pst[j] : base;
            const int slot = base + pos;
            const GAS v4u* src = (const GAS v4u*)(XB + (size_t)tok * DM) + lane; GAS v4u* dst = (GAS v4u*)((bf16*)(ws + WS_XS) + (size_t)slot * DM) + lane;
#pragma unroll
            for (int j = 0; j < 4; ++j) dst[64 * j] = src[64 * j];
            if (lane == 0) { ((int*)(ws + WS_SLOT))[slot] = tok * 2 + k; ((float*)(ws + WS_SLOTG))[slot] = ((const float*)(ws + WS_RTG))[(size_t)tok * 2 + k]; } }
    }
    SEAM(18);
    moe_chunk<0, LO, HI>(lds, bar, ids);
    moe_chunk<1, LO, HI>(lds, bar, ids);
    moe_chunk<2, LO, HI>(lds, bar, ids);
    if constexpr (INK(25, 25)) { PH_LOCALS
#if MOE_CHECK
        { LAS float* xs = (LAS float*)(lds + RING_OFF); LAS float* hid = xs + DM; LAS float* red = hid + DFFE;
          for (int smp = bx; smp < 48; smp += G) { const int tok = (smp * 683 + 5) % M;
            for (int d = tid; d < DM; d += 512) xs[d] = bf2f(XB[(size_t)tok * DM + d]);
            __syncthreads();
            float accv[4] = {0.f, 0.f, 0.f, 0.f};
            for (int kk = 0; kk < 2; ++kk) { const int e = ((const int*)(ws + WS_RT))[(size_t)tok * 4 + kk]; const float gt = ((const float*)(ws + WS_RTG))[(size_t)tok * 2 + kk];
                const float* Wg = args.in(I_MOEG) + (size_t)e * DM * DFFE; const float* Wu = args.in(I_MOEU) + (size_t)e * DM * DFFE; const float* Wd = args.in(I_MOED) + (size_t)e * DFFE * DM;
                for (int j = tid; j < DFFE; j += 512) { float a = 0.f, b = 0.f; for (int d = 0; d < DM; ++d) { const float xv = xs[d]; a += xv * Wg[(size_t)d * DFFE + j]; b += xv * Wu[(size_t)d * DFFE + j]; } hid[j] = (a / (1.0f + __expf(-a))) * b; }
                __syncthreads();
                for (int q = 0; q < 4; ++q) { const int c = tid + 512 * q; float o = 0.f; for (int j = 0; j < DFFE; ++j) o += hid[j] * Wd[(size_t)j * DM + c]; accv[q] += gt * o; }
                __syncthreads(); }
            float num = 0.f, den = 0.f;
            for (int q = 0; q < 4; ++q) { const int c = tid + 512 * q; const float mine = bf2f(((const bf16*)(ws + WS_Y0))[(size_t)tok * DM + c]) + bf2f(((const bf16*)(ws + WS_Y1))[(size_t)tok * DM + c]); const float df = accv[q] - mine; num += df * df; den += accv[q] * accv[q]; }
            num = wave_sum(num); den = wave_sum(den); if (lane == 0) { red[wave * 2] = num; red[wave * 2 + 1] = den; }
            __syncthreads();
            if (tid == 0) { float n = 0.f, dn = 0.f; for (int w = 0; w < 8; ++w) { n += red[w * 2]; dn += red[w * 2 + 1]; } const float rel = n / (dn + 1e-20f); atomicMax((unsigned*)(ctl + 80), __float_as_uint(rel)); }
            if (wave == 0) { float lg[8]; for (int e = 0; e < 8; ++e) { float s = 0.f; for (int d = lane; d < DM; d += 64) s += xs[d] * args.in(I_ROUTER)[d * 8 + e]; lg[e] = wave_sum(s); }
                int e0 = 0; for (int e = 1; e < 8; ++e) if (lg[e] > lg[e0]) e0 = e; int e1 = -1; for (int e = 0; e < 8; ++e) if (e != e0 && (e1 < 0 || lg[e] > lg[e1])) e1 = e;
                const float ex = __expf(lg[e1] - lg[e0]); const float g0 = 1.f / (1.f + ex);
                const int* rt = (const int*)(ws + WS_RT) + (size_t)tok * 4; const float* rg = (const float*)(ws + WS_RTG) + (size_t)tok * 2;
                const bool bad = (rt[0] != e0) || (rt[1] != e1) || fabsf(rg[0] - g0) > 0.03f || fabsf(rg[0] + rg[1] - 1.f) > 1e-3f;
                if (lane == 0 && bad) atomicAdd((unsigned*)(ctl + 81), 1u); }
            __syncthreads(); } }
        __syncthreads();
        { XcdBarrier bb_ = bar; (void)bb_; }
#endif
        const float* gG = args.in(I_LN2G) + DM; const float* gB = args.in(I_LN2B) + DM;
        for (int m = gw; m < M; m += NGW) { f32x4 v[8]; ln_row(XRES + (size_t)m * DM, nullptr, gG, gB, lane, v, (const bf16*)(ws + WS_Y0) + (size_t)m * DM, (const bf16*)(ws + WS_Y1) + (size_t)m * DM, XRES + (size_t)m * DM); }
#if MOE_CHECK
        __syncthreads(); VM_WAIT();
        if (tid == 0) { __builtin_amdgcn_fence(__ATOMIC_RELEASE, "agent"); const unsigned old_ = atomicAdd((unsigned*)(ctl + 82), 1u); ((volatile LAS unsigned*)(lds + MISC_OFF))[12] = (old_ + 1u == (unsigned)G) ? 1u : 0u; }
        __syncthreads();
        if (((volatile LAS unsigned*)(lds + MISC_OFF))[12]) { __builtin_amdgcn_fence(__ATOMIC_ACQUIRE, "agent");
            const float rel = __uint_as_float(__hip_atomic_load(ctl + 80, RLX_AGENT)); const unsigned nbad = __hip_atomic_load(ctl + 81, RLX_AGENT);
            float code = 0.f; if (rel > 0.01f) code += 10.f; if (rel > 0.3f) code += 10.f; if (nbad > 2u) code += 40.f; if (nbad > 8u) code += 40.f;
            if (code > 0.f) for (size_t i = tid; i < (size_t)M * DM; i += 512) XRES[i] = code; }
#endif
    }
}
#undef IN
#undef INK
#undef SEAM

template <int LO, int HI> static void launch_range(int grid, const Args& a, int li, hipStream_t stream) {
    static bool attr = false;
    if (!attr) { if (hipFuncSetAttribute((const void*)mk_fwd<LO, HI>, hipFuncAttributeMaxDynamicSharedMemorySize, LDS_BYTES) != hipSuccess) fprintf(stderr, "kernel_launch: hipFuncSetAttribute failed\n"); attr = true; }
    hipLaunchKernelGGL((mk_fwd<LO, HI>), dim3(grid), dim3(NWAVES * 64), LDS_BYTES, stream, a, li);
}
template <int P> struct PerPhase { static void go(int grid, const Args& a, hipStream_t s) { PerPhase<P - 1>::go(grid, a, s); launch_range<P, P + 1>(grid, a, P, s); } };
template <> struct PerPhase<-1> { static void go(int, const Args&, hipStream_t) {} };

extern "C" void kernel_launch(void* const* d_in, const int* in_sizes, int n_in, void* d_out, int out_size, void* d_ws, size_t ws_size, hipStream_t stream) {
    static int grid = 0;
    if (grid == 0) {
        if (n_in != 35 || out_size != M * DM || ws_size < WS_END) { fprintf(stderr, "kernel_launch: built for 35 inputs, out %d floats, >= %zu bytes of workspace; got n_in %d, out %d, ws %zu; nothing launched\n", M * DM, (size_t)WS_END, n_in, out_size, ws_size); grid = -1; return; }
        int dev = 0, cus = 0;
        if (hipGetDevice(&dev) != hipSuccess || hipDeviceGetAttribute(&cus, hipDeviceAttributeMultiprocessorCount, dev) != hipSuccess) { grid = -1; return; }
        grid = cus;
    }
    if (grid < 0) return;
    if (hipMemsetAsync((char*)d_ws + WS_CTL, 0, CTL_ZERO_BYTES, stream) != hipSuccess) return;
    Args a{};
    for (int i = 0; i < 35; ++i) a.in[i] = (const float*)d_in[i];
    a.out = (float*)d_out; a.ws = (unsigned char*)d_ws; a.ph_lo = 0; a.ph_hi = N_PHASES;
#if MK_CUTS
    PerPhase<N_PHASES - 1>::go(grid, a, stream);
#else
    launch_range<0, N_PHASES>(grid, a, 0, stream);
#endif
    const hipError_t le = hipPeekAtLastError();
    if (le != hipSuccess) fprintf(stderr, "kernel_launch: launch failed: %s\n", hipGetErrorName(le));
}
```

```cpp
#include <hip/hip_runtime.h>
#include <cstdio>
#include <cstdint>
namespace pg8 {
#define PG8_LAS __attribute__((address_space(3)))
typedef unsigned short bf16_t;
typedef short bf16x8 __attribute__((ext_vector_type(8)));
typedef float f32x4 __attribute__((ext_vector_type(4)));
typedef unsigned u32x4 __attribute__((ext_vector_type(4)));
constexpr int BM = 256, BK = 64, HALF = 128, HTB = HALF * BK * 2  , STAGE_BYTES = 8 * HTB, NXCD = 8, WGM = 8;

__host__ __device__ __forceinline__ int lds_byte(int r, int c) { const int st = (r >> 4) * 2 + (c >> 5), rr = r & 15, cc = c & 31, ob = rr * 64 + cc * 2; return st * 1024 + (ob ^ (((ob >> 9) & 1) << 5)); }
__host__ __device__ __forceinline__ void stage_rc(int b, int& R, int& C) { const int st = b / 1024, sb = b % 1024, swz = sb ^ (((sb >> 9) & 1) << 5); R = (st >> 1) * 16 + swz / 64; C = (st & 1) * 32 + (swz % 64) / 2; }
__host__ __device__ __forceinline__ int perm32(int rho) { const int n = rho >> 4, i = rho & 15; return 8 * (i >> 2) + 4 * n + (i & 3); }

struct Unit { int pm, pn; long aoff, boff; int aux; };
struct Gemm { const bf16_t* A; const bf16_t* Bt; int M, N, K; };
__device__ __forceinline__ long rfl64(long v) { const unsigned lo = __builtin_amdgcn_readfirstlane((unsigned)v), hi = __builtin_amdgcn_readfirstlane((unsigned)((unsigned long)v >> 32)); return (long)(((unsigned long)hi << 32) | lo); }
__device__ __forceinline__ void unit_uniform(Unit& u) { u.pm = __builtin_amdgcn_readfirstlane(u.pm); u.pn = __builtin_amdgcn_readfirstlane(u.pn); u.aux = __builtin_amdgcn_readfirstlane(u.aux); u.aoff = rfl64(u.aoff); u.boff = rfl64(u.boff); }

struct StaticOrder {
    int nM, nN, nwg, G, c;
    __host__ __device__ void init(int M, int N, int G_, int c_) { nM = M / BM; nN = N / BM; nwg = nM * nN; G = G_; c = c_; }
    __host__ __device__ bool next(int i, Unit& u) const {
        const long L = (long)i * G + c; if (L >= nwg) return false;
        int wgid = (int)L; { const int q = nwg / NXCD, r = nwg % NXCD, xcd = wgid % NXCD, off = wgid / NXCD; wgid = (xcd < r ? xcd * (q + 1) : r * (q + 1) + (xcd - r) * q) + off; }
        const int nig = WGM * nN, gid = wgid / nig, fm = gid * WGM, gsz = (nM - fm) < WGM ? (nM - fm) : WGM;
        u.pm = fm + ((wgid % nig) % gsz); u.pn = (wgid % nig) / gsz; u.aoff = 0; u.boff = 0; u.aux = 0; return true;
    }
    __device__ __forceinline__ void a_ready(const Unit&) const {}
    __device__ __forceinline__ void done(const Unit&) const {}
};
struct MoeOrder {
    StaticOrder so; int rb0; int pend[8]; long bstride;
    __device__ bool next(int i, Unit& u) const {
        if (!so.next(i, u)) return false;
        const int row = (rb0 + u.pm) * BM; int e = 0;
#pragma unroll
        for (int j = 0; j < 7; ++j) e += (row >= pend[j]) ? 1 : 0;
        u.boff = (long)e * bstride; u.aux = rb0 + u.pm; return true;
    }
    __device__ __forceinline__ void a_ready(const Unit&) const {}
    __device__ __forceinline__ void done(const Unit&) const {}
};

__device__ __forceinline__ unsigned cvt_pk_bf16(float lo, float hi) { unsigned r; asm volatile("v_cvt_pk_bf16_f32 %0, %1, %2" : "=v"(r) : "v"(lo), "v"(hi)); return r; }
__device__ __forceinline__ float silu_f(float v) { return v * __builtin_amdgcn_rcpf(1.0f + __builtin_amdgcn_exp2f(-1.4426950408889634f * v)); }

struct EpiBf16 {
    static constexpr bool PERM = true, AFTER_DRAIN = false;
    bf16_t* O; int ldc; float* F; int fcol0;
    __device__ __forceinline__ void operator()(const f32x4 (&acc)[2][2][4][2], const Unit& u, int wr, int wc, int fr, int fq) const {
        const int row0 = u.pm * BM + wr * 64 + fr; const int col0 = u.pn * BM + wc * 32 + 8 * fq;
#pragma unroll
        for (int ai = 0; ai < 2; ++ai)
#pragma unroll
            for (int m = 0; m < 4; ++m) { bf16_t* rowp = O + (size_t)(row0 + ai * HALF + m * 16) * ldc + col0;
#pragma unroll
                for (int bj = 0; bj < 2; ++bj) { const f32x4 v0 = acc[ai][bj][m][0], v1 = acc[ai][bj][m][1];
                    u32x4 w; w.x = cvt_pk_bf16(v0[0], v0[1]); w.y = cvt_pk_bf16(v0[2], v0[3]); w.z = cvt_pk_bf16(v1[0], v1[1]); w.w = cvt_pk_bf16(v1[2], v1[3]);
                    *(u32x4*)(rowp + bj * HALF) = w;
                    if (F) { const int c = col0 + bj * HALF - fcol0; if (c >= 0 && c < 16) { float* fp = F + (size_t)(row0 + ai * HALF + m * 16) * 16 + c; *(f32x4*)fp = v0; *(f32x4*)(fp + 4) = v1; } }
                } }
    }
};
struct EpiResF32 {
    static constexpr bool PERM = false, AFTER_DRAIN = false;
    const float* Xin; float* X; int ldc; float alpha; float bscale;
    __device__ __forceinline__ void operator()(const f32x4 (&acc)[2][2][4][2], const Unit& u, int wr, int wc, int fr, int fq) const {
        const int row0 = u.pm * BM + wr * 64 + fr, col0 = u.pn * BM + wc * 32 + 4 * fq;
#pragma unroll
        for (int ai = 0; ai < 2; ++ai)
#pragma unroll
            for (int m = 0; m < 4; ++m) { float* rowp = X + (size_t)(row0 + ai * HALF + m * 16) * ldc + col0;
#pragma unroll
                for (int bj = 0; bj < 2; ++bj)
#pragma unroll
                    for (int n = 0; n < 2; ++n) { f32x4* p = (f32x4*)(rowp + bj * HALF + n * 16); const f32x4 x = *(const f32x4*)(Xin + (p - (f32x4*)X) * 4); *p = x * alpha + acc[ai][bj][m][n] * bscale; } }
    }
};
struct EpiSwiglu {
    static constexpr bool PERM = true, AFTER_DRAIN = false;
    bf16_t* H; int ldc;
    __device__ __forceinline__ void operator()(const f32x4 (&acc)[2][2][4][2], const Unit& u, int wr, int wc, int fr, int fq) const {
        const int row0 = u.pm * BM + wr * 64 + fr; const int col0 = u.pn * HALF + wc * 32 + 8 * fq;
#pragma unroll
        for (int ai = 0; ai < 2; ++ai)
#pragma unroll
            for (int m = 0; m < 4; ++m) { bf16_t* rowp = H + (size_t)(row0 + ai * HALF + m * 16) * ldc + col0;
                const f32x4 g0 = acc[ai][0][m][0], g1 = acc[ai][0][m][1], u0 = acc[ai][1][m][0], u1 = acc[ai][1][m][1];
                f32x4 h0, h1;
#pragma unroll
                for (int j = 0; j < 4; ++j) { h0[j] = silu_f(g0[j]) * u0[j]; h1[j] = silu_f(g1[j]) * u1[j]; }
                u32x4 w; w.x = cvt_pk_bf16(h0[0], h0[1]); w.y = cvt_pk_bf16(h0[2], h0[3]); w.z = cvt_pk_bf16(h1[0], h1[1]); w.w = cvt_pk_bf16(h1[2], h1[3]);
                *(u32x4*)rowp = w; }
    }
};
struct EpiSwigluF8 {
    static constexpr bool PERM = true, AFTER_DRAIN = false;
    unsigned char* H; int ldc;
    __device__ __forceinline__ void operator()(const f32x4 (&acc)[2][2][4][2], const Unit& u, int wr, int wc, int fr, int fq) const {
        const int row0 = u.pm * BM + wr * 64 + fr; const int col0 = u.pn * HALF + wc * 32 + 8 * fq;
#pragma unroll
        for (int ai = 0; ai < 2; ++ai)
#pragma unroll
            for (int m = 0; m < 4; ++m) { unsigned char* rowp = H + (size_t)(row0 + ai * HALF + m * 16) * ldc + col0;
                const f32x4 g0 = acc[ai][0][m][0], g1 = acc[ai][0][m][1], u0 = acc[ai][1][m][0], u1 = acc[ai][1][m][1];
                f32x4 h0, h1;
#pragma unroll
                for (int j = 0; j < 4; ++j) { h0[j] = silu_f(g0[j]) * u0[j]; h1[j] = silu_f(g1[j]) * u1[j]; }
                int w0 = 0, w1 = 0;
                w0 = __builtin_amdgcn_cvt_pk_fp8_f32(h0[0], h0[1], w0, false); w0 = __builtin_amdgcn_cvt_pk_fp8_f32(h0[2], h0[3], w0, true);
                w1 = __builtin_amdgcn_cvt_pk_fp8_f32(h1[0], h1[1], w1, false); w1 = __builtin_amdgcn_cvt_pk_fp8_f32(h1[2], h1[3], w1, true);
                typedef int i32x2 __attribute__((ext_vector_type(2))); *(i32x2*)rowp = (i32x2){w0, w1}; __builtin_amdgcn_sched_barrier(0); }
    }
};
struct EpiMoeDown {
    static constexpr bool PERM = true, AFTER_DRAIN = false;
    bf16_t* Y0; long ystride; int ldc; const int* slot_tok2; const float* slot_gate; int rbase;
    __device__ __forceinline__ void operator()(const f32x4 (&acc)[2][2][4][2], const Unit& u, int wr, int wc, int fr, int fq) const {
        const int row0 = rbase + u.pm * BM + wr * 64 + fr; const int col0 = u.pn * BM + wc * 32 + 8 * fq;
#pragma unroll
        for (int ai = 0; ai < 2; ++ai)
#pragma unroll
            for (int m = 0; m < 4; ++m) { const int slot = row0 + ai * HALF + m * 16; const int t2 = slot_tok2[slot]; const float gt = slot_gate[slot];
                if (t2 >= 0) { bf16_t* rowp = Y0 + (size_t)(t2 & 1) * ystride + (size_t)(t2 >> 1) * ldc + col0;
#pragma unroll
                    for (int bj = 0; bj < 2; ++bj) { const f32x4 v0 = acc[ai][bj][m][0] * gt, v1 = acc[ai][bj][m][1] * gt;
                        u32x4 w; w.x = cvt_pk_bf16(v0[0], v0[1]); w.y = cvt_pk_bf16(v0[2], v0[3]); w.z = cvt_pk_bf16(v1[0], v1[1]); w.w = cvt_pk_bf16(v1[2], v1[3]);
                        *(u32x4*)(rowp + bj * HALF) = w; } } __builtin_amdgcn_sched_barrier(0); }
    }
};

template <class Epi, class Sched, bool ALIGN_EPI = false, bool SP2 = false>
__device__ __forceinline__ void gemm_phase(PG8_LAS unsigned char* lds, const Gemm g, const Sched& S, const Epi& E, int tid) {
    asm volatile("" : "+v"(tid));
    const int wid = __builtin_amdgcn_readfirstlane(tid >> 6), lane = tid & 63, wr = wid >> 2, wc = wid & 3, fr = lane & 15, fq = lane >> 4;
    const int K = g.K, nt = K / BK;
    unsigned voffA[2], voffB[2];
#pragma unroll
    for (int i = 0; i < 2; ++i) { int R, C; stage_rc(tid * 16 + i * 8192, R, C); const int Rb = Epi::PERM ? ((R & ~31) + perm32(R & 31)) : R;
        voffA[i] = (unsigned)(R * K + C) * 2u; voffB[i] = (unsigned)(Rb * K + C) * 2u; }
    const size_t kstep = (size_t)(BK * 2);
    const size_t hstep = (size_t)HALF * K * 2;
    const size_t tstep = 2 * hstep;
    const unsigned ldsw = (unsigned)wid * 1024u;
    const int aoff = lds_byte(wr * 64 + fr, fq * 8), boff = lds_byte(wc * 32 + fr, fq * 8);
#define PG8_SA(b, h) (((b) * 2 + (h)) * HTB)
#define PG8_SB(b, h) ((4 + (b) * 2 + (h)) * HTB)
#define PG8_STAGE(bufoff, gbase, voff) do { _Pragma("unroll") for (int _i = 0; _i < 2; ++_i) \
        __builtin_amdgcn_global_load_lds((const unsigned*)((const char*)(gbase) + (voff)[_i]), (PG8_LAS unsigned*)(lds + (bufoff) + ldsw + _i * 8192), 16, 0, 0); } while (0)
#define PG8_LDA(dst, b, h) do { _Pragma("unroll") for (int m = 0; m < 4; ++m) _Pragma("unroll") for (int k = 0; k < 2; ++k) dst[m][k] = *(const PG8_LAS bf16x8*)(lds + PG8_SA(b, h) + aoff + m * 2048 + k * 1024); } while (0)
#define PG8_LDB(dst, b, h) do { _Pragma("unroll") for (int n = 0; n < 2; ++n) _Pragma("unroll") for (int k = 0; k < 2; ++k) dst[n][k] = *(const PG8_LAS bf16x8*)(lds + PG8_SB(b, h) + boff + n * 2048 + k * 1024); } while (0)
#define PG8_MMA(ai, bj, At, Bt) do { __builtin_amdgcn_s_setprio(1); _Pragma("unroll") for (int m = 0; m < 4; ++m) _Pragma("unroll") for (int n = 0; n < 2; ++n) _Pragma("unroll") for (int k = 0; k < 2; ++k) \
        acc[ai][bj][m][n] = __builtin_amdgcn_mfma_f32_16x16x32_bf16(Bt[n][k], At[m][k], acc[ai][bj][m][n], 0, 0, 0); __builtin_amdgcn_s_setprio(0); } while (0)
#define PG8_WAIT_V(n) asm volatile("s_waitcnt vmcnt(" #n ")" ::: "memory")
#define PG8_WAIT_L(n) asm volatile("s_waitcnt lgkmcnt(" #n ")" ::: "memory")
#define PG8_BAR __builtin_amdgcn_s_barrier()
#define PG8_SCHED __builtin_amdgcn_sched_barrier(0)
    Unit cur, nxt; int ui = 0;
    if (!S.next(0, cur)) return;
    f32x4 acc[2][2][4][2];
#pragma unroll
    for (int a = 0; a < 2; ++a)
#pragma unroll
        for (int b = 0; b < 2; ++b)
#pragma unroll
            for (int m = 0; m < 4; ++m)
#pragma unroll
                for (int n = 0; n < 2; ++n) acc[a][b][m][n] = (f32x4){0.f, 0.f, 0.f, 0.f};
    bf16x8 At[4][2], B0[2][2], B1[2][2];
    const char* cA = (const char*)g.A + cur.aoff + (size_t)cur.pm * tstep; const char* cB = (const char*)g.Bt + cur.boff + (size_t)cur.pn * tstep;
    S.a_ready(cur);
    if constexpr (SP2) {
        PG8_STAGE(PG8_SB(0, 0), cB, voffB); PG8_STAGE(PG8_SB(0, 1), cB + hstep, voffB); PG8_STAGE(PG8_SA(0, 0), cA, voffA); PG8_STAGE(PG8_SA(0, 1), cA + hstep, voffA);
        if (wr == 1) PG8_BAR;
        PG8_WAIT_V(2); PG8_BAR;
        PG8_STAGE(PG8_SB(1, 0), cB + kstep, voffB); PG8_STAGE(PG8_SA(1, 0), cA + kstep, voffA); PG8_STAGE(PG8_SB(1, 1), cB + hstep + kstep, voffB);
        PG8_WAIT_V(6); PG8_BAR;
    } else {
        PG8_STAGE(PG8_SB(0, 0), cB, voffB); PG8_STAGE(PG8_SA(0, 0), cA, voffA); PG8_STAGE(PG8_SB(0, 1), cB + hstep, voffB); PG8_STAGE(PG8_SA(0, 1), cA + hstep, voffA);
        if (wr == 1) PG8_BAR;
        PG8_WAIT_V(4); PG8_BAR;
        PG8_STAGE(PG8_SB(1, 0), cB + kstep, voffB); PG8_STAGE(PG8_SA(1, 0), cA + kstep, voffA); PG8_STAGE(PG8_SB(1, 1), cB + hstep + kstep, voffB);
        PG8_WAIT_V(6); PG8_BAR;
    }
    for (;;) {
        const bool has_next = S.next(ui + 1, nxt);
        const char* nA = has_next ? (const char*)g.A + nxt.aoff + (size_t)nxt.pm * tstep : cA; const char* nB = has_next ? (const char*)g.Bt + nxt.boff + (size_t)nxt.pn * tstep : cB;
        for (int t = 0; t < nt; t += 2) {
            const bool last = (t == nt - 2);
            const char* a1 = cA + (size_t)(t + 1) * kstep;
            const char* a2 = last ? nA : cA + (size_t)(t + 2) * kstep; const char* b2 = last ? nB : cB + (size_t)(t + 2) * kstep;
            const char* a3 = a2 + kstep; const char* b3 = b2 + kstep;
            if (last && has_next) S.a_ready(nxt);
            if constexpr (SP2) {
            PG8_LDB(B0, 0, 0); PG8_LDB(B1, 0, 1); PG8_SCHED; PG8_LDA(At, 0, 0); PG8_STAGE(PG8_SA(1, 1), a1 + hstep, voffA);
            PG8_WAIT_V(8); PG8_WAIT_L(0); PG8_BAR; PG8_MMA(0, 0, At, B0); PG8_MMA(0, 1, At, B1); PG8_BAR; PG8_SCHED;
            PG8_LDA(At, 0, 1); PG8_STAGE(PG8_SB(0, 0), b2, voffB); PG8_STAGE(PG8_SB(0, 1), b2 + hstep, voffB); PG8_STAGE(PG8_SA(0, 0), a2, voffA);
            PG8_WAIT_V(8); PG8_WAIT_L(0); PG8_BAR; PG8_MMA(1, 0, At, B0); PG8_MMA(1, 1, At, B1); PG8_BAR; PG8_SCHED;
            PG8_LDB(B0, 1, 0); PG8_LDB(B1, 1, 1); PG8_SCHED; PG8_LDA(At, 1, 0); PG8_STAGE(PG8_SA(0, 1), a2 + hstep, voffA);
            PG8_WAIT_V(8); PG8_WAIT_L(0); PG8_BAR; PG8_MMA(0, 0, At, B0); PG8_MMA(0, 1, At, B1); PG8_BAR; PG8_SCHED;
            PG8_LDA(At, 1, 1); PG8_STAGE(PG8_SB(1, 0), b3, voffB); PG8_STAGE(PG8_SB(1, 1), b3 + hstep, voffB); PG8_STAGE(PG8_SA(1, 0), a3, voffA);
            PG8_WAIT_V(8); PG8_WAIT_L(0); PG8_BAR; PG8_MMA(1, 0, At, B0); PG8_MMA(1, 1, At, B1); PG8_BAR; PG8_SCHED;
            } else {
            PG8_LDB(B0, 0, 0); PG8_SCHED; PG8_LDA(At, 0, 0); PG8_STAGE(PG8_SA(1, 1), a1 + hstep, voffA);
            PG8_WAIT_L(8); PG8_BAR; PG8_WAIT_L(0); PG8_MMA(0, 0, At, B0); PG8_BAR; PG8_SCHED;
            PG8_LDB(B1, 0, 1); PG8_STAGE(PG8_SB(0, 0), b2, voffB);
            PG8_BAR; PG8_WAIT_L(0); PG8_MMA(0, 1, At, B1); PG8_BAR;
            PG8_LDA(At, 0, 1); PG8_STAGE(PG8_SA(0, 0), a2, voffA);
            PG8_BAR; PG8_WAIT_L(0); PG8_MMA(1, 0, At, B0); PG8_BAR; PG8_SCHED;
            PG8_STAGE(PG8_SB(0, 1), b2 + hstep, voffB);
            PG8_WAIT_V(6); PG8_BAR; PG8_MMA(1, 1, At, B1); PG8_BAR;
            PG8_LDB(B0, 1, 0); PG8_SCHED; PG8_LDA(At, 1, 0); PG8_STAGE(PG8_SA(0, 1), a2 + hstep, voffA);
            PG8_WAIT_L(8); PG8_BAR; PG8_WAIT_L(0); PG8_MMA(0, 0, At, B0); PG8_BAR; PG8_SCHED;
            PG8_LDB(B1, 1, 1); PG8_STAGE(PG8_SB(1, 0), b3, voffB);
            PG8_BAR; PG8_WAIT_L(0); PG8_MMA(0, 1, At, B1); PG8_BAR;
            PG8_LDA(At, 1, 1); PG8_STAGE(PG8_SA(1, 0), a3, voffA);
            PG8_BAR; PG8_WAIT_L(0); PG8_MMA(1, 0, At, B0); PG8_BAR; PG8_SCHED;
            PG8_STAGE(PG8_SB(1, 1), b3 + hstep, voffB);
            PG8_WAIT_V(6); PG8_BAR; PG8_MMA(1, 1, At, B1); PG8_BAR;
            }
        }
        if constexpr (ALIGN_EPI) { if (wr == 0) PG8_BAR; }
        if constexpr (!Epi::AFTER_DRAIN) { E(acc, cur, wr, wc, fr, fq); S.done(cur); }
        if (!has_next) break;
#pragma unroll
        for (int a = 0; a < 2; ++a)
#pragma unroll
            for (int b = 0; b < 2; ++b)
#pragma unroll
                for (int m = 0; m < 4; ++m)
#pragma unroll
                    for (int n = 0; n < 2; ++n) acc[a][b][m][n] = (f32x4){0.f, 0.f, 0.f, 0.f};
        cur = nxt; cA = nA; cB = nB; ++ui;
        if constexpr (ALIGN_EPI) { if (wr == 1) PG8_BAR; }
    }
    PG8_WAIT_V(0);
    if constexpr (!ALIGN_EPI) { if (wr == 0) PG8_BAR; }
    PG8_BAR;
#undef PG8_SA
#undef PG8_SB
#undef PG8_STAGE
#undef PG8_LDA
#undef PG8_LDB
#undef PG8_MMA
#undef PG8_WAIT_V
#undef PG8_WAIT_L
#undef PG8_BAR
#undef PG8_SCHED
}
typedef int v8i __attribute__((ext_vector_type(8)));
typedef int v4i __attribute__((ext_vector_type(4)));
typedef int v32i __attribute__((ext_vector_type(32)));
template <class Epi, class Sched, bool ALIGN_EPI = false, bool SP2 = false>
__device__ __forceinline__ void gemm_phase_f8(PG8_LAS unsigned char* lds, const Gemm g, const Sched& S, const Epi& E, int tid, int scaleBt, int scaleA) {
    asm volatile("" : "+v"(tid));
    const int wid = __builtin_amdgcn_readfirstlane(tid >> 6), lane = tid & 63, wr = wid >> 2, wc = wid & 3, fr = lane & 15, fq = lane >> 4;
    const int K = g.K, nt = K / 128;
    unsigned voffA[2], voffB[2];
#pragma unroll
    for (int i = 0; i < 2; ++i) { int R, C; stage_rc(tid * 16 + i * 8192, R, C); const int Rb = Epi::PERM ? ((R & ~31) + perm32(R & 31)) : R;
        voffA[i] = (unsigned)(R * K + C * 2); voffB[i] = (unsigned)(Rb * K + C * 2); }
    const size_t kstep = (size_t)(BK * 2);
    const size_t hstep = (size_t)HALF * K;
    const size_t tstep = 2 * hstep;
    const unsigned ldsw = (unsigned)wid * 1024u;
    const int aoff0 = lds_byte(wr * 64 + fr, fq * 16), aoff1 = lds_byte(wr * 64 + fr, fq * 16 + 8), boff0 = lds_byte(wc * 32 + fr, fq * 16), boff1 = lds_byte(wc * 32 + fr, fq * 16 + 8);
#define PG8_SA(b, h) (((b) * 2 + (h)) * HTB)
#define PG8_SB(b, h) ((4 + (b) * 2 + (h)) * HTB)
#define PG8_STAGE(bufoff, gbase, voff) do { _Pragma("unroll") for (int _i = 0; _i < 2; ++_i) \
        __builtin_amdgcn_global_load_lds((const unsigned*)((const char*)(gbase) + (voff)[_i]), (PG8_LAS unsigned*)(lds + (bufoff) + ldsw + _i * 8192), 16, 0, 0); } while (0)
#define PG8_INS8(big, slot, lo_, hi_) do { const v8i f_ = __builtin_shufflevector(lo_, hi_, 0, 1, 2, 3, 4, 5, 6, 7); \
        const v32i e_ = __builtin_shufflevector(f_, f_, 0, 1, 2, 3, 4, 5, 6, 7, 0, 1, 2, 3, 4, 5, 6, 7, 0, 1, 2, 3, 4, 5, 6, 7, 0, 1, 2, 3, 4, 5, 6, 7); \
        if ((slot) == 0) big = __builtin_shufflevector(big, e_, 32, 33, 34, 35, 36, 37, 38, 39, 8, 9, 10, 11, 12, 13, 14, 15, 16, 17, 18, 19, 20, 21, 22, 23, 24, 25, 26, 27, 28, 29, 30, 31); \
        else if ((slot) == 1) big = __builtin_shufflevector(big, e_, 0, 1, 2, 3, 4, 5, 6, 7, 32, 33, 34, 35, 36, 37, 38, 39, 16, 17, 18, 19, 20, 21, 22, 23, 24, 25, 26, 27, 28, 29, 30, 31); \
        else if ((slot) == 2) big = __builtin_shufflevector(big, e_, 0, 1, 2, 3, 4, 5, 6, 7, 8, 9, 10, 11, 12, 13, 14, 15, 32, 33, 34, 35, 36, 37, 38, 39, 24, 25, 26, 27, 28, 29, 30, 31); \
        else big = __builtin_shufflevector(big, e_, 0, 1, 2, 3, 4, 5, 6, 7, 8, 9, 10, 11, 12, 13, 14, 15, 16, 17, 18, 19, 20, 21, 22, 23, 32, 33, 34, 35, 36, 37, 38, 39); } while (0)
#define PG8_GET8(big, slot) ((slot) == 0 ? __builtin_shufflevector(big, big, 0, 1, 2, 3, 4, 5, 6, 7) : (slot) == 1 ? __builtin_shufflevector(big, big, 8, 9, 10, 11, 12, 13, 14, 15) : (slot) == 2 ? __builtin_shufflevector(big, big, 16, 17, 18, 19, 20, 21, 22, 23) : __builtin_shufflevector(big, big, 24, 25, 26, 27, 28, 29, 30, 31))
#define PG8_LDA(dst, b, h) do { _Pragma("unroll") for (int m = 0; m < 4; ++m) { const v4i lo_ = *(const PG8_LAS v4i*)(lds + PG8_SA(b, h) + aoff0 + m * 2048), hi_ = *(const PG8_LAS v4i*)(lds + PG8_SA(b, h) + aoff1 + m * 2048); PG8_INS8(Afr, m, lo_, hi_); } } while (0)
#define PG8_LDB(dst, b, h) do { _Pragma("unroll") for (int n = 0; n < 2; ++n) { const v4i lo_ = *(const PG8_LAS v4i*)(lds + PG8_SB(b, h) + boff0 + n * 2048), hi_ = *(const PG8_LAS v4i*)(lds + PG8_SB(b, h) + boff1 + n * 2048); PG8_INS8(Bfr, (dst) * 2 + n, lo_, hi_); } } while (0)
#define PG8_F8(x) __builtin_bit_cast(v8i, x)
#define PG8_MMA(ai, bj, At, Bt) do { __builtin_amdgcn_s_setprio(1); _Pragma("unroll") for (int m = 0; m < 4; ++m) _Pragma("unroll") for (int n = 0; n < 2; ++n) { const v8i bop_ = PG8_GET8(Bfr, (Bt) * 2 + n), aop_ = PG8_GET8(Afr, m); \
        asm volatile("v_mfma_scale_f32_16x16x128_f8f6f4 %0, %1, %2, %0, %3, %4 op_sel_hi:[0,0,0]" : "+v"(acc[ai][bj][m][n]) : "v"(bop_), "v"(aop_), "v"(scaleBt), "v"(scaleA)); } __builtin_amdgcn_s_setprio(0); } while (0)
#define PG8_WAIT_V(n) asm volatile("s_waitcnt vmcnt(" #n ")" ::: "memory")
#define PG8_WAIT_L(n) asm volatile("s_waitcnt lgkmcnt(" #n ")" ::: "memory")
#define PG8_BAR __builtin_amdgcn_s_barrier()
#define PG8_SCHED __builtin_amdgcn_sched_barrier(0)
    Unit cur, nxt; int ui = 0;
    if (!S.next(0, cur)) return;
    unit_uniform(cur);
    f32x4 acc[2][2][4][2];
#pragma unroll
    for (int a = 0; a < 2; ++a)
#pragma unroll
        for (int b = 0; b < 2; ++b)
#pragma unroll
            for (int m = 0; m < 4; ++m)
#pragma unroll
                for (int n = 0; n < 2; ++n) acc[a][b][m][n] = (f32x4){0.f, 0.f, 0.f, 0.f};
    v32i Afr, Bfr;
    const char* cA = (const char*)g.A + cur.aoff + (size_t)cur.pm * tstep; const char* cB = (const char*)g.Bt + cur.boff + (size_t)cur.pn * tstep;
    S.a_ready(cur);
    if constexpr (SP2) {
        PG8_STAGE(PG8_SB(0, 0), cB, voffB); PG8_STAGE(PG8_SB(0, 1), cB + hstep, voffB); PG8_STAGE(PG8_SA(0, 0), cA, voffA); PG8_STAGE(PG8_SA(0, 1), cA + hstep, voffA);
        if (wr == 1) PG8_BAR;
        PG8_WAIT_V(2); PG8_BAR;
        PG8_STAGE(PG8_SB(1, 0), cB + kstep, voffB); PG8_STAGE(PG8_SA(1, 0), cA + kstep, voffA); PG8_STAGE(PG8_SB(1, 1), cB + hstep + kstep, voffB);
        PG8_WAIT_V(6); PG8_BAR;
    } else {
        PG8_STAGE(PG8_SB(0, 0), cB, voffB); PG8_STAGE(PG8_SA(0, 0), cA, voffA); PG8_STAGE(PG8_SB(0, 1), cB + hstep, voffB); PG8_STAGE(PG8_SA(0, 1), cA + hstep, voffA);
        if (wr == 1) PG8_BAR;
        PG8_WAIT_V(4); PG8_BAR;
        PG8_STAGE(PG8_SB(1, 0), cB + kstep, voffB); PG8_STAGE(PG8_SA(1, 0), cA + kstep, voffA); PG8_STAGE(PG8_SB(1, 1), cB + hstep + kstep, voffB);
        PG8_WAIT_V(6); PG8_BAR;
    }
    for (;;) {
        const bool has_next = __builtin_amdgcn_readfirstlane((int)S.next(ui + 1, nxt)) != 0; unit_uniform(nxt);
        const char* nA = has_next ? (const char*)g.A + nxt.aoff + (size_t)nxt.pm * tstep : cA; const char* nB = has_next ? (const char*)g.Bt + nxt.boff + (size_t)nxt.pn * tstep : cB;
        for (int t = 0; t < nt; t += 2) {
            const bool last = (t == nt - 2);
            const char* a1 = cA + (size_t)(t + 1) * kstep;
            const char* a2 = last ? nA : cA + (size_t)(t + 2) * kstep; const char* b2 = last ? nB : cB + (size_t)(t + 2) * kstep;
            const char* a3 = a2 + kstep; const char* b3 = b2 + kstep;
            if (last && has_next) S.a_ready(nxt);
            if constexpr (SP2) {
            PG8_LDB(0, 0, 0); PG8_LDB(1, 0, 1); PG8_SCHED; PG8_LDA(0, 0, 0); PG8_STAGE(PG8_SA(1, 1), a1 + hstep, voffA);
            PG8_WAIT_V(8); PG8_WAIT_L(0); PG8_BAR; PG8_MMA(0, 0, 0, 0); PG8_MMA(0, 1, 0, 1); PG8_BAR; PG8_SCHED;
            PG8_LDA(0, 0, 1); PG8_STAGE(PG8_SB(0, 0), b2, voffB); PG8_STAGE(PG8_SB(0, 1), b2 + hstep, voffB); PG8_STAGE(PG8_SA(0, 0), a2, voffA);
            PG8_WAIT_V(8); PG8_WAIT_L(0); PG8_BAR; PG8_MMA(1, 0, 0, 0); PG8_MMA(1, 1, 0, 1); PG8_BAR; PG8_SCHED;
            PG8_LDB(0, 1, 0); PG8_LDB(1, 1, 1); PG8_SCHED; PG8_LDA(0, 1, 0); PG8_STAGE(PG8_SA(0, 1), a2 + hstep, voffA);
            PG8_WAIT_V(8); PG8_WAIT_L(0); PG8_BAR; PG8_MMA(0, 0, 0, 0); PG8_MMA(0, 1, 0, 1); PG8_BAR; PG8_SCHED;
            PG8_LDA(0, 1, 1); PG8_STAGE(PG8_SB(1, 0), b3, voffB); PG8_STAGE(PG8_SB(1, 1), b3 + hstep, voffB); PG8_STAGE(PG8_SA(1, 0), a3, voffA);
            PG8_WAIT_V(8); PG8_WAIT_L(0); PG8_BAR; PG8_MMA(1, 0, 0, 0); PG8_MMA(1, 1, 0, 1); PG8_BAR; PG8_SCHED;
            } else {
            PG8_LDB(0, 0, 0); PG8_SCHED; PG8_LDA(0, 0, 0); PG8_STAGE(PG8_SA(1, 1), a1 + hstep, voffA);
            PG8_WAIT_L(8); PG8_BAR; PG8_WAIT_L(0); PG8_MMA(0, 0, 0, 0); PG8_BAR; PG8_SCHED;
            PG8_LDB(1, 0, 1); PG8_STAGE(PG8_SB(0, 0), b2, voffB);
            PG8_BAR; PG8_WAIT_L(0); PG8_MMA(0, 1, 0, 1); PG8_BAR;
            PG8_LDA(0, 0, 1); PG8_STAGE(PG8_SA(0, 0), a2, voffA);
            PG8_BAR; PG8_WAIT_L(0); PG8_MMA(1, 0, 0, 0); PG8_BAR; PG8_SCHED;
            PG8_STAGE(PG8_SB(0, 1), b2 + hstep, voffB);
            PG8_WAIT_V(6); PG8_BAR; PG8_MMA(1, 1, 0, 1); PG8_BAR;
            PG8_LDB(0, 1, 0); PG8_SCHED; PG8_LDA(0, 1, 0); PG8_STAGE(PG8_SA(0, 1), a2 + hstep, voffA);
            PG8_WAIT_L(8); PG8_BAR; PG8_WAIT_L(0); PG8_MMA(0, 0, 0, 0); PG8_BAR; PG8_SCHED;
            PG8_LDB(1, 1, 1); PG8_STAGE(PG8_SB(1, 0), b3, voffB);
            PG8_BAR; PG8_WAIT_L(0); PG8_MMA(0, 1, 0, 1); PG8_BAR;
            PG8_LDA(0, 1, 1); PG8_STAGE(PG8_SA(1, 0), a3, voffA);
            PG8_BAR; PG8_WAIT_L(0); PG8_MMA(1, 0, 0, 0); PG8_BAR; PG8_SCHED;
            PG8_STAGE(PG8_SB(1, 1), b3 + hstep, voffB);
            PG8_WAIT_V(6); PG8_BAR; PG8_MMA(1, 1, 0, 1); PG8_BAR;
            }
        }
        asm volatile("s_nop 15\n\ts_nop 15" ::: "memory");
        if constexpr (ALIGN_EPI) { if (wr == 0) PG8_BAR; }
        if constexpr (!Epi::AFTER_DRAIN) { E(acc, cur, wr, wc, fr, fq); S.done(cur); }
        if (!has_next) break;
#pragma unroll
        for (int a = 0; a < 2; ++a)
#pragma unroll
            for (int b = 0; b < 2; ++b)
#pragma unroll
                for (int m = 0; m < 4; ++m)
#pragma unroll
                    for (int n = 0; n < 2; ++n) acc[a][b][m][n] = (f32x4){0.f, 0.f, 0.f, 0.f};
        cur = nxt; cA = nA; cB = nB; ++ui;
        if constexpr (ALIGN_EPI) { if (wr == 1) PG8_BAR; }
    }
    PG8_WAIT_V(0);
    if constexpr (!ALIGN_EPI) { if (wr == 0) PG8_BAR; }
    PG8_BAR;
#undef PG8_SA
#undef PG8_SB
#undef PG8_STAGE
#undef PG8_LDA
#undef PG8_LDB
#undef PG8_MMA
#undef PG8_F8
#undef PG8_INS8
#undef PG8_GET8
#undef PG8_WAIT_V
#undef PG8_WAIT_L
#undef PG8_BAR
#undef PG8_SCHED
}
}

#ifndef ZERO_MOE
#define ZERO_MOE 0
#endif
#ifndef ZERO_FFN
#define ZERO_FFN 0
#endif
#ifndef ZERO_A
#define ZERO_A 0
#endif
#ifndef ZERO_B
#define ZERO_B 0
#endif
#ifndef ZERO_C
#define ZERO_C 0
#endif
#ifndef ZERO_D
#define ZERO_D 0
#endif
constexpr int NWAVES = 8;
constexpr int NB = 16, SEQ = 2048, DM = 2048, M = NB * SEQ;
constexpr int NIN = 5328, NINP = 5376;
constexpr int C_QC = 0, C_KVC = 384, C_KPE = 640, C_RQ = 704, C_RK = 960, C_RV = 1216, C_RG = 1728, C_MZ = 2240, C_XBC = 2752, C_DT = 3776, C_HU = 3792;
constexpr int DFF = 5632, DFFE = 7168, NEXP = 8;
constexpr int CAP_ROWS = 2 * M + NEXP * 256, CAP_RB = CAP_ROWS / 256;
constexpr int MOE_CH = 1, MOE_CH_RB = CAP_RB / MOE_CH;
constexpr float ALPHA = 1.4142135623730951f;
constexpr int HY_OFF = 2055, HY_GLEN = 4112;

constexpr size_t al256(size_t x) { return (x + 255) / 256 * 256; }
constexpr size_t WS_CTL = 0, CTL_ZERO_BYTES = 1u << 20;
constexpr size_t SZ_WIN = (size_t)NINP * DM * 2, SZ_WUQ = (size_t)768 * 384 * 2, SZ_WUKV = (size_t)1024 * 256 * 2, SZ_WOUT = (size_t)DM * DM * 2;
constexpr size_t WS_WIN = CTL_ZERO_BYTES;
constexpr size_t WS_WUQ = WS_WIN + 2 * SZ_WIN;
constexpr size_t WS_WUKV = WS_WUQ + 2 * SZ_WUQ;
constexpr size_t WS_WOUT = WS_WUKV + 2 * SZ_WUKV;
constexpr size_t WS_WGU = WS_WOUT + 2 * SZ_WOUT;
constexpr size_t WS_WDN = WS_WGU + (size_t)2 * DFF * DM * 2;
constexpr size_t WS_HYG = WS_WDN + (size_t)DM * DFF * 2;
constexpr size_t WS_XB = al256(WS_HYG + (size_t)2 * 2 * 512 * HY_GLEN * 2);
constexpr size_t WS_XF8 = WS_XB + (size_t)M * DM * 2;
constexpr size_t WS_RT = WS_XF8 + (size_t)M * DM;
constexpr size_t WS_RTG = WS_RT + (size_t)M * 16;
constexpr size_t WS_SLOT = WS_RTG + (size_t)M * 8;
constexpr size_t WS_SLOTG = WS_SLOT + (size_t)CAP_ROWS * 4;
constexpr size_t WS_SCR = al256(WS_SLOTG + (size_t)CAP_ROWS * 4);
constexpr size_t WS_PROJ = WS_SCR;
constexpr size_t WS_DTF = WS_PROJ + (size_t)M * NINP * 2;
constexpr size_t WS_QN = WS_DTF + (size_t)M * 16 * 4;
constexpr size_t WS_KVN = WS_QN + (size_t)M * 384 * 2;
constexpr size_t WS_KPE = WS_KVN + (size_t)M * 256 * 2;
constexpr size_t WS_RQ = WS_KPE + (size_t)M * 64 * 2;
constexpr size_t WS_RK = WS_RQ + (size_t)M * 256 * 2;
constexpr size_t WS_XBC = WS_RK + (size_t)M * 256 * 2;
constexpr size_t WS_SSDP = WS_XBC + (size_t)M * 1024 * 2;
constexpr size_t WS_UT = WS_SSDP + (size_t)M * 8 * 16;
constexpr size_t WS_QB = WS_UT + (size_t)3 * 512 * M * 2;
constexpr size_t WS_KVB = WS_QB + (size_t)M * 768 * 2;
constexpr size_t WS_ATT = WS_KVB + (size_t)M * 1024 * 2;
constexpr size_t WS_YC = WS_ATT + (size_t)M * 512 * 2;
constexpr size_t WS_ZT = WS_YC + (size_t)M * 512 * 2;
constexpr size_t WS_MIX = WS_ZT + (size_t)512 * M * 2;
constexpr size_t WS_MIX_END = WS_MIX + (size_t)M * DM * 2;
constexpr size_t WS_HID = WS_SCR;
constexpr size_t WS_MGU = WS_SCR;
constexpr size_t WS_MDN = WS_MGU + (size_t)NEXP * 2 * DFFE * DM;
constexpr size_t WS_XS = WS_MDN + (size_t)NEXP * DM * DFFE;
constexpr size_t WS_HIDS = WS_XS + (size_t)CAP_ROWS * DM;
constexpr size_t WS_Y0 = WS_HIDS + (size_t)MOE_CH_RB * 256 * DFFE;
constexpr size_t WS_Y1 = WS_Y0 + (size_t)M * DM * 2;
constexpr size_t WS_END = WS_Y1 + (size_t)M * DM * 2;
static_assert(WS_MIX_END <= WS_END && WS_HID + (size_t)M * DFF * 2 <= WS_END, "d_ws map");
static_assert(WS_END <= 1942000000ull, "d_ws map exceeds the guaranteed workspace");
constexpr int CW_TMO = 0, CW_CODE = 1;
constexpr int CW_CNT = 64;
constexpr int CW_MIXQ = 1024;
constexpr int CW_BAR = 4096;

constexpr int RING_OFF = 0, RING_BYTES = 131072;
constexpr int LDSCTL_OFF = RING_BYTES, MISC_OFF = LDSCTL_OFF + 320;
constexpr int LDS_BYTES = 147456;

#define GAS __attribute__((address_space(1)))
#define LAS __attribute__((address_space(3)))
typedef unsigned short bf16;
typedef unsigned v4u __attribute__((ext_vector_type(4)));
typedef unsigned v2u __attribute__((ext_vector_type(2)));
typedef float f32x4 __attribute__((ext_vector_type(4)));
typedef float f32x2 __attribute__((ext_vector_type(2)));
typedef float f32x16 __attribute__((ext_vector_type(16)));
typedef short bf16x8 __attribute__((ext_vector_type(8)));
typedef short s16x4 __attribute__((ext_vector_type(4)));
typedef GAS unsigned gu32;
#define RLX_AGENT __ATOMIC_RELAXED, __HIP_MEMORY_SCOPE_AGENT
#define LDS_WAIT() asm volatile("s_waitcnt lgkmcnt(0)" ::: "memory")
#define VM_WAIT() asm volatile("s_waitcnt vmcnt(0)" ::: "memory")
__device__ __forceinline__ unsigned f2bf(float f) { unsigned u = __builtin_bit_cast(unsigned, f); return (u + 0x7fffu + ((u >> 16) & 1u)) >> 16; }
__device__ __forceinline__ unsigned pk2(float lo, float hi) { return f2bf(lo) | (f2bf(hi) << 16); }
__device__ __forceinline__ float bf2f(unsigned b) { return __builtin_bit_cast(float, b << 16); }
__device__ __forceinline__ float bflo(unsigned w) { return __builtin_bit_cast(float, w << 16); }
__device__ __forceinline__ float bfhi(unsigned w) { return __builtin_bit_cast(float, w & 0xffff0000u); }
__device__ __forceinline__ float silu(float v) { return v / (1.0f + __expf(-v)); }
template <int K> __device__ __forceinline__ float swz_xor(float v) { return __builtin_bit_cast(float, __builtin_amdgcn_ds_swizzle(__builtin_bit_cast(int, v), (K << 10) | 0x1f)); }
__device__ __forceinline__ float half_sum(float v) { v += swz_xor<1>(v); v += swz_xor<2>(v); v += swz_xor<4>(v); v += swz_xor<8>(v); v += swz_xor<16>(v); return v; }
__device__ __forceinline__ float wave_sum(float v) { v = half_sum(v);
    auto rr = __builtin_amdgcn_permlane32_swap(__builtin_bit_cast(unsigned, v), __builtin_bit_cast(unsigned, v), false, false);
    const unsigned r0 = rr[0], r1 = rr[1];
    return __uint_as_float(r0) + __uint_as_float(r1); }

#define XB_TMO      128
#define XB_XCNT(j)  (256  + 64 * (j))
#define XB_XSUB(j)  (1280 + 64 * (j))
#define XB_XGEN(j)  (2304 + 64 * (j))
#define XB_TOP      3328
#define XB_TOPGEN   3392
#define XCD_BAR_WORDS 3456
#define XB_SPIN_CAP (1u << 18)
__device__ __forceinline__ unsigned xb_ld(unsigned* p)              { return __hip_atomic_load(p, __ATOMIC_RELAXED, __HIP_MEMORY_SCOPE_AGENT); }
__device__ __forceinline__ unsigned xb_add(unsigned* p, unsigned v) { return __hip_atomic_fetch_add(p, v, __ATOMIC_RELAXED, __HIP_MEMORY_SCOPE_AGENT); }
__device__ __forceinline__ unsigned xb_xcc_id() { return (unsigned)__builtin_amdgcn_s_getreg((3 << 11) | 20) & 0xFu; }
#define XB_SPIN(cond, bar) do { unsigned _sp = 0; while (cond) { __builtin_amdgcn_s_sleep(1); \
    if ((++_sp & 255u) == 0u) { if (xb_ld(&(bar)[XB_TMO])) break; if (_sp > XB_SPIN_CAP) { atomicAdd(&(bar)[XB_TMO], 1u); break; } } } } while (0)
struct XcdBarrier { unsigned* bar; unsigned x; volatile LAS unsigned* st; };
__device__ __forceinline__ XcdBarrier xcd_barrier_post(unsigned* bar, volatile LAS unsigned* st) {
    XcdBarrier b; b.bar = bar; b.x = xb_xcc_id(); b.st = st;
    if (threadIdx.x == 0) (void)xb_add(&bar[XB_XCNT(b.x)], 1u);
    return b;
}
__device__ __forceinline__ void xcd_barrier_complete(unsigned* bar, unsigned x, unsigned& nloc, unsigned& nx) {
    const unsigned G = gridDim.x * gridDim.y * gridDim.z;
    unsigned sum, cnt, mine, sp = 0u;
    for (;;) {
        sum = 0u; cnt = 0u; mine = 0u;
#pragma unroll
        for (unsigned j = 0; j < 16; ++j) { const unsigned c = xb_ld(&bar[XB_XCNT(j)]); sum += c; cnt += (c > 0u) ? 1u : 0u; mine = (j == x) ? c : mine; }
        if (sum == G) break;
        __builtin_amdgcn_s_sleep(1);
        if ((++sp & 255u) == 0u) { if (xb_ld(&bar[XB_TMO])) break; if (sp > XB_SPIN_CAP) { atomicAdd(&bar[XB_TMO], 1u); break; } }
    }
    nloc = mine > 0u ? mine : 1u; nx = cnt > 0u ? cnt : 1u;
}
__device__ __forceinline__ void xcd_barrier(const XcdBarrier& b) {
    asm volatile("s_waitcnt vmcnt(0)" ::: "memory");
    __syncthreads();
    if (threadIdx.x == 0) {
        unsigned* bar = b.bar;
        __builtin_amdgcn_s_waitcnt(0);
        unsigned nloc = b.st[0], nx = b.st[1];
        if (nloc == 0u) { xcd_barrier_complete(bar, b.x, nloc, nx); b.st[0] = nloc; b.st[1] = nx; }
        const unsigned old = xb_add(&bar[XB_XSUB(b.x)], 1u);
        const unsigned gen = old / nloc;
        if (old + 1u == (gen + 1u) * nloc) {
            __builtin_amdgcn_fence(__ATOMIC_RELEASE, "agent");
            asm volatile("s_waitcnt vmcnt(0)" ::: "memory");
            const unsigned og = xb_add(&bar[XB_TOP], 1u);
            const unsigned tg = og / nx;
            if (og + 1u == (tg + 1u) * nx) xb_add(&bar[XB_TOPGEN], 1u);
            else XB_SPIN(xb_ld(&bar[XB_TOPGEN]) == tg, bar);
            __builtin_amdgcn_fence(__ATOMIC_ACQUIRE, "agent");
            xb_add(&bar[XB_XGEN(b.x)], 1u);
            asm volatile("s_waitcnt vmcnt(0)" ::: "memory");
        } else {
            XB_SPIN(xb_ld(&bar[XB_XGEN(b.x)]) == gen, bar);
            __builtin_amdgcn_fence(__ATOMIC_ACQUIRE, "agent");
            asm volatile("s_waitcnt vmcnt(0)" ::: "memory");
        }
    }
    __syncthreads();
}

struct Args {
    const float* in[35]; float* out; unsigned char* ws; int ph_lo, ph_hi;
};
enum { I_X = 0, I_WIN, I_QNORM, I_WUQ, I_KVNORM, I_WUKV, I_OUTNORM, I_CONVW, I_CONVB, I_DTBIAS, I_ALOG, I_SSDD, I_SSDNORM, I_HYCW, I_HYCB, I_HYW1, I_HYB1, I_HYW2, I_HYB2, I_HYW3, I_HYFREQ, I_HYBIAS, I_HYNORM,
       I_WOUT, I_LN1G, I_LN1B, I_LN2G, I_LN2B, I_FFG, I_FFU, I_FFD, I_ROUTER, I_MOEG, I_MOEU, I_MOED };

typedef __attribute__((address_space(4))) const Args CArgs;
struct AP { const CArgs* p;
    __device__ __forceinline__ const float* in(int i) const { return p->in[i]; }
    __device__ __forceinline__ float* out() const { return p->out; }
    __device__ __forceinline__ unsigned char* ws() const { return p->ws; } };
__device__ __forceinline__ AP kargs() { const CArgs* p = (const CArgs*)__builtin_amdgcn_kernarg_segment_ptr(); asm volatile("" : "+s"(p)); AP a; a.p = p; return a; }

__device__ __forceinline__ void transpose_item(const float* W, int K, int N, int nblk, bf16* WT, int GR, int GS, int off, LAS float* scr, int item, int lane) {
    const int kb = item / nblk, nb = item % nblk, k0 = 64 * kb, n0 = 32 * nb;
    const int nr = n0 + (lane & 31); const bool ok = nr < N;
    float tv[32]; const int nrc = ok ? nr : N - 1;
#pragma unroll
    for (int i = 0; i < 32; ++i) { const int kk = 2 * i + (lane >> 5); tv[i] = W[(size_t)(k0 + kk) * N + nrc]; }
#pragma unroll
    for (int i = 0; i < 32; ++i) { const int kk = 2 * i + (lane >> 5); scr[kk * 33 + (lane & 31)] = ok ? tv[i] : 0.f; }
    LDS_WAIT(); asm volatile("" ::: "memory");
    const int c = lane & 7;
#pragma unroll
    for (int j = 0; j < 4; ++j) { const int nl = (lane >> 3) + 8 * j; const int n = n0 + nl; const LAS float* s = scr + (8 * c) * 33 + nl;
        v4u o; o.x = pk2(s[0 * 33], s[1 * 33]); o.y = pk2(s[2 * 33], s[3 * 33]); o.z = pk2(s[4 * 33], s[5 * 33]); o.w = pk2(s[6 * 33], s[7 * 33]);
        const int dest = (n / GR) * GS + (n % GR) + off;
        *(GAS v4u*)(WT + (size_t)dest * K + k0 + 8 * c) = o; }
    LDS_WAIT(); asm volatile("" ::: "memory");
}
__device__ __forceinline__ unsigned pk4_fp8(float a, float b, float c, float d) { int w = 0; w = __builtin_amdgcn_cvt_pk_fp8_f32(a, b, w, false); w = __builtin_amdgcn_cvt_pk_fp8_f32(c, d, w, true); return (unsigned)w; }
struct TrF8 { const float* W; int K, N, nblk; unsigned char* WT; int GR, GS, off; float scl; };
__device__ __forceinline__ void tr_f8_load(const TrF8& j, int item, int lane, float (&tv)[32]) {
    const int kb = item / j.nblk, nb = item % j.nblk, k0 = 64 * kb, n0 = 32 * nb; const int nr = n0 + (lane & 31);
#pragma unroll
    for (int i = 0; i < 32; ++i) { const int kk = 2 * i + (lane >> 5); tv[i] = j.W[(size_t)(k0 + kk) * j.N + nr]; }
}
__device__ __forceinline__ void tr_f8_finish(const TrF8& j, int item, int lane, const float (&tv)[32], LAS float* scr) {
    const int kb = item / j.nblk, nb = item % j.nblk, k0 = 64 * kb, n0 = 32 * nb;
#pragma unroll
    for (int i = 0; i < 32; ++i) { const int kk = 2 * i + (lane >> 5); scr[kk * 33 + (lane & 31)] = tv[i] * j.scl; }
    LDS_WAIT(); asm volatile("" ::: "memory");
    const int nl = lane >> 1, hf = lane & 1, n = n0 + nl; const LAS float* sp = scr + (32 * hf) * 33 + nl;
    v4u o0, o1;
    o0.x = pk4_fp8(sp[0 * 33], sp[1 * 33], sp[2 * 33], sp[3 * 33]); o0.y = pk4_fp8(sp[4 * 33], sp[5 * 33], sp[6 * 33], sp[7 * 33]);
    o0.z = pk4_fp8(sp[8 * 33], sp[9 * 33], sp[10 * 33], sp[11 * 33]); o0.w = pk4_fp8(sp[12 * 33], sp[13 * 33], sp[14 * 33], sp[15 * 33]);
    o1.x = pk4_fp8(sp[16 * 33], sp[17 * 33], sp[18 * 33], sp[19 * 33]); o1.y = pk4_fp8(sp[20 * 33], sp[21 * 33], sp[22 * 33], sp[23 * 33]);
    o1.z = pk4_fp8(sp[24 * 33], sp[25 * 33], sp[26 * 33], sp[27 * 33]); o1.w = pk4_fp8(sp[28 * 33], sp[29 * 33], sp[30 * 33], sp[31 * 33]);
    const int dest = (n / j.GR) * j.GS + (n % j.GR) + j.off;
    GAS v4u* dp = (GAS v4u*)(j.WT + (size_t)dest * j.K + k0 + 32 * hf); dp[0] = o0; dp[1] = o1;
    LDS_WAIT(); asm volatile("" ::: "memory");
}
__device__ __forceinline__ void transpose_item_f8(const float* W, int K, int N, int nblk, unsigned char* WT, int GR, int GS, int off, float scl, LAS float* scr, int item, int lane) {
    TrF8 j{W, K, N, nblk, WT, GR, GS, off, scl}; float tv[32]; tr_f8_load(j, item, lane, tv); tr_f8_finish(j, item, lane, tv, scr);
}
struct TrJob { const float* W; int K, N, nblk; bf16* WT; int GR, GS, off; int items; };
__device__ __forceinline__ TrJob mk_job(const float* W, int K, int N, int Npad, bf16* WT, int GR, int GS, int off) { TrJob j; j.W = W; j.K = K; j.N = N; j.nblk = Npad / 32; j.WT = WT; j.GR = GR; j.GS = GS; j.off = off; j.items = (K / 64) * (Npad / 32); return j; }

__device__ __forceinline__ void hyena_filter_item(const AP& a, int layer, int pos, bf16* HYG, LAS float* scr, int lane) {
    const float* w1 = a.in(I_HYW1) + layer * 33 * 64; const float* b1 = a.in(I_HYB1) + layer * 64;
    const float* w2 = a.in(I_HYW2) + layer * 64 * 64; const float* b2 = a.in(I_HYB2) + layer * 64;
    const float* w3 = a.in(I_HYW3) + (size_t)layer * 64 * 2048; const float* fr = a.in(I_HYFREQ) + layer * 128;
    const float t = (float)pos / 2047.0f; const float ang = 6.283185307179586f * (float)pos / 2048.0f;
    if (lane < 33) { float z;
        if (lane == 0) z = t;
        else { const int k = (lane - 1) & 15; const float f = 1e-4f + (float)k * ((15.0f - 1e-4f) / 15.0f); z = (lane <= 16) ? cosf(f * ang) : -sinf(f * ang); }
        scr[lane] = z; }
    LDS_WAIT(); asm volatile("" ::: "memory");
    float s = b1[lane];
    for (int i = 0; i < 33; ++i) s += scr[i] * w1[i * 64 + lane];
    const float h1 = sinf(fr[lane] * s);
    scr[64 + lane] = h1;
    LDS_WAIT(); asm volatile("" ::: "memory");
    float s2 = b2[lane];
    for (int i = 0; i < 64; ++i) s2 += scr[64 + i] * w2[i * 64 + lane];
    const float h2 = sinf(fr[64 + lane] * s2);
    scr[128 + lane] = h2;
    LDS_WAIT(); asm volatile("" ::: "memory");
    for (int m = 0; m < 32; ++m) { const int col = lane + 64 * m; float v = 0.f;
        for (int i = 0; i < 64; ++i) v += scr[128 + i] * w3[(size_t)i * 2048 + col];
        const int o = col >> 10, dir = (col >> 9) & 1, c = col & 511;
        const float delta = fabsf(-3.0701134573253945f + (float)c * ((-15.350567286626973f + 3.0701134573253945f) / 511.0f));
        v *= expf(-t * delta);
        if (dir == 0 || pos > 0) { const int n = dir == 0 ? HY_OFF - pos : HY_OFF + pos;
            HYG[(((size_t)layer * 2 + o) * 512 + c) * HY_GLEN + n] = (bf16)f2bf(v); } }
    LDS_WAIT(); asm volatile("" ::: "memory");
}

__device__ __forceinline__ void ln_load(const float* xrow, int lane, f32x4 (&v)[8]) { const GAS f32x4* xr = (const GAS f32x4*)xrow + lane;
#pragma unroll
    for (int j = 0; j < 8; ++j) v[j] = xr[64 * j]; }
__device__ __forceinline__ void ln_row(float* xrow, bf16* brow, const float* g, const float* b, int lane, f32x4 (&v)[8], const bf16* y0, const bf16* y1, float* orow, unsigned char* frow = nullptr) {
    float s = 0.f; (void)xrow;
#pragma unroll
    for (int j = 0; j < 8; ++j) {
        if (y0) { v2u a0 = *((const GAS v2u*)y0 + lane + 64 * j), a1 = *((const GAS v2u*)y1 + lane + 64 * j); if (ZERO_MOE) { a0.x = a0.y = a1.x = a1.y = 0u; }
            v[j].x = ALPHA * v[j].x + bflo(a0.x) + bflo(a1.x); v[j].y = ALPHA * v[j].y + bfhi(a0.x) + bfhi(a1.x); v[j].z = ALPHA * v[j].z + bflo(a0.y) + bflo(a1.y); v[j].w = ALPHA * v[j].w + bfhi(a0.y) + bfhi(a1.y); }
        s += (v[j].x + v[j].y) + (v[j].z + v[j].w); }
    const float mean = wave_sum(s) * (1.f / DM); float s2 = 0.f;
#pragma unroll
    for (int j = 0; j < 8; ++j) { v[j] = v[j] - mean; s2 += (v[j].x * v[j].x + v[j].y * v[j].y) + (v[j].z * v[j].z + v[j].w * v[j].w); }
    const float rstd = 1.f / sqrtf(wave_sum(s2) * (1.f / DM) + 1e-5f);
    GAS f32x4* xo = (GAS f32x4*)orow + lane;
#pragma unroll
    for (int j = 0; j < 8; ++j) { const f32x4 gg = *((const GAS f32x4*)g + lane + 64 * j), bb = *((const GAS f32x4*)b + lane + 64 * j);
        v[j] = v[j] * rstd * gg + bb; xo[64 * j] = v[j];
        if (brow) { v2u w; w.x = pk2(v[j].x, v[j].y); w.y = pk2(v[j].z, v[j].w); *((GAS v2u*)brow + lane + 64 * j) = w; }
        if (frow) *((GAS unsigned*)frow + lane + 64 * j) = pk4_fp8(v[j].x, v[j].y, v[j].z, v[j].w); }
}

__device__ __forceinline__ void ld8bf(const bf16* p, float (&f)[8]) { const v4u w = *(const GAS v4u*)p; f[0] = bflo(w.x); f[1] = bfhi(w.x); f[2] = bflo(w.y); f[3] = bfhi(w.y); f[4] = bflo(w.z); f[5] = bfhi(w.z); f[6] = bflo(w.w); f[7] = bfhi(w.w); }
__device__ __forceinline__ void st8bf(bf16* p, const float (&f)[8]) { v4u w; w.x = pk2(f[0], f[1]); w.y = pk2(f[2], f[3]); w.z = pk2(f[4], f[5]); w.w = pk2(f[6], f[7]); *(GAS v4u*)p = w; }

__device__ __forceinline__ float sum8(float v) { v += swz_xor<1>(v); v += swz_xor<2>(v); v += swz_xor<4>(v); return v; }
__device__ __forceinline__ void prep_rows8(const AP& a, int layer, int item, int lane, unsigned char* ws, const LAS float* cwl) {
    const int rr = lane >> 3, sub = lane & 7, row = item * 8 + rr, t = row & (SEQ - 1);
    const bf16* pr = (const bf16*)(ws + WS_PROJ) + (size_t)row * NINP;
    { float f[6][8]; float ss = 0.f;
#pragma unroll
      for (int i = 0; i < 6; ++i) { ld8bf(pr + C_QC + (sub + 8 * i) * 8, f[i]);
#pragma unroll
          for (int j = 0; j < 8; ++j) ss += f[i][j] * f[i][j]; }
      const float rs = 1.0f / sqrtf(sum8(ss) * (1.f / 384.f) + 1e-6f);
#pragma unroll
      for (int i = 0; i < 6; ++i) { const float* w = a.in(I_QNORM) + layer * 384 + (sub + 8 * i) * 8;
#pragma unroll
          for (int j = 0; j < 8; ++j) f[i][j] = f[i][j] * rs * w[j];
          st8bf((bf16*)(ws + WS_QN) + (size_t)row * 384 + (sub + 8 * i) * 8, f[i]); } }
    { float f[4][8]; float ss = 0.f;
#pragma unroll
      for (int i = 0; i < 4; ++i) { ld8bf(pr + C_KVC + (sub + 8 * i) * 8, f[i]);
#pragma unroll
          for (int j = 0; j < 8; ++j) ss += f[i][j] * f[i][j]; }
      const float rs = 1.0f / sqrtf(sum8(ss) * (1.f / 256.f) + 1e-6f);
#pragma unroll
      for (int i = 0; i < 4; ++i) { const float* w = a.in(I_KVNORM) + layer * 256 + (sub + 8 * i) * 8;
#pragma unroll
          for (int j = 0; j < 8; ++j) f[i][j] = f[i][j] * rs * w[j];
          st8bf((bf16*)(ws + WS_KVN) + (size_t)row * 256 + (sub + 8 * i) * 8, f[i]); } }
    { float sn[4], cs[4];
#pragma unroll
      for (int j = 0; j < 4; ++j) { const float inv = exp2f(-(float)(4 * sub + j) * (13.287712379549449f / 32.0f)); sincosf((float)t * inv, &sn[j], &cs[j]); }
#pragma unroll
      for (int g = 0; g < 9; ++g) { int src; bf16* dst; float sc = 1.f;
          if (g == 0) { src = C_KPE; dst = (bf16*)(ws + WS_KPE) + (size_t)row * 64; }
          else if (g < 5) { src = C_RQ + (g - 1) * 64; dst = (bf16*)(ws + WS_RQ) + (size_t)row * 256 + (g - 1) * 64; }
          else { src = C_RK + (g - 5) * 64; dst = (bf16*)(ws + WS_RK) + (size_t)row * 256 + (g - 5) * 64; sc = 0.125f; }
          const v2u a1 = *(const GAS v2u*)(pr + src + 4 * sub), a2 = *(const GAS v2u*)(pr + src + 32 + 4 * sub);
          const float x1[4] = {bflo(a1.x), bfhi(a1.x), bflo(a1.y), bfhi(a1.y)}, x2[4] = {bflo(a2.x), bfhi(a2.x), bflo(a2.y), bfhi(a2.y)};
          float y1[4], y2[4];
#pragma unroll
          for (int j = 0; j < 4; ++j) { y1[j] = (x1[j] * cs[j] - x2[j] * sn[j]) * sc; y2[j] = (x2[j] * cs[j] + x1[j] * sn[j]) * sc; }
          v2u o1, o2; o1.x = pk2(y1[0], y1[1]); o1.y = pk2(y1[2], y1[3]); o2.x = pk2(y2[0], y2[1]); o2.y = pk2(y2[2], y2[3]);
          *(GAS v2u*)(dst + 4 * sub) = o1; *(GAS v2u*)(dst + 32 + 4 * sub) = o2; } }
#pragma unroll 4
    for (int i = 0; i < 16; ++i) { const int c0 = (sub + 8 * i) * 8; float acc[8];
        { const f32x4 b0 = *(const LAS f32x4*)(cwl + 5 * 1024 + c0), b1 = *(const LAS f32x4*)(cwl + 5 * 1024 + c0 + 4); acc[0] = b0.x; acc[1] = b0.y; acc[2] = b0.z; acc[3] = b0.w; acc[4] = b1.x; acc[5] = b1.y; acc[6] = b1.z; acc[7] = b1.w; }
#pragma unroll
        for (int k = 0; k < 5; ++k) { const int tt = t + k - 2;
            if (tt >= 0 && tt < SEQ) { float f[8]; ld8bf(pr + (long)(k - 2) * NINP + C_XBC + c0, f);
                const f32x4 w0 = *(const LAS f32x4*)(cwl + k * 1024 + c0), w1 = *(const LAS f32x4*)(cwl + k * 1024 + c0 + 4);
                acc[0] += w0.x * f[0]; acc[1] += w0.y * f[1]; acc[2] += w0.z * f[2]; acc[3] += w0.w * f[3]; acc[4] += w1.x * f[4]; acc[5] += w1.y * f[5]; acc[6] += w1.z * f[6]; acc[7] += w1.w * f[7]; } }
#pragma unroll
        for (int j = 0; j < 8; ++j) acc[j] = silu(acc[j]);
        st8bf((bf16*)(ws + WS_XBC) + (size_t)row * 1024 + c0, acc); }
}
__device__ __forceinline__ void prep_scan(const AP& a, int layer, int item, int lane, unsigned char* ws, LAS float* scr) {
    const int b = item >> 4, dir = (item >> 3) & 1, hh = item & 7;
    const float* DTF = (const float*)(ws + WS_DTF); float* SSDP = (float*)(ws + WS_SSDP);
    const float bias = a.in(I_DTBIAS)[layer * 16 + dir * 8 + hh]; const float av = -expf(a.in(I_ALOG)[layer * 16 + dir * 8 + hh]);
    float dt[32]; float tot = 0.f;
#pragma unroll
    for (int j = 0; j < 32; ++j) { const int row = b * SEQ + lane * 32 + j; const float x = DTF[(size_t)row * 16 + dir * 8 + hh] + bias;
        dt[j] = x > 20.f ? x : log1pf(expf(x)); tot += dt[j] * av; }
    scr[lane] = tot; LDS_WAIT(); asm volatile("" ::: "memory");
    float excl = 0.f, T = 0.f;
#pragma unroll 2
    for (int l = 0; l < 64; ++l) { const float v = scr[l]; T += v; excl += (l < lane) ? v : 0.f; }
    LDS_WAIT(); asm volatile("" ::: "memory");
    float run = excl;
#pragma unroll
    for (int j = 0; j < 32; ++j) { const int row = b * SEQ + lane * 32 + j; const float la = dt[j] * av; float c;
        if (dir == 0) { run += la; c = run; } else { c = T - run; run += la; }
        f32x2 o; o.x = c * 1.4426950408889634f; o.y = log2f(dt[j]) - o.x;
        *(GAS f32x2*)(SSDP + ((size_t)row * 8 + hh) * 4 + dir * 2) = o; }
}
__device__ __forceinline__ void prep_hyconv(const AP& a, int layer, int item, int lane, unsigned char* ws, LAS bf16* scr) {
    const int cg = item % 24, tt = (item / 24) & 31, b = item / (24 * 32);
    const int ch = cg * 64 + lane, part = ch >> 9, c = ch & 511, t0 = tt * 64;
    const bf16* PROJ = (const bf16*)(ws + WS_PROJ); const bf16* tile = PROJ + (size_t)(b * SEQ) * NINP + C_HU + cg * 64;
    v4u ld[9];
#pragma unroll
    for (int i = 0; i < 9; ++i) { const int id = lane + 64 * i, r = id >> 3, c8 = id & 7, t = t0 - 1 + r;
        ld[i] = (id < 66 * 8 && t >= 0 && t < SEQ) ? *(const GAS v4u*)(tile + (size_t)t * NINP + c8 * 8) : (v4u){0u, 0u, 0u, 0u}; }
#pragma unroll
    for (int i = 0; i < 9; ++i) { const int id = lane + 64 * i, r = id >> 3, c8 = id & 7; if (id < 66 * 8) *(LAS v4u*)(scr + r * 72 + c8 * 8) = ld[i]; }
    const float* cw = a.in(I_HYCW) + layer * 3 * 1536; const float w0 = cw[ch], w1 = cw[1536 + ch], w2 = cw[3072 + ch], bs = a.in(I_HYCB)[layer * 1536 + ch];
    LDS_WAIT(); asm volatile("" ::: "memory");
    float xm = bf2f(scr[lane]), x0 = bf2f(scr[72 + lane]);
    bf16* dst = (bf16*)(ws + WS_UT) + (((size_t)part * 512 + c) * NB + b) * SEQ + t0;
#pragma unroll
    for (int q = 0; q < 8; ++q) { float u[8];
#pragma unroll
        for (int j = 0; j < 8; ++j) { const float xp = bf2f(scr[(q * 8 + j + 2) * 72 + lane]);
            u[j] = bs + w0 * xm + w1 * x0 + w2 * xp; xm = x0; x0 = xp; }
        st8bf(dst + q * 8, u); }
    LDS_WAIT(); asm volatile("" ::: "memory");
}

__device__ __forceinline__ void post_row(const AP& a, int layer, int row, int lane, unsigned char* ws) {
    bf16* MIX = (bf16*)(ws + WS_MIX) + (size_t)row * DM;
    { float f[8]; ld8bf((const bf16*)(ws + WS_ATT) + (size_t)row * 512 + lane * 8, f); float ss = 0.f;
#pragma unroll
      for (int j = 0; j < 8; ++j) ss += f[j] * f[j];
      const float rs = 1.0f / sqrtf(wave_sum(ss) * (1.f / 512.f) + 1e-6f); const float* w = a.in(I_OUTNORM) + layer * 512 + lane * 8;
#pragma unroll
      for (int j = 0; j < 8; ++j) f[j] = ZERO_A ? 0.f : f[j] * rs * w[j];
      st8bf(MIX + lane * 8, f); }
    { float f[8], z[8]; ld8bf((const bf16*)(ws + WS_YC) + (size_t)row * 512 + lane * 8, f); ld8bf((const bf16*)(ws + WS_PROJ) + (size_t)row * NINP + C_MZ + lane * 8, z); float ss = 0.f;
#pragma unroll
      for (int j = 0; j < 8; ++j) { f[j] = f[j] * silu(z[j]); ss += f[j] * f[j]; }
      const float rs = 1.0f / sqrtf(wave_sum(ss) * (1.f / 512.f) + 1e-6f); const float* w = a.in(I_SSDNORM) + layer * 512 + lane * 8;
#pragma unroll
      for (int j = 0; j < 8; ++j) f[j] = ZERO_C ? 0.f : f[j] * rs * w[j];
      st8bf(MIX + 1024 + lane * 8, f); }
}
__device__ __forceinline__ void post_hy(const AP& a, int layer, int item, int lane, unsigned char* ws, LAS bf16* scr) {
    const int b = item >> 7, t0 = (item & 127) * 16, tl = lane & 15, cs = lane >> 4;
    const bf16* ZT = (const bf16*)(ws + WS_ZT) + (size_t)b * SEQ + t0 + tl; const float* w = a.in(I_HYNORM) + layer * 512;
    float ss = 0.f;
#pragma unroll 16
    for (int cc = 0; cc < 128; ++cc) { const float v = bf2f(ZT[(size_t)(cc * 4 + cs) * M]); ss += v * v; }
    ss += swz_xor<16>(ss);
    { auto rr = __builtin_amdgcn_permlane32_swap(__float_as_uint(ss), __float_as_uint(ss), false, false); const unsigned r0 = rr[0], r1 = rr[1]; ss = __uint_as_float(r0) + __uint_as_float(r1); }
    const float rs = 1.0f / sqrtf(ss * (1.f / 512.f) + 1e-6f);
    for (int cg = 0; cg < 8; ++cg) {
#pragma unroll
        for (int jj = 0; jj < 16; ++jj) { const int cl = jj * 4 + cs, c = cg * 64 + cl; scr[tl * 72 + cl] = (bf16)f2bf(ZERO_D ? 0.f : bf2f(ZT[(size_t)c * M]) * rs * w[c]); }
        LDS_WAIT(); asm volatile("" ::: "memory");
#pragma unroll
        for (int i = 0; i < 2; ++i) { const int t2 = (lane >> 3) + 8 * i, c8 = lane & 7; const v4u v = *(const LAS v4u*)(scr + t2 * 72 + c8 * 8);
            *(GAS v4u*)((bf16*)(ws + WS_MIX) + (size_t)(b * SEQ + t0 + t2) * DM + 1536 + cg * 64 + c8 * 8) = v; }
        LDS_WAIT(); asm volatile("" ::: "memory");
    }
}

namespace mixb {
#define SBAR() __builtin_amdgcn_sched_barrier(0)
__device__ __forceinline__ int crow(int r, int hi) { return (r & 3) + 8 * (r >> 2) + 4 * hi; }
__device__ __forceinline__ unsigned cvtpk(float lo, float hi) { unsigned r; asm volatile("v_cvt_pk_bf16_f32 %0, %1, %2" : "=v"(r) : "v"(lo), "v"(hi)); return r; }
__device__ __forceinline__ int v_st(int k, int c) { const int kk = (k & ~0xC) | ((k & 4) << 1) | ((k & 8) >> 1); return ((kk >> 3) * 4 + (c >> 5)) * 512 + ((kk & 7) * 32 + (c & 31)) * 2; }
__device__ __forceinline__ int v_rd_base(int lane) { return ((lane & 3) << 3) | (((lane >> 2) & 3) << 6) | (((lane >> 4) & 1) << 5) | (((lane >> 5) & 1) << 8); }
constexpr int v_rd_off(int d0, int ks, int half) { return d0 * 512 + ks * 4096 + half * 2048; }
template <int OFF> __device__ __forceinline__ s16x4 tr_read(int vb) { s16x4 r; asm volatile("ds_read_b64_tr_b16 %0, %1 offset:%2" : "=&v"(r) : "v"(vb), "i"(OFF) : "memory"); return r; }
template <int D0> __device__ __forceinline__ void pv_one(f32x16& od, int vb, bf16x8 pa0, bf16x8 pa1, bf16x8 pa2, bf16x8 pa3) {
    const s16x4 l0 = tr_read<v_rd_off(D0, 0, 0)>(vb), h0 = tr_read<v_rd_off(D0, 0, 1)>(vb), l1 = tr_read<v_rd_off(D0, 1, 0)>(vb), h1 = tr_read<v_rd_off(D0, 1, 1)>(vb);
    const s16x4 l2 = tr_read<v_rd_off(D0, 2, 0)>(vb), h2 = tr_read<v_rd_off(D0, 2, 1)>(vb), l3 = tr_read<v_rd_off(D0, 3, 0)>(vb), h3 = tr_read<v_rd_off(D0, 3, 1)>(vb);
    asm volatile("s_waitcnt lgkmcnt(0)" ::: "memory"); SBAR();
#define PKV(L, H) (bf16x8){L[0], L[1], L[2], L[3], H[0], H[1], H[2], H[3]}
    od = __builtin_amdgcn_mfma_f32_32x32x16_bf16(pa0, PKV(l0, h0), od, 0, 0, 0);
    od = __builtin_amdgcn_mfma_f32_32x32x16_bf16(pa1, PKV(l1, h1), od, 0, 0, 0);
    od = __builtin_amdgcn_mfma_f32_32x32x16_bf16(pa2, PKV(l2, h2), od, 0, 0, 0);
    od = __builtin_amdgcn_mfma_f32_32x32x16_bf16(pa3, PKV(l3, h3), od, 0, 0, 0);
#undef PKV
}
__device__ __forceinline__ void fast_sincos(float x, float& s, float& c) { float r = x * 0.15915494309189535f; r = r - floorf(r); s = __builtin_amdgcn_sinf(r); c = __builtin_amdgcn_cosf(r); }

struct MixP {
    const bf16* q; int ldq;
    const bf16* k0; int ldk0; const bf16* k1; int ldk1;
    const bf16* v; int ldv;
    bf16* o; int ldo;
    float lf, lb;
    const float* ssdp;
    const bf16* aux; int ldaux; float dh;
};
constexpr int V_BYTES = 16384, V_OFF = 0, K_OFF = 2 * V_BYTES;
template <int DQK> struct KL { static constexpr int PITCH = DQK * 2, BYTES = 64 * PITCH, WK_OFF = K_OFF + 2 * BYTES, SCR_OFF = WK_OFF + 1024, END = SCR_OFF + NWAVES * 256; };

template <int MODE, int DQK, int DV>
__device__ __forceinline__ void mix_unit(const MixP& P, int q0, LAS unsigned char* lds, int tid) {
    typedef KL<DQK> L;
    constexpr int ND = DQK / 16, NV = DV / 32, CPR = DQK / 8, KCH = 64 * CPR / 512, VPR = DV / 8, VCH = (64 * VPR + 511) / 512;
    constexpr float SCALE = 0.07216878364870322f;
    constexpr float C = SCALE * 1.4426950408889634f, THR = 8.f;
    asm volatile("" : "+v"(tid));
    const int wid = tid >> 6, lane = tid & 63, r32 = lane & 31, hi = lane >> 5;
    const int qrow = q0 + wid * 32 + r32;
    LAS unsigned char* Vl = lds + V_OFF; LAS unsigned char* Kl = lds + K_OFF;
    LAS float* wsc = (LAS float*)(lds + L::SCR_OFF) + wid * 64; LAS float* li_l = wsc; LAS float* al_l = wsc + 32;
    LAS f32x2* wk_l = (LAS f32x2*)(lds + L::WK_OFF);
    bf16x8 qr[ND];
    { const bf16* Qw = P.q + (long)qrow * P.ldq + hi * 8;
#pragma unroll
      for (int d0 = 0; d0 < ND; ++d0) qr[d0] = *(const GAS bf16x8*)(Qw + d0 * 16); }
    if constexpr (MODE == 0) {
#pragma unroll
        for (int dd = 0; dd < 2; ++dd)
#pragma unroll
            for (int j = 0; j < 8; ++j) { const int i = dd * 16 + hi * 8 + j; const float inv = exp2f(-(float)i * (13.287712379549449f / 32.0f)); float sn, cs; fast_sincos((float)qrow * inv, sn, cs);
                const float x1 = bf2f((unsigned short)qr[8 + dd][j]), x2 = bf2f((unsigned short)qr[10 + dd][j]);
                qr[8 + dd][j] = (short)f2bf(x1 * cs - x2 * sn); qr[10 + dd][j] = (short)f2bf(x2 * cs + x1 * sn); }
    }
    float cf_i = 0.f, rb_i = 0.f;
    if constexpr (MODE == 2) { const f32x4 w = *(const GAS f32x4*)(P.ssdp + (size_t)qrow * 32); cf_i = w.x; rb_i = w.z; }
    bf16x8 ks[KCH], vs[VCH]; f32x4 wkreg = {0.f, 0.f, 0.f, 0.f};
#define MX_SLOAD(kr0) do { \
    _Pragma("unroll") for (int i = 0; i < KCH; ++i) { const int cid = tid + 512 * i, row = cid / CPR, c8 = cid % CPR; \
        const bf16* src = (MODE == 0 && c8 >= 16) ? P.k1 + (long)((kr0) + row) * P.ldk1 + (c8 - 16) * 8 : P.k0 + (long)((kr0) + row) * P.ldk0 + c8 * 8; \
        ks[i] = *(const GAS bf16x8*)src; } \
    _Pragma("unroll") for (int i = 0; i < VCH; ++i) { const int cid = tid + 512 * i, row = cid / VPR, c8 = cid % VPR; \
        if (VCH * 512 == 64 * VPR || cid < 64 * VPR) vs[i] = *(const GAS bf16x8*)(P.v + (long)((kr0) + row) * P.ldv + c8 * 8); } \
    if (MODE == 2) { if (tid < 64) wkreg = *(const GAS f32x4*)(P.ssdp + (size_t)((kr0) + tid) * 32); } } while (0)
#define MX_SWRITE(b) do { \
    _Pragma("unroll") for (int i = 0; i < KCH; ++i) { const int cid = tid + 512 * i, row = cid / CPR, c8 = cid % CPR; \
        *(LAS bf16x8*)(Kl + (b) * L::BYTES + row * L::PITCH + ((c8 * 16) ^ ((row & 7) << 4))) = ks[i]; } \
    _Pragma("unroll") for (int i = 0; i < VCH; ++i) { const int cid = tid + 512 * i, row = cid / VPR, c8 = cid % VPR; \
        if (VCH * 512 == 64 * VPR || cid < 64 * VPR) *(LAS bf16x8*)(Vl + (b) * V_BYTES + v_st(row, c8 * 8)) = vs[i]; } \
    if (MODE == 2) { if (tid < 64) wk_l[(b) * 64 + tid] = (f32x2){wkreg.y, wkreg.w}; } } while (0)
    float m_reg = -1e30f, l_reg = 0.f; f32x16 o[NV];
#pragma unroll
    for (int d = 0; d < NV; ++d) o[d] = f32x16{};
    const int vb0 = (int)(uintptr_t)(Vl) + v_rd_base(lane);
    constexpr int NT = SEQ / 64;
    int jlo = 0, jhi = NT - 1;
    if constexpr (MODE == 2) {
        const int l = lane & 31, qt = q0 >> 6;
        const float cfq = P.ssdp[(size_t)q0 * 32 + 0], rbq = P.ssdp[(size_t)(q0 + 255) * 32 + 2];
        const float cfe = P.ssdp[(size_t)(64 * l + 63) * 32 + 0], rbs = P.ssdp[(size_t)(64 * l) * 32 + 2];
        const bool keep = (l < qt) ? (cfq - cfe > -24.f) : ((l > qt + 3) ? (rbq - rbs > -24.f) : true);
        const unsigned m32 = (unsigned)__ballot(keep);
        jlo = __builtin_amdgcn_readfirstlane(__builtin_ctz(m32)); jhi = __builtin_amdgcn_readfirstlane(31 - __builtin_clz(m32));
    } else if constexpr (MODE == 1) {
        const float dmf = 24.f / (-P.lf), dmb = 24.f / (-P.lb);
        int a = (int)floorf(((float)(q0 - 63) - dmf) * (1.f / 64.f)) + 1; int b = (int)ceilf(((float)(q0 + 255) + dmb) * (1.f / 64.f)) - 1;
        jlo = a < 0 ? 0 : a; jhi = b > NT - 1 ? NT - 1 : b;
        jlo = __builtin_amdgcn_readfirstlane(jlo); jhi = __builtin_amdgcn_readfirstlane(jhi);
    }
    MX_SLOAD(jlo * 64); VM_WAIT(); MX_SWRITE(0); __syncthreads();
    for (int j = jlo; j <= jhi; ++j) {
        const int buf = (j - jlo) & 1; const int kr0 = j * 64;
        if (j < jhi) MX_SLOAD(kr0 + 64);
        f32x16 p0 = f32x16{}, p1 = f32x16{};
        { LAS unsigned char* Kb = Kl + buf * L::BYTES;
#pragma unroll
          for (int dg = 0; dg < ND / 4; ++dg) { bf16x8 kb0[4], kb1[4];
#pragma unroll
              for (int dd = 0; dd < 4; ++dd) { const int cb = ((dg * 4 + dd) * 16 + hi * 8) * 2;
                  kb0[dd] = *(const LAS bf16x8*)(Kb + r32 * L::PITCH + (cb ^ ((r32 & 7) << 4)));
                  kb1[dd] = *(const LAS bf16x8*)(Kb + (32 + r32) * L::PITCH + (cb ^ ((r32 & 7) << 4))); }
              LDS_WAIT(); SBAR();
#pragma unroll
              for (int dd = 0; dd < 4; ++dd) { p0 = __builtin_amdgcn_mfma_f32_32x32x16_bf16(kb0[dd], qr[dg * 4 + dd], p0, 0, 0, 0);
                  p1 = __builtin_amdgcn_mfma_f32_32x32x16_bf16(kb1[dd], qr[dg * 4 + dd], p1, 0, 0, 0); }
              SBAR(); } }
        if constexpr (MODE == 0) {
            float pmax = p0[0];
#pragma unroll
            for (int r = 1; r < 16; ++r) pmax = fmaxf(pmax, p0[r]);
#pragma unroll
            for (int r = 0; r < 16; ++r) pmax = fmaxf(pmax, p1[r]);
            { auto rr = __builtin_amdgcn_permlane32_swap(__float_as_uint(pmax), __float_as_uint(pmax), false, false); pmax = fmaxf(__uint_as_float(rr[0]), __uint_as_float(rr[1])); }
            float mn, alpha;
            if (__all(pmax - m_reg <= THR / SCALE)) { mn = m_reg; alpha = 1.f; }
            else { mn = fmaxf(m_reg, pmax); alpha = __builtin_amdgcn_exp2f((m_reg - mn) * C); m_reg = mn; }
            const float mnC = -mn * C;
#pragma unroll
            for (int r = 0; r < 16; ++r) { p0[r] = __builtin_amdgcn_exp2f(fmaf(p0[r], C, mnC)); p1[r] = __builtin_amdgcn_exp2f(fmaf(p1[r], C, mnC)); }
            if (__any(alpha < 1.f)) { if (hi == 0) al_l[r32] = alpha; LDS_WAIT();
#pragma unroll
                for (int r = 0; r < 16; ++r) { const float av = al_l[crow(r, hi)];
#pragma unroll
                    for (int d = 0; d < NV; ++d) o[d][r] *= av; } }
            float ps = 0.f;
#pragma unroll
            for (int r = 0; r < 16; ++r) ps += p0[r] + p1[r];
            { auto rr = __builtin_amdgcn_permlane32_swap(__float_as_uint(ps), __float_as_uint(ps), false, false); ps = __uint_as_float(rr[0]) + __uint_as_float(rr[1]); }
            l_reg = l_reg * alpha + ps;
        } else if constexpr (MODE == 1) {
#pragma unroll
            for (int r = 0; r < 16; ++r) { const int k0 = kr0 + crow(r, hi), k1 = k0 + 32;
                const float e0 = (k0 <= qrow) ? (float)(qrow - k0) * P.lf : (float)(k0 - qrow) * P.lb;
                const float e1 = (k1 <= qrow) ? (float)(qrow - k1) * P.lf : (float)(k1 - qrow) * P.lb;
                p0[r] *= __builtin_amdgcn_exp2f(e0); p1[r] *= __builtin_amdgcn_exp2f(e1); }
        } else {
#pragma unroll
            for (int r = 0; r < 16; ++r) { const int kk = crow(r, hi); const f32x2 w0 = wk_l[buf * 64 + kk], w1 = wk_l[buf * 64 + 32 + kk];
                const int k0 = kr0 + kk, k1 = k0 + 32;
                const float e0 = (k0 <= qrow) ? cf_i + w0.x : rb_i + w0.y;
                const float e1 = (k1 <= qrow) ? cf_i + w1.x : rb_i + w1.y;
                p0[r] *= __builtin_amdgcn_exp2f(e0); p1[r] *= __builtin_amdgcn_exp2f(e1); }
        }
        bf16x8 pa0, pa1, pa2, pa3;
#define MX_PK4(PP, BASE, OUT) do { const unsigned a0 = cvtpk(PP[BASE + 0], PP[BASE + 1]), a1 = cvtpk(PP[BASE + 2], PP[BASE + 3]); \
    const unsigned b0 = cvtpk(PP[BASE + 4], PP[BASE + 5]), b1 = cvtpk(PP[BASE + 6], PP[BASE + 7]); \
    auto r0 = __builtin_amdgcn_permlane32_swap(a0, b0, false, false); auto r1 = __builtin_amdgcn_permlane32_swap(a1, b1, false, false); \
    v4u w = {r0[0], r1[0], r0[1], r1[1]}; OUT = __builtin_bit_cast(bf16x8, w); } while (0)
        MX_PK4(p0, 0, pa0); MX_PK4(p0, 8, pa1); MX_PK4(p1, 0, pa2); MX_PK4(p1, 8, pa3);
#undef MX_PK4
        { const int vb = vb0 + buf * V_BYTES;
          pv_one<0>(o[0], vb, pa0, pa1, pa2, pa3); pv_one<1>(o[1], vb, pa0, pa1, pa2, pa3);
          if constexpr (NV == 4) { pv_one<2>(o[2], vb, pa0, pa1, pa2, pa3); pv_one<3>(o[3], vb, pa0, pa1, pa2, pa3); } }
        if (j < jhi) { VM_WAIT(); MX_SWRITE(buf ^ 1); }
        __syncthreads();
    }
#undef MX_SLOAD
#undef MX_SWRITE
    const int orow0 = q0 + wid * 32;
    if constexpr (MODE == 0) {
        if (hi == 0) li_l[r32] = l_reg; LDS_WAIT();
#pragma unroll
        for (int r = 0; r < 16; ++r) { const int rr = crow(r, hi); const float rl = __builtin_amdgcn_rcpf(li_l[rr]);
#pragma unroll
            for (int d0 = 0; d0 < NV; ++d0) P.o[(long)(orow0 + rr) * P.ldo + d0 * 32 + r32] = (bf16)f2bf(o[d0][r] * rl); }
    } else if constexpr (MODE == 1) {
#pragma unroll
        for (int r = 0; r < 16; ++r) { const int rr = crow(r, hi);
            float s = 0.f;
#pragma unroll
            for (int d0 = 0; d0 < NV; ++d0) s += o[d0][r];
            s = half_sum(s);
            const float mean = s * (1.f / 128.f); float qv = 0.f;
#pragma unroll
            for (int d0 = 0; d0 < NV; ++d0) { const float dlt = o[d0][r] - mean; qv += dlt * dlt; }
            qv = half_sum(qv);
            const float rs = 1.0f / sqrtf(qv * (1.f / 128.f) + 1e-6f);
#pragma unroll
            for (int d0 = 0; d0 < NV; ++d0) { const float gt = bf2f(P.aux[(long)(orow0 + rr) * P.ldaux + d0 * 32 + r32]);
                P.o[(long)(orow0 + rr) * P.ldo + d0 * 32 + r32] = (bf16)f2bf(ZERO_B ? 0.f : (o[d0][r] - mean) * rs * silu(gt)); } }
    } else {
#pragma unroll
        for (int r = 0; r < 16; ++r) { const int rr = crow(r, hi);
#pragma unroll
            for (int d0 = 0; d0 < NV; ++d0) { const float xv = bf2f(P.aux[(long)(orow0 + rr) * P.ldaux + d0 * 32 + r32]);
                P.o[(long)(orow0 + rr) * P.ldo + d0 * 32 + r32] = (bf16)f2bf(o[d0][r] + xv * P.dh); } }
    }
    __syncthreads();
}
#undef SBAR
}

namespace hyb {
constexpr int U_PITCH = 4112, U_BYTES = 16 * U_PITCH, FC_OFF = U_BYTES, FC_PITCH = 8256;
typedef float f32x4v __attribute__((ext_vector_type(4)));
__device__ __forceinline__ void hyena_unit(const AP& a, int layer, int c, unsigned char* ws, LAS unsigned char* lds, int tid) {
    asm volatile("" : "+v"(tid));
    const int wid = tid >> 6, lane = tid & 63, fr = lane & 15, fq = lane >> 4;
    const bf16* UT = (const bf16*)(ws + WS_UT); bf16* ZT = (bf16*)(ws + WS_ZT);
    LAS unsigned char* Ul = lds; LAS unsigned char* FC = lds + FC_OFF;
    const int ksh = (3 - fr) & 3;
    for (int o = 0; o < 2; ++o) {
        const bf16* G = (const bf16*)(ws + WS_HYG) + (((size_t)layer * 2 + o) * 512 + c) * HY_GLEN;
        for (int id = tid; id < HY_GLEN / 8; id += 512) *(LAS v4u*)(FC + id * 16) = *(const GAS v4u*)(G + id * 8);
        if (o == 0) {
#pragma unroll
            for (int i = 0; i < 8; ++i) { const int id = tid + 512 * i, b = id >> 8, t8 = id & 255;
                *(LAS v4u*)(Ul + b * U_PITCH + t8 * 16) = *(const GAS v4u*)(UT + ((size_t)c * NB + b) * SEQ + t8 * 8); } }
        __syncthreads();
        for (int idx = tid; idx < 4104; idx += 512) { const LAS bf16* g0 = (const LAS bf16*)FC + idx;
#pragma unroll
            for (int k = 1; k < 4; ++k) *(LAS bf16*)(FC + k * FC_PITCH + idx * 2) = g0[k]; }
        const bf16* X = UT + (((size_t)(1 + o) * 512 + c) * NB + fr) * SEQ;
        v2u xg[16];
#pragma unroll
        for (int al = 0; al < 16; ++al) xg[al] = *(const GAS v2u*)(X + 16 * (16 * wid + al) + 4 * fq);
        __syncthreads();
        f32x4v acc[16];
#pragma unroll
        for (int i = 0; i < 16; ++i) acc[i] = (f32x4v){0.f, 0.f, 0.f, 0.f};
        for (int kb = 0; kb < 8; ++kb) {
            bf16x8 bfr[8];
#pragma unroll
            for (int kl = 0; kl < 8; ++kl) bfr[kl] = *(const LAS bf16x8*)(Ul + fr * U_PITCH + ((kb * 8 + kl) * 32 + fq * 8) * 2);
            const int n0 = HY_OFF - 16 * (16 * wid - 16 * kb + 15) - fr + 8 * fq;
            const LAS unsigned char* ab = FC + ksh * FC_PITCH + (n0 - ksh) * 2;
#pragma unroll
            for (int hb = 0; hb < 2; ++hb) {
                v2u alo[15], ahi[15];
#pragma unroll
                for (int d = 0; d < 15; ++d) { alo[d] = *(const LAS v2u*)(ab + (29 - (hb * 15 + d)) * 32); ahi[d] = *(const LAS v2u*)(ab + (29 - (hb * 15 + d)) * 32 + 8); }
                LDS_WAIT(); __builtin_amdgcn_sched_barrier(0);
#pragma unroll
                for (int d = 0; d < 15; ++d) { const int ddrel = hb * 15 + d - 14;
                    const v4u w = {alo[d].x, alo[d].y, ahi[d].x, ahi[d].y}; const bf16x8 af = __builtin_bit_cast(bf16x8, w);
#pragma unroll
                    for (int kl = 0; kl < 8; ++kl) { const int al = ddrel + 2 * kl; if (al >= 0 && al < 16) acc[al] = __builtin_amdgcn_mfma_f32_16x16x32_bf16(af, bfr[kl], acc[al], 0, 0, 0); }
                }
                __builtin_amdgcn_sched_barrier(0);
            }
        }
        __syncthreads();
        const float bias = a.in(I_HYBIAS)[(layer * 2 + o) * 512 + c];
#pragma unroll
        for (int al = 0; al < 16; ++al) { const int t = 16 * (16 * wid + al) + 4 * fq;
            const v2u uu = *(const LAS v2u*)(Ul + fr * U_PITCH + t * 2); const v2u xx = xg[al];
            const float r0 = bflo(xx.x) * (acc[al][0] + bflo(uu.x) * bias), r1 = bfhi(xx.x) * (acc[al][1] + bfhi(uu.x) * bias);
            const float r2 = bflo(xx.y) * (acc[al][2] + bflo(uu.y) * bias), r3 = bfhi(xx.y) * (acc[al][3] + bfhi(uu.y) * bias);
            v2u z; z.x = pk2(r0, r1); z.y = pk2(r2, r3);
            if (o == 0) *(LAS v2u*)(Ul + fr * U_PITCH + t * 2) = z;
            else *(GAS v2u*)(ZT + ((size_t)c * NB + fr) * SEQ + t) = z; }
        __syncthreads();
    }
}
}

constexpr int N_PHASES = 26;
#ifndef MK_CUTS
#define MK_CUTS 0
#endif
#ifndef MIXSKIP
#define MIXSKIP 0
#endif
#ifndef MOE_CHECK
#define MOE_CHECK 0
#endif
#ifndef ONLYKIND
#define ONLYKIND -1
#endif
#define KSEL(kind) (ONLYKIND < 0 || ONLYKIND == (kind))
#define IN(k) (LO <= (k) && (k) < HI)
#define INK(k, kind) (KSEL(kind) && LO <= (k) && (k) < HI)
struct Ids { int wave0, G0, bx0, vcu0; };
#define PH_LOCALS int wave = ids.wave0, G = ids.G0, bx = ids.bx0, vcu = ids.vcu0; asm volatile("" : "+s"(wave), "+s"(G), "+s"(bx), "+s"(vcu)); \
    int tid; asm volatile("v_mbcnt_lo_u32_b32 %0, -1, 0\n\tv_mbcnt_hi_u32_b32 %0, -1, %0" : "=v"(tid)); tid += wave * 64; \
    const int lane = tid & 63, gw = wave * G + vcu, NGW = G * NWAVES; LAS float* wscr = (LAS float*)(lds + RING_OFF + wave * 16384); (void)lane; (void)gw; (void)NGW; (void)wscr; (void)bx; \
    const AP args = kargs(); unsigned char* ws = args.ws(); float* XRES = args.out(); bf16* XB = (bf16*)(ws + WS_XB); gu32* ctl = (gu32*)(ws + WS_CTL); (void)XRES; (void)XB; (void)ctl;
#ifndef PROBE_SCALE
#define PROBE_SCALE 0.0025f
#endif
#ifndef TIMING_PROBE
#define TIMING_PROBE 0
#endif
#ifndef PROBE_A0
#define PROBE_A0 0
#define PROBE_A1 1
#define PROBE_B0 1
#define PROBE_B1 2
#endif
#if TIMING_PROBE
#define STAMP(idx) do { if (ids.bx0 == 0 && threadIdx.x == 0) ((volatile LAS unsigned*)(lds + MISC_OFF))[16 + (idx)] = (unsigned)wall_clock64(); } while (0)
#else
#define STAMP(idx) do { } while (0)
#endif
#define SEAM(k) do { if constexpr (IN(k) && IN((k) + 1)) { XcdBarrier bb_ = bar; asm volatile("" : "+s"(bb_.bar), "+s"(bb_.x)); xcd_barrier(bb_); } STAMP((k) + 1); } while (0)

template <int LAYER, int LO, int HI>
__device__ __forceinline__ void layer_phases(LAS unsigned char* lds, const XcdBarrier& bar, const Ids& ids) {
    constexpr int layer = LAYER, pb = 1 + LAYER * 10;
    if constexpr (INK(pb + 0, 1)) { PH_LOCALS
        pg8::Gemm g{XB, (const bf16*)(ws + WS_WIN + layer * SZ_WIN), M, NINP, DM}; pg8::StaticOrder S; S.init(M, NINP, G, bx);
        pg8::EpiBf16 E{(bf16*)(ws + WS_PROJ), NINP, (float*)(ws + WS_DTF), C_DT};
        pg8::gemm_phase<pg8::EpiBf16, pg8::StaticOrder, true, true>(lds + RING_OFF, g, S, E, tid);
    }
    SEAM(pb + 0);
    if constexpr (INK(pb + 1, 2)) { PH_LOCALS
        LAS float* cwl = (LAS float*)(lds + RING_OFF);
        for (int i = tid; i < 6 * 1024; i += NWAVES * 64) cwl[i] = i < 5 * 1024 ? args.in(I_CONVW)[layer * 5 * 1024 + i] : args.in(I_CONVB)[layer * 1024 + i - 5 * 1024];
        __syncthreads();
        LAS float* pscr = (LAS float*)(lds + RING_OFF + 32768 + wave * 12288);
        for (int it = gw; it < M / 8; it += NGW) prep_rows8(args, layer, it, lane, ws, cwl);
        for (int it = gw; it < 256; it += NGW) prep_scan(args, layer, it, lane, ws, pscr);
        for (int it = gw; it < NB * 32 * 24; it += NGW) prep_hyconv(args, layer, it, lane, ws, (LAS bf16*)pscr);
        __syncthreads();
    }
    SEAM(pb + 1);
    if constexpr (INK(pb + 2, 3)) {
        { PH_LOCALS pg8::Gemm g{(const bf16*)(ws + WS_QN), (const bf16*)(ws + WS_WUQ + layer * SZ_WUQ), M, 768, 384}; pg8::StaticOrder S; S.init(M, 768, G, bx);
          pg8::EpiBf16 E{(bf16*)(ws + WS_QB), 768, nullptr, 0};
          pg8::gemm_phase<pg8::EpiBf16, pg8::StaticOrder, true, true>(lds + RING_OFF, g, S, E, tid); }
        { PH_LOCALS pg8::Gemm g{(const bf16*)(ws + WS_KVN), (const bf16*)(ws + WS_WUKV + layer * SZ_WUKV), M, 1024, 256}; pg8::StaticOrder S; S.init(M, 1024, G, bx);
          pg8::EpiBf16 E{(bf16*)(ws + WS_KVB), 1024, nullptr, 0};
          pg8::gemm_phase<pg8::EpiBf16, pg8::StaticOrder, true, true>(lds + RING_OFF, g, S, E, tid); }
    }
    SEAM(pb + 2);
    if constexpr (IN(pb + 3)) {
        if constexpr (KSEL(40)) { PH_LOCALS for (int u = vcu; u < NB * 4 * 8; u += G) { const int b = u >> 5, h = (u >> 3) & 3, qb = u & 7; const size_t r0 = (size_t)b * SEQ;
            mixb::MixP P{}; P.q = (const bf16*)(ws + WS_QB) + r0 * 768 + h * 192; P.ldq = 768; P.k0 = (const bf16*)(ws + WS_KVB) + r0 * 1024 + h * 256; P.ldk0 = 1024;
            P.k1 = (const bf16*)(ws + WS_KPE) + r0 * 64; P.ldk1 = 64; P.v = (const bf16*)(ws + WS_KVB) + r0 * 1024 + h * 256 + 128; P.ldv = 1024;
            P.o = (bf16*)(ws + WS_ATT) + r0 * 512 + h * 128; P.ldo = 512;
            mixb::mix_unit<0, 192, 128>(P, qb * 256, lds + RING_OFF, tid); } }
        STAMP(32 + LAYER * 4 + 0);
        if constexpr (KSEL(41)) { PH_LOCALS for (int u = vcu; u < NB * 4 * 8; u += G) { const int rnd = u / G; const int b = u >> 5, h0 = (u >> 3) & 3, h = (rnd & 1) ? 3 - h0 : h0, qb = u & 7; const size_t r0 = (size_t)b * SEQ;
            mixb::MixP P{}; P.q = (const bf16*)(ws + WS_RQ) + r0 * 256 + h * 64; P.ldq = 256; P.k0 = (const bf16*)(ws + WS_RK) + r0 * 256 + h * 64; P.ldk0 = 256; P.k1 = P.k0; P.ldk1 = 256;
            P.v = (const bf16*)(ws + WS_PROJ) + r0 * NINP + C_RV + h * 128; P.ldv = NINP; P.aux = (const bf16*)(ws + WS_PROJ) + r0 * NINP + C_RG + h * 128; P.ldaux = NINP;
            P.o = (bf16*)(ws + WS_MIX) + r0 * DM + 512 + h * 128; P.ldo = DM;
            P.lf = log2f(1.0f - exp2f(-5.0f - (float)h)); P.lb = log2f(1.0f - exp2f(-5.5f - (float)h));
            mixb::mix_unit<1, 64, 128>(P, qb * 256, lds + RING_OFF, tid); } }
        STAMP(32 + LAYER * 4 + 1);
        if constexpr (KSEL(42)) { PH_LOCALS for (int u = vcu; u < NB * 8 * 8; u += G) { const int rnd = u / G; const int b = u >> 6, hh = (((u >> 3) & 7) + 2 * rnd) & 7, qb = u & 7, gq = hh >> 2; const size_t r0 = (size_t)b * SEQ;
            mixb::MixP P{}; const bf16* XBC = (const bf16*)(ws + WS_XBC) + r0 * 1024;
            P.q = XBC + 768 + gq * 128; P.ldq = 1024; P.k0 = XBC + 512 + gq * 128; P.ldk0 = 1024; P.k1 = P.k0; P.ldk1 = 1024; P.v = XBC + hh * 64; P.ldv = 1024; P.aux = P.v; P.ldaux = 1024;
            P.ssdp = (const float*)(ws + WS_SSDP) + r0 * 32 + hh * 4; P.dh = args.in(I_SSDD)[layer * 8 + hh];
            P.o = (bf16*)(ws + WS_YC) + r0 * 512 + hh * 64; P.ldo = 512;
            mixb::mix_unit<2, 128, 64>(P, qb * 256, lds + RING_OFF, tid); } }
        STAMP(32 + LAYER * 4 + 2);
        if constexpr (KSEL(43)) { PH_LOCALS for (int u = vcu; u < 512; u += G) hyb::hyena_unit(args, layer, u, ws, lds + RING_OFF, tid); }
    }
    SEAM(pb + 3);
    if constexpr (INK(pb + 4, 5)) { PH_LOCALS
        for (int m = gw; m < M; m += NGW) post_row(args, layer, m, lane, ws);
        for (int it = gw; it < NB * 128; it += NGW) post_hy(args, layer, it, lane, ws, (LAS bf16*)wscr);
    }
    SEAM(pb + 4);
    if constexpr (INK(pb + 5, 6)) { PH_LOCALS
        pg8::Gemm g{(const bf16*)(ws + WS_MIX), (const bf16*)(ws + WS_WOUT + layer * SZ_WOUT), M, DM, DM}; pg8::StaticOrder S; S.init(M, DM, G, bx);
        pg8::EpiResF32 E{LAYER == 0 ? args.in(I_X) : (const float*)XRES, XRES, DM, ALPHA, 1.f};
        pg8::gemm_phase<pg8::EpiResF32, pg8::StaticOrder, true, true>(lds + RING_OFF, g, S, E, tid);
    }
    SEAM(pb + 5);
    if constexpr (INK(pb + 6, 7)) { PH_LOCALS
        const float* gG = args.in(I_LN1G) + layer * DM; const float* gB = args.in(I_LN1B) + layer * DM;
        if constexpr (LAYER == 1) {
            LAS float* WrT = (LAS float*)(lds + RING_OFF);
            for (int i = tid; i < DM * NEXP; i += NWAVES * 64) WrT[(i & 7) * DM + (i >> 3)] = args.in(I_ROUTER)[i];
            for (int i = bx * NWAVES * 64 + tid; i < CAP_ROWS; i += G * NWAVES * 64) ((int*)(ws + WS_SLOT))[i] = -1;
            LAS unsigned* lcnt = (LAS unsigned*)(lds + RING_OFF + 65536); LAS unsigned* lbase = lcnt + 8; LAS int* lrec = (LAS int*)(lcnt + 16);
            if (tid < 16) lcnt[tid] = 0u;
            __syncthreads();
            int nrow = 0;
            f32x4 nv[8]; if (gw < M) ln_load(XRES + (size_t)gw * DM, lane, nv);
            for (int m = gw; m < M; m += NGW) { f32x4 v[8];
#pragma unroll
                for (int j = 0; j < 8; ++j) v[j] = nv[j];
                if (m + NGW < M) ln_load(XRES + (size_t)(m + NGW) * DM, lane, nv);
                ln_row(XRES + (size_t)m * DM, XB + (size_t)m * DM, gG, gB, lane, v, nullptr, nullptr, XRES + (size_t)m * DM);
                float lg[8];
#pragma unroll
                for (int e = 0; e < 8; ++e) { float s = 0.f;
#pragma unroll
                    for (int j = 0; j < 8; ++j) { const f32x4 w = *((const LAS f32x4*)(WrT + e * DM) + lane + 64 * j); s += (v[j].x * w.x + v[j].y * w.y) + (v[j].z * w.z + v[j].w * w.w); }
                    lg[e] = wave_sum(s); __builtin_amdgcn_sched_barrier(0); }
                int e0 = 0; float v0 = lg[0];
#pragma unroll
                for (int e = 1; e < 8; ++e) if (lg[e] > v0) { v0 = lg[e]; e0 = e; }
                int e1 = -1; float v1 = -3.0e38f;
#pragma unroll
                for (int e = 0; e < 8; ++e) if (e != e0 && lg[e] > v1) { v1 = lg[e]; e1 = e; }
                if (lane == 0) { const float ex = __expf(v1 - v0); const float g0 = 1.0f / (1.0f + ex), g1 = ex / (1.0f + ex);
                    const int p0 = (int)__hip_atomic_fetch_add(lcnt + e0, 1u, __ATOMIC_RELAXED, __HIP_MEMORY_SCOPE_WORKGROUP), p1 = (int)__hip_atomic_fetch_add(lcnt + e1, 1u, __ATOMIC_RELAXED, __HIP_MEMORY_SCOPE_WORKGROUP);
                    LAS int* rec = lrec + (wave * 64 + nrow) * 4; rec[0] = e0; rec[1] = e1; rec[2] = p0; rec[3] = p1;
                    float* rg = (float*)(ws + WS_RTG) + (size_t)m * 2; rg[0] = g0; rg[1] = g1; }
                ++nrow; }
            __syncthreads();
            if (tid < NEXP) lbase[tid] = atomicAdd((unsigned*)(ctl + CW_CNT + tid), lcnt[tid]);
            __syncthreads();
            { int r = 0; for (int m = gw; m < M; m += NGW, ++r) if (lane == 0) { const LAS int* rec = lrec + (wave * 64 + r) * 4; const int e0 = rec[0], e1 = rec[1];
                int* rt = (int*)(ws + WS_RT) + (size_t)m * 4; rt[0] = e0; rt[1] = e1; rt[2] = rec[2] + (int)lbase[e0]; rt[3] = rec[3] + (int)lbase[e1]; } }
            __syncthreads();
        } else {
            f32x4 nv[8]; if (gw < M) ln_load(XRES + (size_t)gw * DM, lane, nv);
            for (int m = gw; m < M; m += NGW) { f32x4 v[8];
#pragma unroll
                for (int j = 0; j < 8; ++j) v[j] = nv[j];
                if (m + NGW < M) ln_load(XRES + (size_t)(m + NGW) * DM, lane, nv);
                ln_row(XRES + (size_t)m * DM, XB + (size_t)m * DM, gG, gB, lane, v, nullptr, nullptr, XRES + (size_t)m * DM, ws + WS_XF8 + (size_t)m * DM); }
        }
    }
    SEAM(pb + 6);
    if constexpr (LAYER == 0) {
        if constexpr (INK(8, 8)) { PH_LOCALS
            pg8::Gemm g{(const bf16*)(ws + WS_XF8), (const bf16*)(ws + WS_WGU), M, 2 * DFF, DM}; pg8::StaticOrder S; S.init(M, 2 * DFF, G, bx);
            pg8::EpiSwigluF8 E{ws + WS_HID, DFF};
            pg8::gemm_phase_f8<pg8::EpiSwigluF8, pg8::StaticOrder, true, true>(lds + RING_OFF, g, S, E, tid, 0x79797979, 0x7f7f7f7f);
        }
        SEAM(8);
        if constexpr (INK(9, 9)) { PH_LOCALS
            pg8::Gemm g{(const bf16*)(ws + WS_HID), (const bf16*)(ws + WS_WDN), M, DM, DFF}; pg8::StaticOrder S; S.init(M, DM, G, bx);
            pg8::EpiResF32 E{XRES, XRES, DM, ALPHA, ZERO_FFN ? 0.f : 1.f};
            pg8::gemm_phase_f8<pg8::EpiResF32, pg8::StaticOrder, true, true>(lds + RING_OFF, g, S, E, tid, 0x77777777, 0x7f7f7f7f);
        }
        SEAM(9);
        if constexpr (INK(10, 10)) { PH_LOCALS
            const float* gG = args.in(I_LN2G); const float* gB = args.in(I_LN2B);
            f32x4 nv[8]; if (gw < M) ln_load(XRES + (size_t)gw * DM, lane, nv);
            for (int m = gw; m < M; m += NGW) { f32x4 v[8];
#pragma unroll
                for (int j = 0; j < 8; ++j) v[j] = nv[j];
                if (m + NGW < M) ln_load(XRES + (size_t)(m + NGW) * DM, lane, nv);
                ln_row(XRES + (size_t)m * DM, XB + (size_t)m * DM, gG, gB, lane, v, nullptr, nullptr, XRES + (size_t)m * DM); }
        }
        SEAM(10);
    }
}

template <int CH, int LO, int HI>
__device__ __forceinline__ void moe_chunk(LAS unsigned char* lds, const XcdBarrier& bar, const Ids& ids) {
    if constexpr (INK(19 + 2 * CH, 19)) { PH_LOCALS
        pg8::MoeOrder S; int acc = 0;
#pragma unroll
        for (int e = 0; e < 8; ++e) { const int c = (int)__hip_atomic_load(ctl + CW_CNT + e, RLX_AGENT); acc += (c + 255) / 256 * 256; S.pend[e] = acc; }
        const int nrb = acc / 256; const int rb0 = CH * MOE_CH_RB; int nrbc = nrb - rb0; nrbc = nrbc < 0 ? 0 : (nrbc > MOE_CH_RB ? MOE_CH_RB : nrbc);
        pg8::Gemm g{(const bf16*)(ws + WS_XS + (size_t)rb0 * 256 * DM), (const bf16*)(ws + WS_MGU), nrbc * 256, 2 * DFFE, DM};
        S.so.init(nrbc * 256, 2 * DFFE, G, bx); S.rb0 = rb0; S.bstride = (long)2 * DFFE * DM;
        pg8::EpiSwigluF8 E{ws + WS_HIDS, DFFE};
        pg8::gemm_phase_f8<pg8::EpiSwigluF8, pg8::MoeOrder, true, true>(lds + RING_OFF, g, S, E, tid, 0x79797979, 0x7f7f7f7f);
    }
    SEAM(19 + 2 * CH);
    if constexpr (INK(20 + 2 * CH, 20)) { PH_LOCALS
        pg8::MoeOrder S; int acc = 0;
#pragma unroll
        for (int e = 0; e < 8; ++e) { const int c = (int)__hip_atomic_load(ctl + CW_CNT + e, RLX_AGENT); acc += (c + 255) / 256 * 256; S.pend[e] = acc; }
        const int nrb = acc / 256; const int rb0 = CH * MOE_CH_RB; int nrbc = nrb - rb0; nrbc = nrbc < 0 ? 0 : (nrbc > MOE_CH_RB ? MOE_CH_RB : nrbc);
        pg8::Gemm g{(const bf16*)(ws + WS_HIDS), (const bf16*)(ws + WS_MDN), nrbc * 256, DM, DFFE};
        S.so.init(nrbc * 256, DM, G, bx); S.rb0 = rb0; S.bstride = (long)DM * DFFE;
        pg8::EpiMoeDown E{(bf16*)(ws + WS_Y0), (long)((WS_Y1 - WS_Y0) / 2), DM, (const int*)(ws + WS_SLOT), (const float*)(ws + WS_SLOTG), rb0 * 256};
        pg8::gemm_phase_f8<pg8::EpiMoeDown, pg8::MoeOrder, true, true>(lds + RING_OFF, g, S, E, tid, 0x77777777, 0x7f7f7f7f);
    }
    SEAM(20 + 2 * CH);
}

template <int LO, int HI>
__global__ void __launch_bounds__(NWAVES * 64, 2) mk_fwd(Args args_unused, int li) {
    extern __shared__ __attribute__((aligned(16))) unsigned char lds_raw[];
    LAS unsigned char* lds = (LAS unsigned char*)lds_raw;
    volatile LAS unsigned* MISC = (volatile LAS unsigned*)(lds + MISC_OFF);
    Ids ids; { const int tid0 = threadIdx.x; ids.wave0 = __builtin_amdgcn_readfirstlane(tid0 >> 6); ids.G0 = gridDim.x; ids.bx0 = blockIdx.x;
        ids.vcu0 = (ids.G0 % 8 == 0) ? (ids.bx0 % 8) * (ids.G0 / 8) + ids.bx0 / 8 : ids.bx0;
        for (int u = tid0; u < (LDS_BYTES - LDSCTL_OFF) / 4; u += NWAVES * 64) ((LAS unsigned*)(lds + LDSCTL_OFF))[u] = 0u; }
    __syncthreads();
    XcdBarrier bar; bar.bar = nullptr; bar.x = 0; bar.st = nullptr;
    if constexpr (HI - LO > 1) { const AP a0 = kargs(); bar = xcd_barrier_post((unsigned*)((gu32*)(a0.ws() + WS_CTL) + CW_BAR) + li * XCD_BAR_WORDS, MISC + 8); }

    STAMP(0);
    if constexpr (INK(0, 0)) { PH_LOCALS
        constexpr int I_WIN_ = 32 * (NINP / 32), I_UQ = 6 * 24, I_UKV = 4 * 32, I_OUT = 32 * 64, I_GU = 32 * (DFF / 32), I_DN = (DFF / 64) * 64;
        constexpr int NIT = 2 * I_WIN_ + 2 * I_UQ + 2 * I_UKV + 2 * I_OUT + 2 * I_GU + I_DN;
        for (int it = gw; it < NIT; it += NGW) { int r = it;
#define TRJ(n, W, K, N, NP, WT, GR, GS, OFF) if (r < (n)) { transpose_item((W), (K), (N), (NP) / 32, (bf16*)(WT), (GR), (GS), (OFF), wscr, r, lane); continue; } r -= (n);
            TRJ(I_WIN_, args.in(I_WIN), DM, NIN, NINP, ws + WS_WIN, 1 << 30, 0, 0)
            TRJ(I_WIN_, args.in(I_WIN) + (size_t)DM * NIN, DM, NIN, NINP, ws + WS_WIN + SZ_WIN, 1 << 30, 0, 0)
            TRJ(I_UQ, args.in(I_WUQ), 384, 768, 768, ws + WS_WUQ, 1 << 30, 0, 0)
            TRJ(I_UQ, args.in(I_WUQ) + 384 * 768, 384, 768, 768, ws + WS_WUQ + SZ_WUQ, 1 << 30, 0, 0)
            TRJ(I_UKV, args.in(I_WUKV), 256, 1024, 1024, ws + WS_WUKV, 1 << 30, 0, 0)
            TRJ(I_UKV, args.in(I_WUKV) + 256 * 1024, 256, 1024, 1024, ws + WS_WUKV + SZ_WUKV, 1 << 30, 0, 0)
            TRJ(I_OUT, args.in(I_WOUT), DM, DM, DM, ws + WS_WOUT, 1 << 30, 0, 0)
            TRJ(I_OUT, args.in(I_WOUT) + (size_t)DM * DM, DM, DM, DM, ws + WS_WOUT + SZ_WOUT, 1 << 30, 0, 0)
            if (r < I_GU) { transpose_item_f8(args.in(I_FFG), DM, DFF, DFF / 32, ws + WS_WGU, 128, 256, 0, 64.0f, wscr, r, lane); continue; } r -= I_GU;
            if (r < I_GU) { transpose_item_f8(args.in(I_FFU), DM, DFF, DFF / 32, ws + WS_WGU, 128, 256, 128, 64.0f, wscr, r, lane); continue; } r -= I_GU;
            transpose_item_f8(args.in(I_FFD), DFF, DM, DM / 32, ws + WS_WDN, 1 << 30, 0, 0, 256.0f, wscr, r, lane);
#undef TRJ
        }
        for (int m = gw; m < M; m += NGW) { const GAS f32x4* xr = (const GAS f32x4*)(args.in(I_X) + (size_t)m * DM) + lane; GAS v2u* xb = (GAS v2u*)(XB + (size_t)m * DM) + lane;
#pragma unroll
            for (int j = 0; j < 8; ++j) { const f32x4 v = xr[64 * j]; v2u w; w.x = pk2(v.x, v.y); w.y = pk2(v.z, v.w); xb[64 * j] = w; } }
        for (int it = gw; it < 2 * SEQ; it += NGW) hyena_filter_item(args, it >> 11, it & (SEQ - 1), (bf16*)(ws + WS_HYG), wscr, lane);
    }
    SEAM(0);
    layer_phases<0, LO, HI>(lds, bar, ids);
    layer_phases<1, LO, HI>(lds, bar, ids);
    if constexpr (INK(18, 18)) { PH_LOCALS
        auto mkjob = [&](int it, TrF8& j, int& r) { const int job = it / 7168, e = job / 3, kind = job - e * 3; r = it - job * 7168;
            if (kind < 2) j = TrF8{args.in(kind == 0 ? I_MOEG : I_MOEU) + (size_t)e * DM * DFFE, DM, DFFE, DFFE / 32, ws + WS_MGU + (size_t)e * 2 * DFFE * DM, 128, 256, kind * 128, 64.0f};
            else j = TrF8{args.in(I_MOED) + (size_t)e * DFFE * DM, DFFE, DM, DM / 32, ws + WS_MDN + (size_t)e * DM * DFFE, 1 << 30, 0, 0, 256.0f}; };
        for (int it = gw; it < 24 * 7168; it += 2 * NGW) { TrF8 ja, jb; int ra, rb; float ta[32], tb[32]; const bool hb = it + NGW < 24 * 7168;
            mkjob(it, ja, ra); tr_f8_load(ja, ra, lane, ta);
            if (hb) { mkjob(it + NGW, jb, rb); tr_f8_load(jb, rb, lane, tb); }
            tr_f8_finish(ja, ra, lane, ta, wscr);
            if (hb) tr_f8_finish(jb, rb, lane, tb, wscr); }
        int pst[8]; { int acc = 0;
#pragma unroll
            for (int e = 0; e < 8; ++e) { pst[e] = acc; const int c = (int)__hip_atomic_load(ctl + CW_CNT + e, RLX_AGENT); acc += (c + 255) / 256 * 256; } }
        for (int it = gw; it < 2 * M; it += NGW) { const int tok = it >> 1, k = it & 1; const int* rt = (const int*)(ws + WS_RT) + (size_t)tok * 4; const int e = rt[k], pos = rt[2 + k];
            int base = 0;
#pragma unroll
            for (int j = 0; j < 8; ++j) base = (e == j) ? pst[j] : base;
            const int slot = base + pos;
            const GAS v4u* src = (const GAS v4u*)(XB + (size_t)tok * DM) + lane; GAS v2u* dst = (GAS v2u*)(ws + WS_XS + (size_t)slot * DM) + lane;
#pragma unroll
            for (int j = 0; j < 4; ++j) { const v4u w = src[64 * j]; v2u o; o.x = pk4_fp8(bflo(w.x), bfhi(w.x), bflo(w.y), bfhi(w.y)); o.y = pk4_fp8(bflo(w.z), bfhi(w.z), bflo(w.w), bfhi(w.w)); dst[64 * j] = o; }
            if (lane == 0) { ((int*)(ws + WS_SLOT))[slot] = tok * 2 + k; ((float*)(ws + WS_SLOTG))[slot] = ((const float*)(ws + WS_RTG))[(size_t)tok * 2 + k]; } }
    }
    SEAM(18);
    moe_chunk<0, LO, HI>(lds, bar, ids);
    SEAM(21); SEAM(22); SEAM(23); SEAM(24);
    if constexpr (INK(25, 25)) { PH_LOCALS
#if MOE_CHECK
        { LAS float* xs = (LAS float*)(lds + RING_OFF); LAS float* hid = xs + DM; LAS float* red = hid + DFFE;
          for (int smp = bx; smp < 48; smp += G) { const int tok = (smp * 683 + 5) % M;
            for (int d = tid; d < DM; d += 512) xs[d] = bf2f(XB[(size_t)tok * DM + d]);
            __syncthreads();
            float accv[4] = {0.f, 0.f, 0.f, 0.f};
            for (int kk = 0; kk < 2; ++kk) { const int e = ((const int*)(ws + WS_RT))[(size_t)tok * 4 + kk]; const float gt = ((const float*)(ws + WS_RTG))[(size_t)tok * 2 + kk];
                const float* Wg = args.in(I_MOEG) + (size_t)e * DM * DFFE; const float* Wu = args.in(I_MOEU) + (size_t)e * DM * DFFE; const float* Wd = args.in(I_MOED) + (size_t)e * DFFE * DM;
                for (int j = tid; j < DFFE; j += 512) { float a = 0.f, b = 0.f; for (int d = 0; d < DM; ++d) { const float xv = xs[d]; a += xv * Wg[(size_t)d * DFFE + j]; b += xv * Wu[(size_t)d * DFFE + j]; } hid[j] = (a / (1.0f + __expf(-a))) * b; }
                __syncthreads();
                for (int q = 0; q < 4; ++q) { const int c = tid + 512 * q; float o = 0.f; for (int j = 0; j < DFFE; ++j) o += hid[j] * Wd[(size_t)j * DM + c]; accv[q] += gt * o; }
                __syncthreads(); }
            float num = 0.f, den = 0.f;
            for (int q = 0; q < 4; ++q) { const int c = tid + 512 * q; const float mine = bf2f(((const bf16*)(ws + WS_Y0))[(size_t)tok * DM + c]) + bf2f(((const bf16*)(ws + WS_Y1))[(size_t)tok * DM + c]); const float df = accv[q] - mine; num += df * df; den += accv[q] * accv[q]; }
            num = wave_sum(num); den = wave_sum(den); if (lane == 0) { red[wave * 2] = num; red[wave * 2 + 1] = den; }
            __syncthreads();
            if (tid == 0) { float n = 0.f, dn = 0.f; for (int w = 0; w < 8; ++w) { n += red[w * 2]; dn += red[w * 2 + 1]; } const float rel = n / (dn + 1e-20f); atomicMax((unsigned*)(ctl + 80), __float_as_uint(rel)); }
            if (wave == 0) { float lg[8]; for (int e = 0; e < 8; ++e) { float s = 0.f; for (int d = lane; d < DM; d += 64) s += xs[d] * args.in(I_ROUTER)[d * 8 + e]; lg[e] = wave_sum(s); }
                int e0 = 0; for (int e = 1; e < 8; ++e) if (lg[e] > lg[e0]) e0 = e; int e1 = -1; for (int e = 0; e < 8; ++e) if (e != e0 && (e1 < 0 || lg[e] > lg[e1])) e1 = e;
                const float ex = __expf(lg[e1] - lg[e0]); const float g0 = 1.f / (1.f + ex);
                const int* rt = (const int*)(ws + WS_RT) + (size_t)tok * 4; const float* rg = (const float*)(ws + WS_RTG) + (size_t)tok * 2;
                const bool bad = (rt[0] != e0) || (rt[1] != e1) || fabsf(rg[0] - g0) > 0.03f || fabsf(rg[0] + rg[1] - 1.f) > 1e-3f;
                if (lane == 0 && bad) atomicAdd((unsigned*)(ctl + 81), 1u); }
            __syncthreads(); } }
        __syncthreads();
        { XcdBarrier bb_ = bar; (void)bb_; }
#endif
        const float* gG = args.in(I_LN2G) + DM; const float* gB = args.in(I_LN2B) + DM;
        f32x4 nv[8]; if (gw < M) ln_load(XRES + (size_t)gw * DM, lane, nv);
        for (int m = gw; m < M; m += NGW) { f32x4 v[8];
#pragma unroll
            for (int j = 0; j < 8; ++j) v[j] = nv[j];
            if (m + NGW < M) ln_load(XRES + (size_t)(m + NGW) * DM, lane, nv);
            ln_row(XRES + (size_t)m * DM, nullptr, gG, gB, lane, v, (const bf16*)(ws + WS_Y0) + (size_t)m * DM, (const bf16*)(ws + WS_Y1) + (size_t)m * DM, XRES + (size_t)m * DM); }
#if TIMING_PROBE
        { XcdBarrier bb_ = bar; asm volatile("" : "+s"(bb_.bar), "+s"(bb_.x)); xcd_barrier(bb_); }
        STAMP(26);
        __syncthreads();
        if (bx == 0) { volatile LAS unsigned* T = (volatile LAS unsigned*)(lds + MISC_OFF) + 16;
            const float t1 = (float)(T[PROBE_A1] - T[PROBE_A0]) * 0.01f, t2 = (float)(T[PROBE_B1] - T[PROBE_B0]) * 0.01f;
            if (tid == 0) XRES[12345] = t1 * PROBE_SCALE + 0.f * t2; }
#endif
#if MOE_CHECK
        __syncthreads(); VM_WAIT();
        if (tid == 0) { __builtin_amdgcn_fence(__ATOMIC_RELEASE, "agent"); const unsigned old_ = atomicAdd((unsigned*)(ctl + 82), 1u); ((volatile LAS unsigned*)(lds + MISC_OFF))[12] = (old_ + 1u == (unsigned)G) ? 1u : 0u; }
        __syncthreads();
        if (((volatile LAS unsigned*)(lds + MISC_OFF))[12]) { __builtin_amdgcn_fence(__ATOMIC_ACQUIRE, "agent");
            const float rel = __uint_as_float(__hip_atomic_load(ctl + 80, RLX_AGENT)); const unsigned nbad = __hip_atomic_load(ctl + 81, RLX_AGENT);
            float code = 0.f; if (rel > 0.03f) code += 10.f; if (rel > 0.3f) code += 10.f; if (nbad > 2u) code += 40.f; if (nbad > 8u) code += 40.f;
            if (code > 0.f) for (size_t i = tid; i < (size_t)M * DM; i += 512) XRES[i] = code; }
#endif
    }
}
#undef IN
#undef INK
#undef SEAM
#undef STAMP

template <int LO, int HI> static void launch_range(int grid, const Args& a, int li, hipStream_t stream) {
    static bool attr = false;
    if (!attr) { if (hipFuncSetAttribute((const void*)mk_fwd<LO, HI>, hipFuncAttributeMaxDynamicSharedMemorySize, LDS_BYTES) != hipSuccess) fprintf(stderr, "kernel_launch: hipFuncSetAttribute failed\n"); attr = true; }
    hipLaunchKernelGGL((mk_fwd<LO, HI>), dim3(grid), dim3(NWAVES * 64), LDS_BYTES, stream, a, li);
}
template <int P> struct PerPhase { static void go(int grid, const Args& a, hipStream_t s) { PerPhase<P - 1>::go(grid, a, s); launch_range<P, P + 1>(grid, a, P, s); } };
template <> struct PerPhase<-1> { static void go(int, const Args&, hipStream_t) {} };

extern "C" void kernel_launch(void* const* d_in, const int* in_sizes, int n_in, void* d_out, int out_size, void* d_ws, size_t ws_size, hipStream_t stream) {
    static int grid = 0;
    if (grid == 0) {
        if (n_in != 35 || out_size != M * DM || ws_size < WS_END) { fprintf(stderr, "kernel_launch: built for 35 inputs, out %d floats, >= %zu bytes of workspace; got n_in %d, out %d, ws %zu; nothing launched\n", M * DM, (size_t)WS_END, n_in, out_size, ws_size); grid = -1; return; }
        int dev = 0, cus = 0;
        if (hipGetDevice(&dev) != hipSuccess || hipDeviceGetAttribute(&cus, hipDeviceAttributeMultiprocessorCount, dev) != hipSuccess) { grid = -1; return; }
        grid = cus;
    }
    if (grid < 0) return;
    if (hipMemsetAsync((char*)d_ws + WS_CTL, 0, CTL_ZERO_BYTES, stream) != hipSuccess) return;
    Args a{};
    for (int i = 0; i < 35; ++i) a.in[i] = (const float*)d_in[i];
    a.out = (float*)d_out; a.ws = (unsigned char*)d_ws; a.ph_lo = 0; a.ph_hi = N_PHASES;
#if MK_CUTS
    PerPhase<N_PHASES - 1>::go(grid, a, stream);
#else
    launch_range<0, N_PHASES>(grid, a, 0, stream);
#endif
    const hipError_t le = hipPeekAtLastError();
    if (le != hipSuccess) fprintf(stderr, "kernel_launch: launch failed: %s\n", hipGetErrorName(le));
}
```

```cpp
#include <hip/hip_runtime.h>
#include <cstdio>
#include <cstdint>
namespace pg8 {
#define PG8_LAS __attribute__((address_space(3)))
typedef unsigned short bf16_t;
typedef short bf16x8 __attribute__((ext_vector_type(8)));
typedef float f32x4 __attribute__((ext_vector_type(4)));
typedef unsigned u32x4 __attribute__((ext_vector_type(4)));
constexpr int BM = 256, BK = 64, HALF = 128, HTB = HALF * BK * 2  , STAGE_BYTES = 8 * HTB, NXCD = 8, WGM = 8;

__host__ __device__ __forceinline__ int lds_byte(int r, int c) { const int st = (r >> 4) * 2 + (c >> 5), rr = r & 15, cc = c & 31, ob = rr * 64 + cc * 2; return st * 1024 + (ob ^ (((ob >> 9) & 1) << 5)); }
__host__ __device__ __forceinline__ void stage_rc(int b, int& R, int& C) { const int st = b / 1024, sb = b % 1024, swz = sb ^ (((sb >> 9) & 1) << 5); R = (st >> 1) * 16 + swz / 64; C = (st & 1) * 32 + (swz % 64) / 2; }
__host__ __device__ __forceinline__ int perm32(int rho) { const int n = rho >> 4, i = rho & 15; return 8 * (i >> 2) + 4 * n + (i & 3); }

struct Unit { int pm, pn; long aoff, boff; int aux; };
struct Gemm { const bf16_t* A; const bf16_t* Bt; int M, N, K; };
__device__ __forceinline__ long rfl64(long v) { const unsigned lo = __builtin_amdgcn_readfirstlane((unsigned)v), hi = __builtin_amdgcn_readfirstlane((unsigned)((unsigned long)v >> 32)); return (long)(((unsigned long)hi << 32) | lo); }
__device__ __forceinline__ void unit_uniform(Unit& u) { u.pm = __builtin_amdgcn_readfirstlane(u.pm); u.pn = __builtin_amdgcn_readfirstlane(u.pn); u.aux = __builtin_amdgcn_readfirstlane(u.aux); u.aoff = rfl64(u.aoff); u.boff = rfl64(u.boff); }

struct StaticOrder {
    int nM, nN, nwg, G, c;
    __host__ __device__ void init(int M, int N, int G_, int c_) { nM = M / BM; nN = N / BM; nwg = nM * nN; G = G_; c = c_; }
    __host__ __device__ bool next(int i, Unit& u) const {
        const long L = (long)i * G + c; if (L >= nwg) return false;
        int wgid = (int)L; { const int q = nwg / NXCD, r = nwg % NXCD, xcd = wgid % NXCD, off = wgid / NXCD; wgid = (xcd < r ? xcd * (q + 1) : r * (q + 1) + (xcd - r) * q) + off; }
        const int nig = WGM * nN, gid = wgid / nig, fm = gid * WGM, gsz = (nM - fm) < WGM ? (nM - fm) : WGM;
        u.pm = fm + ((wgid % nig) % gsz); u.pn = (wgid % nig) / gsz; u.aoff = 0; u.boff = 0; u.aux = 0; return true;
    }
    __device__ __forceinline__ void a_ready(const Unit&) const {}
    __device__ __forceinline__ void done(const Unit&) const {}
};
struct MoeOrder {
    StaticOrder so; int rb0; int pend[8]; long bstride;
    __device__ bool next(int i, Unit& u) const {
        if (!so.next(i, u)) return false;
        const int row = (rb0 + u.pm) * BM; int e = 0;
#pragma unroll
        for (int j = 0; j < 7; ++j) e += (row >= pend[j]) ? 1 : 0;
        u.boff = (long)e * bstride; u.aux = rb0 + u.pm; return true;
    }
    __device__ __forceinline__ void a_ready(const Unit&) const {}
    __device__ __forceinline__ void done(const Unit&) const {}
};

__device__ __forceinline__ unsigned cvt_pk_bf16(float lo, float hi) { unsigned r; asm volatile("v_cvt_pk_bf16_f32 %0, %1, %2" : "=v"(r) : "v"(lo), "v"(hi)); return r; }
__device__ __forceinline__ float silu_f(float v) { return v * __builtin_amdgcn_rcpf(1.0f + __builtin_amdgcn_exp2f(-1.4426950408889634f * v)); }

struct EpiBf16 {
    static constexpr bool PERM = true, AFTER_DRAIN = false;
    bf16_t* O; int ldc; float* F; int fcol0;
    __device__ __forceinline__ void operator()(const f32x4 (&acc)[2][2][4][2], const Unit& u, int wr, int wc, int fr, int fq) const {
        const int row0 = u.pm * BM + wr * 64 + fr; const int col0 = u.pn * BM + wc * 32 + 8 * fq;
#pragma unroll
        for (int ai = 0; ai < 2; ++ai)
#pragma unroll
            for (int m = 0; m < 4; ++m) { bf16_t* rowp = O + (size_t)(row0 + ai * HALF + m * 16) * ldc + col0;
#pragma unroll
                for (int bj = 0; bj < 2; ++bj) { const f32x4 v0 = acc[ai][bj][m][0], v1 = acc[ai][bj][m][1];
                    u32x4 w; w.x = cvt_pk_bf16(v0[0], v0[1]); w.y = cvt_pk_bf16(v0[2], v0[3]); w.z = cvt_pk_bf16(v1[0], v1[1]); w.w = cvt_pk_bf16(v1[2], v1[3]);
                    *(u32x4*)(rowp + bj * HALF) = w;
                    if (F) { const int c = col0 + bj * HALF - fcol0; if (c >= 0 && c < 16) { float* fp = F + (size_t)(row0 + ai * HALF + m * 16) * 16 + c; *(f32x4*)fp = v0; *(f32x4*)(fp + 4) = v1; } }
                } }
    }
};
struct EpiResF32 {
    static constexpr bool PERM = false, AFTER_DRAIN = false;
    const float* Xin; float* X; int ldc; float alpha; float bscale;
    __device__ __forceinline__ void operator()(const f32x4 (&acc)[2][2][4][2], const Unit& u, int wr, int wc, int fr, int fq) const {
        const int row0 = u.pm * BM + wr * 64 + fr, col0 = u.pn * BM + wc * 32 + 4 * fq;
#pragma unroll
        for (int ai = 0; ai < 2; ++ai)
#pragma unroll
            for (int m = 0; m < 4; ++m) { float* rowp = X + (size_t)(row0 + ai * HALF + m * 16) * ldc + col0;
#pragma unroll
                for (int bj = 0; bj < 2; ++bj)
#pragma unroll
                    for (int n = 0; n < 2; ++n) { f32x4* p = (f32x4*)(rowp + bj * HALF + n * 16); const f32x4 x = *(const f32x4*)(Xin + (p - (f32x4*)X) * 4); *p = x * alpha + acc[ai][bj][m][n] * bscale; } }
    }
};
struct EpiSwiglu {
    static constexpr bool PERM = true, AFTER_DRAIN = false;
    bf16_t* H; int ldc;
    __device__ __forceinline__ void operator()(const f32x4 (&acc)[2][2][4][2], const Unit& u, int wr, int wc, int fr, int fq) const {
        const int row0 = u.pm * BM + wr * 64 + fr; const int col0 = u.pn * HALF + wc * 32 + 8 * fq;
#pragma unroll
        for (int ai = 0; ai < 2; ++ai)
#pragma unroll
            for (int m = 0; m < 4; ++m) { bf16_t* rowp = H + (size_t)(row0 + ai * HALF + m * 16) * ldc + col0;
                const f32x4 g0 = acc[ai][0][m][0], g1 = acc[ai][0][m][1], u0 = acc[ai][1][m][0], u1 = acc[ai][1][m][1];
                f32x4 h0, h1;
#pragma unroll
                for (int j = 0; j < 4; ++j) { h0[j] = silu_f(g0[j]) * u0[j]; h1[j] = silu_f(g1[j]) * u1[j]; }
                u32x4 w; w.x = cvt_pk_bf16(h0[0], h0[1]); w.y = cvt_pk_bf16(h0[2], h0[3]); w.z = cvt_pk_bf16(h1[0], h1[1]); w.w = cvt_pk_bf16(h1[2], h1[3]);
                *(u32x4*)rowp = w; }
    }
};
struct EpiSwigluF8 {
    static constexpr bool PERM = true, AFTER_DRAIN = false;
    unsigned char* H; int ldc;
    __device__ __forceinline__ void operator()(const f32x4 (&acc)[2][2][4][2], const Unit& u, int wr, int wc, int fr, int fq) const {
        const int row0 = u.pm * BM + wr * 64 + fr; const int col0 = u.pn * HALF + wc * 32 + 8 * fq;
#pragma unroll
        for (int ai = 0; ai < 2; ++ai)
#pragma unroll
            for (int m = 0; m < 4; ++m) { unsigned char* rowp = H + (size_t)(row0 + ai * HALF + m * 16) * ldc + col0;
                const f32x4 g0 = acc[ai][0][m][0], g1 = acc[ai][0][m][1], u0 = acc[ai][1][m][0], u1 = acc[ai][1][m][1];
                f32x4 h0, h1;
#pragma unroll
                for (int j = 0; j < 4; ++j) { h0[j] = silu_f(g0[j]) * u0[j]; h1[j] = silu_f(g1[j]) * u1[j]; }
                int w0 = 0, w1 = 0;
                w0 = __builtin_amdgcn_cvt_pk_fp8_f32(h0[0], h0[1], w0, false); w0 = __builtin_amdgcn_cvt_pk_fp8_f32(h0[2], h0[3], w0, true);
                w1 = __builtin_amdgcn_cvt_pk_fp8_f32(h1[0], h1[1], w1, false); w1 = __builtin_amdgcn_cvt_pk_fp8_f32(h1[2], h1[3], w1, true);
                typedef int i32x2 __attribute__((ext_vector_type(2))); *(i32x2*)rowp = (i32x2){w0, w1}; __builtin_amdgcn_sched_barrier(0); }
    }
};
struct EpiMoeDown {
    static constexpr bool PERM = true, AFTER_DRAIN = false;
    bf16_t* Y0; long ystride; int ldc; const int* slot_tok2; const float* slot_gate; int rbase;
    __device__ __forceinline__ void operator()(const f32x4 (&acc)[2][2][4][2], const Unit& u, int wr, int wc, int fr, int fq) const {
        const int row0 = rbase + u.pm * BM + wr * 64 + fr; const int col0 = u.pn * BM + wc * 32 + 8 * fq;
#pragma unroll
        for (int ai = 0; ai < 2; ++ai)
#pragma unroll
            for (int m = 0; m < 4; ++m) { const int slot = row0 + ai * HALF + m * 16; const int t2 = slot_tok2[slot]; const float gt = slot_gate[slot];
                if (t2 >= 0) { bf16_t* rowp = Y0 + (size_t)(t2 & 1) * ystride + (size_t)(t2 >> 1) * ldc + col0;
#pragma unroll
                    for (int bj = 0; bj < 2; ++bj) { const f32x4 v0 = acc[ai][bj][m][0] * gt, v1 = acc[ai][bj][m][1] * gt;
                        u32x4 w; w.x = cvt_pk_bf16(v0[0], v0[1]); w.y = cvt_pk_bf16(v0[2], v0[3]); w.z = cvt_pk_bf16(v1[0], v1[1]); w.w = cvt_pk_bf16(v1[2], v1[3]);
                        *(u32x4*)(rowp + bj * HALF) = w; } } __builtin_amdgcn_sched_barrier(0); }
    }
};

template <class Epi, class Sched, bool ALIGN_EPI = false, bool SP2 = false>
__device__ __forceinline__ void gemm_phase(PG8_LAS unsigned char* lds, const Gemm g, const Sched& S, const Epi& E, int tid) {
    asm volatile("" : "+v"(tid));
    const int wid = __builtin_amdgcn_readfirstlane(tid >> 6), lane = tid & 63, wr = wid >> 2, wc = wid & 3, fr = lane & 15, fq = lane >> 4;
    const int K = g.K, nt = K / BK;
    unsigned voffA[2], voffB[2];
#pragma unroll
    for (int i = 0; i < 2; ++i) { int R, C; stage_rc(tid * 16 + i * 8192, R, C); const int Rb = Epi::PERM ? ((R & ~31) + perm32(R & 31)) : R;
        voffA[i] = (unsigned)(R * K + C) * 2u; voffB[i] = (unsigned)(Rb * K + C) * 2u; }
    const size_t kstep = (size_t)(BK * 2);
    const size_t hstep = (size_t)HALF * K * 2;
    const size_t tstep = 2 * hstep;
    const unsigned ldsw = (unsigned)wid * 1024u;
    const int aoff = lds_byte(wr * 64 + fr, fq * 8), boff = lds_byte(wc * 32 + fr, fq * 8);
#define PG8_SA(b, h) (((b) * 2 + (h)) * HTB)
#define PG8_SB(b, h) ((4 + (b) * 2 + (h)) * HTB)
#define PG8_STAGE(bufoff, gbase, voff) do { _Pragma("unroll") for (int _i = 0; _i < 2; ++_i) \
        __builtin_amdgcn_global_load_lds((const unsigned*)((const char*)(gbase) + (voff)[_i]), (PG8_LAS unsigned*)(lds + (bufoff) + ldsw + _i * 8192), 16, 0, 0); } while (0)
#define PG8_LDA(dst, b, h) do { _Pragma("unroll") for (int m = 0; m < 4; ++m) _Pragma("unroll") for (int k = 0; k < 2; ++k) dst[m][k] = *(const PG8_LAS bf16x8*)(lds + PG8_SA(b, h) + aoff + m * 2048 + k * 1024); } while (0)
#define PG8_LDB(dst, b, h) do { _Pragma("unroll") for (int n = 0; n < 2; ++n) _Pragma("unroll") for (int k = 0; k < 2; ++k) dst[n][k] = *(const PG8_LAS bf16x8*)(lds + PG8_SB(b, h) + boff + n * 2048 + k * 1024); } while (0)
#define PG8_MMA(ai, bj, At, Bt) do { __builtin_amdgcn_s_setprio(1); _Pragma("unroll") for (int m = 0; m < 4; ++m) _Pragma("unroll") for (int n = 0; n < 2; ++n) _Pragma("unroll") for (int k = 0; k < 2; ++k) \
        acc[ai][bj][m][n] = __builtin_amdgcn_mfma_f32_16x16x32_bf16(Bt[n][k], At[m][k], acc[ai][bj][m][n], 0, 0, 0); __builtin_amdgcn_s_setprio(0); } while (0)
#define PG8_WAIT_V(n) asm volatile("s_waitcnt vmcnt(" #n ")" ::: "memory")
#define PG8_WAIT_L(n) asm volatile("s_waitcnt lgkmcnt(" #n ")" ::: "memory")
#define PG8_BAR __builtin_amdgcn_s_barrier()
#define PG8_SCHED __builtin_amdgcn_sched_barrier(0)
    Unit cur, nxt; int ui = 0;
    if (!S.next(0, cur)) return;
    f32x4 acc[2][2][4][2];
#pragma unroll
    for (int a = 0; a < 2; ++a)
#pragma unroll
        for (int b = 0; b < 2; ++b)
#pragma unroll
            for (int m = 0; m < 4; ++m)
#pragma unroll
                for (int n = 0; n < 2; ++n) acc[a][b][m][n] = (f32x4){0.f, 0.f, 0.f, 0.f};
    bf16x8 At[4][2], B0[2][2], B1[2][2];
    const char* cA = (const char*)g.A + cur.aoff + (size_t)cur.pm * tstep; const char* cB = (const char*)g.Bt + cur.boff + (size_t)cur.pn * tstep;
    S.a_ready(cur);
    if constexpr (SP2) {
        PG8_STAGE(PG8_SB(0, 0), cB, voffB); PG8_STAGE(PG8_SB(0, 1), cB + hstep, voffB); PG8_STAGE(PG8_SA(0, 0), cA, voffA); PG8_STAGE(PG8_SA(0, 1), cA + hstep, voffA);
        if (wr == 1) PG8_BAR;
        PG8_WAIT_V(2); PG8_BAR;
        PG8_STAGE(PG8_SB(1, 0), cB + kstep, voffB); PG8_STAGE(PG8_SA(1, 0), cA + kstep, voffA); PG8_STAGE(PG8_SB(1, 1), cB + hstep + kstep, voffB);
        PG8_WAIT_V(6); PG8_BAR;
    } else {
        PG8_STAGE(PG8_SB(0, 0), cB, voffB); PG8_STAGE(PG8_SA(0, 0), cA, voffA); PG8_STAGE(PG8_SB(0, 1), cB + hstep, voffB); PG8_STAGE(PG8_SA(0, 1), cA + hstep, voffA);
        if (wr == 1) PG8_BAR;
        PG8_WAIT_V(4); PG8_BAR;
        PG8_STAGE(PG8_SB(1, 0), cB + kstep, voffB); PG8_STAGE(PG8_SA(1, 0), cA + kstep, voffA); PG8_STAGE(PG8_SB(1, 1), cB + hstep + kstep, voffB);
        PG8_WAIT_V(6); PG8_BAR;
    }
    for (;;) {
        const bool has_next = S.next(ui + 1, nxt);
        const char* nA = has_next ? (const char*)g.A + nxt.aoff + (size_t)nxt.pm * tstep : cA; const char* nB = has_next ? (const char*)g.Bt + nxt.boff + (size_t)nxt.pn * tstep : cB;
        for (int t = 0; t < nt; t += 2) {
            const bool last = (t == nt - 2);
            const char* a1 = cA + (size_t)(t + 1) * kstep;
            const char* a2 = last ? nA : cA + (size_t)(t + 2) * kstep; const char* b2 = last ? nB : cB + (size_t)(t + 2) * kstep;
            const char* a3 = a2 + kstep; const char* b3 = b2 + kstep;
            if (last && has_next) S.a_ready(nxt);
            if constexpr (SP2) {
            PG8_LDB(B0, 0, 0); PG8_LDB(B1, 0, 1); PG8_SCHED; PG8_LDA(At, 0, 0); PG8_STAGE(PG8_SA(1, 1), a1 + hstep, voffA);
            PG8_WAIT_V(8); PG8_WAIT_L(0); PG8_BAR; PG8_MMA(0, 0, At, B0); PG8_MMA(0, 1, At, B1); PG8_BAR; PG8_SCHED;
            PG8_LDA(At, 0, 1); PG8_STAGE(PG8_SB(0, 0), b2, voffB); PG8_STAGE(PG8_SB(0, 1), b2 + hstep, voffB); PG8_STAGE(PG8_SA(0, 0), a2, voffA);
            PG8_WAIT_V(8); PG8_WAIT_L(0); PG8_BAR; PG8_MMA(1, 0, At, B0); PG8_MMA(1, 1, At, B1); PG8_BAR; PG8_SCHED;
            PG8_LDB(B0, 1, 0); PG8_LDB(B1, 1, 1); PG8_SCHED; PG8_LDA(At, 1, 0); PG8_STAGE(PG8_SA(0, 1), a2 + hstep, voffA);
            PG8_WAIT_V(8); PG8_WAIT_L(0); PG8_BAR; PG8_MMA(0, 0, At, B0); PG8_MMA(0, 1, At, B1); PG8_BAR; PG8_SCHED;
            PG8_LDA(At, 1, 1); PG8_STAGE(PG8_SB(1, 0), b3, voffB); PG8_STAGE(PG8_SB(1, 1), b3 + hstep, voffB); PG8_STAGE(PG8_SA(1, 0), a3, voffA);
            PG8_WAIT_V(8); PG8_WAIT_L(0); PG8_BAR; PG8_MMA(1, 0, At, B0); PG8_MMA(1, 1, At, B1); PG8_BAR; PG8_SCHED;
            } else {
            PG8_LDB(B0, 0, 0); PG8_SCHED; PG8_LDA(At, 0, 0); PG8_STAGE(PG8_SA(1, 1), a1 + hstep, voffA);
            PG8_WAIT_L(8); PG8_BAR; PG8_WAIT_L(0); PG8_MMA(0, 0, At, B0); PG8_BAR; PG8_SCHED;
            PG8_LDB(B1, 0, 1); PG8_STAGE(PG8_SB(0, 0), b2, voffB);
            PG8_BAR; PG8_WAIT_L(0); PG8_MMA(0, 1, At, B1); PG8_BAR;
            PG8_LDA(At, 0, 1); PG8_STAGE(PG8_SA(0, 0), a2, voffA);
            PG8_BAR; PG8_WAIT_L(0); PG8_MMA(1, 0, At, B0); PG8_BAR; PG8_SCHED;
            PG8_STAGE(PG8_SB(0, 1), b2 + hstep, voffB);
            PG8_WAIT_V(6); PG8_BAR; PG8_MMA(1, 1, At, B1); PG8_BAR;
            PG8_LDB(B0, 1, 0); PG8_SCHED; PG8_LDA(At, 1, 0); PG8_STAGE(PG8_SA(0, 1), a2 + hstep, voffA);
            PG8_WAIT_L(8); PG8_BAR; PG8_WAIT_L(0); PG8_MMA(0, 0, At, B0); PG8_BAR; PG8_SCHED;
            PG8_LDB(B1, 1, 1); PG8_STAGE(PG8_SB(1, 0), b3, voffB);
            PG8_BAR; PG8_WAIT_L(0); PG8_MMA(0, 1, At, B1); PG8_BAR;
            PG8_LDA(At, 1, 1); PG8_STAGE(PG8_SA(1, 0), a3, voffA);
            PG8_BAR; PG8_WAIT_L(0); PG8_MMA(1, 0, At, B0); PG8_BAR; PG8_SCHED;
            PG8_STAGE(PG8_SB(1, 1), b3 + hstep, voffB);
            PG8_WAIT_V(6); PG8_BAR; PG8_MMA(1, 1, At, B1); PG8_BAR;
            }
        }
        if constexpr (ALIGN_EPI) { if (wr == 0) PG8_BAR; }
        if constexpr (!Epi::AFTER_DRAIN) { E(acc, cur, wr, wc, fr, fq); S.done(cur); }
        if (!has_next) break;
#pragma unroll
        for (int a = 0; a < 2; ++a)
#pragma unroll
            for (int b = 0; b < 2; ++b)
#pragma unroll
                for (int m = 0; m < 4; ++m)
#pragma unroll
                    for (int n = 0; n < 2; ++n) acc[a][b][m][n] = (f32x4){0.f, 0.f, 0.f, 0.f};
        cur = nxt; cA = nA; cB = nB; ++ui;
        if constexpr (ALIGN_EPI) { if (wr == 1) PG8_BAR; }
    }
    PG8_WAIT_V(0);
    if constexpr (!ALIGN_EPI) { if (wr == 0) PG8_BAR; }
    PG8_BAR;
#undef PG8_SA
#undef PG8_SB
#undef PG8_STAGE
#undef PG8_LDA
#undef PG8_LDB
#undef PG8_MMA
#undef PG8_WAIT_V
#undef PG8_WAIT_L
#undef PG8_BAR
#undef PG8_SCHED
}
typedef int v8i __attribute__((ext_vector_type(8)));
typedef int v4i __attribute__((ext_vector_type(4)));
typedef int v32i __attribute__((ext_vector_type(32)));
template <class Epi, class Sched, bool ALIGN_EPI = false, bool SP2 = false>
__device__ __forceinline__ void gemm_phase_f8(PG8_LAS unsigned char* lds, const Gemm g, const Sched& S, const Epi& E, int tid, int scaleBt, int scaleA) {
    asm volatile("" : "+v"(tid));
    const int wid = __builtin_amdgcn_readfirstlane(tid >> 6), lane = tid & 63, wr = wid >> 2, wc = wid & 3, fr = lane & 15, fq = lane >> 4;
    const int K = g.K, nt = K / 128;
    unsigned voffA[2], voffB[2];
#pragma unroll
    for (int i = 0; i < 2; ++i) { int R, C; stage_rc(tid * 16 + i * 8192, R, C); const int Rb = Epi::PERM ? ((R & ~31) + perm32(R & 31)) : R;
        voffA[i] = (unsigned)(R * K + C * 2); voffB[i] = (unsigned)(Rb * K + C * 2); }
    const size_t kstep = (size_t)(BK * 2);
    const size_t hstep = (size_t)HALF * K;
    const size_t tstep = 2 * hstep;
    const unsigned ldsw = (unsigned)wid * 1024u;
    const int aoff0 = lds_byte(wr * 64 + fr, fq * 16), aoff1 = lds_byte(wr * 64 + fr, fq * 16 + 8), boff0 = lds_byte(wc * 32 + fr, fq * 16), boff1 = lds_byte(wc * 32 + fr, fq * 16 + 8);
#define PG8_SA(b, h) (((b) * 2 + (h)) * HTB)
#define PG8_SB(b, h) ((4 + (b) * 2 + (h)) * HTB)
#define PG8_STAGE(bufoff, gbase, voff) do { _Pragma("unroll") for (int _i = 0; _i < 2; ++_i) \
        __builtin_amdgcn_global_load_lds((const unsigned*)((const char*)(gbase) + (voff)[_i]), (PG8_LAS unsigned*)(lds + (bufoff) + ldsw + _i * 8192), 16, 0, 0); } while (0)
#define PG8_INS8(big, slot, lo_, hi_) do { const v8i f_ = __builtin_shufflevector(lo_, hi_, 0, 1, 2, 3, 4, 5, 6, 7); \
        const v32i e_ = __builtin_shufflevector(f_, f_, 0, 1, 2, 3, 4, 5, 6, 7, 0, 1, 2, 3, 4, 5, 6, 7, 0, 1, 2, 3, 4, 5, 6, 7, 0, 1, 2, 3, 4, 5, 6, 7); \
        if ((slot) == 0) big = __builtin_shufflevector(big, e_, 32, 33, 34, 35, 36, 37, 38, 39, 8, 9, 10, 11, 12, 13, 14, 15, 16, 17, 18, 19, 20, 21, 22, 23, 24, 25, 26, 27, 28, 29, 30, 31); \
        else if ((slot) == 1) big = __builtin_shufflevector(big, e_, 0, 1, 2, 3, 4, 5, 6, 7, 32, 33, 34, 35, 36, 37, 38, 39, 16, 17, 18, 19, 20, 21, 22, 23, 24, 25, 26, 27, 28, 29, 30, 31); \
        else if ((slot) == 2) big = __builtin_shufflevector(big, e_, 0, 1, 2, 3, 4, 5, 6, 7, 8, 9, 10, 11, 12, 13, 14, 15, 32, 33, 34, 35, 36, 37, 38, 39, 24, 25, 26, 27, 28, 29, 30, 31); \
        else big = __builtin_shufflevector(big, e_, 0, 1, 2, 3, 4, 5, 6, 7, 8, 9, 10, 11, 12, 13, 14, 15, 16, 17, 18, 19, 20, 21, 22, 23, 32, 33, 34, 35, 36, 37, 38, 39); } while (0)
#define PG8_GET8(big, slot) ((slot) == 0 ? __builtin_shufflevector(big, big, 0, 1, 2, 3, 4, 5, 6, 7) : (slot) == 1 ? __builtin_shufflevector(big, big, 8, 9, 10, 11, 12, 13, 14, 15) : (slot) == 2 ? __builtin_shufflevector(big, big, 16, 17, 18, 19, 20, 21, 22, 23) : __builtin_shufflevector(big, big, 24, 25, 26, 27, 28, 29, 30, 31))
#define PG8_LDA(dst, b, h) do { _Pragma("unroll") for (int m = 0; m < 4; ++m) { const v4i lo_ = *(const PG8_LAS v4i*)(lds + PG8_SA(b, h) + aoff0 + m * 2048), hi_ = *(const PG8_LAS v4i*)(lds + PG8_SA(b, h) + aoff1 + m * 2048); PG8_INS8(Afr, m, lo_, hi_); } } while (0)
#define PG8_LDB(dst, b, h) do { _Pragma("unroll") for (int n = 0; n < 2; ++n) { const v4i lo_ = *(const PG8_LAS v4i*)(lds + PG8_SB(b, h) + boff0 + n * 2048), hi_ = *(const PG8_LAS v4i*)(lds + PG8_SB(b, h) + boff1 + n * 2048); PG8_INS8(Bfr, (dst) * 2 + n, lo_, hi_); } } while (0)
#define PG8_F8(x) __builtin_bit_cast(v8i, x)
#define PG8_MMA(ai, bj, At, Bt) do { __builtin_amdgcn_s_setprio(1); _Pragma("unroll") for (int m = 0; m < 4; ++m) _Pragma("unroll") for (int n = 0; n < 2; ++n) { const v8i bop_ = PG8_GET8(Bfr, (Bt) * 2 + n), aop_ = PG8_GET8(Afr, m); \
        asm volatile("v_mfma_scale_f32_16x16x128_f8f6f4 %0, %1, %2, %0, %3, %4 op_sel_hi:[0,0,0]" : "+v"(acc[ai][bj][m][n]) : "v"(bop_), "v"(aop_), "v"(scaleBt), "v"(scaleA)); } __builtin_amdgcn_s_setprio(0); } while (0)
#define PG8_WAIT_V(n) asm volatile("s_waitcnt vmcnt(" #n ")" ::: "memory")
#define PG8_WAIT_L(n) asm volatile("s_waitcnt lgkmcnt(" #n ")" ::: "memory")
#define PG8_BAR __builtin_amdgcn_s_barrier()
#define PG8_SCHED __builtin_amdgcn_sched_barrier(0)
    Unit cur, nxt; int ui = 0;
    if (!S.next(0, cur)) return;
    unit_uniform(cur);
    f32x4 acc[2][2][4][2];
#pragma unroll
    for (int a = 0; a < 2; ++a)
#pragma unroll
        for (int b = 0; b < 2; ++b)
#pragma unroll
            for (int m = 0; m < 4; ++m)
#pragma unroll
                for (int n = 0; n < 2; ++n) acc[a][b][m][n] = (f32x4){0.f, 0.f, 0.f, 0.f};
    v32i Afr, Bfr;
    const char* cA = (const char*)g.A + cur.aoff + (size_t)cur.pm * tstep; const char* cB = (const char*)g.Bt + cur.boff + (size_t)cur.pn * tstep;
    S.a_ready(cur);
    if constexpr (SP2) {
        PG8_STAGE(PG8_SB(0, 0), cB, voffB); PG8_STAGE(PG8_SB(0, 1), cB + hstep, voffB); PG8_STAGE(PG8_SA(0, 0), cA, voffA); PG8_STAGE(PG8_SA(0, 1), cA + hstep, voffA);
        if (wr == 1) PG8_BAR;
        PG8_WAIT_V(2); PG8_BAR;
        PG8_STAGE(PG8_SB(1, 0), cB + kstep, voffB); PG8_STAGE(PG8_SA(1, 0), cA + kstep, voffA); PG8_STAGE(PG8_SB(1, 1), cB + hstep + kstep, voffB);
        PG8_WAIT_V(6); PG8_BAR;
    } else {
        PG8_STAGE(PG8_SB(0, 0), cB, voffB); PG8_STAGE(PG8_SA(0, 0), cA, voffA); PG8_STAGE(PG8_SB(0, 1), cB + hstep, voffB); PG8_STAGE(PG8_SA(0, 1), cA + hstep, voffA);
        if (wr == 1) PG8_BAR;
        PG8_WAIT_V(4); PG8_BAR;
        PG8_STAGE(PG8_SB(1, 0), cB + kstep, voffB); PG8_STAGE(PG8_SA(1, 0), cA + kstep, voffA); PG8_STAGE(PG8_SB(1, 1), cB + hstep + kstep, voffB);
        PG8_WAIT_V(6); PG8_BAR;
    }
    for (;;) {
        const bool has_next = __builtin_amdgcn_readfirstlane((int)S.next(ui + 1, nxt)) != 0; unit_uniform(nxt);
        const char* nA = has_next ? (const char*)g.A + nxt.aoff + (size_t)nxt.pm * tstep : cA; const char* nB = has_next ? (const char*)g.Bt + nxt.boff + (size_t)nxt.pn * tstep : cB;
        for (int t = 0; t < nt; t += 2) {
            const bool last = (t == nt - 2);
            const char* a1 = cA + (size_t)(t + 1) * kstep;
            const char* a2 = last ? nA : cA + (size_t)(t + 2) * kstep; const char* b2 = last ? nB : cB + (size_t)(t + 2) * kstep;
            const char* a3 = a2 + kstep; const char* b3 = b2 + kstep;
            if (last && has_next) S.a_ready(nxt);
            if constexpr (SP2) {
            PG8_LDB(0, 0, 0); PG8_LDB(1, 0, 1); PG8_SCHED; PG8_LDA(0, 0, 0); PG8_STAGE(PG8_SA(1, 1), a1 + hstep, voffA);
            PG8_WAIT_V(8); PG8_WAIT_L(0); PG8_BAR; PG8_MMA(0, 0, 0, 0); PG8_MMA(0, 1, 0, 1); PG8_BAR; PG8_SCHED;
            PG8_LDA(0, 0, 1); PG8_STAGE(PG8_SB(0, 0), b2, voffB); PG8_STAGE(PG8_SB(0, 1), b2 + hstep, voffB); PG8_STAGE(PG8_SA(0, 0), a2, voffA);
            PG8_WAIT_V(8); PG8_WAIT_L(0); PG8_BAR; PG8_MMA(1, 0, 0, 0); PG8_MMA(1, 1, 0, 1); PG8_BAR; PG8_SCHED;
            PG8_LDB(0, 1, 0); PG8_LDB(1, 1, 1); PG8_SCHED; PG8_LDA(0, 1, 0); PG8_STAGE(PG8_SA(0, 1), a2 + hstep, voffA);
            PG8_WAIT_V(8); PG8_WAIT_L(0); PG8_BAR; PG8_MMA(0, 0, 0, 0); PG8_MMA(0, 1, 0, 1); PG8_BAR; PG8_SCHED;
            PG8_LDA(0, 1, 1); PG8_STAGE(PG8_SB(1, 0), b3, voffB); PG8_STAGE(PG8_SB(1, 1), b3 + hstep, voffB); PG8_STAGE(PG8_SA(1, 0), a3, voffA);
            PG8_WAIT_V(8); PG8_WAIT_L(0); PG8_BAR; PG8_MMA(1, 0, 0, 0); PG8_MMA(1, 1, 0, 1); PG8_BAR; PG8_SCHED;
            } else {
            PG8_LDB(0, 0, 0); PG8_SCHED; PG8_LDA(0, 0, 0); PG8_STAGE(PG8_SA(1, 1), a1 + hstep, voffA);
            PG8_WAIT_L(8); PG8_BAR; PG8_WAIT_L(0); PG8_MMA(0, 0, 0, 0); PG8_BAR; PG8_SCHED;
            PG8_LDB(1, 0, 1); PG8_STAGE(PG8_SB(0, 0), b2, voffB);
            PG8_BAR; PG8_WAIT_L(0); PG8_MMA(0, 1, 0, 1); PG8_BAR;
            PG8_LDA(0, 0, 1); PG8_STAGE(PG8_SA(0, 0), a2, voffA);
            PG8_BAR; PG8_WAIT_L(0); PG8_MMA(1, 0, 0, 0); PG8_BAR; PG8_SCHED;
            PG8_STAGE(PG8_SB(0, 1), b2 + hstep, voffB);
            PG8_WAIT_V(6); PG8_BAR; PG8_MMA(1, 1, 0, 1); PG8_BAR;
            PG8_LDB(0, 1, 0); PG8_SCHED; PG8_LDA(0, 1, 0); PG8_STAGE(PG8_SA(0, 1), a2 + hstep, voffA);
            PG8_WAIT_L(8); PG8_BAR; PG8_WAIT_L(0); PG8_MMA(0, 0, 0, 0); PG8_BAR; PG8_SCHED;
            PG8_LDB(1, 1, 1); PG8_STAGE(PG8_SB(1, 0), b3, voffB);
            PG8_BAR; PG8_WAIT_L(0); PG8_MMA(0, 1, 0, 1); PG8_BAR;
            PG8_LDA(0, 1, 1); PG8_STAGE(PG8_SA(1, 0), a3, voffA);
            PG8_BAR; PG8_WAIT_L(0); PG8_MMA(1, 0, 0, 0); PG8_BAR; PG8_SCHED;
            PG8_STAGE(PG8_SB(1, 1), b3 + hstep, voffB);
            PG8_WAIT_V(6); PG8_BAR; PG8_MMA(1, 1, 0, 1); PG8_BAR;
            }
        }
        asm volatile("s_nop 15\n\ts_nop 15" ::: "memory");
        if constexpr (ALIGN_EPI) { if (wr == 0) PG8_BAR; }
        if constexpr (!Epi::AFTER_DRAIN) { E(acc, cur, wr, wc, fr, fq); S.done(cur); }
        if (!has_next) break;
#pragma unroll
        for (int a = 0; a < 2; ++a)
#pragma unroll
            for (int b = 0; b < 2; ++b)
#pragma unroll
                for (int m = 0; m < 4; ++m)
#pragma unroll
                    for (int n = 0; n < 2; ++n) acc[a][b][m][n] = (f32x4){0.f, 0.f, 0.f, 0.f};
        cur = nxt; cA = nA; cB = nB; ++ui;
        if constexpr (ALIGN_EPI) { if (wr == 1) PG8_BAR; }
    }
    PG8_WAIT_V(0);
    if constexpr (!ALIGN_EPI) { if (wr == 0) PG8_BAR; }
    PG8_BAR;
#undef PG8_SA
#undef PG8_SB
#undef PG8_STAGE
#undef PG8_LDA
#undef PG8_LDB
#undef PG8_MMA
#undef PG8_F8
#undef PG8_INS8
#undef PG8_GET8
#undef PG8_WAIT_V
#undef PG8_WAIT_L
#undef PG8_BAR
#undef PG8_SCHED
}
}

#ifndef ZERO_MOE
#define ZERO_MOE 0
#endif
#ifndef ZERO_FFN
#define ZERO_FFN 0
#endif
#ifndef ZERO_A
#define ZERO_A 0
#endif
#ifndef ZERO_B
#define ZERO_B 0
#endif
#ifndef ZERO_C
#define ZERO_C 0
#endif
#ifndef ZERO_D
#define ZERO_D 0
#endif
constexpr int NWAVES = 8;
constexpr int NB = 16, SEQ = 2048, DM = 2048, M = NB * SEQ;
constexpr int NIN = 5328, NINP = 5376;
constexpr int C_QC = 0, C_KVC = 384, C_KPE = 640, C_RQ = 704, C_RK = 960, C_RV = 1216, C_RG = 1728, C_MZ = 2240, C_XBC = 2752, C_DT = 3776, C_HU = 3792;
constexpr int DFF = 5632, DFFE = 7168, NEXP = 8;
constexpr int CAP_ROWS = 2 * M + NEXP * 256, CAP_RB = CAP_ROWS / 256;
constexpr int MOE_CH = 1, MOE_CH_RB = CAP_RB / MOE_CH;
constexpr float ALPHA = 1.4142135623730951f;
constexpr int HY_OFF = 2055, HY_GLEN = 4112;

constexpr size_t al256(size_t x) { return (x + 255) / 256 * 256; }
constexpr size_t WS_CTL = 0, CTL_ZERO_BYTES = 1u << 20;
constexpr size_t SZ_WIN = (size_t)NINP * DM * 2, SZ_WUQ = (size_t)768 * 384 * 2, SZ_WUKV = (size_t)1024 * 256 * 2, SZ_WOUT = (size_t)DM * DM * 2;
constexpr size_t WS_WIN = CTL_ZERO_BYTES;
constexpr size_t WS_WUQ = WS_WIN + 2 * SZ_WIN;
constexpr size_t WS_WUKV = WS_WUQ + 2 * SZ_WUQ;
constexpr size_t WS_WOUT = WS_WUKV + 2 * SZ_WUKV;
constexpr size_t WS_WGU = WS_WOUT + 2 * SZ_WOUT;
constexpr size_t WS_WDN = WS_WGU + (size_t)2 * DFF * DM * 2;
constexpr size_t WS_HYG = WS_WDN + (size_t)DM * DFF * 2;
constexpr size_t WS_XB = al256(WS_HYG + (size_t)2 * 2 * 512 * HY_GLEN * 2);
constexpr size_t WS_XF8 = WS_XB + (size_t)M * DM * 2;
constexpr size_t WS_RT = WS_XF8 + (size_t)M * DM;
constexpr size_t WS_RTG = WS_RT + (size_t)M * 16;
constexpr size_t WS_SLOT = WS_RTG + (size_t)M * 8;
constexpr size_t WS_SLOTG = WS_SLOT + (size_t)CAP_ROWS * 4;
constexpr size_t WS_SCR = al256(WS_SLOTG + (size_t)CAP_ROWS * 4);
constexpr size_t WS_PROJ = WS_SCR;
constexpr size_t WS_DTF = WS_PROJ + (size_t)M * NINP * 2;
constexpr size_t WS_QN = WS_DTF + (size_t)M * 16 * 4;
constexpr size_t WS_KVN = WS_QN + (size_t)M * 384 * 2;
constexpr size_t WS_KPE = WS_KVN + (size_t)M * 256 * 2;
constexpr size_t WS_RQ = WS_KPE + (size_t)M * 64 * 2;
constexpr size_t WS_RK = WS_RQ + (size_t)M * 256 * 2;
constexpr size_t WS_XBC = WS_RK + (size_t)M * 256 * 2;
constexpr size_t WS_SSDP = WS_XBC + (size_t)M * 1024 * 2;
constexpr size_t WS_UT = WS_SSDP + (size_t)M * 8 * 16;
constexpr size_t WS_QB = WS_UT + (size_t)3 * 512 * M * 2;
constexpr size_t WS_KVB = WS_QB + (size_t)M * 768 * 2;
constexpr size_t WS_ATT = WS_KVB + (size_t)M * 1024 * 2;
constexpr size_t WS_YC = WS_ATT + (size_t)M * 512 * 2;
constexpr size_t WS_ZT = WS_YC + (size_t)M * 512 * 2;
constexpr size_t WS_MIX = WS_ZT + (size_t)512 * M * 2;
constexpr size_t WS_MIX_END = WS_MIX + (size_t)M * DM * 2;
constexpr size_t WS_HID = WS_SCR;
constexpr size_t WS_MGU = WS_SCR;
constexpr size_t WS_MDN = WS_MGU + (size_t)NEXP * 2 * DFFE * DM;
constexpr size_t WS_XS = WS_MDN + (size_t)NEXP * DM * DFFE;
constexpr size_t WS_HIDS = WS_XS + (size_t)CAP_ROWS * DM;
constexpr size_t WS_Y0 = WS_HIDS + (size_t)MOE_CH_RB * 256 * DFFE;
constexpr size_t WS_Y1 = WS_Y0 + (size_t)M * DM * 2;
constexpr size_t WS_END = WS_Y1 + (size_t)M * DM * 2;
static_assert(WS_MIX_END <= WS_END && WS_HID + (size_t)M * DFF * 2 <= WS_END, "d_ws map");
static_assert(WS_END <= 1942000000ull, "d_ws map exceeds the guaranteed workspace");
constexpr int CW_TMO = 0, CW_CODE = 1;
constexpr int CW_CNT = 64;
constexpr int CW_MIXQ = 1024;
constexpr int CW_BAR = 4096;

constexpr int RING_OFF = 0, RING_BYTES = 131072;
constexpr int LDSCTL_OFF = RING_BYTES, MISC_OFF = LDSCTL_OFF + 320;
constexpr int LDS_BYTES = 147456;

#define GAS __attribute__((address_space(1)))
#define LAS __attribute__((address_space(3)))
typedef unsigned short bf16;
typedef unsigned v4u __attribute__((ext_vector_type(4)));
typedef unsigned v2u __attribute__((ext_vector_type(2)));
typedef float f32x4 __attribute__((ext_vector_type(4)));
typedef float f32x2 __attribute__((ext_vector_type(2)));
typedef float f32x16 __attribute__((ext_vector_type(16)));
typedef short bf16x8 __attribute__((ext_vector_type(8)));
typedef short s16x4 __attribute__((ext_vector_type(4)));
typedef GAS unsigned gu32;
#define RLX_AGENT __ATOMIC_RELAXED, __HIP_MEMORY_SCOPE_AGENT
#define LDS_WAIT() asm volatile("s_waitcnt lgkmcnt(0)" ::: "memory")
#define VM_WAIT() asm volatile("s_waitcnt vmcnt(0)" ::: "memory")
__device__ __forceinline__ unsigned f2bf(float f) { unsigned u = __builtin_bit_cast(unsigned, f); return (u + 0x7fffu + ((u >> 16) & 1u)) >> 16; }
__device__ __forceinline__ unsigned pk2(float lo, float hi) { return f2bf(lo) | (f2bf(hi) << 16); }
__device__ __forceinline__ float bf2f(unsigned b) { return __builtin_bit_cast(float, b << 16); }
__device__ __forceinline__ float bflo(unsigned w) { return __builtin_bit_cast(float, w << 16); }
__device__ __forceinline__ float bfhi(unsigned w) { return __builtin_bit_cast(float, w & 0xffff0000u); }
__device__ __forceinline__ float silu(float v) { return v / (1.0f + __expf(-v)); }
template <int K> __device__ __forceinline__ float swz_xor(float v) { return __builtin_bit_cast(float, __builtin_amdgcn_ds_swizzle(__builtin_bit_cast(int, v), (K << 10) | 0x1f)); }
__device__ __forceinline__ float half_sum(float v) { v += swz_xor<1>(v); v += swz_xor<2>(v); v += swz_xor<4>(v); v += swz_xor<8>(v); v += swz_xor<16>(v); return v; }
__device__ __forceinline__ float wave_sum(float v) { v = half_sum(v);
    auto rr = __builtin_amdgcn_permlane32_swap(__builtin_bit_cast(unsigned, v), __builtin_bit_cast(unsigned, v), false, false);
    const unsigned r0 = rr[0], r1 = rr[1];
    return __uint_as_float(r0) + __uint_as_float(r1); }

#define XB_TMO      128
#define XB_XCNT(j)  (256  + 64 * (j))
#define XB_XSUB(j)  (1280 + 64 * (j))
#define XB_XGEN(j)  (2304 + 64 * (j))
#define XB_TOP      3328
#define XB_TOPGEN   3392
#define XCD_BAR_WORDS 3456
#define XB_SPIN_CAP (1u << 18)
__device__ __forceinline__ unsigned xb_ld(unsigned* p)              { return __hip_atomic_load(p, __ATOMIC_RELAXED, __HIP_MEMORY_SCOPE_AGENT); }
__device__ __forceinline__ unsigned xb_add(unsigned* p, unsigned v) { return __hip_atomic_fetch_add(p, v, __ATOMIC_RELAXED, __HIP_MEMORY_SCOPE_AGENT); }
__device__ __forceinline__ unsigned xb_xcc_id() { return (unsigned)__builtin_amdgcn_s_getreg((3 << 11) | 20) & 0xFu; }
#define XB_SPIN(cond, bar) do { unsigned _sp = 0; while (cond) { __builtin_amdgcn_s_sleep(1); \
    if ((++_sp & 255u) == 0u) { if (xb_ld(&(bar)[XB_TMO])) break; if (_sp > XB_SPIN_CAP) { atomicAdd(&(bar)[XB_TMO], 1u); break; } } } } while (0)
struct XcdBarrier { unsigned* bar; unsigned x; volatile LAS unsigned* st; };
__device__ __forceinline__ XcdBarrier xcd_barrier_post(unsigned* bar, volatile LAS unsigned* st) {
    XcdBarrier b; b.bar = bar; b.x = xb_xcc_id(); b.st = st;
    if (threadIdx.x == 0) (void)xb_add(&bar[XB_XCNT(b.x)], 1u);
    return b;
}
__device__ __forceinline__ void xcd_barrier_complete(unsigned* bar, unsigned x, unsigned& nloc, unsigned& nx) {
    const unsigned G = gridDim.x * gridDim.y * gridDim.z;
    unsigned sum, cnt, mine, sp = 0u;
    for (;;) {
        sum = 0u; cnt = 0u; mine = 0u;
#pragma unroll
        for (unsigned j = 0; j < 16; ++j) { const unsigned c = xb_ld(&bar[XB_XCNT(j)]); sum += c; cnt += (c > 0u) ? 1u : 0u; mine = (j == x) ? c : mine; }
        if (sum == G) break;
        __builtin_amdgcn_s_sleep(1);
        if ((++sp & 255u) == 0u) { if (xb_ld(&bar[XB_TMO])) break; if (sp > XB_SPIN_CAP) { atomicAdd(&bar[XB_TMO], 1u); break; } }
    }
    nloc = mine > 0u ? mine : 1u; nx = cnt > 0u ? cnt : 1u;
}
__device__ __forceinline__ void xcd_barrier(const XcdBarrier& b) {
    asm volatile("s_waitcnt vmcnt(0)" ::: "memory");
    __syncthreads();
    if (threadIdx.x == 0) {
        unsigned* bar = b.bar;
        __builtin_amdgcn_s_waitcnt(0);
        unsigned nloc = b.st[0], nx = b.st[1];
        if (nloc == 0u) { xcd_barrier_complete(bar, b.x, nloc, nx); b.st[0] = nloc; b.st[1] = nx; }
        const unsigned old = xb_add(&bar[XB_XSUB(b.x)], 1u);
        const unsigned gen = old / nloc;
        if (old + 1u == (gen + 1u) * nloc) {
            __builtin_amdgcn_fence(__ATOMIC_RELEASE, "agent");
            asm volatile("s_waitcnt vmcnt(0)" ::: "memory");
            const unsigned og = xb_add(&bar[XB_TOP], 1u);
            const unsigned tg = og / nx;
            if (og + 1u == (tg + 1u) * nx) xb_add(&bar[XB_TOPGEN], 1u);
            else XB_SPIN(xb_ld(&bar[XB_TOPGEN]) == tg, bar);
            __builtin_amdgcn_fence(__ATOMIC_ACQUIRE, "agent");
            xb_add(&bar[XB_XGEN(b.x)], 1u);
            asm volatile("s_waitcnt vmcnt(0)" ::: "memory");
        } else {
            XB_SPIN(xb_ld(&bar[XB_XGEN(b.x)]) == gen, bar);
            __builtin_amdgcn_fence(__ATOMIC_ACQUIRE, "agent");
            asm volatile("s_waitcnt vmcnt(0)" ::: "memory");
        }
    }
    __syncthreads();
}

struct Args {
    const float* in[35]; float* out; unsigned char* ws; int ph_lo, ph_hi;
};
enum { I_X = 0, I_WIN, I_QNORM, I_WUQ, I_KVNORM, I_WUKV, I_OUTNORM, I_CONVW, I_CONVB, I_DTBIAS, I_ALOG, I_SSDD, I_SSDNORM, I_HYCW, I_HYCB, I_HYW1, I_HYB1, I_HYW2, I_HYB2, I_HYW3, I_HYFREQ, I_HYBIAS, I_HYNORM,
       I_WOUT, I_LN1G, I_LN1B, I_LN2G, I_LN2B, I_FFG, I_FFU, I_FFD, I_ROUTER, I_MOEG, I_MOEU, I_MOED };

typedef __attribute__((address_space(4))) const Args CArgs;
struct AP { const CArgs* p;
    __device__ __forceinline__ const float* in(int i) const { return p->in[i]; }
    __device__ __forceinline__ float* out() const { return p->out; }
    __device__ __forceinline__ unsigned char* ws() const { return p->ws; } };
__device__ __forceinline__ AP kargs() { const CArgs* p = (const CArgs*)__builtin_amdgcn_kernarg_segment_ptr(); asm volatile("" : "+s"(p)); AP a; a.p = p; return a; }

__device__ __forceinline__ void transpose_item(const float* W, int K, int N, int nblk, bf16* WT, int GR, int GS, int off, LAS float* scr, int item, int lane) {
    const int kb = item / nblk, nb = item % nblk, k0 = 64 * kb, n0 = 32 * nb;
    const int nr = n0 + (lane & 31); const bool ok = nr < N;
    float tv[32]; const int nrc = ok ? nr : N - 1;
#pragma unroll
    for (int i = 0; i < 32; ++i) { const int kk = 2 * i + (lane >> 5); tv[i] = W[(size_t)(k0 + kk) * N + nrc]; }
#pragma unroll
    for (int i = 0; i < 32; ++i) { const int kk = 2 * i + (lane >> 5); scr[kk * 33 + (lane & 31)] = ok ? tv[i] : 0.f; }
    LDS_WAIT(); asm volatile("" ::: "memory");
    const int c = lane & 7;
#pragma unroll
    for (int j = 0; j < 4; ++j) { const int nl = (lane >> 3) + 8 * j; const int n = n0 + nl; const LAS float* s = scr + (8 * c) * 33 + nl;
        v4u o; o.x = pk2(s[0 * 33], s[1 * 33]); o.y = pk2(s[2 * 33], s[3 * 33]); o.z = pk2(s[4 * 33], s[5 * 33]); o.w = pk2(s[6 * 33], s[7 * 33]);
        const int dest = (n / GR) * GS + (n % GR) + off;
        *(GAS v4u*)(WT + (size_t)dest * K + k0 + 8 * c) = o; }
    LDS_WAIT(); asm volatile("" ::: "memory");
}
__device__ __forceinline__ unsigned pk4_fp8(float a, float b, float c, float d) { int w = 0; w = __builtin_amdgcn_cvt_pk_fp8_f32(a, b, w, false); w = __builtin_amdgcn_cvt_pk_fp8_f32(c, d, w, true); return (unsigned)w; }
struct TrF8 { const float* W; int K, N, nblk; unsigned char* WT; int GR, GS, off; float scl; };
__device__ __forceinline__ void tr_f8_load(const TrF8& j, int item, int lane, float (&tv)[32]) {
    const int kb = item / j.nblk, nb = item % j.nblk, k0 = 64 * kb, n0 = 32 * nb; const int nr = n0 + (lane & 31);
#pragma unroll
    for (int i = 0; i < 32; ++i) { const int kk = 2 * i + (lane >> 5); tv[i] = j.W[(size_t)(k0 + kk) * j.N + nr]; }
}
__device__ __forceinline__ void tr_f8_finish(const TrF8& j, int item, int lane, const float (&tv)[32], LAS float* scr) {
    const int kb = item / j.nblk, nb = item % j.nblk, k0 = 64 * kb, n0 = 32 * nb;
#pragma unroll
    for (int i = 0; i < 32; ++i) { const int kk = 2 * i + (lane >> 5); scr[kk * 33 + (lane & 31)] = tv[i] * j.scl; }
    LDS_WAIT(); asm volatile("" ::: "memory");
    const int nl = lane >> 1, hf = lane & 1, n = n0 + nl; const LAS float* sp = scr + (32 * hf) * 33 + nl;
    v4u o0, o1;
    o0.x = pk4_fp8(sp[0 * 33], sp[1 * 33], sp[2 * 33], sp[3 * 33]); o0.y = pk4_fp8(sp[4 * 33], sp[5 * 33], sp[6 * 33], sp[7 * 33]);
    o0.z = pk4_fp8(sp[8 * 33], sp[9 * 33], sp[10 * 33], sp[11 * 33]); o0.w = pk4_fp8(sp[12 * 33], sp[13 * 33], sp[14 * 33], sp[15 * 33]);
    o1.x = pk4_fp8(sp[16 * 33], sp[17 * 33], sp[18 * 33], sp[19 * 33]); o1.y = pk4_fp8(sp[20 * 33], sp[21 * 33], sp[22 * 33], sp[23 * 33]);
    o1.z = pk4_fp8(sp[24 * 33], sp[25 * 33], sp[26 * 33], sp[27 * 33]); o1.w = pk4_fp8(sp[28 * 33], sp[29 * 33], sp[30 * 33], sp[31 * 33]);
    const int dest = (n / j.GR) * j.GS + (n % j.GR) + j.off;
    GAS v4u* dp = (GAS v4u*)(j.WT + (size_t)dest * j.K + k0 + 32 * hf); dp[0] = o0; dp[1] = o1;
    LDS_WAIT(); asm volatile("" ::: "memory");
}
__device__ __forceinline__ void transpose_item_f8(const float* W, int K, int N, int nblk, unsigned char* WT, int GR, int GS, int off, float scl, LAS float* scr, int item, int lane) {
    TrF8 j{W, K, N, nblk, WT, GR, GS, off, scl}; float tv[32]; tr_f8_load(j, item, lane, tv); tr_f8_finish(j, item, lane, tv, scr);
}
struct TrJob { const float* W; int K, N, nblk; bf16* WT; int GR, GS, off; int items; };
__device__ __forceinline__ TrJob mk_job(const float* W, int K, int N, int Npad, bf16* WT, int GR, int GS, int off) { TrJob j; j.W = W; j.K = K; j.N = N; j.nblk = Npad / 32; j.WT = WT; j.GR = GR; j.GS = GS; j.off = off; j.items = (K / 64) * (Npad / 32); return j; }

__device__ __forceinline__ void hyena_filter_item(const AP& a, int layer, int pos, bf16* HYG, LAS float* scr, int lane) {
    const float* w1 = a.in(I_HYW1) + layer * 33 * 64; const float* b1 = a.in(I_HYB1) + layer * 64;
    const float* w2 = a.in(I_HYW2) + layer * 64 * 64; const float* b2 = a.in(I_HYB2) + layer * 64;
    const float* w3 = a.in(I_HYW3) + (size_t)layer * 64 * 2048; const float* fr = a.in(I_HYFREQ) + layer * 128;
    const float t = (float)pos / 2047.0f; const float ang = 6.283185307179586f * (float)pos / 2048.0f;
    if (lane < 33) { float z;
        if (lane == 0) z = t;
        else { const int k = (lane - 1) & 15; const float f = 1e-4f + (float)k * ((15.0f - 1e-4f) / 15.0f); z = (lane <= 16) ? cosf(f * ang) : -sinf(f * ang); }
        scr[lane] = z; }
    LDS_WAIT(); asm volatile("" ::: "memory");
    float s = b1[lane];
    for (int i = 0; i < 33; ++i) s += scr[i] * w1[i * 64 + lane];
    const float h1 = sinf(fr[lane] * s);
    scr[64 + lane] = h1;
    LDS_WAIT(); asm volatile("" ::: "memory");
    float s2 = b2[lane];
    for (int i = 0; i < 64; ++i) s2 += scr[64 + i] * w2[i * 64 + lane];
    const float h2 = sinf(fr[64 + lane] * s2);
    scr[128 + lane] = h2;
    LDS_WAIT(); asm volatile("" ::: "memory");
    for (int m = 0; m < 32; ++m) { const int col = lane + 64 * m; float v = 0.f;
        for (int i = 0; i < 64; ++i) v += scr[128 + i] * w3[(size_t)i * 2048 + col];
        const int o = col >> 10, dir = (col >> 9) & 1, c = col & 511;
        const float delta = fabsf(-3.0701134573253945f + (float)c * ((-15.350567286626973f + 3.0701134573253945f) / 511.0f));
        v *= expf(-t * delta);
        if (dir == 0 || pos > 0) { const int n = dir == 0 ? HY_OFF - pos : HY_OFF + pos;
            HYG[(((size_t)layer * 2 + o) * 512 + c) * HY_GLEN + n] = (bf16)f2bf(v); } }
    LDS_WAIT(); asm volatile("" ::: "memory");
}

__device__ __forceinline__ void ln_load(const float* xrow, int lane, f32x4 (&v)[8]) { const GAS f32x4* xr = (const GAS f32x4*)xrow + lane;
#pragma unroll
    for (int j = 0; j < 8; ++j) v[j] = xr[64 * j]; }
__device__ __forceinline__ void ln_row(float* xrow, bf16* brow, const float* g, const float* b, int lane, f32x4 (&v)[8], const bf16* y0, const bf16* y1, float* orow, unsigned char* frow = nullptr) {
    float s = 0.f; (void)xrow;
#pragma unroll
    for (int j = 0; j < 8; ++j) {
        if (y0) { v2u a0 = *((const GAS v2u*)y0 + lane + 64 * j), a1 = *((const GAS v2u*)y1 + lane + 64 * j); if (ZERO_MOE) { a0.x = a0.y = a1.x = a1.y = 0u; }
            v[j].x = ALPHA * v[j].x + bflo(a0.x) + bflo(a1.x); v[j].y = ALPHA * v[j].y + bfhi(a0.x) + bfhi(a1.x); v[j].z = ALPHA * v[j].z + bflo(a0.y) + bflo(a1.y); v[j].w = ALPHA * v[j].w + bfhi(a0.y) + bfhi(a1.y); }
        s += (v[j].x + v[j].y) + (v[j].z + v[j].w); }
    const float mean = wave_sum(s) * (1.f / DM); float s2 = 0.f;
#pragma unroll
    for (int j = 0; j < 8; ++j) { v[j] = v[j] - mean; s2 += (v[j].x * v[j].x + v[j].y * v[j].y) + (v[j].z * v[j].z + v[j].w * v[j].w); }
    const float rstd = 1.f / sqrtf(wave_sum(s2) * (1.f / DM) + 1e-5f);
    GAS f32x4* xo = (GAS f32x4*)orow + lane;
#pragma unroll
    for (int j = 0; j < 8; ++j) { const f32x4 gg = *((const GAS f32x4*)g + lane + 64 * j), bb = *((const GAS f32x4*)b + lane + 64 * j);
        v[j] = v[j] * rstd * gg + bb; xo[64 * j] = v[j];
        if (brow) { v2u w; w.x = pk2(v[j].x, v[j].y); w.y = pk2(v[j].z, v[j].w); *((GAS v2u*)brow + lane + 64 * j) = w; }
        if (frow) *((GAS unsigned*)frow + lane + 64 * j) = pk4_fp8(v[j].x, v[j].y, v[j].z, v[j].w); }
}

__device__ __forceinline__ void ld8bf(const bf16* p, float (&f)[8]) { const v4u w = *(const GAS v4u*)p; f[0] = bflo(w.x); f[1] = bfhi(w.x); f[2] = bflo(w.y); f[3] = bfhi(w.y); f[4] = bflo(w.z); f[5] = bfhi(w.z); f[6] = bflo(w.w); f[7] = bfhi(w.w); }
__device__ __forceinline__ void st8bf(bf16* p, const float (&f)[8]) { v4u w; w.x = pk2(f[0], f[1]); w.y = pk2(f[2], f[3]); w.z = pk2(f[4], f[5]); w.w = pk2(f[6], f[7]); *(GAS v4u*)p = w; }

__device__ __forceinline__ float sum8(float v) { v += swz_xor<1>(v); v += swz_xor<2>(v); v += swz_xor<4>(v); return v; }
__device__ __forceinline__ void prep_rows8(const AP& a, int layer, int item, int lane, unsigned char* ws, const LAS float* cwl) {
    const int rr = lane >> 3, sub = lane & 7, row = item * 8 + rr, t = row & (SEQ - 1);
    const bf16* pr = (const bf16*)(ws + WS_PROJ) + (size_t)row * NINP;
    { float f[6][8]; float ss = 0.f;
#pragma unroll
      for (int i = 0; i < 6; ++i) { ld8bf(pr + C_QC + (sub + 8 * i) * 8, f[i]);
#pragma unroll
          for (int j = 0; j < 8; ++j) ss += f[i][j] * f[i][j]; }
      const float rs = 1.0f / sqrtf(sum8(ss) * (1.f / 384.f) + 1e-6f);
#pragma unroll
      for (int i = 0; i < 6; ++i) { const float* w = a.in(I_QNORM) + layer * 384 + (sub + 8 * i) * 8;
#pragma unroll
          for (int j = 0; j < 8; ++j) f[i][j] = f[i][j] * rs * w[j];
          st8bf((bf16*)(ws + WS_QN) + (size_t)row * 384 + (sub + 8 * i) * 8, f[i]); } }
    { float f[4][8]; float ss = 0.f;
#pragma unroll
      for (int i = 0; i < 4; ++i) { ld8bf(pr + C_KVC + (sub + 8 * i) * 8, f[i]);
#pragma unroll
          for (int j = 0; j < 8; ++j) ss += f[i][j] * f[i][j]; }
      const float rs = 1.0f / sqrtf(sum8(ss) * (1.f / 256.f) + 1e-6f);
#pragma unroll
      for (int i = 0; i < 4; ++i) { const float* w = a.in(I_KVNORM) + layer * 256 + (sub + 8 * i) * 8;
#pragma unroll
          for (int j = 0; j < 8; ++j) f[i][j] = f[i][j] * rs * w[j];
          st8bf((bf16*)(ws + WS_KVN) + (size_t)row * 256 + (sub + 8 * i) * 8, f[i]); } }
    { float sn[4], cs[4];
#pragma unroll
      for (int j = 0; j < 4; ++j) { const float inv = exp2f(-(float)(4 * sub + j) * (13.287712379549449f / 32.0f)); sincosf((float)t * inv, &sn[j], &cs[j]); }
#pragma unroll
      for (int g = 0; g < 9; ++g) { int src; bf16* dst; float sc = 1.f;
          if (g == 0) { src = C_KPE; dst = (bf16*)(ws + WS_KPE) + (size_t)row * 64; }
          else if (g < 5) { src = C_RQ + (g - 1) * 64; dst = (bf16*)(ws + WS_RQ) + (size_t)row * 256 + (g - 1) * 64; }
          else { src = C_RK + (g - 5) * 64; dst = (bf16*)(ws + WS_RK) + (size_t)row * 256 + (g - 5) * 64; sc = 0.125f; }
          const v2u a1 = *(const GAS v2u*)(pr + src + 4 * sub), a2 = *(const GAS v2u*)(pr + src + 32 + 4 * sub);
          const float x1[4] = {bflo(a1.x), bfhi(a1.x), bflo(a1.y), bfhi(a1.y)}, x2[4] = {bflo(a2.x), bfhi(a2.x), bflo(a2.y), bfhi(a2.y)};
          float y1[4], y2[4];
#pragma unroll
          for (int j = 0; j < 4; ++j) { y1[j] = (x1[j] * cs[j] - x2[j] * sn[j]) * sc; y2[j] = (x2[j] * cs[j] + x1[j] * sn[j]) * sc; }
          v2u o1, o2; o1.x = pk2(y1[0], y1[1]); o1.y = pk2(y1[2], y1[3]); o2.x = pk2(y2[0], y2[1]); o2.y = pk2(y2[2], y2[3]);
          *(GAS v2u*)(dst + 4 * sub) = o1; *(GAS v2u*)(dst + 32 + 4 * sub) = o2; } }
#pragma unroll 4
    for (int i = 0; i < 16; ++i) { const int c0 = (sub + 8 * i) * 8; float acc[8];
        { const f32x4 b0 = *(const LAS f32x4*)(cwl + 5 * 1024 + c0), b1 = *(const LAS f32x4*)(cwl + 5 * 1024 + c0 + 4); acc[0] = b0.x; acc[1] = b0.y; acc[2] = b0.z; acc[3] = b0.w; acc[4] = b1.x; acc[5] = b1.y; acc[6] = b1.z; acc[7] = b1.w; }
#pragma unroll
        for (int k = 0; k < 5; ++k) { const int tt = t + k - 2;
            if (tt >= 0 && tt < SEQ) { float f[8]; ld8bf(pr + (long)(k - 2) * NINP + C_XBC + c0, f);
                const f32x4 w0 = *(const LAS f32x4*)(cwl + k * 1024 + c0), w1 = *(const LAS f32x4*)(cwl + k * 1024 + c0 + 4);
                acc[0] += w0.x * f[0]; acc[1] += w0.y * f[1]; acc[2] += w0.z * f[2]; acc[3] += w0.w * f[3]; acc[4] += w1.x * f[4]; acc[5] += w1.y * f[5]; acc[6] += w1.z * f[6]; acc[7] += w1.w * f[7]; } }
#pragma unroll
        for (int j = 0; j < 8; ++j) acc[j] = silu(acc[j]);
        st8bf((bf16*)(ws + WS_XBC) + (size_t)row * 1024 + c0, acc); }
}
__device__ __forceinline__ void prep_scan(const AP& a, int layer, int item, int lane, unsigned char* ws, LAS float* scr) {
    const int b = item >> 4, dir = (item >> 3) & 1, hh = item & 7;
    const float* DTF = (const float*)(ws + WS_DTF); float* SSDP = (float*)(ws + WS_SSDP);
    const float bias = a.in(I_DTBIAS)[layer * 16 + dir * 8 + hh]; const float av = -expf(a.in(I_ALOG)[layer * 16 + dir * 8 + hh]);
    float dt[32]; float tot = 0.f;
#pragma unroll
    for (int j = 0; j < 32; ++j) { const int row = b * SEQ + lane * 32 + j; const float x = DTF[(size_t)row * 16 + dir * 8 + hh] + bias;
        dt[j] = x > 20.f ? x : log1pf(expf(x)); tot += dt[j] * av; }
    scr[lane] = tot; LDS_WAIT(); asm volatile("" ::: "memory");
    float excl = 0.f, T = 0.f;
#pragma unroll 2
    for (int l = 0; l < 64; ++l) { const float v = scr[l]; T += v; excl += (l < lane) ? v : 0.f; }
    LDS_WAIT(); asm volatile("" ::: "memory");
    float run = excl;
#pragma unroll
    for (int j = 0; j < 32; ++j) { const int row = b * SEQ + lane * 32 + j; const float la = dt[j] * av; float c;
        if (dir == 0) { run += la; c = run; } else { c = T - run; run += la; }
        f32x2 o; o.x = c * 1.4426950408889634f; o.y = log2f(dt[j]) - o.x;
        *(GAS f32x2*)(SSDP + ((size_t)row * 8 + hh) * 4 + dir * 2) = o; }
}
__device__ __forceinline__ void prep_hyconv(const AP& a, int layer, int item, int lane, unsigned char* ws, LAS bf16* scr) {
    const int cg = item % 24, tt = (item / 24) & 31, b = item / (24 * 32);
    const int ch = cg * 64 + lane, part = ch >> 9, c = ch & 511, t0 = tt * 64;
    const bf16* PROJ = (const bf16*)(ws + WS_PROJ); const bf16* tile = PROJ + (size_t)(b * SEQ) * NINP + C_HU + cg * 64;
    v4u ld[9];
#pragma unroll
    for (int i = 0; i < 9; ++i) { const int id = lane + 64 * i, r = id >> 3, c8 = id & 7, t = t0 - 1 + r;
        ld[i] = (id < 66 * 8 && t >= 0 && t < SEQ) ? *(const GAS v4u*)(tile + (size_t)t * NINP + c8 * 8) : (v4u){0u, 0u, 0u, 0u}; }
#pragma unroll
    for (int i = 0; i < 9; ++i) { const int id = lane + 64 * i, r = id >> 3, c8 = id & 7; if (id < 66 * 8) *(LAS v4u*)(scr + r * 72 + c8 * 8) = ld[i]; }
    const float* cw = a.in(I_HYCW) + layer * 3 * 1536; const float w0 = cw[ch], w1 = cw[1536 + ch], w2 = cw[3072 + ch], bs = a.in(I_HYCB)[layer * 1536 + ch];
    LDS_WAIT(); asm volatile("" ::: "memory");
    float xm = bf2f(scr[lane]), x0 = bf2f(scr[72 + lane]);
    bf16* dst = (bf16*)(ws + WS_UT) + (((size_t)part * 512 + c) * NB + b) * SEQ + t0;
#pragma unroll
    for (int q = 0; q < 8; ++q) { float u[8];
#pragma unroll
        for (int j = 0; j < 8; ++j) { const float xp = bf2f(scr[(q * 8 + j + 2) * 72 + lane]);
            u[j] = bs + w0 * xm + w1 * x0 + w2 * xp; xm = x0; x0 = xp; }
        st8bf(dst + q * 8, u); }
    LDS_WAIT(); asm volatile("" ::: "memory");
}

__device__ __forceinline__ void post_row(const AP& a, int layer, int row, int lane, unsigned char* ws) {
    bf16* MIX = (bf16*)(ws + WS_MIX) + (size_t)row * DM;
    { float f[8]; ld8bf((const bf16*)(ws + WS_ATT) + (size_t)row * 512 + lane * 8, f); float ss = 0.f;
#pragma unroll
      for (int j = 0; j < 8; ++j) ss += f[j] * f[j];
      const float rs = 1.0f / sqrtf(wave_sum(ss) * (1.f / 512.f) + 1e-6f); const float* w = a.in(I_OUTNORM) + layer * 512 + lane * 8;
#pragma unroll
      for (int j = 0; j < 8; ++j) f[j] = ZERO_A ? 0.f : f[j] * rs * w[j];
      st8bf(MIX + lane * 8, f); }
    { float f[8], z[8]; ld8bf((const bf16*)(ws + WS_YC) + (size_t)row * 512 + lane * 8, f); ld8bf((const bf16*)(ws + WS_PROJ) + (size_t)row * NINP + C_MZ + lane * 8, z); float ss = 0.f;
#pragma unroll
      for (int j = 0; j < 8; ++j) { f[j] = f[j] * silu(z[j]); ss += f[j] * f[j]; }
      const float rs = 1.0f / sqrtf(wave_sum(ss) * (1.f / 512.f) + 1e-6f); const float* w = a.in(I_SSDNORM) + layer * 512 + lane * 8;
#pragma unroll
      for (int j = 0; j < 8; ++j) f[j] = ZERO_C ? 0.f : f[j] * rs * w[j];
      st8bf(MIX + 1024 + lane * 8, f); }
}
__device__ __forceinline__ void post_hy(const AP& a, int layer, int item, int lane, unsigned char* ws, LAS bf16* scr) {
    const int b = item >> 7, t0 = (item & 127) * 16, tl = lane & 15, cs = lane >> 4;
    const bf16* ZT = (const bf16*)(ws + WS_ZT) + (size_t)b * SEQ + t0 + tl; const float* w = a.in(I_HYNORM) + layer * 512;
    float ss = 0.f;
#pragma unroll 16
    for (int cc = 0; cc < 128; ++cc) { const float v = bf2f(ZT[(size_t)(cc * 4 + cs) * M]); ss += v * v; }
    ss += swz_xor<16>(ss);
    { auto rr = __builtin_amdgcn_permlane32_swap(__float_as_uint(ss), __float_as_uint(ss), false, false); const unsigned r0 = rr[0], r1 = rr[1]; ss = __uint_as_float(r0) + __uint_as_float(r1); }
    const float rs = 1.0f / sqrtf(ss * (1.f / 512.f) + 1e-6f);
    for (int cg = 0; cg < 8; ++cg) {
#pragma unroll
        for (int jj = 0; jj < 16; ++jj) { const int cl = jj * 4 + cs, c = cg * 64 + cl; scr[tl * 72 + cl] = (bf16)f2bf(ZERO_D ? 0.f : bf2f(ZT[(size_t)c * M]) * rs * w[c]); }
        LDS_WAIT(); asm volatile("" ::: "memory");
#pragma unroll
        for (int i = 0; i < 2; ++i) { const int t2 = (lane >> 3) + 8 * i, c8 = lane & 7; const v4u v = *(const LAS v4u*)(scr + t2 * 72 + c8 * 8);
            *(GAS v4u*)((bf16*)(ws + WS_MIX) + (size_t)(b * SEQ + t0 + t2) * DM + 1536 + cg * 64 + c8 * 8) = v; }
        LDS_WAIT(); asm volatile("" ::: "memory");
    }
}

namespace mixb {
#define SBAR() __builtin_amdgcn_sched_barrier(0)
__device__ __forceinline__ int crow(int r, int hi) { return (r & 3) + 8 * (r >> 2) + 4 * hi; }
__device__ __forceinline__ unsigned cvtpk(float lo, float hi) { unsigned r; asm volatile("v_cvt_pk_bf16_f32 %0, %1, %2" : "=v"(r) : "v"(lo), "v"(hi)); return r; }
__device__ __forceinline__ int v_st(int k, int c) { const int kk = (k & ~0xC) | ((k & 4) << 1) | ((k & 8) >> 1); return ((kk >> 3) * 4 + (c >> 5)) * 512 + ((kk & 7) * 32 + (c & 31)) * 2; }
__device__ __forceinline__ int v_rd_base(int lane) { return ((lane & 3) << 3) | (((lane >> 2) & 3) << 6) | (((lane >> 4) & 1) << 5) | (((lane >> 5) & 1) << 8); }
constexpr int v_rd_off(int d0, int ks, int half) { return d0 * 512 + ks * 4096 + half * 2048; }
template <int OFF> __device__ __forceinline__ s16x4 tr_read(int vb) { s16x4 r; asm volatile("ds_read_b64_tr_b16 %0, %1 offset:%2" : "=&v"(r) : "v"(vb), "i"(OFF) : "memory"); return r; }
template <int D0> __device__ __forceinline__ void pv_one(f32x16& od, int vb, bf16x8 pa0, bf16x8 pa1, bf16x8 pa2, bf16x8 pa3) {
    const s16x4 l0 = tr_read<v_rd_off(D0, 0, 0)>(vb), h0 = tr_read<v_rd_off(D0, 0, 1)>(vb), l1 = tr_read<v_rd_off(D0, 1, 0)>(vb), h1 = tr_read<v_rd_off(D0, 1, 1)>(vb);
    const s16x4 l2 = tr_read<v_rd_off(D0, 2, 0)>(vb), h2 = tr_read<v_rd_off(D0, 2, 1)>(vb), l3 = tr_read<v_rd_off(D0, 3, 0)>(vb), h3 = tr_read<v_rd_off(D0, 3, 1)>(vb);
    asm volatile("s_waitcnt lgkmcnt(0)" ::: "memory"); SBAR();
#define PKV(L, H) (bf16x8){L[0], L[1], L[2], L[3], H[0], H[1], H[2], H[3]}
    od = __builtin_amdgcn_mfma_f32_32x32x16_bf16(pa0, PKV(l0, h0), od, 0, 0, 0);
    od = __builtin_amdgcn_mfma_f32_32x32x16_bf16(pa1, PKV(l1, h1), od, 0, 0, 0);
    od = __builtin_amdgcn_mfma_f32_32x32x16_bf16(pa2, PKV(l2, h2), od, 0, 0, 0);
    od = __builtin_amdgcn_mfma_f32_32x32x16_bf16(pa3, PKV(l3, h3), od, 0, 0, 0);
#undef PKV
}
__device__ __forceinline__ void fast_sincos(float x, float& s, float& c) { float r = x * 0.15915494309189535f; r = r - floorf(r); s = __builtin_amdgcn_sinf(r); c = __builtin_amdgcn_cosf(r); }

struct MixP {
    const bf16* q; int ldq;
    const bf16* k0; int ldk0; const bf16* k1; int ldk1;
    const bf16* v; int ldv;
    bf16* o; int ldo;
    float lf, lb;
    const float* ssdp;
    const bf16* aux; int ldaux; float dh;
};
constexpr int V_BYTES = 16384, V_OFF = 0, K_OFF = 2 * V_BYTES;
template <int DQK> struct KL { static constexpr int PITCH = DQK * 2, BYTES = 64 * PITCH, WK_OFF = K_OFF + 2 * BYTES, SCR_OFF = WK_OFF + 2176, END = SCR_OFF + NWAVES * 256; };

template <int MODE, int DQK, int DV>
__device__ __forceinline__ void mix_unit(const MixP& P, int q0, LAS unsigned char* lds, int tid) {
    typedef KL<DQK> L;
    constexpr int ND = DQK / 16, NV = DV / 32, CPR = DQK / 8, KCH = 64 * CPR / 512, VPR = DV / 8, VCH = (64 * VPR + 511) / 512;
    constexpr float SCALE = 0.07216878364870322f;
    constexpr float C = SCALE * 1.4426950408889634f, THR = 8.f;
    asm volatile("" : "+v"(tid));
    const int wid = tid >> 6, lane = tid & 63, r32 = lane & 31, hi = lane >> 5;
    const int qrow = q0 + wid * 32 + r32;
    LAS unsigned char* Vl = lds + V_OFF; LAS unsigned char* Kl = lds + K_OFF;
    LAS float* wsc = (LAS float*)(lds + L::SCR_OFF) + wid * 64; LAS float* li_l = wsc; LAS float* al_l = wsc + 32;
    LAS f32x4* wk_l = (LAS f32x4*)(lds + L::WK_OFF);
    LAS f32x2* wkref_l = (LAS f32x2*)(lds + L::WK_OFF + 2048);
    const int wq0 = q0 + __builtin_amdgcn_readfirstlane(wid) * 32;
    bf16x8 qr[ND];
    { const bf16* Qw = P.q + (long)qrow * P.ldq + hi * 8;
#pragma unroll
      for (int d0 = 0; d0 < ND; ++d0) qr[d0] = *(const GAS bf16x8*)(Qw + d0 * 16); }
    if constexpr (MODE == 0) {
#pragma unroll
        for (int dd = 0; dd < 2; ++dd)
#pragma unroll
            for (int j = 0; j < 8; ++j) { const int i = dd * 16 + hi * 8 + j; const float inv = exp2f(-(float)i * (13.287712379549449f / 32.0f)); float sn, cs; fast_sincos((float)qrow * inv, sn, cs);
                const float x1 = bf2f((unsigned short)qr[8 + dd][j]), x2 = bf2f((unsigned short)qr[10 + dd][j]);
                qr[8 + dd][j] = (short)f2bf(x1 * cs - x2 * sn); qr[10 + dd][j] = (short)f2bf(x2 * cs + x1 * sn); }
    }
    float cf_i = 0.f, rb_i = 0.f;
    if constexpr (MODE == 2) { const f32x4 w = *(const GAS f32x4*)(P.ssdp + (size_t)qrow * 32); cf_i = w.x; rb_i = w.z; }
    bf16x8 ks[KCH], vs[VCH]; f32x4 wkreg = {0.f, 0.f, 0.f, 0.f}; float crf = 0.f, rrf = 0.f;
#define MX_SLOAD(kr0) do { \
    _Pragma("unroll") for (int i = 0; i < KCH; ++i) { const int cid = tid + 512 * i, row = cid / CPR, c8 = cid % CPR; \
        const bf16* src = (MODE == 0 && c8 >= 16) ? P.k1 + (long)((kr0) + row) * P.ldk1 + (c8 - 16) * 8 : P.k0 + (long)((kr0) + row) * P.ldk0 + c8 * 8; \
        ks[i] = *(const GAS bf16x8*)src; } \
    _Pragma("unroll") for (int i = 0; i < VCH; ++i) { const int cid = tid + 512 * i, row = cid / VPR, c8 = cid % VPR; \
        if (VCH * 512 == 64 * VPR || cid < 64 * VPR) vs[i] = *(const GAS bf16x8*)(P.v + (long)((kr0) + row) * P.ldv + c8 * 8); } \
    if (MODE == 2) { if (tid < 64) { wkreg = *(const GAS f32x4*)(P.ssdp + (size_t)((kr0) + tid) * 32); crf = P.ssdp[(size_t)((kr0) + 63) * 32]; rrf = P.ssdp[(size_t)(kr0) * 32 + 2]; } } } while (0)
#define MX_SWRITE(b) do { \
    _Pragma("unroll") for (int i = 0; i < KCH; ++i) { const int cid = tid + 512 * i, row = cid / CPR, c8 = cid % CPR; \
        *(LAS bf16x8*)(Kl + (b) * L::BYTES + row * L::PITCH + ((c8 * 16) ^ ((row & 7) << 4))) = ks[i]; } \
    _Pragma("unroll") for (int i = 0; i < VCH; ++i) { const int cid = tid + 512 * i, row = cid / VPR, c8 = cid % VPR; \
        if (VCH * 512 == 64 * VPR || cid < 64 * VPR) *(LAS bf16x8*)(Vl + (b) * V_BYTES + v_st(row, c8 * 8)) = vs[i]; } \
    if (MODE == 2) { if (tid < 64) { wk_l[(b) * 64 + tid] = (f32x4){wkreg.y, wkreg.w, __builtin_amdgcn_exp2f(wkreg.y + crf), __builtin_amdgcn_exp2f(wkreg.w + rrf)}; if (tid == 0) wkref_l[(b)] = (f32x2){crf, rrf}; } } } while (0)
    float bfw0[16], bbw0[16]; float c32f = 1.f, c32b = 1.f;
    if constexpr (MODE == 1) {
#pragma unroll
        for (int r = 0; r < 16; ++r) { const int j0 = crow(r, hi);
            bfw0[r] = __builtin_amdgcn_exp2f((float)(63 - j0) * P.lf); bbw0[r] = __builtin_amdgcn_exp2f((float)j0 * P.lb); }
        c32f = __builtin_amdgcn_exp2f(-32.f * P.lf); c32b = __builtin_amdgcn_exp2f(32.f * P.lb);
    }
    float m_reg = -1e30f, l_reg = 0.f; f32x16 o[NV];
#pragma unroll
    for (int d = 0; d < NV; ++d) o[d] = f32x16{};
    const int vb0 = (int)(uintptr_t)(Vl) + v_rd_base(lane);
    constexpr int NT = SEQ / 64;
    int jlo = 0, jhi = NT - 1;
    if constexpr (MODE == 2) {
        const int l = lane & 31, qt = q0 >> 6;
        const float cfq = P.ssdp[(size_t)q0 * 32 + 0], rbq = P.ssdp[(size_t)(q0 + 255) * 32 + 2];
        const float cfe = P.ssdp[(size_t)(64 * l + 63) * 32 + 0], rbs = P.ssdp[(size_t)(64 * l) * 32 + 2];
        const bool keep = (l < qt) ? (cfq - cfe > -24.f) : ((l > qt + 3) ? (rbq - rbs > -24.f) : true);
        const unsigned m32 = (unsigned)__ballot(keep);
        jlo = __builtin_amdgcn_readfirstlane(__builtin_ctz(m32)); jhi = __builtin_amdgcn_readfirstlane(31 - __builtin_clz(m32));
    } else if constexpr (MODE == 1) {
        const float dmf = 24.f / (-P.lf), dmb = 24.f / (-P.lb);
        int a = (int)floorf(((float)(q0 - 63) - dmf) * (1.f / 64.f)) + 1; int b = (int)ceilf(((float)(q0 + 255) + dmb) * (1.f / 64.f)) - 1;
        jlo = a < 0 ? 0 : a; jhi = b > NT - 1 ? NT - 1 : b;
        jlo = __builtin_amdgcn_readfirstlane(jlo); jhi = __builtin_amdgcn_readfirstlane(jhi);
    }
    MX_SLOAD(jlo * 64); VM_WAIT(); MX_SWRITE(0); __syncthreads();
    for (int j = jlo; j <= jhi; ++j) {
        const int buf = (j - jlo) & 1; const int kr0 = j * 64;
        if (j < jhi) MX_SLOAD(kr0 + 64);
        f32x16 p0 = f32x16{}, p1 = f32x16{};
        { LAS unsigned char* Kb = Kl + buf * L::BYTES;
#pragma unroll
          for (int dg = 0; dg < ND / 4; ++dg) { bf16x8 kb0[4], kb1[4];
#pragma unroll
              for (int dd = 0; dd < 4; ++dd) { const int cb = ((dg * 4 + dd) * 16 + hi * 8) * 2;
                  kb0[dd] = *(const LAS bf16x8*)(Kb + r32 * L::PITCH + (cb ^ ((r32 & 7) << 4)));
                  kb1[dd] = *(const LAS bf16x8*)(Kb + (32 + r32) * L::PITCH + (cb ^ ((r32 & 7) << 4))); }
              LDS_WAIT(); SBAR();
#pragma unroll
              for (int dd = 0; dd < 4; ++dd) { p0 = __builtin_amdgcn_mfma_f32_32x32x16_bf16(kb0[dd], qr[dg * 4 + dd], p0, 0, 0, 0);
                  p1 = __builtin_amdgcn_mfma_f32_32x32x16_bf16(kb1[dd], qr[dg * 4 + dd], p1, 0, 0, 0); }
              SBAR(); } }
        if constexpr (MODE == 0) {
            float pmax = p0[0];
#pragma unroll
            for (int r = 1; r < 16; ++r) pmax = fmaxf(pmax, p0[r]);
#pragma unroll
            for (int r = 0; r < 16; ++r) pmax = fmaxf(pmax, p1[r]);
            { auto rr = __builtin_amdgcn_permlane32_swap(__float_as_uint(pmax), __float_as_uint(pmax), false, false); pmax = fmaxf(__uint_as_float(rr[0]), __uint_as_float(rr[1])); }
            float mn, alpha;
            if (__all(pmax - m_reg <= THR / SCALE)) { mn = m_reg; alpha = 1.f; }
            else { mn = fmaxf(m_reg, pmax); alpha = __builtin_amdgcn_exp2f((m_reg - mn) * C); m_reg = mn; }
            const float mnC = -mn * C;
#pragma unroll
            for (int r = 0; r < 16; ++r) { p0[r] = __builtin_amdgcn_exp2f(fmaf(p0[r], C, mnC)); p1[r] = __builtin_amdgcn_exp2f(fmaf(p1[r], C, mnC)); }
            if (__any(alpha < 1.f)) { if (hi == 0) al_l[r32] = alpha; LDS_WAIT();
#pragma unroll
                for (int r = 0; r < 16; ++r) { const float av = al_l[crow(r, hi)];
#pragma unroll
                    for (int d = 0; d < NV; ++d) o[d][r] *= av; } }
            float ps = 0.f;
#pragma unroll
            for (int r = 0; r < 16; ++r) ps += p0[r] + p1[r];
            { auto rr = __builtin_amdgcn_permlane32_swap(__float_as_uint(ps), __float_as_uint(ps), false, false); ps = __uint_as_float(rr[0]) + __uint_as_float(rr[1]); }
            l_reg = l_reg * alpha + ps;
        } else if constexpr (MODE == 1) {
            if (kr0 + 63 <= wq0) {
                const float ai = __builtin_amdgcn_exp2f((float)(qrow - kr0 - 63) * P.lf);
                const float ai1 = ai * c32f;
#pragma unroll
                for (int r = 0; r < 16; ++r) { p0[r] *= ai * bfw0[r]; p1[r] *= ai1 * bfw0[r]; }
            } else if (kr0 > wq0 + 31) {
                const float ai = __builtin_amdgcn_exp2f((float)(kr0 - qrow) * P.lb);
                const float ai1 = ai * c32b;
#pragma unroll
                for (int r = 0; r < 16; ++r) { p0[r] *= ai * bbw0[r]; p1[r] *= ai1 * bbw0[r]; }
            } else {
#pragma unroll
                for (int r = 0; r < 16; ++r) { const int k0 = kr0 + crow(r, hi), k1 = k0 + 32;
                    const float e0 = (k0 <= qrow) ? (float)(qrow - k0) * P.lf : (float)(k0 - qrow) * P.lb;
                    const float e1 = (k1 <= qrow) ? (float)(qrow - k1) * P.lf : (float)(k1 - qrow) * P.lb;
                    p0[r] *= __builtin_amdgcn_exp2f(e0); p1[r] *= __builtin_amdgcn_exp2f(e1); }
            }
        } else {
            if (kr0 + 63 <= wq0) {
                const float ai = __builtin_amdgcn_exp2f(cf_i - wkref_l[buf].x);
#pragma unroll
                for (int r = 0; r < 16; ++r) { const int kk = crow(r, hi); p0[r] *= ai * wk_l[buf * 64 + kk].z; p1[r] *= ai * wk_l[buf * 64 + 32 + kk].z; }
            } else if (kr0 > wq0 + 31) {
                const float ai = __builtin_amdgcn_exp2f(rb_i - wkref_l[buf].y);
#pragma unroll
                for (int r = 0; r < 16; ++r) { const int kk = crow(r, hi); p0[r] *= ai * wk_l[buf * 64 + kk].w; p1[r] *= ai * wk_l[buf * 64 + 32 + kk].w; }
            } else {
#pragma unroll
                for (int r = 0; r < 16; ++r) { const int kk = crow(r, hi); const f32x4 w0 = wk_l[buf * 64 + kk], w1 = wk_l[buf * 64 + 32 + kk];
                    const int k0 = kr0 + kk, k1 = k0 + 32;
                    const float e0 = (k0 <= qrow) ? cf_i + w0.x : rb_i + w0.y;
                    const float e1 = (k1 <= qrow) ? cf_i + w1.x : rb_i + w1.y;
                    p0[r] *= __builtin_amdgcn_exp2f(e0); p1[r] *= __builtin_amdgcn_exp2f(e1); }
            }
        }
        bf16x8 pa0, pa1, pa2, pa3;
#define MX_PK4(PP, BASE, OUT) do { const unsigned a0 = cvtpk(PP[BASE + 0], PP[BASE + 1]), a1 = cvtpk(PP[BASE + 2], PP[BASE + 3]); \
    const unsigned b0 = cvtpk(PP[BASE + 4], PP[BASE + 5]), b1 = cvtpk(PP[BASE + 6], PP[BASE + 7]); \
    auto r0 = __builtin_amdgcn_permlane32_swap(a0, b0, false, false); auto r1 = __builtin_amdgcn_permlane32_swap(a1, b1, false, false); \
    v4u w = {r0[0], r1[0], r0[1], r1[1]}; OUT = __builtin_bit_cast(bf16x8, w); } while (0)
        MX_PK4(p0, 0, pa0); MX_PK4(p0, 8, pa1); MX_PK4(p1, 0, pa2); MX_PK4(p1, 8, pa3);
#undef MX_PK4
        { const int vb = vb0 + buf * V_BYTES;
          pv_one<0>(o[0], vb, pa0, pa1, pa2, pa3); pv_one<1>(o[1], vb, pa0, pa1, pa2, pa3);
          if constexpr (NV == 4) { pv_one<2>(o[2], vb, pa0, pa1, pa2, pa3); pv_one<3>(o[3], vb, pa0, pa1, pa2, pa3); } }
        if (j < jhi) { VM_WAIT(); MX_SWRITE(buf ^ 1); }
        __syncthreads();
    }
#undef MX_SLOAD
#undef MX_SWRITE
    const int orow0 = q0 + wid * 32;
    if constexpr (MODE == 0) {
        if (hi == 0) li_l[r32] = l_reg; LDS_WAIT();
#pragma unroll
        for (int r = 0; r < 16; ++r) { const int rr = crow(r, hi); const float rl = __builtin_amdgcn_rcpf(li_l[rr]);
#pragma unroll
            for (int d0 = 0; d0 < NV; ++d0) P.o[(long)(orow0 + rr) * P.ldo + d0 * 32 + r32] = (bf16)f2bf(o[d0][r] * rl); }
    } else if constexpr (MODE == 1) {
#pragma unroll
        for (int r = 0; r < 16; ++r) { const int rr = crow(r, hi);
            float s = 0.f;
#pragma unroll
            for (int d0 = 0; d0 < NV; ++d0) s += o[d0][r];
            s = half_sum(s);
            const float mean = s * (1.f / 128.f); float qv = 0.f;
#pragma unroll
            for (int d0 = 0; d0 < NV; ++d0) { const float dlt = o[d0][r] - mean; qv += dlt * dlt; }
            qv = half_sum(qv);
            const float rs = 1.0f / sqrtf(qv * (1.f / 128.f) + 1e-6f);
#pragma unroll
            for (int d0 = 0; d0 < NV; ++d0) { const float gt = bf2f(P.aux[(long)(orow0 + rr) * P.ldaux + d0 * 32 + r32]);
                P.o[(long)(orow0 + rr) * P.ldo + d0 * 32 + r32] = (bf16)f2bf(ZERO_B ? 0.f : (o[d0][r] - mean) * rs * silu(gt)); } }
    } else {
#pragma unroll
        for (int r = 0; r < 16; ++r) { const int rr = crow(r, hi);
#pragma unroll
            for (int d0 = 0; d0 < NV; ++d0) { const float xv = bf2f(P.aux[(long)(orow0 + rr) * P.ldaux + d0 * 32 + r32]);
                P.o[(long)(orow0 + rr) * P.ldo + d0 * 32 + r32] = (bf16)f2bf(o[d0][r] + xv * P.dh); } }
    }
    __syncthreads();
}
#undef SBAR
}

namespace hyb {
constexpr int U_PITCH = 4112, U_BYTES = 16 * U_PITCH, FC_OFF = U_BYTES, FC_PITCH = 8256;
typedef float f32x4v __attribute__((ext_vector_type(4)));
__device__ __forceinline__ void hyena_unit(const AP& a, int layer, int c, unsigned char* ws, LAS unsigned char* lds, int tid) {
    asm volatile("" : "+v"(tid));
    const int wid = tid >> 6, lane = tid & 63, fr = lane & 15, fq = lane >> 4;
    const bf16* UT = (const bf16*)(ws + WS_UT); bf16* ZT = (bf16*)(ws + WS_ZT);
    LAS unsigned char* Ul = lds; LAS unsigned char* FC = lds + FC_OFF;
    const int ksh = (3 - fr) & 3;
    for (int o = 0; o < 2; ++o) {
        const bf16* G = (const bf16*)(ws + WS_HYG) + (((size_t)layer * 2 + o) * 512 + c) * HY_GLEN;
        for (int id = tid; id < HY_GLEN / 8; id += 512) *(LAS v4u*)(FC + id * 16) = *(const GAS v4u*)(G + id * 8);
        if (o == 0) {
#pragma unroll
            for (int i = 0; i < 8; ++i) { const int id = tid + 512 * i, b = id >> 8, t8 = id & 255;
                *(LAS v4u*)(Ul + b * U_PITCH + t8 * 16) = *(const GAS v4u*)(UT + ((size_t)c * NB + b) * SEQ + t8 * 8); } }
        __syncthreads();
        for (int idx = tid; idx < 4104; idx += 512) { const LAS bf16* g0 = (const LAS bf16*)FC + idx;
#pragma unroll
            for (int k = 1; k < 4; ++k) *(LAS bf16*)(FC + k * FC_PITCH + idx * 2) = g0[k]; }
        const bf16* X = UT + (((size_t)(1 + o) * 512 + c) * NB + fr) * SEQ;
        v2u xg[16];
#pragma unroll
        for (int al = 0; al < 16; ++al) xg[al] = *(const GAS v2u*)(X + 16 * (16 * wid + al) + 4 * fq);
        __syncthreads();
        f32x4v acc[16];
#pragma unroll
        for (int i = 0; i < 16; ++i) acc[i] = (f32x4v){0.f, 0.f, 0.f, 0.f};
        for (int kb = 0; kb < 8; ++kb) {
            bf16x8 bfr[8];
#pragma unroll
            for (int kl = 0; kl < 8; ++kl) bfr[kl] = *(const LAS bf16x8*)(Ul + fr * U_PITCH + ((kb * 8 + kl) * 32 + fq * 8) * 2);
            const int n0 = HY_OFF - 16 * (16 * wid - 16 * kb + 15) - fr + 8 * fq;
            const LAS unsigned char* ab = FC + ksh * FC_PITCH + (n0 - ksh) * 2;
#pragma unroll
            for (int hb = 0; hb < 2; ++hb) {
                v2u alo[15], ahi[15];
#pragma unroll
                for (int d = 0; d < 15; ++d) { alo[d] = *(const LAS v2u*)(ab + (29 - (hb * 15 + d)) * 32); ahi[d] = *(const LAS v2u*)(ab + (29 - (hb * 15 + d)) * 32 + 8); }
                LDS_WAIT(); __builtin_amdgcn_sched_barrier(0);
#pragma unroll
                for (int d = 0; d < 15; ++d) { const int ddrel = hb * 15 + d - 14;
                    const v4u w = {alo[d].x, alo[d].y, ahi[d].x, ahi[d].y}; const bf16x8 af = __builtin_bit_cast(bf16x8, w);
#pragma unroll
                    for (int kl = 0; kl < 8; ++kl) { const int al = ddrel + 2 * kl; if (al >= 0 && al < 16) acc[al] = __builtin_amdgcn_mfma_f32_16x16x32_bf16(af, bfr[kl], acc[al], 0, 0, 0); }
                }
                __builtin_amdgcn_sched_barrier(0);
            }
        }
        __syncthreads();
        const float bias = a.in(I_HYBIAS)[(layer * 2 + o) * 512 + c];
#pragma unroll
        for (int al = 0; al < 16; ++al) { const int t = 16 * (16 * wid + al) + 4 * fq;
            const v2u uu = *(const LAS v2u*)(Ul + fr * U_PITCH + t * 2); const v2u xx = xg[al];
            const float r0 = bflo(xx.x) * (acc[al][0] + bflo(uu.x) * bias), r1 = bfhi(xx.x) * (acc[al][1] + bfhi(uu.x) * bias);
            const float r2 = bflo(xx.y) * (acc[al][2] + bflo(uu.y) * bias), r3 = bfhi(xx.y) * (acc[al][3] + bfhi(uu.y) * bias);
            v2u z; z.x = pk2(r0, r1); z.y = pk2(r2, r3);
            if (o == 0) *(LAS v2u*)(Ul + fr * U_PITCH + t * 2) = z;
            else *(GAS v2u*)(ZT + ((size_t)c * NB + fr) * SEQ + t) = z; }
        __syncthreads();
    }
}
}

constexpr int N_PHASES = 26;
#ifndef MK_CUTS
#define MK_CUTS 0
#endif
#ifndef MIXSKIP
#define MIXSKIP 0
#endif
#ifndef MOE_CHECK
#define MOE_CHECK 0
#endif
#ifndef ONLYKIND
#define ONLYKIND -1
#endif
#define KSEL(kind) (ONLYKIND < 0 || ONLYKIND == (kind))
#define IN(k) (LO <= (k) && (k) < HI)
#define INK(k, kind) (KSEL(kind) && LO <= (k) && (k) < HI)
struct Ids { int wave0, G0, bx0, vcu0; };
#define PH_LOCALS int wave = ids.wave0, G = ids.G0, bx = ids.bx0, vcu = ids.vcu0; asm volatile("" : "+s"(wave), "+s"(G), "+s"(bx), "+s"(vcu)); \
    int tid; asm volatile("v_mbcnt_lo_u32_b32 %0, -1, 0\n\tv_mbcnt_hi_u32_b32 %0, -1, %0" : "=v"(tid)); tid += wave * 64; \
    const int lane = tid & 63, gw = wave * G + vcu, NGW = G * NWAVES; LAS float* wscr = (LAS float*)(lds + RING_OFF + wave * 16384); (void)lane; (void)gw; (void)NGW; (void)wscr; (void)bx; \
    const AP args = kargs(); unsigned char* ws = args.ws(); float* XRES = args.out(); bf16* XB = (bf16*)(ws + WS_XB); gu32* ctl = (gu32*)(ws + WS_CTL); (void)XRES; (void)XB; (void)ctl;
#ifndef PROBE_SCALE
#define PROBE_SCALE 0.0025f
#endif
#ifndef TIMING_PROBE
#define TIMING_PROBE 0
#endif
#ifndef PROBE_A0
#define PROBE_A0 0
#define PROBE_A1 1
#define PROBE_B0 1
#define PROBE_B1 2
#endif
#if TIMING_PROBE
#define STAMP(idx) do { if (ids.bx0 == 0 && threadIdx.x == 0) ((volatile LAS unsigned*)(lds + MISC_OFF))[16 + (idx)] = (unsigned)wall_clock64(); } while (0)
#else
#define STAMP(idx) do { } while (0)
#endif
#define SEAM(k) do { if constexpr (IN(k) && IN((k) + 1)) { XcdBarrier bb_ = bar; asm volatile("" : "+s"(bb_.bar), "+s"(bb_.x)); xcd_barrier(bb_); } STAMP((k) + 1); } while (0)

template <int LAYER, int LO, int HI>
__device__ __forceinline__ void layer_phases(LAS unsigned char* lds, const XcdBarrier& bar, const Ids& ids) {
    constexpr int layer = LAYER, pb = 1 + LAYER * 10;
    if constexpr (INK(pb + 0, 1)) { PH_LOCALS
        pg8::Gemm g{XB, (const bf16*)(ws + WS_WIN + layer * SZ_WIN), M, NINP, DM}; pg8::StaticOrder S; S.init(M, NINP, G, bx);
        pg8::EpiBf16 E{(bf16*)(ws + WS_PROJ), NINP, (float*)(ws + WS_DTF), C_DT};
        pg8::gemm_phase<pg8::EpiBf16, pg8::StaticOrder, true, true>(lds + RING_OFF, g, S, E, tid);
    }
    SEAM(pb + 0);
    if constexpr (INK(pb + 1, 2)) { PH_LOCALS
        LAS float* cwl = (LAS float*)(lds + RING_OFF);
        for (int i = tid; i < 6 * 1024; i += NWAVES * 64) cwl[i] = i < 5 * 1024 ? args.in(I_CONVW)[layer * 5 * 1024 + i] : args.in(I_CONVB)[layer * 1024 + i - 5 * 1024];
        __syncthreads();
        LAS float* pscr = (LAS float*)(lds + RING_OFF + 32768 + wave * 12288);
        for (int it = gw; it < M / 8; it += NGW) prep_rows8(args, layer, it, lane, ws, cwl);
        for (int it = gw; it < 256; it += NGW) prep_scan(args, layer, it, lane, ws, pscr);
        for (int it = gw; it < NB * 32 * 24; it += NGW) prep_hyconv(args, layer, it, lane, ws, (LAS bf16*)pscr);
        __syncthreads();
    }
    SEAM(pb + 1);
    if constexpr (INK(pb + 2, 3)) {
        { PH_LOCALS pg8::Gemm g{(const bf16*)(ws + WS_QN), (const bf16*)(ws + WS_WUQ + layer * SZ_WUQ), M, 768, 384}; pg8::StaticOrder S; S.init(M, 768, G, bx);
          pg8::EpiBf16 E{(bf16*)(ws + WS_QB), 768, nullptr, 0};
          pg8::gemm_phase<pg8::EpiBf16, pg8::StaticOrder, true, true>(lds + RING_OFF, g, S, E, tid); }
        { PH_LOCALS pg8::Gemm g{(const bf16*)(ws + WS_KVN), (const bf16*)(ws + WS_WUKV + layer * SZ_WUKV), M, 1024, 256}; pg8::StaticOrder S; S.init(M, 1024, G, bx);
          pg8::EpiBf16 E{(bf16*)(ws + WS_KVB), 1024, nullptr, 0};
          pg8::gemm_phase<pg8::EpiBf16, pg8::StaticOrder, true, true>(lds + RING_OFF, g, S, E, tid); }
    }
    SEAM(pb + 2);
    if constexpr (IN(pb + 3)) {
        if constexpr (KSEL(40)) { PH_LOCALS for (int u = vcu; u < NB * 4 * 8; u += G) { const int b = u >> 5, h = (u >> 3) & 3, qb = u & 7; const size_t r0 = (size_t)b * SEQ;
            mixb::MixP P{}; P.q = (const bf16*)(ws + WS_QB) + r0 * 768 + h * 192; P.ldq = 768; P.k0 = (const bf16*)(ws + WS_KVB) + r0 * 1024 + h * 256; P.ldk0 = 1024;
            P.k1 = (const bf16*)(ws + WS_KPE) + r0 * 64; P.ldk1 = 64; P.v = (const bf16*)(ws + WS_KVB) + r0 * 1024 + h * 256 + 128; P.ldv = 1024;
            P.o = (bf16*)(ws + WS_ATT) + r0 * 512 + h * 128; P.ldo = 512;
            mixb::mix_unit<0, 192, 128>(P, qb * 256, lds + RING_OFF, tid); } }
        STAMP(32 + LAYER * 4 + 0);
        if constexpr (KSEL(41)) { PH_LOCALS for (int u = vcu; u < NB * 4 * 8; u += G) { const int rnd = u / G; const int b = u >> 5, h0 = (u >> 3) & 3, h = (rnd & 1) ? 3 - h0 : h0, qb = u & 7; const size_t r0 = (size_t)b * SEQ;
            mixb::MixP P{}; P.q = (const bf16*)(ws + WS_RQ) + r0 * 256 + h * 64; P.ldq = 256; P.k0 = (const bf16*)(ws + WS_RK) + r0 * 256 + h * 64; P.ldk0 = 256; P.k1 = P.k0; P.ldk1 = 256;
            P.v = (const bf16*)(ws + WS_PROJ) + r0 * NINP + C_RV + h * 128; P.ldv = NINP; P.aux = (const bf16*)(ws + WS_PROJ) + r0 * NINP + C_RG + h * 128; P.ldaux = NINP;
            P.o = (bf16*)(ws + WS_MIX) + r0 * DM + 512 + h * 128; P.ldo = DM;
            P.lf = log2f(1.0f - exp2f(-5.0f - (float)h)); P.lb = log2f(1.0f - exp2f(-5.5f - (float)h));
            mixb::mix_unit<1, 64, 128>(P, qb * 256, lds + RING_OFF, tid); } }
        STAMP(32 + LAYER * 4 + 1);
        if constexpr (KSEL(42)) { PH_LOCALS for (int u = vcu; u < NB * 8 * 8; u += G) { const int rnd = u / G; const int b = u >> 6, hh = (((u >> 3) & 7) + 2 * rnd) & 7, qb = u & 7, gq = hh >> 2; const size_t r0 = (size_t)b * SEQ;
            mixb::MixP P{}; const bf16* XBC = (const bf16*)(ws + WS_XBC) + r0 * 1024;
            P.q = XBC + 768 + gq * 128; P.ldq = 1024; P.k0 = XBC + 512 + gq * 128; P.ldk0 = 1024; P.k1 = P.k0; P.ldk1 = 1024; P.v = XBC + hh * 64; P.ldv = 1024; P.aux = P.v; P.ldaux = 1024;
            P.ssdp = (const float*)(ws + WS_SSDP) + r0 * 32 + hh * 4; P.dh = args.in(I_SSDD)[layer * 8 + hh];
            P.o = (bf16*)(ws + WS_YC) + r0 * 512 + hh * 64; P.ldo = 512;
            mixb::mix_unit<2, 128, 64>(P, qb * 256, lds + RING_OFF, tid); } }
        STAMP(32 + LAYER * 4 + 2);
        if constexpr (KSEL(43)) { PH_LOCALS for (int u = vcu; u < 512; u += G) hyb::hyena_unit(args, layer, u, ws, lds + RING_OFF, tid); }
    }
    SEAM(pb + 3);
    if constexpr (INK(pb + 4, 5)) { PH_LOCALS
        for (int m = gw; m < M; m += NGW) post_row(args, layer, m, lane, ws);
        for (int it = gw; it < NB * 128; it += NGW) post_hy(args, layer, it, lane, ws, (LAS bf16*)wscr);
    }
    SEAM(pb + 4);
    if constexpr (INK(pb + 5, 6)) { PH_LOCALS
        pg8::Gemm g{(const bf16*)(ws + WS_MIX), (const bf16*)(ws + WS_WOUT + layer * SZ_WOUT), M, DM, DM}; pg8::StaticOrder S; S.init(M, DM, G, bx);
        pg8::EpiResF32 E{LAYER == 0 ? args.in(I_X) : (const float*)XRES, XRES, DM, ALPHA, 1.f};
        pg8::gemm_phase<pg8::EpiResF32, pg8::StaticOrder, true, true>(lds + RING_OFF, g, S, E, tid);
    }
    SEAM(pb + 5);
    if constexpr (INK(pb + 6, 7)) { PH_LOCALS
        const float* gG = args.in(I_LN1G) + layer * DM; const float* gB = args.in(I_LN1B) + layer * DM;
        if constexpr (LAYER == 1) {
            LAS float* WrT = (LAS float*)(lds + RING_OFF);
            for (int i = tid; i < DM * NEXP; i += NWAVES * 64) WrT[(i & 7) * DM + (i >> 3)] = args.in(I_ROUTER)[i];
            for (int i = bx * NWAVES * 64 + tid; i < CAP_ROWS; i += G * NWAVES * 64) ((int*)(ws + WS_SLOT))[i] = -1;
            LAS unsigned* lcnt = (LAS unsigned*)(lds + RING_OFF + 65536); LAS unsigned* lbase = lcnt + 8; LAS int* lrec = (LAS int*)(lcnt + 16);
            if (tid < 16) lcnt[tid] = 0u;
            __syncthreads();
            int nrow = 0;
            f32x4 nv[8]; if (gw < M) ln_load(XRES + (size_t)gw * DM, lane, nv);
            for (int m = gw; m < M; m += NGW) { f32x4 v[8];
#pragma unroll
                for (int j = 0; j < 8; ++j) v[j] = nv[j];
                if (m + NGW < M) ln_load(XRES + (size_t)(m + NGW) * DM, lane, nv);
                ln_row(XRES + (size_t)m * DM, XB + (size_t)m * DM, gG, gB, lane, v, nullptr, nullptr, XRES + (size_t)m * DM);
                float lg[8];
#pragma unroll
                for (int e = 0; e < 8; ++e) { float s = 0.f;
#pragma unroll
                    for (int j = 0; j < 8; ++j) { const f32x4 w = *((const LAS f32x4*)(WrT + e * DM) + lane + 64 * j); s += (v[j].x * w.x + v[j].y * w.y) + (v[j].z * w.z + v[j].w * w.w); }
                    lg[e] = wave_sum(s); __builtin_amdgcn_sched_barrier(0); }
                int e0 = 0; float v0 = lg[0];
#pragma unroll
                for (int e = 1; e < 8; ++e) if (lg[e] > v0) { v0 = lg[e]; e0 = e; }
                int e1 = -1; float v1 = -3.0e38f;
#pragma unroll
                for (int e = 0; e < 8; ++e) if (e != e0 && lg[e] > v1) { v1 = lg[e]; e1 = e; }
                if (lane == 0) { const float ex = __expf(v1 - v0); const float g0 = 1.0f / (1.0f + ex), g1 = ex / (1.0f + ex);
                    const int p0 = (int)__hip_atomic_fetch_add(lcnt + e0, 1u, __ATOMIC_RELAXED, __HIP_MEMORY_SCOPE_WORKGROUP), p1 = (int)__hip_atomic_fetch_add(lcnt + e1, 1u, __ATOMIC_RELAXED, __HIP_MEMORY_SCOPE_WORKGROUP);
                    LAS int* rec = lrec + (wave * 64 + nrow) * 4; rec[0] = e0; rec[1] = e1; rec[2] = p0; rec[3] = p1;
                    float* rg = (float*)(ws + WS_RTG) + (size_t)m * 2; rg[0] = g0; rg[1] = g1; }
                ++nrow; }
            __syncthreads();
            if (tid < NEXP) lbase[tid] = atomicAdd((unsigned*)(ctl + CW_CNT + tid), lcnt[tid]);
            __syncthreads();
            { int r = 0; for (int m = gw; m < M; m += NGW, ++r) if (lane == 0) { const LAS int* rec = lrec + (wave * 64 + r) * 4; const int e0 = rec[0], e1 = rec[1];
                int* rt = (int*)(ws + WS_RT) + (size_t)m * 4; rt[0] = e0; rt[1] = e1; rt[2] = rec[2] + (int)lbase[e0]; rt[3] = rec[3] + (int)lbase[e1]; } }
            __syncthreads();
        } else {
            f32x4 nv[8]; if (gw < M) ln_load(XRES + (size_t)gw * DM, lane, nv);
            for (int m = gw; m < M; m += NGW) { f32x4 v[8];
#pragma unroll
                for (int j = 0; j < 8; ++j) v[j] = nv[j];
                if (m + NGW < M) ln_load(XRES + (size_t)(m + NGW) * DM, lane, nv);
                ln_row(XRES + (size_t)m * DM, XB + (size_t)m * DM, gG, gB, lane, v, nullptr, nullptr, XRES + (size_t)m * DM, ws + WS_XF8 + (size_t)m * DM); }
        }
    }
    SEAM(pb + 6);
    if constexpr (LAYER == 0) {
        if constexpr (INK(8, 8)) { PH_LOCALS
            pg8::Gemm g{(const bf16*)(ws + WS_XF8), (const bf16*)(ws + WS_WGU), M, 2 * DFF, DM}; pg8::StaticOrder S; S.init(M, 2 * DFF, G, bx);
            pg8::EpiSwigluF8 E{ws + WS_HID, DFF};
            pg8::gemm_phase_f8<pg8::EpiSwigluF8, pg8::StaticOrder, true, true>(lds + RING_OFF, g, S, E, tid, 0x79797979, 0x7f7f7f7f);
        }
        SEAM(8);
        if constexpr (INK(9, 9)) { PH_LOCALS
            pg8::Gemm g{(const bf16*)(ws + WS_HID), (const bf16*)(ws + WS_WDN), M, DM, DFF}; pg8::StaticOrder S; S.init(M, DM, G, bx);
            pg8::EpiResF32 E{XRES, XRES, DM, ALPHA, ZERO_FFN ? 0.f : 1.f};
            pg8::gemm_phase_f8<pg8::EpiResF32, pg8::StaticOrder, true, true>(lds + RING_OFF, g, S, E, tid, 0x77777777, 0x7f7f7f7f);
        }
        SEAM(9);
        if constexpr (INK(10, 10)) { PH_LOCALS
            const float* gG = args.in(I_LN2G); const float* gB = args.in(I_LN2B);
            f32x4 nv[8]; if (gw < M) ln_load(XRES + (size_t)gw * DM, lane, nv);
            for (int m = gw; m < M; m += NGW) { f32x4 v[8];
#pragma unroll
                for (int j = 0; j < 8; ++j) v[j] = nv[j];
                if (m + NGW < M) ln_load(XRES + (size_t)(m + NGW) * DM, lane, nv);
                ln_row(XRES + (size_t)m * DM, XB + (size_t)m * DM, gG, gB, lane, v, nullptr, nullptr, XRES + (size_t)m * DM); }
        }
        SEAM(10);
    }
}

template <int CH, int LO, int HI>
__device__ __forceinline__ void moe_chunk(LAS unsigned char* lds, const XcdBarrier& bar, const Ids& ids) {
    if constexpr (INK(19 + 2 * CH, 19)) { PH_LOCALS
        pg8::MoeOrder S; int acc = 0;
#pragma unroll
        for (int e = 0; e < 8; ++e) { const int c = (int)__hip_atomic_load(ctl + CW_CNT + e, RLX_AGENT); acc += (c + 255) / 256 * 256; S.pend[e] = acc; }
        const int nrb = acc / 256; const int rb0 = CH * MOE_CH_RB; int nrbc = nrb - rb0; nrbc = nrbc < 0 ? 0 : (nrbc > MOE_CH_RB ? MOE_CH_RB : nrbc);
        pg8::Gemm g{(const bf16*)(ws + WS_XS + (size_t)rb0 * 256 * DM), (const bf16*)(ws + WS_MGU), nrbc * 256, 2 * DFFE, DM};
        S.so.init(nrbc * 256, 2 * DFFE, G, bx); S.rb0 = rb0; S.bstride = (long)2 * DFFE * DM;
        pg8::EpiSwigluF8 E{ws + WS_HIDS, DFFE};
        pg8::gemm_phase_f8<pg8::EpiSwigluF8, pg8::MoeOrder, true, true>(lds + RING_OFF, g, S, E, tid, 0x79797979, 0x7f7f7f7f);
    }
    SEAM(19 + 2 * CH);
    if constexpr (INK(20 + 2 * CH, 20)) { PH_LOCALS
        pg8::MoeOrder S; int acc = 0;
#pragma unroll
        for (int e = 0; e < 8; ++e) { const int c = (int)__hip_atomic_load(ctl + CW_CNT + e, RLX_AGENT); acc += (c + 255) / 256 * 256; S.pend[e] = acc; }
        const int nrb = acc / 256; const int rb0 = CH * MOE_CH_RB; int nrbc = nrb - rb0; nrbc = nrbc < 0 ? 0 : (nrbc > MOE_CH_RB ? MOE_CH_RB : nrbc);
        pg8::Gemm g{(const bf16*)(ws + WS_HIDS), (const bf16*)(ws + WS_MDN), nrbc * 256, DM, DFFE};
        S.so.init(nrbc * 256, DM, G, bx); S.rb0 = rb0; S.bstride = (long)DM * DFFE;
        pg8::EpiMoeDown E{(bf16*)(ws + WS_Y0), (long)((WS_Y1 - WS_Y0) / 2), DM, (const int*)(ws + WS_SLOT), (const float*)(ws + WS_SLOTG), rb0 * 256};
        pg8::gemm_phase_f8<pg8::EpiMoeDown, pg8::MoeOrder, true, true>(lds + RING_OFF, g, S, E, tid, 0x77777777, 0x7f7f7f7f);
    }
    SEAM(20 + 2 * CH);
}

template <int LO, int HI>
__global__ void __launch_bounds__(NWAVES * 64, 2) mk_fwd(Args args_unused, int li) {
    extern __shared__ __attribute__((aligned(16))) unsigned char lds_raw[];
    LAS unsigned char* lds = (LAS unsigned char*)lds_raw;
    volatile LAS unsigned* MISC = (volatile LAS unsigned*)(lds + MISC_OFF);
    Ids ids; { const int tid0 = threadIdx.x; ids.wave0 = __builtin_amdgcn_readfirstlane(tid0 >> 6); ids.G0 = gridDim.x; ids.bx0 = blockIdx.x;
        ids.vcu0 = (ids.G0 % 8 == 0) ? (ids.bx0 % 8) * (ids.G0 / 8) + ids.bx0 / 8 : ids.bx0;
        for (int u = tid0; u < (LDS_BYTES - LDSCTL_OFF) / 4; u += NWAVES * 64) ((LAS unsigned*)(lds + LDSCTL_OFF))[u] = 0u; }
    __syncthreads();
    XcdBarrier bar; bar.bar = nullptr; bar.x = 0; bar.st = nullptr;
    if constexpr (HI - LO > 1) { const AP a0 = kargs(); bar = xcd_barrier_post((unsigned*)((gu32*)(a0.ws() + WS_CTL) + CW_BAR) + li * XCD_BAR_WORDS, MISC + 8); }

    STAMP(0);
    if constexpr (INK(0, 0)) { PH_LOCALS
        constexpr int I_WIN_ = 32 * (NINP / 32), I_UQ = 6 * 24, I_UKV = 4 * 32, I_OUT = 32 * 64, I_GU = 32 * (DFF / 32), I_DN = (DFF / 64) * 64;
        constexpr int NIT = 2 * I_WIN_ + 2 * I_UQ + 2 * I_UKV + 2 * I_OUT + 2 * I_GU + I_DN;
        for (int it = gw; it < NIT; it += NGW) { int r = it;
#define TRJ(n, W, K, N, NP, WT, GR, GS, OFF) if (r < (n)) { transpose_item((W), (K), (N), (NP) / 32, (bf16*)(WT), (GR), (GS), (OFF), wscr, r, lane); continue; } r -= (n);
            TRJ(I_WIN_, args.in(I_WIN), DM, NIN, NINP, ws + WS_WIN, 1 << 30, 0, 0)
            TRJ(I_WIN_, args.in(I_WIN) + (size_t)DM * NIN, DM, NIN, NINP, ws + WS_WIN + SZ_WIN, 1 << 30, 0, 0)
            TRJ(I_UQ, args.in(I_WUQ), 384, 768, 768, ws + WS_WUQ, 1 << 30, 0, 0)
            TRJ(I_UQ, args.in(I_WUQ) + 384 * 768, 384, 768, 768, ws + WS_WUQ + SZ_WUQ, 1 << 30, 0, 0)
            TRJ(I_UKV, args.in(I_WUKV), 256, 1024, 1024, ws + WS_WUKV, 1 << 30, 0, 0)
            TRJ(I_UKV, args.in(I_WUKV) + 256 * 1024, 256, 1024, 1024, ws + WS_WUKV + SZ_WUKV, 1 << 30, 0, 0)
            TRJ(I_OUT, args.in(I_WOUT), DM, DM, DM, ws + WS_WOUT, 1 << 30, 0, 0)
            TRJ(I_OUT, args.in(I_WOUT) + (size_t)DM * DM, DM, DM, DM, ws + WS_WOUT + SZ_WOUT, 1 << 30, 0, 0)
            if (r < I_GU) { transpose_item_f8(args.in(I_FFG), DM, DFF, DFF / 32, ws + WS_WGU, 128, 256, 0, 64.0f, wscr, r, lane); continue; } r -= I_GU;
            if (r < I_GU) { transpose_item_f8(args.in(I_FFU), DM, DFF, DFF / 32, ws + WS_WGU, 128, 256, 128, 64.0f, wscr, r, lane); continue; } r -= I_GU;
            transpose_item_f8(args.in(I_FFD), DFF, DM, DM / 32, ws + WS_WDN, 1 << 30, 0, 0, 256.0f, wscr, r, lane);
#undef TRJ
        }
        for (int m = gw; m < M; m += NGW) { const GAS f32x4* xr = (const GAS f32x4*)(args.in(I_X) + (size_t)m * DM) + lane; GAS v2u* xb = (GAS v2u*)(XB + (size_t)m * DM) + lane;
#pragma unroll
            for (int j = 0; j < 8; ++j) { const f32x4 v = xr[64 * j]; v2u w; w.x = pk2(v.x, v.y); w.y = pk2(v.z, v.w); xb[64 * j] = w; } }
        for (int it = gw; it < 2 * SEQ; it += NGW) hyena_filter_item(args, it >> 11, it & (SEQ - 1), (bf16*)(ws + WS_HYG), wscr, lane);
    }
    SEAM(0);
    layer_phases<0, LO, HI>(lds, bar, ids);
    layer_phases<1, LO, HI>(lds, bar, ids);
    if constexpr (INK(18, 18)) { PH_LOCALS
        auto mkjob = [&](int it, TrF8& j, int& r) { const int job = it / 7168, e = job / 3, kind = job - e * 3; r = it - job * 7168;
            if (kind < 2) j = TrF8{args.in(kind == 0 ? I_MOEG : I_MOEU) + (size_t)e * DM * DFFE, DM, DFFE, DFFE / 32, ws + WS_MGU + (size_t)e * 2 * DFFE * DM, 128, 256, kind * 128, 64.0f};
            else j = TrF8{args.in(I_MOED) + (size_t)e * DFFE * DM, DFFE, DM, DM / 32, ws + WS_MDN + (size_t)e * DM * DFFE, 1 << 30, 0, 0, 256.0f}; };
        for (int it = gw; it < 24 * 7168; it += 2 * NGW) { TrF8 ja, jb; int ra, rb; float ta[32], tb[32]; const bool hb = it + NGW < 24 * 7168;
            mkjob(it, ja, ra); tr_f8_load(ja, ra, lane, ta);
            if (hb) { mkjob(it + NGW, jb, rb); tr_f8_load(jb, rb, lane, tb); }
            tr_f8_finish(ja, ra, lane, ta, wscr);
            if (hb) tr_f8_finish(jb, rb, lane, tb, wscr); }
        int pst[8]; { int acc = 0;
#pragma unroll
            for (int e = 0; e < 8; ++e) { pst[e] = acc; const int c = (int)__hip_atomic_load(ctl + CW_CNT + e, RLX_AGENT); acc += (c + 255) / 256 * 256; } }
        for (int it = gw; it < 2 * M; it += NGW) { const int tok = it >> 1, k = it & 1; const int* rt = (const int*)(ws + WS_RT) + (size_t)tok * 4; const int e = rt[k], pos = rt[2 + k];
            int base = 0;
#pragma unroll
            for (int j = 0; j < 8; ++j) base = (e == j) ? pst[j] : base;
            const int slot = base + pos;
            const GAS v4u* src = (const GAS v4u*)(XB + (size_t)tok * DM) + lane; GAS v2u* dst = (GAS v2u*)(ws + WS_XS + (size_t)slot * DM) + lane;
#pragma unroll
            for (int j = 0; j < 4; ++j) { const v4u w = src[64 * j]; v2u o; o.x = pk4_fp8(bflo(w.x), bfhi(w.x), bflo(w.y), bfhi(w.y)); o.y = pk4_fp8(bflo(w.z), bfhi(w.z), bflo(w.w), bfhi(w.w)); dst[64 * j] = o; }
            if (lane == 0) { ((int*)(ws + WS_SLOT))[slot] = tok * 2 + k; ((float*)(ws + WS_SLOTG))[slot] = ((const float*)(ws + WS_RTG))[(size_t)tok * 2 + k]; } }
    }
    SEAM(18);
    moe_chunk<0, LO, HI>(lds, bar, ids);
    SEAM(21); SEAM(22); SEAM(23); SEAM(24);
    if constexpr (INK(25, 25)) { PH_LOCALS
#if MOE_CHECK
        { LAS float* xs = (LAS float*)(lds + RING_OFF); LAS float* hid = xs + DM; LAS float* red = hid + DFFE;
          for (int smp = bx; smp < 48; smp += G) { const int tok = (smp * 683 + 5) % M;
            for (int d = tid; d < DM; d += 512) xs[d] = bf2f(XB[(size_t)tok * DM + d]);
            __syncthreads();
            float accv[4] = {0.f, 0.f, 0.f, 0.f};
            for (int kk = 0; kk < 2; ++kk) { const int e = ((const int*)(ws + WS_RT))[(size_t)tok * 4 + kk]; const float gt = ((const float*)(ws + WS_RTG))[(size_t)tok * 2 + kk];
                const float* Wg = args.in(I_MOEG) + (size_t)e * DM * DFFE; const float* Wu = args.in(I_MOEU) + (size_t)e * DM * DFFE; const float* Wd = args.in(I_MOED) + (size_t)e * DFFE * DM;
                for (int j = tid; j < DFFE; j += 512) { float a = 0.f, b = 0.f; for (int d = 0; d < DM; ++d) { const float xv = xs[d]; a += xv * Wg[(size_t)d * DFFE + j]; b += xv * Wu[(size_t)d * DFFE + j]; } hid[j] = (a / (1.0f + __expf(-a))) * b; }
                __syncthreads();
                for (int q = 0; q < 4; ++q) { const int c = tid + 512 * q; float o = 0.f; for (int j = 0; j < DFFE; ++j) o += hid[j] * Wd[(size_t)j * DM + c]; accv[q] += gt * o; }
                __syncthreads(); }
            float num = 0.f, den = 0.f;
            for (int q = 0; q < 4; ++q) { const int c = tid + 512 * q; const float mine = bf2f(((const bf16*)(ws + WS_Y0))[(size_t)tok * DM + c]) + bf2f(((const bf16*)(ws + WS_Y1))[(size_t)tok * DM + c]); const float df = accv[q] - mine; num += df * df; den += accv[q] * accv[q]; }
            num = wave_sum(num); den = wave_sum(den); if (lane == 0) { red[wave * 2] = num; red[wave * 2 + 1] = den; }
            __syncthreads();
            if (tid == 0) { float n = 0.f, dn = 0.f; for (int w = 0; w < 8; ++w) { n += red[w * 2]; dn += red[w * 2 + 1]; } const float rel = n / (dn + 1e-20f); atomicMax((unsigned*)(ctl + 80), __float_as_uint(rel)); }
            if (wave == 0) { float lg[8]; for (int e = 0; e < 8; ++e) { float s = 0.f; for (int d = lane; d < DM; d += 64) s += xs[d] * args.in(I_ROUTER)[d * 8 + e]; lg[e] = wave_sum(s); }
                int e0 = 0; for (int e = 1; e < 8; ++e) if (lg[e] > lg[e0]) e0 = e; int e1 = -1; for (int e = 0; e < 8; ++e) if (e != e0 && (e1 < 0 || lg[e] > lg[e1])) e1 = e;
                const float ex = __expf(lg[e1] - lg[e0]); const float g0 = 1.f / (1.f + ex);
                const int* rt = (const int*)(ws + WS_RT) + (size_t)tok * 4; const float* rg = (const float*)(ws + WS_RTG) + (size_t)tok * 2;
                const bool bad = (rt[0] != e0) || (rt[1] != e1) || fabsf(rg[0] - g0) > 0.03f || fabsf(rg[0] + rg[1] - 1.f) > 1e-3f;
                if (lane == 0 && bad) atomicAdd((unsigned*)(ctl + 81), 1u); }
            __syncthreads(); } }
        __syncthreads();
        { XcdBarrier bb_ = bar; (void)bb_; }
#endif
        const float* gG = args.in(I_LN2G) + DM; const float* gB = args.in(I_LN2B) + DM;
        f32x4 nv[8]; if (gw < M) ln_load(XRES + (size_t)gw * DM, lane, nv);
        for (int m = gw; m < M; m += NGW) { f32x4 v[8];
#pragma unroll
            for (int j = 0; j < 8; ++j) v[j] = nv[j];
            if (m + NGW < M) ln_load(XRES + (size_t)(m + NGW) * DM, lane, nv);
            ln_row(XRES + (size_t)m * DM, nullptr, gG, gB, lane, v, (const bf16*)(ws + WS_Y0) + (size_t)m * DM, (const bf16*)(ws + WS_Y1) + (size_t)m * DM, XRES + (size_t)m * DM); }
#if TIMING_PROBE
        { XcdBarrier bb_ = bar; asm volatile("" : "+s"(bb_.bar), "+s"(bb_.x)); xcd_barrier(bb_); }
        STAMP(26);
        __syncthreads();
        if (bx == 0) { volatile LAS unsigned* T = (volatile LAS unsigned*)(lds + MISC_OFF) + 16;
            const float t1 = (float)(T[PROBE_A1] - T[PROBE_A0]) * 0.01f, t2 = (float)(T[PROBE_B1] - T[PROBE_B0]) * 0.01f;
            if (tid == 0) XRES[12345] = t1 * PROBE_SCALE + 0.f * t2; }
#endif
#if MOE_CHECK
        __syncthreads(); VM_WAIT();
        if (tid == 0) { __builtin_amdgcn_fence(__ATOMIC_RELEASE, "agent"); const unsigned old_ = atomicAdd((unsigned*)(ctl + 82), 1u); ((volatile LAS unsigned*)(lds + MISC_OFF))[12] = (old_ + 1u == (unsigned)G) ? 1u : 0u; }
        __syncthreads();
        if (((volatile LAS unsigned*)(lds + MISC_OFF))[12]) { __builtin_amdgcn_fence(__ATOMIC_ACQUIRE, "agent");
            const float rel = __uint_as_float(__hip_atomic_load(ctl + 80, RLX_AGENT)); const unsigned nbad = __hip_atomic_load(ctl + 81, RLX_AGENT);
            float code = 0.f; if (rel > 0.03f) code += 10.f; if (rel > 0.3f) code += 10.f; if (nbad > 2u) code += 40.f; if (nbad > 8u) code += 40.f;
            if (code > 0.f) for (size_t i = tid; i < (size_t)M * DM; i += 512) XRES[i] = code; }
#endif
    }
}
#undef IN
#undef INK
#undef SEAM
#undef STAMP

template <int LO, int HI> static void launch_range(int grid, const Args& a, int li, hipStream_t stream) {
    static bool attr = false;
    if (!attr) { if (hipFuncSetAttribute((const void*)mk_fwd<LO, HI>, hipFuncAttributeMaxDynamicSharedMemorySize, LDS_BYTES) != hipSuccess) fprintf(stderr, "kernel_launch: hipFuncSetAttribute failed\n"); attr = true; }
    hipLaunchKernelGGL((mk_fwd<LO, HI>), dim3(grid), dim3(NWAVES * 64), LDS_BYTES, stream, a, li);
}
template <int P> struct PerPhase { static void go(int grid, const Args& a, hipStream_t s) { PerPhase<P - 1>::go(grid, a, s); launch_range<P, P + 1>(grid, a, P, s); } };
template <> struct PerPhase<-1> { static void go(int, const Args&, hipStream_t) {} };

extern "C" void kernel_launch(void* const* d_in, const int* in_sizes, int n_in, void* d_out, int out_size, void* d_ws, size_t ws_size, hipStream_t stream) {
    static int grid = 0;
    if (grid == 0) {
        if (n_in != 35 || out_size != M * DM || ws_size < WS_END) { fprintf(stderr, "kernel_launch: built for 35 inputs, out %d floats, >= %zu bytes of workspace; got n_in %d, out %d, ws %zu; nothing launched\n", M * DM, (size_t)WS_END, n_in, out_size, ws_size); grid = -1; return; }
        int dev = 0, cus = 0;
        if (hipGetDevice(&dev) != hipSuccess || hipDeviceGetAttribute(&cus, hipDeviceAttributeMultiprocessorCount, dev) != hipSuccess) { grid = -1; return; }
        grid = cus;
    }
    if (grid < 0) return;
    if (hipMemsetAsync((char*)d_ws + WS_CTL, 0, CTL_ZERO_BYTES, stream) != hipSuccess) return;
    Args a{};
    for (int i = 0; i < 35; ++i) a.in[i] = (const float*)d_in[i];
    a.out = (float*)d_out; a.ws = (unsigned char*)d_ws; a.ph_lo = 0; a.ph_hi = N_PHASES;
#if MK_CUTS
    PerPhase<N_PHASES - 1>::go(grid, a, stream);
#else
    launch_range<0, N_PHASES>(grid, a, 0, stream);
#endif
    const hipError_t le = hipPeekAtLastError();
    if (le != hipSuccess) fprintf(stderr, "kernel_launch: launch failed: %s\n", hipGetErrorName(le));
}
```

```cpp
#include <hip/hip_runtime.h>
#include <cstdio>
#include <cstdint>
namespace pg8 {
#define PG8_LAS __attribute__((address_space(3)))
typedef unsigned short bf16_t;
typedef short bf16x8 __attribute__((ext_vector_type(8)));
typedef float f32x4 __attribute__((ext_vector_type(4)));
typedef unsigned u32x4 __attribute__((ext_vector_type(4)));
constexpr int BM = 256, BK = 64, HALF = 128, HTB = HALF * BK * 2  , STAGE_BYTES = 8 * HTB, NXCD = 8, WGM = 8;

__host__ __device__ __forceinline__ int lds_byte(int r, int c) { const int st = (r >> 4) * 2 + (c >> 5), rr = r & 15, cc = c & 31, ob = rr * 64 + cc * 2; return st * 1024 + (ob ^ (((ob >> 9) & 1) << 5)); }
__host__ __device__ __forceinline__ void stage_rc(int b, int& R, int& C) { const int st = b / 1024, sb = b % 1024, swz = sb ^ (((sb >> 9) & 1) << 5); R = (st >> 1) * 16 + swz / 64; C = (st & 1) * 32 + (swz % 64) / 2; }
__host__ __device__ __forceinline__ int perm32(int rho) { const int n = rho >> 4, i = rho & 15; return 8 * (i >> 2) + 4 * n + (i & 3); }

struct Unit { int pm, pn; long aoff, boff; int aux; };
struct Gemm { const bf16_t* A; const bf16_t* Bt; int M, N, K; };
__device__ __forceinline__ long rfl64(long v) { const unsigned lo = __builtin_amdgcn_readfirstlane((unsigned)v), hi = __builtin_amdgcn_readfirstlane((unsigned)((unsigned long)v >> 32)); return (long)(((unsigned long)hi << 32) | lo); }
__device__ __forceinline__ void unit_uniform(Unit& u) { u.pm = __builtin_amdgcn_readfirstlane(u.pm); u.pn = __builtin_amdgcn_readfirstlane(u.pn); u.aux = __builtin_amdgcn_readfirstlane(u.aux); u.aoff = rfl64(u.aoff); u.boff = rfl64(u.boff); }

struct StaticOrder {
    int nM, nN, nwg, G, c;
    __host__ __device__ void init(int M, int N, int G_, int c_) { nM = M / BM; nN = N / BM; nwg = nM * nN; G = G_; c = c_; }
    __host__ __device__ bool next(int i, Unit& u) const {
        const long L = (long)i * G + c; if (L >= nwg) return false;
        int wgid = (int)L; { const int q = nwg / NXCD, r = nwg % NXCD, xcd = wgid % NXCD, off = wgid / NXCD; wgid = (xcd < r ? xcd * (q + 1) : r * (q + 1) + (xcd - r) * q) + off; }
        const int nig = WGM * nN, gid = wgid / nig, fm = gid * WGM, gsz = (nM - fm) < WGM ? (nM - fm) : WGM;
        u.pm = fm + ((wgid % nig) % gsz); u.pn = (wgid % nig) / gsz; u.aoff = 0; u.boff = 0; u.aux = 0; return true;
    }
    __device__ __forceinline__ void a_ready(const Unit&) const {}
    __device__ __forceinline__ void done(const Unit&) const {}
};
struct MoeOrder {
    StaticOrder so; int rb0; int pend[8]; long bstride;
    __device__ bool next(int i, Unit& u) const {
        if (!so.next(i, u)) return false;
        const int row = (rb0 + u.pm) * BM; int e = 0;
#pragma unroll
        for (int j = 0; j < 7; ++j) e += (row >= pend[j]) ? 1 : 0;
        u.boff = (long)e * bstride; u.aux = rb0 + u.pm; return true;
    }
    __device__ __forceinline__ void a_ready(const Unit&) const {}
    __device__ __forceinline__ void done(const Unit&) const {}
};

__device__ __forceinline__ unsigned cvt_pk_bf16(float lo, float hi) { unsigned r; asm volatile("v_cvt_pk_bf16_f32 %0, %1, %2" : "=v"(r) : "v"(lo), "v"(hi)); return r; }
__device__ __forceinline__ float silu_f(float v) { return v * __builtin_amdgcn_rcpf(1.0f + __builtin_amdgcn_exp2f(-1.4426950408889634f * v)); }

struct EpiBf16 {
    static constexpr bool PERM = true, AFTER_DRAIN = false;
    bf16_t* O; int ldc; float* F; int fcol0;
    __device__ __forceinline__ void operator()(const f32x4 (&acc)[2][2][4][2], const Unit& u, int wr, int wc, int fr, int fq) const {
        const int row0 = u.pm * BM + wr * 64 + fr; const int col0 = u.pn * BM + wc * 32 + 8 * fq;
#pragma unroll
        for (int ai = 0; ai < 2; ++ai)
#pragma unroll
            for (int m = 0; m < 4; ++m) { bf16_t* rowp = O + (size_t)(row0 + ai * HALF + m * 16) * ldc + col0;
#pragma unroll
                for (int bj = 0; bj < 2; ++bj) { const f32x4 v0 = acc[ai][bj][m][0], v1 = acc[ai][bj][m][1];
                    u32x4 w; w.x = cvt_pk_bf16(v0[0], v0[1]); w.y = cvt_pk_bf16(v0[2], v0[3]); w.z = cvt_pk_bf16(v1[0], v1[1]); w.w = cvt_pk_bf16(v1[2], v1[3]);
                    *(u32x4*)(rowp + bj * HALF) = w;
                    if (F) { const int c = col0 + bj * HALF - fcol0; if (c >= 0 && c < 16) { float* fp = F + (size_t)(row0 + ai * HALF + m * 16) * 16 + c; *(f32x4*)fp = v0; *(f32x4*)(fp + 4) = v1; } }
                } }
    }
};
struct EpiResF32 {
    static constexpr bool PERM = false, AFTER_DRAIN = false;
    const float* Xin; float* X; int ldc; float alpha; float bscale;
    __device__ __forceinline__ void operator()(const f32x4 (&acc)[2][2][4][2], const Unit& u, int wr, int wc, int fr, int fq) const {
        const int row0 = u.pm * BM + wr * 64 + fr, col0 = u.pn * BM + wc * 32 + 4 * fq;
#pragma unroll
        for (int ai = 0; ai < 2; ++ai)
#pragma unroll
            for (int m = 0; m < 4; ++m) { float* rowp = X + (size_t)(row0 + ai * HALF + m * 16) * ldc + col0;
#pragma unroll
                for (int bj = 0; bj < 2; ++bj)
#pragma unroll
                    for (int n = 0; n < 2; ++n) { f32x4* p = (f32x4*)(rowp + bj * HALF + n * 16); const f32x4 x = *(const f32x4*)(Xin + (p - (f32x4*)X) * 4); *p = x * alpha + acc[ai][bj][m][n] * bscale; } }
    }
};
struct EpiSwiglu {
    static constexpr bool PERM = true, AFTER_DRAIN = false;
    bf16_t* H; int ldc;
    __device__ __forceinline__ void operator()(const f32x4 (&acc)[2][2][4][2], const Unit& u, int wr, int wc, int fr, int fq) const {
        const int row0 = u.pm * BM + wr * 64 + fr; const int col0 = u.pn * HALF + wc * 32 + 8 * fq;
#pragma unroll
        for (int ai = 0; ai < 2; ++ai)
#pragma unroll
            for (int m = 0; m < 4; ++m) { bf16_t* rowp = H + (size_t)(row0 + ai * HALF + m * 16) * ldc + col0;
                const f32x4 g0 = acc[ai][0][m][0], g1 = acc[ai][0][m][1], u0 = acc[ai][1][m][0], u1 = acc[ai][1][m][1];
                f32x4 h0, h1;
#pragma unroll
                for (int j = 0; j < 4; ++j) { h0[j] = silu_f(g0[j]) * u0[j]; h1[j] = silu_f(g1[j]) * u1[j]; }
                u32x4 w; w.x = cvt_pk_bf16(h0[0], h0[1]); w.y = cvt_pk_bf16(h0[2], h0[3]); w.z = cvt_pk_bf16(h1[0], h1[1]); w.w = cvt_pk_bf16(h1[2], h1[3]);
                *(u32x4*)rowp = w; }
    }
};
struct EpiSwigluF8 {
    static constexpr bool PERM = true, AFTER_DRAIN = false;
    unsigned char* H; int ldc;
    __device__ __forceinline__ void operator()(const f32x4 (&acc)[2][2][4][2], const Unit& u, int wr, int wc, int fr, int fq) const {
        const int row0 = u.pm * BM + wr * 64 + fr; const int col0 = u.pn * HALF + wc * 32 + 8 * fq;
#pragma unroll
        for (int ai = 0; ai < 2; ++ai)
#pragma unroll
            for (int m = 0; m < 4; ++m) { unsigned char* rowp = H + (size_t)(row0 + ai * HALF + m * 16) * ldc + col0;
                const f32x4 g0 = acc[ai][0][m][0], g1 = acc[ai][0][m][1], u0 = acc[ai][1][m][0], u1 = acc[ai][1][m][1];
                f32x4 h0, h1;
#pragma unroll
                for (int j = 0; j < 4; ++j) { h0[j] = silu_f(g0[j]) * u0[j]; h1[j] = silu_f(g1[j]) * u1[j]; }
                int w0 = 0, w1 = 0;
                w0 = __builtin_amdgcn_cvt_pk_fp8_f32(h0[0], h0[1], w0, false); w0 = __builtin_amdgcn_cvt_pk_fp8_f32(h0[2], h0[3], w0, true);
                w1 = __builtin_amdgcn_cvt_pk_fp8_f32(h1[0], h1[1], w1, false); w1 = __builtin_amdgcn_cvt_pk_fp8_f32(h1[2], h1[3], w1, true);
                typedef int i32x2 __attribute__((ext_vector_type(2))); *(i32x2*)rowp = (i32x2){w0, w1}; __builtin_amdgcn_sched_barrier(0); }
    }
};
struct EpiMoeDown {
    static constexpr bool PERM = true, AFTER_DRAIN = false;
    bf16_t* Y0; long ystride; int ldc; const int* slot_tok2; const float* slot_gate; int rbase;
    __device__ __forceinline__ void operator()(const f32x4 (&acc)[2][2][4][2], const Unit& u, int wr, int wc, int fr, int fq) const {
        const int row0 = rbase + u.pm * BM + wr * 64 + fr; const int col0 = u.pn * BM + wc * 32 + 8 * fq;
#pragma unroll
        for (int ai = 0; ai < 2; ++ai)
#pragma unroll
            for (int m = 0; m < 4; ++m) { const int slot = row0 + ai * HALF + m * 16; const int t2 = slot_tok2[slot]; const float gt = slot_gate[slot];
                if (t2 >= 0) { bf16_t* rowp = Y0 + (size_t)(t2 & 1) * ystride + (size_t)(t2 >> 1) * ldc + col0;
#pragma unroll
                    for (int bj = 0; bj < 2; ++bj) { const f32x4 v0 = acc[ai][bj][m][0] * gt, v1 = acc[ai][bj][m][1] * gt;
                        u32x4 w; w.x = cvt_pk_bf16(v0[0], v0[1]); w.y = cvt_pk_bf16(v0[2], v0[3]); w.z = cvt_pk_bf16(v1[0], v1[1]); w.w = cvt_pk_bf16(v1[2], v1[3]);
                        *(u32x4*)(rowp + bj * HALF) = w; } } __builtin_amdgcn_sched_barrier(0); }
    }
};

template <class Epi, class Sched, bool ALIGN_EPI = false, bool SP2 = false>
__device__ __forceinline__ void gemm_phase(PG8_LAS unsigned char* lds, const Gemm g, const Sched& S, const Epi& E, int tid) {
    asm volatile("" : "+v"(tid));
    const int wid = __builtin_amdgcn_readfirstlane(tid >> 6), lane = tid & 63, wr = wid >> 2, wc = wid & 3, fr = lane & 15, fq = lane >> 4;
    const int K = g.K, nt = K / BK;
    unsigned voffA[2], voffB[2];
#pragma unroll
    for (int i = 0; i < 2; ++i) { int R, C; stage_rc(tid * 16 + i * 8192, R, C); const int Rb = Epi::PERM ? ((R & ~31) + perm32(R & 31)) : R;
        voffA[i] = (unsigned)(R * K + C) * 2u; voffB[i] = (unsigned)(Rb * K + C) * 2u; }
    const size_t kstep = (size_t)(BK * 2);
    const size_t hstep = (size_t)HALF * K * 2;
    const size_t tstep = 2 * hstep;
    const unsigned ldsw = (unsigned)wid * 1024u;
    const int aoff = lds_byte(wr * 64 + fr, fq * 8), boff = lds_byte(wc * 32 + fr, fq * 8);
#define PG8_SA(b, h) (((b) * 2 + (h)) * HTB)
#define PG8_SB(b, h) ((4 + (b) * 2 + (h)) * HTB)
#define PG8_STAGE(bufoff, gbase, voff) do { _Pragma("unroll") for (int _i = 0; _i < 2; ++_i) \
        __builtin_amdgcn_global_load_lds((const unsigned*)((const char*)(gbase) + (voff)[_i]), (PG8_LAS unsigned*)(lds + (bufoff) + ldsw + _i * 8192), 16, 0, 0); } while (0)
#define PG8_LDA(dst, b, h) do { _Pragma("unroll") for (int m = 0; m < 4; ++m) _Pragma("unroll") for (int k = 0; k < 2; ++k) dst[m][k] = *(const PG8_LAS bf16x8*)(lds + PG8_SA(b, h) + aoff + m * 2048 + k * 1024); } while (0)
#define PG8_LDB(dst, b, h) do { _Pragma("unroll") for (int n = 0; n < 2; ++n) _Pragma("unroll") for (int k = 0; k < 2; ++k) dst[n][k] = *(const PG8_LAS bf16x8*)(lds + PG8_SB(b, h) + boff + n * 2048 + k * 1024); } while (0)
#define PG8_MMA(ai, bj, At, Bt) do { __builtin_amdgcn_s_setprio(1); _Pragma("unroll") for (int m = 0; m < 4; ++m) _Pragma("unroll") for (int n = 0; n < 2; ++n) _Pragma("unroll") for (int k = 0; k < 2; ++k) \
        acc[ai][bj][m][n] = __builtin_amdgcn_mfma_f32_16x16x32_bf16(Bt[n][k], At[m][k], acc[ai][bj][m][n], 0, 0, 0); __builtin_amdgcn_s_setprio(0); } while (0)
#define PG8_WAIT_V(n) asm volatile("s_waitcnt vmcnt(" #n ")" ::: "memory")
#define PG8_WAIT_L(n) asm volatile("s_waitcnt lgkmcnt(" #n ")" ::: "memory")
#define PG8_BAR __builtin_amdgcn_s_barrier()
#define PG8_SCHED __builtin_amdgcn_sched_barrier(0)
    Unit cur, nxt; int ui = 0;
    if (!S.next(0, cur)) return;
    f32x4 acc[2][2][4][2];
#pragma unroll
    for (int a = 0; a < 2; ++a)
#pragma unroll
        for (int b = 0; b < 2; ++b)
#pragma unroll
            for (int m = 0; m < 4; ++m)
#pragma unroll
                for (int n = 0; n < 2; ++n) acc[a][b][m][n] = (f32x4){0.f, 0.f, 0.f, 0.f};
    bf16x8 At[4][2], B0[2][2], B1[2][2];
    const char* cA = (const char*)g.A + cur.aoff + (size_t)cur.pm * tstep; const char* cB = (const char*)g.Bt + cur.boff + (size_t)cur.pn * tstep;
    S.a_ready(cur);
    if constexpr (SP2) {
        PG8_STAGE(PG8_SB(0, 0), cB, voffB); PG8_STAGE(PG8_SB(0, 1), cB + hstep, voffB); PG8_STAGE(PG8_SA(0, 0), cA, voffA); PG8_STAGE(PG8_SA(0, 1), cA + hstep, voffA);
        if (wr == 1) PG8_BAR;
        PG8_WAIT_V(2); PG8_BAR;
        PG8_STAGE(PG8_SB(1, 0), cB + kstep, voffB); PG8_STAGE(PG8_SA(1, 0), cA + kstep, voffA); PG8_STAGE(PG8_SB(1, 1), cB + hstep + kstep, voffB);
        PG8_WAIT_V(6); PG8_BAR;
    } else {
        PG8_STAGE(PG8_SB(0, 0), cB, voffB); PG8_STAGE(PG8_SA(0, 0), cA, voffA); PG8_STAGE(PG8_SB(0, 1), cB + hstep, voffB); PG8_STAGE(PG8_SA(0, 1), cA + hstep, voffA);
        if (wr == 1) PG8_BAR;
        PG8_WAIT_V(4); PG8_BAR;
        PG8_STAGE(PG8_SB(1, 0), cB + kstep, voffB); PG8_STAGE(PG8_SA(1, 0), cA + kstep, voffA); PG8_STAGE(PG8_SB(1, 1), cB + hstep + kstep, voffB);
        PG8_WAIT_V(6); PG8_BAR;
    }
    for (;;) {
        const bool has_next = S.next(ui + 1, nxt);
        const char* nA = has_next ? (const char*)g.A + nxt.aoff + (size_t)nxt.pm * tstep : cA; const char* nB = has_next ? (const char*)g.Bt + nxt.boff + (size_t)nxt.pn * tstep : cB;
        for (int t = 0; t < nt; t += 2) {
            const bool last = (t == nt - 2);
            const char* a1 = cA + (size_t)(t + 1) * kstep;
            const char* a2 = last ? nA : cA + (size_t)(t + 2) * kstep; const char* b2 = last ? nB : cB + (size_t)(t + 2) * kstep;
            const char* a3 = a2 + kstep; const char* b3 = b2 + kstep;
            if (last && has_next) S.a_ready(nxt);
            if constexpr (SP2) {
            PG8_LDB(B0, 0, 0); PG8_LDB(B1, 0, 1); PG8_SCHED; PG8_LDA(At, 0, 0); PG8_STAGE(PG8_SA(1, 1), a1 + hstep, voffA);
            PG8_WAIT_V(8); PG8_WAIT_L(0); PG8_BAR; PG8_MMA(0, 0, At, B0); PG8_MMA(0, 1, At, B1); PG8_BAR; PG8_SCHED;
            PG8_LDA(At, 0, 1); PG8_STAGE(PG8_SB(0, 0), b2, voffB); PG8_STAGE(PG8_SB(0, 1), b2 + hstep, voffB); PG8_STAGE(PG8_SA(0, 0), a2, voffA);
            PG8_WAIT_V(8); PG8_WAIT_L(0); PG8_BAR; PG8_MMA(1, 0, At, B0); PG8_MMA(1, 1, At, B1); PG8_BAR; PG8_SCHED;
            PG8_LDB(B0, 1, 0); PG8_LDB(B1, 1, 1); PG8_SCHED; PG8_LDA(At, 1, 0); PG8_STAGE(PG8_SA(0, 1), a2 + hstep, voffA);
            PG8_WAIT_V(8); PG8_WAIT_L(0); PG8_BAR; PG8_MMA(0, 0, At, B0); PG8_MMA(0, 1, At, B1); PG8_BAR; PG8_SCHED;
            PG8_LDA(At, 1, 1); PG8_STAGE(PG8_SB(1, 0), b3, voffB); PG8_STAGE(PG8_SB(1, 1), b3 + hstep, voffB); PG8_STAGE(PG8_SA(1, 0), a3, voffA);
            PG8_WAIT_V(8); PG8_WAIT_L(0); PG8_BAR; PG8_MMA(1, 0, At, B0); PG8_MMA(1, 1, At, B1); PG8_BAR; PG8_SCHED;
            } else {
            PG8_LDB(B0, 0, 0); PG8_SCHED; PG8_LDA(At, 0, 0); PG8_STAGE(PG8_SA(1, 1), a1 + hstep, voffA);
            PG8_WAIT_L(8); PG8_BAR; PG8_WAIT_L(0); PG8_MMA(0, 0, At, B0); PG8_BAR; PG8_SCHED;
            PG8_LDB(B1, 0, 1); PG8_STAGE(PG8_SB(0, 0), b2, voffB);
            PG8_BAR; PG8_WAIT_L(0); PG8_MMA(0, 1, At, B1); PG8_BAR;
            PG8_LDA(At, 0, 1); PG8_STAGE(PG8_SA(0, 0), a2, voffA);
            PG8_BAR; PG8_WAIT_L(0); PG8_MMA(1, 0, At, B0); PG8_BAR; PG8_SCHED;
            PG8_STAGE(PG8_SB(0, 1), b2 + hstep, voffB);
            PG8_WAIT_V(6); PG8_BAR; PG8_MMA(1, 1, At, B1); PG8_BAR;
            PG8_LDB(B0, 1, 0); PG8_SCHED; PG8_LDA(At, 1, 0); PG8_STAGE(PG8_SA(0, 1), a2 + hstep, voffA);
            PG8_WAIT_L(8); PG8_BAR; PG8_WAIT_L(0); PG8_MMA(0, 0, At, B0); PG8_BAR; PG8_SCHED;
            PG8_LDB(B1, 1, 1); PG8_STAGE(PG8_SB(1, 0), b3, voffB);
            PG8_BAR; PG8_WAIT_L(0); PG8_MMA(0, 1, At, B1); PG8_BAR;
            PG8_LDA(At, 1, 1); PG8_STAGE(PG8_SA(1, 0), a3, voffA);
            PG8_BAR; PG8_WAIT_L(0); PG8_MMA(1, 0, At, B0); PG8_BAR; PG8_SCHED;
            PG8_STAGE(PG8_SB(1, 1), b3 + hstep, voffB);
            PG8_WAIT_V(6); PG8_BAR; PG8_MMA(1, 1, At, B1); PG8_BAR;
            }
        }
        if constexpr (ALIGN_EPI) { if (wr == 0) PG8_BAR; }
        if constexpr (!Epi::AFTER_DRAIN) { E(acc, cur, wr, wc, fr, fq); S.done(cur); }
        if (!has_next) break;
#pragma unroll
        for (int a = 0; a < 2; ++a)
#pragma unroll
            for (int b = 0; b < 2; ++b)
#pragma unroll
                for (int m = 0; m < 4; ++m)
#pragma unroll
                    for (int n = 0; n < 2; ++n) acc[a][b][m][n] = (f32x4){0.f, 0.f, 0.f, 0.f};
        cur = nxt; cA = nA; cB = nB; ++ui;
        if constexpr (ALIGN_EPI) { if (wr == 1) PG8_BAR; }
    }
    PG8_WAIT_V(0);
    if constexpr (!ALIGN_EPI) { if (wr == 0) PG8_BAR; }
    PG8_BAR;
#undef PG8_SA
#undef PG8_SB
#undef PG8_STAGE
#undef PG8_LDA
#undef PG8_LDB
#undef PG8_MMA
#undef PG8_WAIT_V
#undef PG8_WAIT_L
#undef PG8_BAR
#undef PG8_SCHED
}
typedef int v8i __attribute__((ext_vector_type(8)));
typedef int v4i __attribute__((ext_vector_type(4)));
typedef int v32i __attribute__((ext_vector_type(32)));
template <class Epi, class Sched, bool ALIGN_EPI = false, bool SP2 = false>
__device__ __forceinline__ void gemm_phase_f8(PG8_LAS unsigned char* lds, const Gemm g, const Sched& S, const Epi& E, int tid, int scaleBt, int scaleA) {
    asm volatile("" : "+v"(tid));
    const int wid = __builtin_amdgcn_readfirstlane(tid >> 6), lane = tid & 63, wr = wid >> 2, wc = wid & 3, fr = lane & 15, fq = lane >> 4;
    const int K = g.K, nt = K / 128;
    unsigned voffA[2], voffB[2];
#pragma unroll
    for (int i = 0; i < 2; ++i) { int R, C; stage_rc(tid * 16 + i * 8192, R, C); const int Rb = Epi::PERM ? ((R & ~31) + perm32(R & 31)) : R;
        voffA[i] = (unsigned)(R * K + C * 2); voffB[i] = (unsigned)(Rb * K + C * 2); }
    const size_t kstep = (size_t)(BK * 2);
    const size_t hstep = (size_t)HALF * K;
    const size_t tstep = 2 * hstep;
    const unsigned ldsw = (unsigned)wid * 1024u;
    const int aoff0 = lds_byte(wr * 64 + fr, fq * 16), aoff1 = lds_byte(wr * 64 + fr, fq * 16 + 8), boff0 = lds_byte(wc * 32 + fr, fq * 16), boff1 = lds_byte(wc * 32 + fr, fq * 16 + 8);
#define PG8_SA(b, h) (((b) * 2 + (h)) * HTB)
#define PG8_SB(b, h) ((4 + (b) * 2 + (h)) * HTB)
#define PG8_STAGE(bufoff, gbase, voff) do { _Pragma("unroll") for (int _i = 0; _i < 2; ++_i) \
        __builtin_amdgcn_global_load_lds((const unsigned*)((const char*)(gbase) + (voff)[_i]), (PG8_LAS unsigned*)(lds + (bufoff) + ldsw + _i * 8192), 16, 0, 0); } while (0)
#define PG8_INS8(big, slot, lo_, hi_) do { const v8i f_ = __builtin_shufflevector(lo_, hi_, 0, 1, 2, 3, 4, 5, 6, 7); \
        const v32i e_ = __builtin_shufflevector(f_, f_, 0, 1, 2, 3, 4, 5, 6, 7, 0, 1, 2, 3, 4, 5, 6, 7, 0, 1, 2, 3, 4, 5, 6, 7, 0, 1, 2, 3, 4, 5, 6, 7); \
        if ((slot) == 0) big = __builtin_shufflevector(big, e_, 32, 33, 34, 35, 36, 37, 38, 39, 8, 9, 10, 11, 12, 13, 14, 15, 16, 17, 18, 19, 20, 21, 22, 23, 24, 25, 26, 27, 28, 29, 30, 31); \
        else if ((slot) == 1) big = __builtin_shufflevector(big, e_, 0, 1, 2, 3, 4, 5, 6, 7, 32, 33, 34, 35, 36, 37, 38, 39, 16, 17, 18, 19, 20, 21, 22, 23, 24, 25, 26, 27, 28, 29, 30, 31); \
        else if ((slot) == 2) big = __builtin_shufflevector(big, e_, 0, 1, 2, 3, 4, 5, 6, 7, 8, 9, 10, 11, 12, 13, 14, 15, 32, 33, 34, 35, 36, 37, 38, 39, 24, 25, 26, 27, 28, 29, 30, 31); \
        else big = __builtin_shufflevector(big, e_, 0, 1, 2, 3, 4, 5, 6, 7, 8, 9, 10, 11, 12, 13, 14, 15, 16, 17, 18, 19, 20, 21, 22, 23, 32, 33, 34, 35, 36, 37, 38, 39); } while (0)
#define PG8_GET8(big, slot) ((slot) == 0 ? __builtin_shufflevector(big, big, 0, 1, 2, 3, 4, 5, 6, 7) : (slot) == 1 ? __builtin_shufflevector(big, big, 8, 9, 10, 11, 12, 13, 14, 15) : (slot) == 2 ? __builtin_shufflevector(big, big, 16, 17, 18, 19, 20, 21, 22, 23) : __builtin_shufflevector(big, big, 24, 25, 26, 27, 28, 29, 30, 31))
#define PG8_LDA(dst, b, h) do { _Pragma("unroll") for (int m = 0; m < 4; ++m) { const v4i lo_ = *(const PG8_LAS v4i*)(lds + PG8_SA(b, h) + aoff0 + m * 2048), hi_ = *(const PG8_LAS v4i*)(lds + PG8_SA(b, h) + aoff1 + m * 2048); PG8_INS8(Afr, m, lo_, hi_); } } while (0)
#define PG8_LDB(dst, b, h) do { _Pragma("unroll") for (int n = 0; n < 2; ++n) { const v4i lo_ = *(const PG8_LAS v4i*)(lds + PG8_SB(b, h) + boff0 + n * 2048), hi_ = *(const PG8_LAS v4i*)(lds + PG8_SB(b, h) + boff1 + n * 2048); PG8_INS8(Bfr, (dst) * 2 + n, lo_, hi_); } } while (0)
#define PG8_F8(x) __builtin_bit_cast(v8i, x)
#define PG8_MMA(ai, bj, At, Bt) do { __builtin_amdgcn_s_setprio(1); _Pragma("unroll") for (int m = 0; m < 4; ++m) _Pragma("unroll") for (int n = 0; n < 2; ++n) { const v8i bop_ = PG8_GET8(Bfr, (Bt) * 2 + n), aop_ = PG8_GET8(Afr, m); \
        asm volatile("v_mfma_scale_f32_16x16x128_f8f6f4 %0, %1, %2, %0, %3, %4 op_sel_hi:[0,0,0]" : "+v"(acc[ai][bj][m][n]) : "v"(bop_), "v"(aop_), "v"(scaleBt), "v"(scaleA)); } __builtin_amdgcn_s_setprio(0); } while (0)
#define PG8_WAIT_V(n) asm volatile("s_waitcnt vmcnt(" #n ")" ::: "memory")
#define PG8_WAIT_L(n) asm volatile("s_waitcnt lgkmcnt(" #n ")" ::: "memory")
#define PG8_BAR __builtin_amdgcn_s_barrier()
#define PG8_SCHED __builtin_amdgcn_sched_barrier(0)
    Unit cur, nxt; int ui = 0;
    if (!S.next(0, cur)) return;
    unit_uniform(cur);
    f32x4 acc[2][2][4][2];
#pragma unroll
    for (int a = 0; a < 2; ++a)
#pragma unroll
        for (int b = 0; b < 2; ++b)
#pragma unroll
            for (int m = 0; m < 4; ++m)
#pragma unroll
                for (int n = 0; n < 2; ++n) acc[a][b][m][n] = (f32x4){0.f, 0.f, 0.f, 0.f};
    v32i Afr, Bfr;
    const char* cA = (const char*)g.A + cur.aoff + (size_t)cur.pm * tstep; const char* cB = (const char*)g.Bt + cur.boff + (size_t)cur.pn * tstep;
    S.a_ready(cur);
    if constexpr (SP2) {
        PG8_STAGE(PG8_SB(0, 0), cB, voffB); PG8_STAGE(PG8_SB(0, 1), cB + hstep, voffB); PG8_STAGE(PG8_SA(0, 0), cA, voffA); PG8_STAGE(PG8_SA(0, 1), cA + hstep, voffA);
        if (wr == 1) PG8_BAR;
        PG8_WAIT_V(2); PG8_BAR;
        PG8_STAGE(PG8_SB(1, 0), cB + kstep, voffB); PG8_STAGE(PG8_SA(1, 0), cA + kstep, voffA); PG8_STAGE(PG8_SB(1, 1), cB + hstep + kstep, voffB);
        PG8_WAIT_V(6); PG8_BAR;
    } else {
        PG8_STAGE(PG8_SB(0, 0), cB, voffB); PG8_STAGE(PG8_SA(0, 0), cA, voffA); PG8_STAGE(PG8_SB(0, 1), cB + hstep, voffB); PG8_STAGE(PG8_SA(0, 1), cA + hstep, voffA);
        if (wr == 1) PG8_BAR;
        PG8_WAIT_V(4); PG8_BAR;
        PG8_STAGE(PG8_SB(1, 0), cB + kstep, voffB); PG8_STAGE(PG8_SA(1, 0), cA + kstep, voffA); PG8_STAGE(PG8_SB(1, 1), cB + hstep + kstep, voffB);
        PG8_WAIT_V(6); PG8_BAR;
    }
    for (;;) {
        const bool has_next = __builtin_amdgcn_readfirstlane((int)S.next(ui + 1, nxt)) != 0; unit_uniform(nxt);
        const char* nA = has_next ? (const char*)g.A + nxt.aoff + (size_t)nxt.pm * tstep : cA; const char* nB = has_next ? (const char*)g.Bt + nxt.boff + (size_t)nxt.pn * tstep : cB;
        for (int t = 0; t < nt; t += 2) {
            const bool last = (t == nt - 2);
            const char* a1 = cA + (size_t)(t + 1) * kstep;
            const char* a2 = last ? nA : cA + (size_t)(t + 2) * kstep; const char* b2 = last ? nB : cB + (size_t)(t + 2) * kstep;
            const char* a3 = a2 + kstep; const char* b3 = b2 + kstep;
            if (last && has_next) S.a_ready(nxt);
            if constexpr (SP2) {
            PG8_LDB(0, 0, 0); PG8_LDB(1, 0, 1); PG8_SCHED; PG8_LDA(0, 0, 0); PG8_STAGE(PG8_SA(1, 1), a1 + hstep, voffA);
            PG8_WAIT_V(8); PG8_WAIT_L(0); PG8_BAR; PG8_MMA(0, 0, 0, 0); PG8_MMA(0, 1, 0, 1); PG8_BAR; PG8_SCHED;
            PG8_LDA(0, 0, 1); PG8_STAGE(PG8_SB(0, 0), b2, voffB); PG8_STAGE(PG8_SB(0, 1), b2 + hstep, voffB); PG8_STAGE(PG8_SA(0, 0), a2, voffA);
            PG8_WAIT_V(8); PG8_WAIT_L(0); PG8_BAR; PG8_MMA(1, 0, 0, 0); PG8_MMA(1, 1, 0, 1); PG8_BAR; PG8_SCHED;
            PG8_LDB(0, 1, 0); PG8_LDB(1, 1, 1); PG8_SCHED; PG8_LDA(0, 1, 0); PG8_STAGE(PG8_SA(0, 1), a2 + hstep, voffA);
            PG8_WAIT_V(8); PG8_WAIT_L(0); PG8_BAR; PG8_MMA(0, 0, 0, 0); PG8_MMA(0, 1, 0, 1); PG8_BAR; PG8_SCHED;
            PG8_LDA(0, 1, 1); PG8_STAGE(PG8_SB(1, 0), b3, voffB); PG8_STAGE(PG8_SB(1, 1), b3 + hstep, voffB); PG8_STAGE(PG8_SA(1, 0), a3, voffA);
            PG8_WAIT_V(8); PG8_WAIT_L(0); PG8_BAR; PG8_MMA(1, 0, 0, 0); PG8_MMA(1, 1, 0, 1); PG8_BAR; PG8_SCHED;
            } else {
            PG8_LDB(0, 0, 0); PG8_SCHED; PG8_LDA(0, 0, 0); PG8_STAGE(PG8_SA(1, 1), a1 + hstep, voffA);
            PG8_WAIT_L(8); PG8_BAR; PG8_WAIT_L(0); PG8_MMA(0, 0, 0, 0); PG8_BAR; PG8_SCHED;
            PG8_LDB(1, 0, 1); PG8_STAGE(PG8_SB(0, 0), b2, voffB);
            PG8_BAR; PG8_WAIT_L(0); PG8_MMA(0, 1, 0, 1); PG8_BAR;
            PG8_LDA(0, 0, 1); PG8_STAGE(PG8_SA(0, 0), a2, voffA);
            PG8_BAR; PG8_WAIT_L(0); PG8_MMA(1, 0, 0, 0); PG8_BAR; PG8_SCHED;
            PG8_STAGE(PG8_SB(0, 1), b2 + hstep, voffB);
            PG8_WAIT_V(6); PG8_BAR; PG8_MMA(1, 1, 0, 1); PG8_BAR;
            PG8_LDB(0, 1, 0); PG8_SCHED; PG8_LDA(0, 1, 0); PG8_STAGE(PG8_SA(0, 1), a2 + hstep, voffA);
            PG8_WAIT_L(8); PG8_BAR; PG8_WAIT_L(0); PG8_MMA(0, 0, 0, 0); PG8_BAR; PG8_SCHED;
            PG8_LDB(1, 1, 1); PG8_STAGE(PG8_SB(1, 0), b3, voffB);
            PG8_BAR; PG8_WAIT_L(0); PG8_MMA(0, 1, 0, 1); PG8_BAR;
            PG8_LDA(0, 1, 1); PG8_STAGE(PG8_SA(1, 0), a3, voffA);
            PG8_BAR; PG8_WAIT_L(0); PG8_MMA(1, 0, 0, 0); PG8_BAR; PG8_SCHED;
            PG8_STAGE(PG8_SB(1, 1), b3 + hstep, voffB);
            PG8_WAIT_V(6); PG8_BAR; PG8_MMA(1, 1, 0, 1); PG8_BAR;
            }
        }
        asm volatile("s_nop 15\n\ts_nop 15" ::: "memory");
        if constexpr (ALIGN_EPI) { if (wr == 0) PG8_BAR; }
        if constexpr (!Epi::AFTER_DRAIN) { E(acc, cur, wr, wc, fr, fq); S.done(cur); }
        if (!has_next) break;
#pragma unroll
        for (int a = 0; a < 2; ++a)
#pragma unroll
            for (int b = 0; b < 2; ++b)
#pragma unroll
                for (int m = 0; m < 4; ++m)
#pragma unroll
                    for (int n = 0; n < 2; ++n) acc[a][b][m][n] = (f32x4){0.f, 0.f, 0.f, 0.f};
        cur = nxt; cA = nA; cB = nB; ++ui;
        if constexpr (ALIGN_EPI) { if (wr == 1) PG8_BAR; }
    }
    PG8_WAIT_V(0);
    if constexpr (!ALIGN_EPI) { if (wr == 0) PG8_BAR; }
    PG8_BAR;
#undef PG8_SA
#undef PG8_SB
#undef PG8_STAGE
#undef PG8_LDA
#undef PG8_LDB
#undef PG8_MMA
#undef PG8_F8
#undef PG8_INS8
#undef PG8_GET8
#undef PG8_WAIT_V
#undef PG8_WAIT_L
#undef PG8_BAR
#undef PG8_SCHED
}
}

#ifndef ZERO_MOE
#define ZERO_MOE 0
#endif
#ifndef ZERO_FFN
#define ZERO_FFN 0
#endif
#ifndef ZERO_A
#define ZERO_A 0
#endif
#ifndef ZERO_B
#define ZERO_B 0
#endif
#ifndef ZERO_C
#define ZERO_C 0
#endif
#ifndef ZERO_D
#define ZERO_D 0
#endif
constexpr int NWAVES = 8;
constexpr int NB = 16, SEQ = 2048, DM = 2048, M = NB * SEQ;
constexpr int NIN = 5328, NINP = 5376;
constexpr int C_QC = 0, C_KVC = 384, C_KPE = 640, C_RQ = 704, C_RK = 960, C_RV = 1216, C_RG = 1728, C_MZ = 2240, C_XBC = 2752, C_DT = 3776, C_HU = 3792;
constexpr int DFF = 5632, DFFE = 7168, NEXP = 8;
constexpr int CAP_ROWS = 2 * M + NEXP * 256, CAP_RB = CAP_ROWS / 256;
constexpr int MOE_CH = 1, MOE_CH_RB = CAP_RB / MOE_CH;
constexpr float ALPHA = 1.4142135623730951f;
constexpr int HY_OFF = 2055, HY_GLEN = 4112;

constexpr size_t al256(size_t x) { return (x + 255) / 256 * 256; }
constexpr size_t WS_CTL = 0, CTL_ZERO_BYTES = 1u << 20;
constexpr size_t SZ_WIN = (size_t)NINP * DM * 2, SZ_WUQ = (size_t)768 * 384 * 2, SZ_WUKV = (size_t)1024 * 256 * 2, SZ_WOUT = (size_t)DM * DM * 2;
constexpr size_t WS_WIN = CTL_ZERO_BYTES;
constexpr size_t WS_WUQ = WS_WIN + 2 * SZ_WIN;
constexpr size_t WS_WUKV = WS_WUQ + 2 * SZ_WUQ;
constexpr size_t WS_WOUT = WS_WUKV + 2 * SZ_WUKV;
constexpr size_t WS_WGU = WS_WOUT + 2 * SZ_WOUT;
constexpr size_t WS_WDN = WS_WGU + (size_t)2 * DFF * DM * 2;
constexpr size_t WS_HYG = WS_WDN + (size_t)DM * DFF * 2;
constexpr size_t WS_XB = al256(WS_HYG + (size_t)2 * 2 * 512 * HY_GLEN * 2);
constexpr size_t WS_XF8 = WS_XB + (size_t)M * DM * 2;
constexpr size_t WS_RT = WS_XF8 + (size_t)M * DM;
constexpr size_t WS_RTG = WS_RT + (size_t)M * 16;
constexpr size_t WS_SLOT = WS_RTG + (size_t)M * 8;
constexpr size_t WS_SLOTG = WS_SLOT + (size_t)CAP_ROWS * 4;
constexpr size_t WS_SCR = al256(WS_SLOTG + (size_t)CAP_ROWS * 4);
constexpr size_t WS_PROJ = WS_SCR;
constexpr size_t WS_DTF = WS_PROJ + (size_t)M * NINP * 2;
constexpr size_t WS_QN = WS_DTF + (size_t)M * 16 * 4;
constexpr size_t WS_KVN = WS_QN + (size_t)M * 384 * 2;
constexpr size_t WS_KPE = WS_KVN + (size_t)M * 256 * 2;
constexpr size_t WS_RQ = WS_KPE + (size_t)M * 64 * 2;
constexpr size_t WS_RK = WS_RQ + (size_t)M * 256 * 2;
constexpr size_t WS_XBC = WS_RK + (size_t)M * 256 * 2;
constexpr size_t WS_SSDP = WS_XBC + (size_t)M * 1024 * 2;
constexpr size_t WS_UT = WS_SSDP + (size_t)M * 8 * 16;
constexpr size_t WS_QB = WS_UT + (size_t)3 * 512 * M * 2;
constexpr size_t WS_KVB = WS_QB + (size_t)M * 768 * 2;
constexpr size_t WS_ATT = WS_KVB + (size_t)M * 1024 * 2;
constexpr size_t WS_YC = WS_ATT + (size_t)M * 512 * 2;
constexpr size_t WS_ZT = WS_YC + (size_t)M * 512 * 2;
constexpr size_t WS_MIX = WS_ZT + (size_t)512 * M * 2;
constexpr size_t WS_MIX_END = WS_MIX + (size_t)M * DM * 2;
constexpr size_t WS_HID = WS_SCR;
constexpr size_t WS_MGU = WS_SCR;
constexpr size_t WS_MDN = WS_MGU + (size_t)NEXP * 2 * DFFE * DM;
constexpr size_t WS_XS = WS_MDN + (size_t)NEXP * DM * DFFE;
constexpr size_t WS_HIDS = WS_XS + (size_t)CAP_ROWS * DM;
constexpr size_t WS_Y0 = WS_HIDS + (size_t)MOE_CH_RB * 256 * DFFE;
constexpr size_t WS_Y1 = WS_Y0 + (size_t)M * DM * 2;
constexpr size_t WS_END = WS_Y1 + (size_t)M * DM * 2;
static_assert(WS_MIX_END <= WS_END && WS_HID + (size_t)M * DFF * 2 <= WS_END, "d_ws map");
static_assert(WS_END <= 1942000000ull, "d_ws map exceeds the guaranteed workspace");
constexpr int CW_TMO = 0, CW_CODE = 1;
constexpr int CW_CNT = 64;
constexpr int CW_MIXQ = 1024;
constexpr int CW_BAR = 4096;

constexpr int RING_OFF = 0, RING_BYTES = 131072;
constexpr int LDSCTL_OFF = RING_BYTES, MISC_OFF = LDSCTL_OFF + 320;
constexpr int LDS_BYTES = 147456;

#define GAS __attribute__((address_space(1)))
#define LAS __attribute__((address_space(3)))
typedef unsigned short bf16;
typedef unsigned v4u __attribute__((ext_vector_type(4)));
typedef unsigned v2u __attribute__((ext_vector_type(2)));
typedef float f32x4 __attribute__((ext_vector_type(4)));
typedef float f32x2 __attribute__((ext_vector_type(2)));
typedef float f32x16 __attribute__((ext_vector_type(16)));
typedef short bf16x8 __attribute__((ext_vector_type(8)));
typedef short s16x4 __attribute__((ext_vector_type(4)));
typedef GAS unsigned gu32;
#define RLX_AGENT __ATOMIC_RELAXED, __HIP_MEMORY_SCOPE_AGENT
#define LDS_WAIT() asm volatile("s_waitcnt lgkmcnt(0)" ::: "memory")
#define VM_WAIT() asm volatile("s_waitcnt vmcnt(0)" ::: "memory")
__device__ __forceinline__ unsigned f2bf(float f) { unsigned u = __builtin_bit_cast(unsigned, f); return (u + 0x7fffu + ((u >> 16) & 1u)) >> 16; }
__device__ __forceinline__ unsigned pk2(float lo, float hi) { return f2bf(lo) | (f2bf(hi) << 16); }
__device__ __forceinline__ float bf2f(unsigned b) { return __builtin_bit_cast(float, b << 16); }
__device__ __forceinline__ float bflo(unsigned w) { return __builtin_bit_cast(float, w << 16); }
__device__ __forceinline__ float bfhi(unsigned w) { return __builtin_bit_cast(float, w & 0xffff0000u); }
__device__ __forceinline__ float silu(float v) { return v / (1.0f + __expf(-v)); }
template <int K> __device__ __forceinline__ float swz_xor(float v) { return __builtin_bit_cast(float, __builtin_amdgcn_ds_swizzle(__builtin_bit_cast(int, v), (K << 10) | 0x1f)); }
__device__ __forceinline__ float half_sum(float v) { v += swz_xor<1>(v); v += swz_xor<2>(v); v += swz_xor<4>(v); v += swz_xor<8>(v); v += swz_xor<16>(v); return v; }
__device__ __forceinline__ float wave_sum(float v) { v = half_sum(v);
    auto rr = __builtin_amdgcn_permlane32_swap(__builtin_bit_cast(unsigned, v), __builtin_bit_cast(unsigned, v), false, false);
    const unsigned r0 = rr[0], r1 = rr[1];
    return __uint_as_float(r0) + __uint_as_float(r1); }

#define XB_TMO      128
#define XB_XCNT(j)  (256  + 64 * (j))
#define XB_XSUB(j)  (1280 + 64 * (j))
#define XB_XGEN(j)  (2304 + 64 * (j))
#define XB_TOP      3328
#define XB_TOPGEN   3392
#define XCD_BAR_WORDS 3456
#define XB_SPIN_CAP (1u << 18)
__device__ __forceinline__ unsigned xb_ld(unsigned* p)              { return __hip_atomic_load(p, __ATOMIC_RELAXED, __HIP_MEMORY_SCOPE_AGENT); }
__device__ __forceinline__ unsigned xb_add(unsigned* p, unsigned v) { return __hip_atomic_fetch_add(p, v, __ATOMIC_RELAXED, __HIP_MEMORY_SCOPE_AGENT); }
__device__ __forceinline__ unsigned xb_xcc_id() { return (unsigned)__builtin_amdgcn_s_getreg((3 << 11) | 20) & 0xFu; }
#define XB_SPIN(cond, bar) do { unsigned _sp = 0; while (cond) { __builtin_amdgcn_s_sleep(1); \
    if ((++_sp & 255u) == 0u) { if (xb_ld(&(bar)[XB_TMO])) break; if (_sp > XB_SPIN_CAP) { atomicAdd(&(bar)[XB_TMO], 1u); break; } } } } while (0)
struct XcdBarrier { unsigned* bar; unsigned x; volatile LAS unsigned* st; };
__device__ __forceinline__ XcdBarrier xcd_barrier_post(unsigned* bar, volatile LAS unsigned* st) {
    XcdBarrier b; b.bar = bar; b.x = xb_xcc_id(); b.st = st;
    if (threadIdx.x == 0) (void)xb_add(&bar[XB_XCNT(b.x)], 1u);
    return b;
}
__device__ __forceinline__ void xcd_barrier_complete(unsigned* bar, unsigned x, unsigned& nloc, unsigned& nx) {
    const unsigned G = gridDim.x * gridDim.y * gridDim.z;
    unsigned sum, cnt, mine, sp = 0u;
    for (;;) {
        sum = 0u; cnt = 0u; mine = 0u;
#pragma unroll
        for (unsigned j = 0; j < 16; ++j) { const unsigned c = xb_ld(&bar[XB_XCNT(j)]); sum += c; cnt += (c > 0u) ? 1u : 0u; mine = (j == x) ? c : mine; }
        if (sum == G) break;
        __builtin_amdgcn_s_sleep(1);
        if ((++sp & 255u) == 0u) { if (xb_ld(&bar[XB_TMO])) break; if (sp > XB_SPIN_CAP) { atomicAdd(&bar[XB_TMO], 1u); break; } }
    }
    nloc = mine > 0u ? mine : 1u; nx = cnt > 0u ? cnt : 1u;
}
__device__ __forceinline__ void xcd_barrier(const XcdBarrier& b) {
    asm volatile("s_waitcnt vmcnt(0)" ::: "memory");
    __syncthreads();
    if (threadIdx.x == 0) {
        unsigned* bar = b.bar;
        __builtin_amdgcn_s_waitcnt(0);
        unsigned nloc = b.st[0], nx = b.st[1];
        if (nloc == 0u) { xcd_barrier_complete(bar, b.x, nloc, nx); b.st[0] = nloc; b.st[1] = nx; }
        const unsigned old = xb_add(&bar[XB_XSUB(b.x)], 1u);
        const unsigned gen = old / nloc;
        if (old + 1u == (gen + 1u) * nloc) {
            __builtin_amdgcn_fence(__ATOMIC_RELEASE, "agent");
            asm volatile("s_waitcnt vmcnt(0)" ::: "memory");
            const unsigned og = xb_add(&bar[XB_TOP], 1u);
            const unsigned tg = og / nx;
            if (og + 1u == (tg + 1u) * nx) xb_add(&bar[XB_TOPGEN], 1u);
            else XB_SPIN(xb_ld(&bar[XB_TOPGEN]) == tg, bar);
            __builtin_amdgcn_fence(__ATOMIC_ACQUIRE, "agent");
            xb_add(&bar[XB_XGEN(b.x)], 1u);
            asm volatile("s_waitcnt vmcnt(0)" ::: "memory");
        } else {
            XB_SPIN(xb_ld(&bar[XB_XGEN(b.x)]) == gen, bar);
            __builtin_amdgcn_fence(__ATOMIC_ACQUIRE, "agent");
            asm volatile("s_waitcnt vmcnt(0)" ::: "memory");
        }
    }
    __syncthreads();
}

struct Args {
    const float* in[35]; float* out; unsigned char* ws; int ph_lo, ph_hi;
};
enum { I_X = 0, I_WIN, I_QNORM, I_WUQ, I_KVNORM, I_WUKV, I_OUTNORM, I_CONVW, I_CONVB, I_DTBIAS, I_ALOG, I_SSDD, I_SSDNORM, I_HYCW, I_HYCB, I_HYW1, I_HYB1, I_HYW2, I_HYB2, I_HYW3, I_HYFREQ, I_HYBIAS, I_HYNORM,
       I_WOUT, I_LN1G, I_LN1B, I_LN2G, I_LN2B, I_FFG, I_FFU, I_FFD, I_ROUTER, I_MOEG, I_MOEU, I_MOED };

typedef __attribute__((address_space(4))) const Args CArgs;
struct AP { const CArgs* p;
    __device__ __forceinline__ const float* in(int i) const { return p->in[i]; }
    __device__ __forceinline__ float* out() const { return p->out; }
    __device__ __forceinline__ unsigned char* ws() const { return p->ws; } };
__device__ __forceinline__ AP kargs() { const CArgs* p = (const CArgs*)__builtin_amdgcn_kernarg_segment_ptr(); asm volatile("" : "+s"(p)); AP a; a.p = p; return a; }

__device__ __forceinline__ void transpose_item(const float* W, int K, int N, int nblk, bf16* WT, int GR, int GS, int off, LAS float* scr, int item, int lane) {
    const int kb = item / nblk, nb = item % nblk, k0 = 64 * kb, n0 = 32 * nb;
    const int nr = n0 + (lane & 31); const bool ok = nr < N;
    float tv[32]; const int nrc = ok ? nr : N - 1;
#pragma unroll
    for (int i = 0; i < 32; ++i) { const int kk = 2 * i + (lane >> 5); tv[i] = __builtin_nontemporal_load(W + (size_t)(k0 + kk) * N + nrc); }
#pragma unroll
    for (int i = 0; i < 32; ++i) { const int kk = 2 * i + (lane >> 5); scr[kk * 33 + (lane & 31)] = ok ? tv[i] : 0.f; }
    LDS_WAIT(); asm volatile("" ::: "memory");
    const int c = lane & 7;
#pragma unroll
    for (int j = 0; j < 4; ++j) { const int nl = (lane >> 3) + 8 * j; const int n = n0 + nl; const LAS float* s = scr + (8 * c) * 33 + nl;
        v4u o; o.x = pk2(s[0 * 33], s[1 * 33]); o.y = pk2(s[2 * 33], s[3 * 33]); o.z = pk2(s[4 * 33], s[5 * 33]); o.w = pk2(s[6 * 33], s[7 * 33]);
        const int dest = (n / GR) * GS + (n % GR) + off;
        *(GAS v4u*)(WT + (size_t)dest * K + k0 + 8 * c) = o; }
    LDS_WAIT(); asm volatile("" ::: "memory");
}
__device__ __forceinline__ unsigned pk4_fp8(float a, float b, float c, float d) { int w = 0; w = __builtin_amdgcn_cvt_pk_fp8_f32(a, b, w, false); w = __builtin_amdgcn_cvt_pk_fp8_f32(c, d, w, true); return (unsigned)w; }
struct TrF8 { const float* W; int K, N, nblk; unsigned char* WT; int GR, GS, off; float scl; };
__device__ __forceinline__ void tr_f8_load(const TrF8& j, int item, int lane, float (&tv)[32]) {
    const int kb = item / j.nblk, nb = item % j.nblk, k0 = 64 * kb, n0 = 32 * nb; const int nr = n0 + (lane & 31);
#pragma unroll
    for (int i = 0; i < 32; ++i) { const int kk = 2 * i + (lane >> 5); tv[i] = __builtin_nontemporal_load(j.W + (size_t)(k0 + kk) * j.N + nr); }
}
__device__ __forceinline__ void tr_f8_finish(const TrF8& j, int item, int lane, const float (&tv)[32], LAS float* scr) {
    const int kb = item / j.nblk, nb = item % j.nblk, k0 = 64 * kb, n0 = 32 * nb;
#pragma unroll
    for (int i = 0; i < 32; ++i) { const int kk = 2 * i + (lane >> 5); scr[kk * 33 + (lane & 31)] = tv[i] * j.scl; }
    LDS_WAIT(); asm volatile("" ::: "memory");
    const int nl = lane >> 1, hf = lane & 1, n = n0 + nl; const LAS float* sp = scr + (32 * hf) * 33 + nl;
    v4u o0, o1;
    o0.x = pk4_fp8(sp[0 * 33], sp[1 * 33], sp[2 * 33], sp[3 * 33]); o0.y = pk4_fp8(sp[4 * 33], sp[5 * 33], sp[6 * 33], sp[7 * 33]);
    o0.z = pk4_fp8(sp[8 * 33], sp[9 * 33], sp[10 * 33], sp[11 * 33]); o0.w = pk4_fp8(sp[12 * 33], sp[13 * 33], sp[14 * 33], sp[15 * 33]);
    o1.x = pk4_fp8(sp[16 * 33], sp[17 * 33], sp[18 * 33], sp[19 * 33]); o1.y = pk4_fp8(sp[20 * 33], sp[21 * 33], sp[22 * 33], sp[23 * 33]);
    o1.z = pk4_fp8(sp[24 * 33], sp[25 * 33], sp[26 * 33], sp[27 * 33]); o1.w = pk4_fp8(sp[28 * 33], sp[29 * 33], sp[30 * 33], sp[31 * 33]);
    const int dest = (n / j.GR) * j.GS + (n % j.GR) + j.off;
    GAS v4u* dp = (GAS v4u*)(j.WT + (size_t)dest * j.K + k0 + 32 * hf); dp[0] = o0; dp[1] = o1;
    LDS_WAIT(); asm volatile("" ::: "memory");
}
__device__ __forceinline__ void transpose_item_f8(const float* W, int K, int N, int nblk, unsigned char* WT, int GR, int GS, int off, float scl, LAS float* scr, int item, int lane) {
    TrF8 j{W, K, N, nblk, WT, GR, GS, off, scl}; float tv[32]; tr_f8_load(j, item, lane, tv); tr_f8_finish(j, item, lane, tv, scr);
}
struct TrJob { const float* W; int K, N, nblk; bf16* WT; int GR, GS, off; int items; };
__device__ __forceinline__ TrJob mk_job(const float* W, int K, int N, int Npad, bf16* WT, int GR, int GS, int off) { TrJob j; j.W = W; j.K = K; j.N = N; j.nblk = Npad / 32; j.WT = WT; j.GR = GR; j.GS = GS; j.off = off; j.items = (K / 64) * (Npad / 32); return j; }

__device__ __forceinline__ void hyena_filter_item(const AP& a, int layer, int pos, bf16* HYG, LAS float* scr, int lane) {
    const float* w1 = a.in(I_HYW1) + layer * 33 * 64; const float* b1 = a.in(I_HYB1) + layer * 64;
    const float* w2 = a.in(I_HYW2) + layer * 64 * 64; const float* b2 = a.in(I_HYB2) + layer * 64;
    const float* w3 = a.in(I_HYW3) + (size_t)layer * 64 * 2048; const float* fr = a.in(I_HYFREQ) + layer * 128;
    const float t = (float)pos / 2047.0f; const float ang = 6.283185307179586f * (float)pos / 2048.0f;
    if (lane < 33) { float z;
        if (lane == 0) z = t;
        else { const int k = (lane - 1) & 15; const float f = 1e-4f + (float)k * ((15.0f - 1e-4f) / 15.0f); z = (lane <= 16) ? cosf(f * ang) : -sinf(f * ang); }
        scr[lane] = z; }
    LDS_WAIT(); asm volatile("" ::: "memory");
    float s = b1[lane];
    for (int i = 0; i < 33; ++i) s += scr[i] * w1[i * 64 + lane];
    const float h1 = sinf(fr[lane] * s);
    scr[64 + lane] = h1;
    LDS_WAIT(); asm volatile("" ::: "memory");
    float s2 = b2[lane];
    for (int i = 0; i < 64; ++i) s2 += scr[64 + i] * w2[i * 64 + lane];
    const float h2 = sinf(fr[64 + lane] * s2);
    scr[128 + lane] = h2;
    LDS_WAIT(); asm volatile("" ::: "memory");
    for (int m = 0; m < 32; ++m) { const int col = lane + 64 * m; float v = 0.f;
        for (int i = 0; i < 64; ++i) v += scr[128 + i] * w3[(size_t)i * 2048 + col];
        const int o = col >> 10, dir = (col >> 9) & 1, c = col & 511;
        const float delta = fabsf(-3.0701134573253945f + (float)c * ((-15.350567286626973f + 3.0701134573253945f) / 511.0f));
        v *= expf(-t * delta);
        if (dir == 0 || pos > 0) { const int n = dir == 0 ? HY_OFF - pos : HY_OFF + pos;
            HYG[(((size_t)layer * 2 + o) * 512 + c) * HY_GLEN + n] = (bf16)f2bf(v); } }
    LDS_WAIT(); asm volatile("" ::: "memory");
}

__device__ __forceinline__ void ln_load(const float* xrow, int lane, f32x4 (&v)[8]) { const GAS f32x4* xr = (const GAS f32x4*)xrow + lane;
#pragma unroll
    for (int j = 0; j < 8; ++j) v[j] = xr[64 * j]; }
__device__ __forceinline__ void ln_row(float* xrow, bf16* brow, const float* g, const float* b, int lane, f32x4 (&v)[8], const bf16* y0, const bf16* y1, float* orow, unsigned char* frow = nullptr) {
    float s = 0.f; (void)xrow;
#pragma unroll
    for (int j = 0; j < 8; ++j) {
        if (y0) { v2u a0 = *((const GAS v2u*)y0 + lane + 64 * j), a1 = *((const GAS v2u*)y1 + lane + 64 * j); if (ZERO_MOE) { a0.x = a0.y = a1.x = a1.y = 0u; }
            v[j].x = ALPHA * v[j].x + bflo(a0.x) + bflo(a1.x); v[j].y = ALPHA * v[j].y + bfhi(a0.x) + bfhi(a1.x); v[j].z = ALPHA * v[j].z + bflo(a0.y) + bflo(a1.y); v[j].w = ALPHA * v[j].w + bfhi(a0.y) + bfhi(a1.y); }
        s += (v[j].x + v[j].y) + (v[j].z + v[j].w); }
    const float mean = wave_sum(s) * (1.f / DM); float s2 = 0.f;
#pragma unroll
    for (int j = 0; j < 8; ++j) { v[j] = v[j] - mean; s2 += (v[j].x * v[j].x + v[j].y * v[j].y) + (v[j].z * v[j].z + v[j].w * v[j].w); }
    const float rstd = 1.f / sqrtf(wave_sum(s2) * (1.f / DM) + 1e-5f);
    GAS f32x4* xo = (GAS f32x4*)orow + lane;
#pragma unroll
    for (int j = 0; j < 8; ++j) { const f32x4 gg = *((const GAS f32x4*)g + lane + 64 * j), bb = *((const GAS f32x4*)b + lane + 64 * j);
        v[j] = v[j] * rstd * gg + bb; xo[64 * j] = v[j];
        if (brow) { v2u w; w.x = pk2(v[j].x, v[j].y); w.y = pk2(v[j].z, v[j].w); *((GAS v2u*)brow + lane + 64 * j) = w; }
        if (frow) *((GAS unsigned*)frow + lane + 64 * j) = pk4_fp8(v[j].x, v[j].y, v[j].z, v[j].w); }
}

__device__ __forceinline__ void ld8bf(const bf16* p, float (&f)[8]) { const v4u w = *(const GAS v4u*)p; f[0] = bflo(w.x); f[1] = bfhi(w.x); f[2] = bflo(w.y); f[3] = bfhi(w.y); f[4] = bflo(w.z); f[5] = bfhi(w.z); f[6] = bflo(w.w); f[7] = bfhi(w.w); }
__device__ __forceinline__ void st8bf(bf16* p, const float (&f)[8]) { v4u w; w.x = pk2(f[0], f[1]); w.y = pk2(f[2], f[3]); w.z = pk2(f[4], f[5]); w.w = pk2(f[6], f[7]); *(GAS v4u*)p = w; }

__device__ __forceinline__ float sum8(float v) { v += swz_xor<1>(v); v += swz_xor<2>(v); v += swz_xor<4>(v); return v; }
__device__ __forceinline__ void prep_rows8(const AP& a, int layer, int item, int lane, unsigned char* ws, const LAS float* cwl) {
    const int rr = lane >> 3, sub = lane & 7, row = item * 8 + rr, t = row & (SEQ - 1);
    const bf16* pr = (const bf16*)(ws + WS_PROJ) + (size_t)row * NINP;
    { float f[6][8]; float ss = 0.f;
#pragma unroll
      for (int i = 0; i < 6; ++i) { ld8bf(pr + C_QC + (sub + 8 * i) * 8, f[i]);
#pragma unroll
          for (int j = 0; j < 8; ++j) ss += f[i][j] * f[i][j]; }
      const float rs = 1.0f / sqrtf(sum8(ss) * (1.f / 384.f) + 1e-6f);
#pragma unroll
      for (int i = 0; i < 6; ++i) { const float* w = a.in(I_QNORM) + layer * 384 + (sub + 8 * i) * 8;
#pragma unroll
          for (int j = 0; j < 8; ++j) f[i][j] = f[i][j] * rs * w[j];
          st8bf((bf16*)(ws + WS_QN) + (size_t)row * 384 + (sub + 8 * i) * 8, f[i]); } }
    { float f[4][8]; float ss = 0.f;
#pragma unroll
      for (int i = 0; i < 4; ++i) { ld8bf(pr + C_KVC + (sub + 8 * i) * 8, f[i]);
#pragma unroll
          for (int j = 0; j < 8; ++j) ss += f[i][j] * f[i][j]; }
      const float rs = 1.0f / sqrtf(sum8(ss) * (1.f / 256.f) + 1e-6f);
#pragma unroll
      for (int i = 0; i < 4; ++i) { const float* w = a.in(I_KVNORM) + layer * 256 + (sub + 8 * i) * 8;
#pragma unroll
          for (int j = 0; j < 8; ++j) f[i][j] = f[i][j] * rs * w[j];
          st8bf((bf16*)(ws + WS_KVN) + (size_t)row * 256 + (sub + 8 * i) * 8, f[i]); } }
    { float sn[4], cs[4];
#pragma unroll
      for (int j = 0; j < 4; ++j) { const float inv = exp2f(-(float)(4 * sub + j) * (13.287712379549449f / 32.0f)); sincosf((float)t * inv, &sn[j], &cs[j]); }
#pragma unroll
      for (int g = 0; g < 9; ++g) { int src; bf16* dst; float sc = 1.f;
          if (g == 0) { src = C_KPE; dst = (bf16*)(ws + WS_KPE) + (size_t)row * 64; }
          else if (g < 5) { src = C_RQ + (g - 1) * 64; dst = (bf16*)(ws + WS_RQ) + (size_t)row * 256 + (g - 1) * 64; }
          else { src = C_RK + (g - 5) * 64; dst = (bf16*)(ws + WS_RK) + (size_t)row * 256 + (g - 5) * 64; sc = 0.125f; }
          const v2u a1 = *(const GAS v2u*)(pr + src + 4 * sub), a2 = *(const GAS v2u*)(pr + src + 32 + 4 * sub);
          const float x1[4] = {bflo(a1.x), bfhi(a1.x), bflo(a1.y), bfhi(a1.y)}, x2[4] = {bflo(a2.x), bfhi(a2.x), bflo(a2.y), bfhi(a2.y)};
          float y1[4], y2[4];
#pragma unroll
          for (int j = 0; j < 4; ++j) { y1[j] = (x1[j] * cs[j] - x2[j] * sn[j]) * sc; y2[j] = (x2[j] * cs[j] + x1[j] * sn[j]) * sc; }
          v2u o1, o2; o1.x = pk2(y1[0], y1[1]); o1.y = pk2(y1[2], y1[3]); o2.x = pk2(y2[0], y2[1]); o2.y = pk2(y2[2], y2[3]);
          *(GAS v2u*)(dst + 4 * sub) = o1; *(GAS v2u*)(dst + 32 + 4 * sub) = o2; } }
#pragma unroll 4
    for (int i = 0; i < 16; ++i) { const int c0 = (sub + 8 * i) * 8; float acc[8];
        { const f32x4 b0 = *(const LAS f32x4*)(cwl + 5 * 1024 + c0), b1 = *(const LAS f32x4*)(cwl + 5 * 1024 + c0 + 4); acc[0] = b0.x; acc[1] = b0.y; acc[2] = b0.z; acc[3] = b0.w; acc[4] = b1.x; acc[5] = b1.y; acc[6] = b1.z; acc[7] = b1.w; }
#pragma unroll
        for (int k = 0; k < 5; ++k) { const int tt = t + k - 2;
            if (tt >= 0 && tt < SEQ) { float f[8]; ld8bf(pr + (long)(k - 2) * NINP + C_XBC + c0, f);
                const f32x4 w0 = *(const LAS f32x4*)(cwl + k * 1024 + c0), w1 = *(const LAS f32x4*)(cwl + k * 1024 + c0 + 4);
                acc[0] += w0.x * f[0]; acc[1] += w0.y * f[1]; acc[2] += w0.z * f[2]; acc[3] += w0.w * f[3]; acc[4] += w1.x * f[4]; acc[5] += w1.y * f[5]; acc[6] += w1.z * f[6]; acc[7] += w1.w * f[7]; } }
#pragma unroll
        for (int j = 0; j < 8; ++j) acc[j] = silu(acc[j]);
        st8bf((bf16*)(ws + WS_XBC) + (size_t)row * 1024 + c0, acc); }
}
__device__ __forceinline__ void prep_scan(const AP& a, int layer, int item, int lane, unsigned char* ws, LAS float* scr) {
    const int b = item >> 4, dir = (item >> 3) & 1, hh = item & 7;
    const float* DTF = (const float*)(ws + WS_DTF); float* SSDP = (float*)(ws + WS_SSDP);
    const float bias = a.in(I_DTBIAS)[layer * 16 + dir * 8 + hh]; const float av = -expf(a.in(I_ALOG)[layer * 16 + dir * 8 + hh]);
    float dt[32]; float tot = 0.f;
#pragma unroll
    for (int j = 0; j < 32; ++j) { const int row = b * SEQ + lane * 32 + j; const float x = DTF[(size_t)row * 16 + dir * 8 + hh] + bias;
        dt[j] = x > 20.f ? x : log1pf(expf(x)); tot += dt[j] * av; }
    scr[lane] = tot; LDS_WAIT(); asm volatile("" ::: "memory");
    float excl = 0.f, T = 0.f;
#pragma unroll 2
    for (int l = 0; l < 64; ++l) { const float v = scr[l]; T += v; excl += (l < lane) ? v : 0.f; }
    LDS_WAIT(); asm volatile("" ::: "memory");
    float run = excl;
#pragma unroll
    for (int j = 0; j < 32; ++j) { const int row = b * SEQ + lane * 32 + j; const float la = dt[j] * av; float c;
        if (dir == 0) { run += la; c = run; } else { c = T - run; run += la; }
        f32x2 o; o.x = c * 1.4426950408889634f; o.y = log2f(dt[j]) - o.x;
        *(GAS f32x2*)(SSDP + ((size_t)row * 8 + hh) * 4 + dir * 2) = o; }
}
__device__ __forceinline__ void prep_hyconv(const AP& a, int layer, int item, int lane, unsigned char* ws, LAS bf16* scr) {
    const int cg = item % 24, tt = (item / 24) & 31, b = item / (24 * 32);
    const int ch = cg * 64 + lane, part = ch >> 9, c = ch & 511, t0 = tt * 64;
    const bf16* PROJ = (const bf16*)(ws + WS_PROJ); const bf16* tile = PROJ + (size_t)(b * SEQ) * NINP + C_HU + cg * 64;
    v4u ld[9];
#pragma unroll
    for (int i = 0; i < 9; ++i) { const int id = lane + 64 * i, r = id >> 3, c8 = id & 7, t = t0 - 1 + r;
        ld[i] = (id < 66 * 8 && t >= 0 && t < SEQ) ? *(const GAS v4u*)(tile + (size_t)t * NINP + c8 * 8) : (v4u){0u, 0u, 0u, 0u}; }
#pragma unroll
    for (int i = 0; i < 9; ++i) { const int id = lane + 64 * i, r = id >> 3, c8 = id & 7; if (id < 66 * 8) *(LAS v4u*)(scr + r * 72 + c8 * 8) = ld[i]; }
    const float* cw = a.in(I_HYCW) + layer * 3 * 1536; const float w0 = cw[ch], w1 = cw[1536 + ch], w2 = cw[3072 + ch], bs = a.in(I_HYCB)[layer * 1536 + ch];
    LDS_WAIT(); asm volatile("" ::: "memory");
    float xm = bf2f(scr[lane]), x0 = bf2f(scr[72 + lane]);
    bf16* dst = (bf16*)(ws + WS_UT) + (((size_t)part * 512 + c) * NB + b) * SEQ + t0;
#pragma unroll
    for (int q = 0; q < 8; ++q) { float u[8];
#pragma unroll
        for (int j = 0; j < 8; ++j) { const float xp = bf2f(scr[(q * 8 + j + 2) * 72 + lane]);
            u[j] = bs + w0 * xm + w1 * x0 + w2 * xp; xm = x0; x0 = xp; }
        st8bf(dst + q * 8, u); }
    LDS_WAIT(); asm volatile("" ::: "memory");
}

__device__ __forceinline__ void post_row(const AP& a, int layer, int row, int lane, unsigned char* ws) {
    bf16* MIX = (bf16*)(ws + WS_MIX) + (size_t)row * DM;
    { float f[8]; ld8bf((const bf16*)(ws + WS_ATT) + (size_t)row * 512 + lane * 8, f); float ss = 0.f;
#pragma unroll
      for (int j = 0; j < 8; ++j) ss += f[j] * f[j];
      const float rs = 1.0f / sqrtf(wave_sum(ss) * (1.f / 512.f) + 1e-6f); const float* w = a.in(I_OUTNORM) + layer * 512 + lane * 8;
#pragma unroll
      for (int j = 0; j < 8; ++j) f[j] = ZERO_A ? 0.f : f[j] * rs * w[j];
      st8bf(MIX + lane * 8, f); }
    { float f[8], z[8]; ld8bf((const bf16*)(ws + WS_YC) + (size_t)row * 512 + lane * 8, f); ld8bf((const bf16*)(ws + WS_PROJ) + (size_t)row * NINP + C_MZ + lane * 8, z); float ss = 0.f;
#pragma unroll
      for (int j = 0; j < 8; ++j) { f[j] = f[j] * silu(z[j]); ss += f[j] * f[j]; }
      const float rs = 1.0f / sqrtf(wave_sum(ss) * (1.f / 512.f) + 1e-6f); const float* w = a.in(I_SSDNORM) + layer * 512 + lane * 8;
#pragma unroll
      for (int j = 0; j < 8; ++j) f[j] = ZERO_C ? 0.f : f[j] * rs * w[j];
      st8bf(MIX + 1024 + lane * 8, f); }
}
__device__ __forceinline__ void post_hy(const AP& a, int layer, int item, int lane, unsigned char* ws, LAS bf16* scr) {
    const int b = item >> 7, t0 = (item & 127) * 16, tl = lane & 15, cs = lane >> 4;
    const bf16* ZT = (const bf16*)(ws + WS_ZT) + (size_t)b * SEQ + t0 + tl; const float* w = a.in(I_HYNORM) + layer * 512;
    float ss = 0.f;
#pragma unroll 16
    for (int cc = 0; cc < 128; ++cc) { const float v = bf2f(ZT[(size_t)(cc * 4 + cs) * M]); ss += v * v; }
    ss += swz_xor<16>(ss);
    { auto rr = __builtin_amdgcn_permlane32_swap(__float_as_uint(ss), __float_as_uint(ss), false, false); const unsigned r0 = rr[0], r1 = rr[1]; ss = __uint_as_float(r0) + __uint_as_float(r1); }
    const float rs = 1.0f / sqrtf(ss * (1.f / 512.f) + 1e-6f);
    for (int cg = 0; cg < 8; ++cg) {
#pragma unroll
        for (int jj = 0; jj < 16; ++jj) { const int cl = jj * 4 + cs, c = cg * 64 + cl; scr[tl * 72 + cl] = (bf16)f2bf(ZERO_D ? 0.f : bf2f(ZT[(size_t)c * M]) * rs * w[c]); }
        LDS_WAIT(); asm volatile("" ::: "memory");
#pragma unroll
        for (int i = 0; i < 2; ++i) { const int t2 = (lane >> 3) + 8 * i, c8 = lane & 7; const v4u v = *(const LAS v4u*)(scr + t2 * 72 + c8 * 8);
            *(GAS v4u*)((bf16*)(ws + WS_MIX) + (size_t)(b * SEQ + t0 + t2) * DM + 1536 + cg * 64 + c8 * 8) = v; }
        LDS_WAIT(); asm volatile("" ::: "memory");
    }
}

namespace mixb {
#define SBAR() __builtin_amdgcn_sched_barrier(0)
__device__ __forceinline__ int crow(int r, int hi) { return (r & 3) + 8 * (r >> 2) + 4 * hi; }
__device__ __forceinline__ unsigned cvtpk(float lo, float hi) { unsigned r; asm volatile("v_cvt_pk_bf16_f32 %0, %1, %2" : "=v"(r) : "v"(lo), "v"(hi)); return r; }
__device__ __forceinline__ int v_st(int k, int c) { const int kk = (k & ~0xC) | ((k & 4) << 1) | ((k & 8) >> 1); return ((kk >> 3) * 4 + (c >> 5)) * 512 + ((kk & 7) * 32 + (c & 31)) * 2; }
__device__ __forceinline__ int v_rd_base(int lane) { return ((lane & 3) << 3) | (((lane >> 2) & 3) << 6) | (((lane >> 4) & 1) << 5) | (((lane >> 5) & 1) << 8); }
constexpr int v_rd_off(int d0, int ks, int half) { return d0 * 512 + ks * 4096 + half * 2048; }
template <int OFF> __device__ __forceinline__ s16x4 tr_read(int vb) { s16x4 r; asm volatile("ds_read_b64_tr_b16 %0, %1 offset:%2" : "=&v"(r) : "v"(vb), "i"(OFF) : "memory"); return r; }
template <int D0> __device__ __forceinline__ void pv_one(f32x16& od, int vb, bf16x8 pa0, bf16x8 pa1, bf16x8 pa2, bf16x8 pa3) {
    const s16x4 l0 = tr_read<v_rd_off(D0, 0, 0)>(vb), h0 = tr_read<v_rd_off(D0, 0, 1)>(vb), l1 = tr_read<v_rd_off(D0, 1, 0)>(vb), h1 = tr_read<v_rd_off(D0, 1, 1)>(vb);
    const s16x4 l2 = tr_read<v_rd_off(D0, 2, 0)>(vb), h2 = tr_read<v_rd_off(D0, 2, 1)>(vb), l3 = tr_read<v_rd_off(D0, 3, 0)>(vb), h3 = tr_read<v_rd_off(D0, 3, 1)>(vb);
    asm volatile("s_waitcnt lgkmcnt(0)" ::: "memory"); SBAR();
#define PKV(L, H) (bf16x8){L[0], L[1], L[2], L[3], H[0], H[1], H[2], H[3]}
    od = __builtin_amdgcn_mfma_f32_32x32x16_bf16(pa0, PKV(l0, h0), od, 0, 0, 0);
    od = __builtin_amdgcn_mfma_f32_32x32x16_bf16(pa1, PKV(l1, h1), od, 0, 0, 0);
    od = __builtin_amdgcn_mfma_f32_32x32x16_bf16(pa2, PKV(l2, h2), od, 0, 0, 0);
    od = __builtin_amdgcn_mfma_f32_32x32x16_bf16(pa3, PKV(l3, h3), od, 0, 0, 0);
#undef PKV
}
__device__ __forceinline__ void fast_sincos(float x, float& s, float& c) { float r = x * 0.15915494309189535f; r = r - floorf(r); s = __builtin_amdgcn_sinf(r); c = __builtin_amdgcn_cosf(r); }

struct MixP {
    const bf16* q; int ldq;
    const bf16* k0; int ldk0; const bf16* k1; int ldk1;
    const bf16* v; int ldv;
    bf16* o; int ldo;
    float lf, lb;
    const float* ssdp;
    const bf16* aux; int ldaux; float dh;
};
constexpr int V_BYTES = 16384, V_OFF = 0, K_OFF = 2 * V_BYTES;
template <int DQK> struct KL { static constexpr int PITCH = DQK * 2, BYTES = 64 * PITCH, WK_OFF = K_OFF + 2 * BYTES, SCR_OFF = WK_OFF + 2176, END = SCR_OFF + NWAVES * 256; };

template <int MODE, int DQK, int DV>
__device__ __forceinline__ void mix_unit(const MixP& P, int q0, LAS unsigned char* lds, int tid) {
    typedef KL<DQK> L;
    constexpr int ND = DQK / 16, NV = DV / 32, CPR = DQK / 8, KCH = 64 * CPR / 512, VPR = DV / 8, VCH = (64 * VPR + 511) / 512;
    constexpr float SCALE = 0.07216878364870322f;
    constexpr float C = SCALE * 1.4426950408889634f, THR = 8.f;
    asm volatile("" : "+v"(tid));
    const int wid = tid >> 6, lane = tid & 63, r32 = lane & 31, hi = lane >> 5;
    const int qrow = q0 + wid * 32 + r32;
    LAS unsigned char* Vl = lds + V_OFF; LAS unsigned char* Kl = lds + K_OFF;
    LAS float* wsc = (LAS float*)(lds + L::SCR_OFF) + wid * 64; LAS float* li_l = wsc; LAS float* al_l = wsc + 32;
    LAS f32x4* wk_l = (LAS f32x4*)(lds + L::WK_OFF);
    LAS f32x2* wkref_l = (LAS f32x2*)(lds + L::WK_OFF + 2048);
    const int wq0 = q0 + __builtin_amdgcn_readfirstlane(wid) * 32;
    bf16x8 qr[ND];
    { const bf16* Qw = P.q + (long)qrow * P.ldq + hi * 8;
#pragma unroll
      for (int d0 = 0; d0 < ND; ++d0) qr[d0] = *(const GAS bf16x8*)(Qw + d0 * 16); }
    if constexpr (MODE == 0) {
#pragma unroll
        for (int dd = 0; dd < 2; ++dd)
#pragma unroll
            for (int j = 0; j < 8; ++j) { const int i = dd * 16 + hi * 8 + j; const float inv = exp2f(-(float)i * (13.287712379549449f / 32.0f)); float sn, cs; fast_sincos((float)qrow * inv, sn, cs);
                const float x1 = bf2f((unsigned short)qr[8 + dd][j]), x2 = bf2f((unsigned short)qr[10 + dd][j]);
                qr[8 + dd][j] = (short)f2bf(x1 * cs - x2 * sn); qr[10 + dd][j] = (short)f2bf(x2 * cs + x1 * sn); }
    }
    float cf_i = 0.f, rb_i = 0.f;
    if constexpr (MODE == 2) { const f32x4 w = *(const GAS f32x4*)(P.ssdp + (size_t)qrow * 32); cf_i = w.x; rb_i = w.z; }
    bf16x8 ks[KCH], vs[VCH]; f32x4 wkreg = {0.f, 0.f, 0.f, 0.f}; float crf = 0.f, rrf = 0.f;
#define MX_SLOAD(kr0) do { \
    _Pragma("unroll") for (int i = 0; i < KCH; ++i) { const int cid = tid + 512 * i, row = cid / CPR, c8 = cid % CPR; \
        const bf16* src = (MODE == 0 && c8 >= 16) ? P.k1 + (long)((kr0) + row) * P.ldk1 + (c8 - 16) * 8 : P.k0 + (long)((kr0) + row) * P.ldk0 + c8 * 8; \
        ks[i] = *(const GAS bf16x8*)src; } \
    _Pragma("unroll") for (int i = 0; i < VCH; ++i) { const int cid = tid + 512 * i, row = cid / VPR, c8 = cid % VPR; \
        if (VCH * 512 == 64 * VPR || cid < 64 * VPR) vs[i] = *(const GAS bf16x8*)(P.v + (long)((kr0) + row) * P.ldv + c8 * 8); } \
    if (MODE == 2) { if (tid < 64) { wkreg = *(const GAS f32x4*)(P.ssdp + (size_t)((kr0) + tid) * 32); crf = P.ssdp[(size_t)((kr0) + 63) * 32]; rrf = P.ssdp[(size_t)(kr0) * 32 + 2]; } } } while (0)
#define MX_SWRITE(b) do { \
    _Pragma("unroll") for (int i = 0; i < KCH; ++i) { const int cid = tid + 512 * i, row = cid / CPR, c8 = cid % CPR; \
        *(LAS bf16x8*)(Kl + (b) * L::BYTES + row * L::PITCH + ((c8 * 16) ^ ((row & 7) << 4))) = ks[i]; } \
    _Pragma("unroll") for (int i = 0; i < VCH; ++i) { const int cid = tid + 512 * i, row = cid / VPR, c8 = cid % VPR; \
        if (VCH * 512 == 64 * VPR || cid < 64 * VPR) *(LAS bf16x8*)(Vl + (b) * V_BYTES + v_st(row, c8 * 8)) = vs[i]; } \
    if (MODE == 2) { if (tid < 64) { wk_l[(b) * 64 + tid] = (f32x4){wkreg.y, wkreg.w, __builtin_amdgcn_exp2f(wkreg.y + crf), __builtin_amdgcn_exp2f(wkreg.w + rrf)}; if (tid == 0) wkref_l[(b)] = (f32x2){crf, rrf}; } } } while (0)
    float bfw0[16], bbw0[16]; float c32f = 1.f, c32b = 1.f;
    if constexpr (MODE == 1) {
#pragma unroll
        for (int r = 0; r < 16; ++r) { const int j0 = crow(r, hi);
            bfw0[r] = __builtin_amdgcn_exp2f((float)(63 - j0) * P.lf); bbw0[r] = __builtin_amdgcn_exp2f((float)j0 * P.lb); }
        c32f = __builtin_amdgcn_exp2f(-32.f * P.lf); c32b = __builtin_amdgcn_exp2f(32.f * P.lb);
    }
    float m_reg = -1e30f, l_reg = 0.f; f32x16 o[NV];
#pragma unroll
    for (int d = 0; d < NV; ++d) o[d] = f32x16{};
    const int vb0 = (int)(uintptr_t)(Vl) + v_rd_base(lane);
    constexpr int NT = SEQ / 64;
    int jlo = 0, jhi = NT - 1;
    if constexpr (MODE == 2) {
        const int l = lane & 31, qt = q0 >> 6;
        const float cfq = P.ssdp[(size_t)q0 * 32 + 0], rbq = P.ssdp[(size_t)(q0 + 255) * 32 + 2];
        const float cfe = P.ssdp[(size_t)(64 * l + 63) * 32 + 0], rbs = P.ssdp[(size_t)(64 * l) * 32 + 2];
        const bool keep = (l < qt) ? (cfq - cfe > -24.f) : ((l > qt + 3) ? (rbq - rbs > -24.f) : true);
        const unsigned m32 = (unsigned)__ballot(keep);
        jlo = __builtin_amdgcn_readfirstlane(__builtin_ctz(m32)); jhi = __builtin_amdgcn_readfirstlane(31 - __builtin_clz(m32));
    } else if constexpr (MODE == 1) {
        const float dmf = 24.f / (-P.lf), dmb = 24.f / (-P.lb);
        int a = (int)floorf(((float)(q0 - 63) - dmf) * (1.f / 64.f)) + 1; int b = (int)ceilf(((float)(q0 + 255) + dmb) * (1.f / 64.f)) - 1;
        jlo = a < 0 ? 0 : a; jhi = b > NT - 1 ? NT - 1 : b;
        jlo = __builtin_amdgcn_readfirstlane(jlo); jhi = __builtin_amdgcn_readfirstlane(jhi);
    }
    MX_SLOAD(jlo * 64); VM_WAIT(); MX_SWRITE(0); __syncthreads();
    for (int j = jlo; j <= jhi; ++j) {
        const int buf = (j - jlo) & 1; const int kr0 = j * 64;
        if (j < jhi) MX_SLOAD(kr0 + 64);
        f32x16 p0 = f32x16{}, p1 = f32x16{};
        { LAS unsigned char* Kb = Kl + buf * L::BYTES;
#pragma unroll
          for (int dg = 0; dg < ND / 4; ++dg) { bf16x8 kb0[4], kb1[4];
#pragma unroll
              for (int dd = 0; dd < 4; ++dd) { const int cb = ((dg * 4 + dd) * 16 + hi * 8) * 2;
                  kb0[dd] = *(const LAS bf16x8*)(Kb + r32 * L::PITCH + (cb ^ ((r32 & 7) << 4)));
                  kb1[dd] = *(const LAS bf16x8*)(Kb + (32 + r32) * L::PITCH + (cb ^ ((r32 & 7) << 4))); }
              LDS_WAIT(); SBAR();
#pragma unroll
              for (int dd = 0; dd < 4; ++dd) { p0 = __builtin_amdgcn_mfma_f32_32x32x16_bf16(kb0[dd], qr[dg * 4 + dd], p0, 0, 0, 0);
                  p1 = __builtin_amdgcn_mfma_f32_32x32x16_bf16(kb1[dd], qr[dg * 4 + dd], p1, 0, 0, 0); }
              SBAR(); } }
        if constexpr (MODE == 0) {
            float pmax = p0[0];
#pragma unroll
            for (int r = 1; r < 16; ++r) pmax = fmaxf(pmax, p0[r]);
#pragma unroll
            for (int r = 0; r < 16; ++r) pmax = fmaxf(pmax, p1[r]);
            { auto rr = __builtin_amdgcn_permlane32_swap(__float_as_uint(pmax), __float_as_uint(pmax), false, false); pmax = fmaxf(__uint_as_float(rr[0]), __uint_as_float(rr[1])); }
            float mn, alpha;
            if (__all(pmax - m_reg <= THR / SCALE)) { mn = m_reg; alpha = 1.f; }
            else { mn = fmaxf(m_reg, pmax); alpha = __builtin_amdgcn_exp2f((m_reg - mn) * C); m_reg = mn; }
            const float mnC = -mn * C;
#pragma unroll
            for (int r = 0; r < 16; ++r) { p0[r] = __builtin_amdgcn_exp2f(fmaf(p0[r], C, mnC)); p1[r] = __builtin_amdgcn_exp2f(fmaf(p1[r], C, mnC)); }
            if (__any(alpha < 1.f)) { if (hi == 0) al_l[r32] = alpha; LDS_WAIT();
#pragma unroll
                for (int r = 0; r < 16; ++r) { const float av = al_l[crow(r, hi)];
#pragma unroll
                    for (int d = 0; d < NV; ++d) o[d][r] *= av; } }
            float ps = 0.f;
#pragma unroll
            for (int r = 0; r < 16; ++r) ps += p0[r] + p1[r];
            { auto rr = __builtin_amdgcn_permlane32_swap(__float_as_uint(ps), __float_as_uint(ps), false, false); ps = __uint_as_float(rr[0]) + __uint_as_float(rr[1]); }
            l_reg = l_reg * alpha + ps;
        } else if constexpr (MODE == 1) {
            if (kr0 + 63 <= wq0) {
                const float ai = __builtin_amdgcn_exp2f((float)(qrow - kr0 - 63) * P.lf);
                const float ai1 = ai * c32f;
#pragma unroll
                for (int r = 0; r < 16; ++r) { p0[r] *= ai * bfw0[r]; p1[r] *= ai1 * bfw0[r]; }
            } else if (kr0 > wq0 + 31) {
                const float ai = __builtin_amdgcn_exp2f((float)(kr0 - qrow) * P.lb);
                const float ai1 = ai * c32b;
#pragma unroll
                for (int r = 0; r < 16; ++r) { p0[r] *= ai * bbw0[r]; p1[r] *= ai1 * bbw0[r]; }
            } else {
#pragma unroll
                for (int r = 0; r < 16; ++r) { const int k0 = kr0 + crow(r, hi), k1 = k0 + 32;
                    const float e0 = (k0 <= qrow) ? (float)(qrow - k0) * P.lf : (float)(k0 - qrow) * P.lb;
                    const float e1 = (k1 <= qrow) ? (float)(qrow - k1) * P.lf : (float)(k1 - qrow) * P.lb;
                    p0[r] *= __builtin_amdgcn_exp2f(e0); p1[r] *= __builtin_amdgcn_exp2f(e1); }
            }
        } else {
            if (kr0 + 63 <= wq0) {
                const float ai = __builtin_amdgcn_exp2f(cf_i - wkref_l[buf].x);
#pragma unroll
                for (int r = 0; r < 16; ++r) { const int kk = crow(r, hi); p0[r] *= ai * wk_l[buf * 64 + kk].z; p1[r] *= ai * wk_l[buf * 64 + 32 + kk].z; }
            } else if (kr0 > wq0 + 31) {
                const float ai = __builtin_amdgcn_exp2f(rb_i - wkref_l[buf].y);
#pragma unroll
                for (int r = 0; r < 16; ++r) { const int kk = crow(r, hi); p0[r] *= ai * wk_l[buf * 64 + kk].w; p1[r] *= ai * wk_l[buf * 64 + 32 + kk].w; }
            } else {
#pragma unroll
                for (int r = 0; r < 16; ++r) { const int kk = crow(r, hi); const f32x4 w0 = wk_l[buf * 64 + kk], w1 = wk_l[buf * 64 + 32 + kk];
                    const int k0 = kr0 + kk, k1 = k0 + 32;
                    const float e0 = (k0 <= qrow) ? cf_i + w0.x : rb_i + w0.y;
                    const float e1 = (k1 <= qrow) ? cf_i + w1.x : rb_i + w1.y;
                    p0[r] *= __builtin_amdgcn_exp2f(e0); p1[r] *= __builtin_amdgcn_exp2f(e1); }
            }
        }
        bf16x8 pa0, pa1, pa2, pa3;
#define MX_PK4(PP, BASE, OUT) do { const unsigned a0 = cvtpk(PP[BASE + 0], PP[BASE + 1]), a1 = cvtpk(PP[BASE + 2], PP[BASE + 3]); \
    const unsigned b0 = cvtpk(PP[BASE + 4], PP[BASE + 5]), b1 = cvtpk(PP[BASE + 6], PP[BASE + 7]); \
    auto r0 = __builtin_amdgcn_permlane32_swap(a0, b0, false, false); auto r1 = __builtin_amdgcn_permlane32_swap(a1, b1, false, false); \
    v4u w = {r0[0], r1[0], r0[1], r1[1]}; OUT = __builtin_bit_cast(bf16x8, w); } while (0)
        MX_PK4(p0, 0, pa0); MX_PK4(p0, 8, pa1); MX_PK4(p1, 0, pa2); MX_PK4(p1, 8, pa3);
#undef MX_PK4
        { const int vb = vb0 + buf * V_BYTES;
          pv_one<0>(o[0], vb, pa0, pa1, pa2, pa3); pv_one<1>(o[1], vb, pa0, pa1, pa2, pa3);
          if constexpr (NV == 4) { pv_one<2>(o[2], vb, pa0, pa1, pa2, pa3); pv_one<3>(o[3], vb, pa0, pa1, pa2, pa3); } }
        if (j < jhi) { VM_WAIT(); MX_SWRITE(buf ^ 1); }
        __syncthreads();
    }
#undef MX_SLOAD
#undef MX_SWRITE
    const int orow0 = q0 + wid * 32;
    if constexpr (MODE == 0) {
        if (hi == 0) li_l[r32] = l_reg; LDS_WAIT();
#pragma unroll
        for (int r = 0; r < 16; ++r) { const int rr = crow(r, hi); const float rl = __builtin_amdgcn_rcpf(li_l[rr]);
#pragma unroll
            for (int d0 = 0; d0 < NV; ++d0) P.o[(long)(orow0 + rr) * P.ldo + d0 * 32 + r32] = (bf16)f2bf(o[d0][r] * rl); }
    } else if constexpr (MODE == 1) {
#pragma unroll
        for (int r = 0; r < 16; ++r) { const int rr = crow(r, hi);
            float s = 0.f;
#pragma unroll
            for (int d0 = 0; d0 < NV; ++d0) s += o[d0][r];
            s = half_sum(s);
            const float mean = s * (1.f / 128.f); float qv = 0.f;
#pragma unroll
            for (int d0 = 0; d0 < NV; ++d0) { const float dlt = o[d0][r] - mean; qv += dlt * dlt; }
            qv = half_sum(qv);
            const float rs = 1.0f / sqrtf(qv * (1.f / 128.f) + 1e-6f);
#pragma unroll
            for (int d0 = 0; d0 < NV; ++d0) { const float gt = bf2f(P.aux[(long)(orow0 + rr) * P.ldaux + d0 * 32 + r32]);
                P.o[(long)(orow0 + rr) * P.ldo + d0 * 32 + r32] = (bf16)f2bf(ZERO_B ? 0.f : (o[d0][r] - mean) * rs * silu(gt)); } }
    } else {
#pragma unroll
        for (int r = 0; r < 16; ++r) { const int rr = crow(r, hi);
#pragma unroll
            for (int d0 = 0; d0 < NV; ++d0) { const float xv = bf2f(P.aux[(long)(orow0 + rr) * P.ldaux + d0 * 32 + r32]);
                P.o[(long)(orow0 + rr) * P.ldo + d0 * 32 + r32] = (bf16)f2bf(o[d0][r] + xv * P.dh); } }
    }
    __syncthreads();
}
#undef SBAR
}

namespace hyb {
constexpr int U_PITCH = 4112, U_BYTES = 16 * U_PITCH, FC_OFF = U_BYTES, FC_PITCH = 8256;
typedef float f32x4v __attribute__((ext_vector_type(4)));
__device__ __forceinline__ void hyena_unit(const AP& a, int layer, int c, unsigned char* ws, LAS unsigned char* lds, int tid) {
    asm volatile("" : "+v"(tid));
    const int wid = tid >> 6, lane = tid & 63, fr = lane & 15, fq = lane >> 4;
    const bf16* UT = (const bf16*)(ws + WS_UT); bf16* ZT = (bf16*)(ws + WS_ZT);
    LAS unsigned char* Ul = lds; LAS unsigned char* FC = lds + FC_OFF;
    const int ksh = (3 - fr) & 3;
    for (int o = 0; o < 2; ++o) {
        const bf16* G = (const bf16*)(ws + WS_HYG) + (((size_t)layer * 2 + o) * 512 + c) * HY_GLEN;
        for (int id = tid; id < HY_GLEN / 8; id += 512) *(LAS v4u*)(FC + id * 16) = *(const GAS v4u*)(G + id * 8);
        if (o == 0) {
#pragma unroll
            for (int i = 0; i < 8; ++i) { const int id = tid + 512 * i, b = id >> 8, t8 = id & 255;
                *(LAS v4u*)(Ul + b * U_PITCH + t8 * 16) = *(const GAS v4u*)(UT + ((size_t)c * NB + b) * SEQ + t8 * 8); } }
        __syncthreads();
        for (int idx = tid; idx < 4104; idx += 512) { const LAS bf16* g0 = (const LAS bf16*)FC + idx;
#pragma unroll
            for (int k = 1; k < 4; ++k) *(LAS bf16*)(FC + k * FC_PITCH + idx * 2) = g0[k]; }
        const bf16* X = UT + (((size_t)(1 + o) * 512 + c) * NB + fr) * SEQ;
        v2u xg[16];
#pragma unroll
        for (int al = 0; al < 16; ++al) xg[al] = *(const GAS v2u*)(X + 16 * (16 * wid + al) + 4 * fq);
        __syncthreads();
        f32x4v acc[16];
#pragma unroll
        for (int i = 0; i < 16; ++i) acc[i] = (f32x4v){0.f, 0.f, 0.f, 0.f};
        for (int kb = 0; kb < 8; ++kb) {
            bf16x8 bfr[8];
#pragma unroll
            for (int kl = 0; kl < 8; ++kl) bfr[kl] = *(const LAS bf16x8*)(Ul + fr * U_PITCH + ((kb * 8 + kl) * 32 + fq * 8) * 2);
            const int n0 = HY_OFF - 16 * (16 * wid - 16 * kb + 15) - fr + 8 * fq;
            const LAS unsigned char* ab = FC + ksh * FC_PITCH + (n0 - ksh) * 2;
#pragma unroll
            for (int hb = 0; hb < 2; ++hb) {
                v2u alo[15], ahi[15];
#pragma unroll
                for (int d = 0; d < 15; ++d) { alo[d] = *(const LAS v2u*)(ab + (29 - (hb * 15 + d)) * 32); ahi[d] = *(const LAS v2u*)(ab + (29 - (hb * 15 + d)) * 32 + 8); }
                LDS_WAIT(); __builtin_amdgcn_sched_barrier(0);
#pragma unroll
                for (int d = 0; d < 15; ++d) { const int ddrel = hb * 15 + d - 14;
                    const v4u w = {alo[d].x, alo[d].y, ahi[d].x, ahi[d].y}; const bf16x8 af = __builtin_bit_cast(bf16x8, w);
#pragma unroll
                    for (int kl = 0; kl < 8; ++kl) { const int al = ddrel + 2 * kl; if (al >= 0 && al < 16) acc[al] = __builtin_amdgcn_mfma_f32_16x16x32_bf16(af, bfr[kl], acc[al], 0, 0, 0); }
                }
                __builtin_amdgcn_sched_barrier(0);
            }
        }
        __syncthreads();
        const float bias = a.in(I_HYBIAS)[(layer * 2 + o) * 512 + c];
#pragma unroll
        for (int al = 0; al < 16; ++al) { const int t = 16 * (16 * wid + al) + 4 * fq;
            const v2u uu = *(const LAS v2u*)(Ul + fr * U_PITCH + t * 2); const v2u xx = xg[al];
            const float r0 = bflo(xx.x) * (acc[al][0] + bflo(uu.x) * bias), r1 = bfhi(xx.x) * (acc[al][1] + bfhi(uu.x) * bias);
            const float r2 = bflo(xx.y) * (acc[al][2] + bflo(uu.y) * bias), r3 = bfhi(xx.y) * (acc[al][3] + bfhi(uu.y) * bias);
            v2u z; z.x = pk2(r0, r1); z.y = pk2(r2, r3);
            if (o == 0) *(LAS v2u*)(Ul + fr * U_PITCH + t * 2) = z;
            else *(GAS v2u*)(ZT + ((size_t)c * NB + fr) * SEQ + t) = z; }
        __syncthreads();
    }
}
}

constexpr int N_PHASES = 26;
#ifndef MK_CUTS
#define MK_CUTS 0
#endif
#ifndef MIXSKIP
#define MIXSKIP 0
#endif
#ifndef MOE_CHECK
#define MOE_CHECK 0
#endif
#ifndef ONLYKIND
#define ONLYKIND -1
#endif
#define KSEL(kind) (ONLYKIND < 0 || ONLYKIND == (kind))
#define IN(k) (LO <= (k) && (k) < HI)
#define INK(k, kind) (KSEL(kind) && LO <= (k) && (k) < HI)
struct Ids { int wave0, G0, bx0, vcu0; };
#define PH_LOCALS int wave = ids.wave0, G = ids.G0, bx = ids.bx0, vcu = ids.vcu0; asm volatile("" : "+s"(wave), "+s"(G), "+s"(bx), "+s"(vcu)); \
    int tid; asm volatile("v_mbcnt_lo_u32_b32 %0, -1, 0\n\tv_mbcnt_hi_u32_b32 %0, -1, %0" : "=v"(tid)); tid += wave * 64; \
    const int lane = tid & 63, gw = wave * G + vcu, NGW = G * NWAVES; LAS float* wscr = (LAS float*)(lds + RING_OFF + wave * 16384); (void)lane; (void)gw; (void)NGW; (void)wscr; (void)bx; \
    const AP args = kargs(); unsigned char* ws = args.ws(); float* XRES = args.out(); bf16* XB = (bf16*)(ws + WS_XB); gu32* ctl = (gu32*)(ws + WS_CTL); (void)XRES; (void)XB; (void)ctl;
#ifndef PROBE_SCALE
#define PROBE_SCALE 0.0025f
#endif
#ifndef TIMING_PROBE
#define TIMING_PROBE 0
#endif
#ifndef PROBE_A0
#define PROBE_A0 0
#define PROBE_A1 1
#define PROBE_B0 1
#define PROBE_B1 2
#endif
#if TIMING_PROBE
#define STAMP(idx) do { if (ids.bx0 == 0 && threadIdx.x == 0) ((volatile LAS unsigned*)(lds + MISC_OFF))[16 + (idx)] = (unsigned)wall_clock64(); } while (0)
#else
#define STAMP(idx) do { } while (0)
#endif
#define SEAM(k) do { if constexpr (IN(k) && IN((k) + 1)) { XcdBarrier bb_ = bar; asm volatile("" : "+s"(bb_.bar), "+s"(bb_.x)); xcd_barrier(bb_); } STAMP((k) + 1); } while (0)

template <int LAYER, int LO, int HI>
__device__ __forceinline__ void layer_phases(LAS unsigned char* lds, const XcdBarrier& bar, const Ids& ids) {
    constexpr int layer = LAYER, pb = 1 + LAYER * 10;
    if constexpr (INK(pb + 0, 1)) { PH_LOCALS
        pg8::Gemm g{XB, (const bf16*)(ws + WS_WIN + layer * SZ_WIN), M, NINP, DM}; pg8::StaticOrder S; S.init(M, NINP, G, bx);
        pg8::EpiBf16 E{(bf16*)(ws + WS_PROJ), NINP, (float*)(ws + WS_DTF), C_DT};
        pg8::gemm_phase<pg8::EpiBf16, pg8::StaticOrder, true, true>(lds + RING_OFF, g, S, E, tid);
    }
    SEAM(pb + 0);
    if constexpr (INK(pb + 1, 2)) { PH_LOCALS
        LAS float* cwl = (LAS float*)(lds + RING_OFF);
        for (int i = tid; i < 6 * 1024; i += NWAVES * 64) cwl[i] = i < 5 * 1024 ? args.in(I_CONVW)[layer * 5 * 1024 + i] : args.in(I_CONVB)[layer * 1024 + i - 5 * 1024];
        __syncthreads();
        LAS float* pscr = (LAS float*)(lds + RING_OFF + 32768 + wave * 12288);
        for (int it = gw; it < M / 8; it += NGW) prep_rows8(args, layer, it, lane, ws, cwl);
        for (int it = gw; it < 256; it += NGW) prep_scan(args, layer, it, lane, ws, pscr);
        for (int it = gw; it < NB * 32 * 24; it += NGW) prep_hyconv(args, layer, it, lane, ws, (LAS bf16*)pscr);
        __syncthreads();
    }
    SEAM(pb + 1);
    if constexpr (INK(pb + 2, 3)) {
        { PH_LOCALS pg8::Gemm g{(const bf16*)(ws + WS_QN), (const bf16*)(ws + WS_WUQ + layer * SZ_WUQ), M, 768, 384}; pg8::StaticOrder S; S.init(M, 768, G, bx);
          pg8::EpiBf16 E{(bf16*)(ws + WS_QB), 768, nullptr, 0};
          pg8::gemm_phase<pg8::EpiBf16, pg8::StaticOrder, true, true>(lds + RING_OFF, g, S, E, tid); }
        { PH_LOCALS pg8::Gemm g{(const bf16*)(ws + WS_KVN), (const bf16*)(ws + WS_WUKV + layer * SZ_WUKV), M, 1024, 256}; pg8::StaticOrder S; S.init(M, 1024, G, bx);
          pg8::EpiBf16 E{(bf16*)(ws + WS_KVB), 1024, nullptr, 0};
          pg8::gemm_phase<pg8::EpiBf16, pg8::StaticOrder, true, true>(lds + RING_OFF, g, S, E, tid); }
    }
    SEAM(pb + 2);
    if constexpr (IN(pb + 3)) {
        if constexpr (KSEL(40)) { PH_LOCALS for (int u = vcu; u < NB * 4 * 8; u += G) { const int b = u >> 5, h = (u >> 3) & 3, qb = u & 7; const size_t r0 = (size_t)b * SEQ;
            mixb::MixP P{}; P.q = (const bf16*)(ws + WS_QB) + r0 * 768 + h * 192; P.ldq = 768; P.k0 = (const bf16*)(ws + WS_KVB) + r0 * 1024 + h * 256; P.ldk0 = 1024;
            P.k1 = (const bf16*)(ws + WS_KPE) + r0 * 64; P.ldk1 = 64; P.v = (const bf16*)(ws + WS_KVB) + r0 * 1024 + h * 256 + 128; P.ldv = 1024;
            P.o = (bf16*)(ws + WS_ATT) + r0 * 512 + h * 128; P.ldo = 512;
            mixb::mix_unit<0, 192, 128>(P, qb * 256, lds + RING_OFF, tid); } }
        STAMP(32 + LAYER * 4 + 0);
        if constexpr (KSEL(41)) { PH_LOCALS for (int u = vcu; u < NB * 4 * 8; u += G) { const int rnd = u / G; const int b = u >> 5, h0 = (u >> 3) & 3, h = (rnd & 1) ? 3 - h0 : h0, qb = u & 7; const size_t r0 = (size_t)b * SEQ;
            mixb::MixP P{}; P.q = (const bf16*)(ws + WS_RQ) + r0 * 256 + h * 64; P.ldq = 256; P.k0 = (const bf16*)(ws + WS_RK) + r0 * 256 + h * 64; P.ldk0 = 256; P.k1 = P.k0; P.ldk1 = 256;
            P.v = (const bf16*)(ws + WS_PROJ) + r0 * NINP + C_RV + h * 128; P.ldv = NINP; P.aux = (const bf16*)(ws + WS_PROJ) + r0 * NINP + C_RG + h * 128; P.ldaux = NINP;
            P.o = (bf16*)(ws + WS_MIX) + r0 * DM + 512 + h * 128; P.ldo = DM;
            P.lf = log2f(1.0f - exp2f(-5.0f - (float)h)); P.lb = log2f(1.0f - exp2f(-5.5f - (float)h));
            mixb::mix_unit<1, 64, 128>(P, qb * 256, lds + RING_OFF, tid); } }
        STAMP(32 + LAYER * 4 + 1);
        if constexpr (KSEL(42)) { PH_LOCALS for (int u = vcu; u < NB * 8 * 8; u += G) { const int rnd = u / G; const int b = u >> 6, hh = (((u >> 3) & 7) + 2 * rnd) & 7, qb = u & 7, gq = hh >> 2; const size_t r0 = (size_t)b * SEQ;
            mixb::MixP P{}; const bf16* XBC = (const bf16*)(ws + WS_XBC) + r0 * 1024;
            P.q = XBC + 768 + gq * 128; P.ldq = 1024; P.k0 = XBC + 512 + gq * 128; P.ldk0 = 1024; P.k1 = P.k0; P.ldk1 = 1024; P.v = XBC + hh * 64; P.ldv = 1024; P.aux = P.v; P.ldaux = 1024;
            P.ssdp = (const float*)(ws + WS_SSDP) + r0 * 32 + hh * 4; P.dh = args.in(I_SSDD)[layer * 8 + hh];
            P.o = (bf16*)(ws + WS_YC) + r0 * 512 + hh * 64; P.ldo = 512;
            mixb::mix_unit<2, 128, 64>(P, qb * 256, lds + RING_OFF, tid); } }
        STAMP(32 + LAYER * 4 + 2);
        if constexpr (KSEL(43)) { PH_LOCALS for (int u = vcu; u < 512; u += G) hyb::hyena_unit(args, layer, u, ws, lds + RING_OFF, tid); }
        STAMP(32 + LAYER * 4 + 3);
    }
    SEAM(pb + 3);
    if constexpr (INK(pb + 4, 5)) { PH_LOCALS
        for (int m = gw; m < M; m += NGW) post_row(args, layer, m, lane, ws);
        for (int it = gw; it < NB * 128; it += NGW) post_hy(args, layer, it, lane, ws, (LAS bf16*)wscr);
    }
    SEAM(pb + 4);
    if constexpr (INK(pb + 5, 6)) { PH_LOCALS
        pg8::Gemm g{(const bf16*)(ws + WS_MIX), (const bf16*)(ws + WS_WOUT + layer * SZ_WOUT), M, DM, DM}; pg8::StaticOrder S; S.init(M, DM, G, bx);
        pg8::EpiResF32 E{LAYER == 0 ? args.in(I_X) : (const float*)XRES, XRES, DM, ALPHA, 1.f};
        pg8::gemm_phase<pg8::EpiResF32, pg8::StaticOrder, true, true>(lds + RING_OFF, g, S, E, tid);
    }
    SEAM(pb + 5);
    if constexpr (INK(pb + 6, 7)) { PH_LOCALS
        const float* gG = args.in(I_LN1G) + layer * DM; const float* gB = args.in(I_LN1B) + layer * DM;
        if constexpr (LAYER == 1) {
            LAS float* WrT = (LAS float*)(lds + RING_OFF);
            for (int i = tid; i < DM * NEXP; i += NWAVES * 64) WrT[(i & 7) * DM + (i >> 3)] = args.in(I_ROUTER)[i];
            for (int i = bx * NWAVES * 64 + tid; i < CAP_ROWS; i += G * NWAVES * 64) ((int*)(ws + WS_SLOT))[i] = -1;
            LAS unsigned* lcnt = (LAS unsigned*)(lds + RING_OFF + 65536); LAS unsigned* lbase = lcnt + 8; LAS int* lrec = (LAS int*)(lcnt + 16);
            if (tid < 16) lcnt[tid] = 0u;
            __syncthreads();
            int nrow = 0;
            f32x4 nv[8]; if (gw < M) ln_load(XRES + (size_t)gw * DM, lane, nv);
            for (int m = gw; m < M; m += NGW) { f32x4 v[8];
#pragma unroll
                for (int j = 0; j < 8; ++j) v[j] = nv[j];
                if (m + NGW < M) ln_load(XRES + (size_t)(m + NGW) * DM, lane, nv);
                ln_row(XRES + (size_t)m * DM, XB + (size_t)m * DM, gG, gB, lane, v, nullptr, nullptr, XRES + (size_t)m * DM);
                float lg[8];
#pragma unroll
                for (int e = 0; e < 8; ++e) { float s = 0.f;
#pragma unroll
                    for (int j = 0; j < 8; ++j) { const f32x4 w = *((const LAS f32x4*)(WrT + e * DM) + lane + 64 * j); s += (v[j].x * w.x + v[j].y * w.y) + (v[j].z * w.z + v[j].w * w.w); }
                    lg[e] = wave_sum(s); __builtin_amdgcn_sched_barrier(0); }
                int e0 = 0; float v0 = lg[0];
#pragma unroll
                for (int e = 1; e < 8; ++e) if (lg[e] > v0) { v0 = lg[e]; e0 = e; }
                int e1 = -1; float v1 = -3.0e38f;
#pragma unroll
                for (int e = 0; e < 8; ++e) if (e != e0 && lg[e] > v1) { v1 = lg[e]; e1 = e; }
                if (lane == 0) { const float ex = __expf(v1 - v0); const float g0 = 1.0f / (1.0f + ex), g1 = ex / (1.0f + ex);
                    const int p0 = (int)__hip_atomic_fetch_add(lcnt + e0, 1u, __ATOMIC_RELAXED, __HIP_MEMORY_SCOPE_WORKGROUP), p1 = (int)__hip_atomic_fetch_add(lcnt + e1, 1u, __ATOMIC_RELAXED, __HIP_MEMORY_SCOPE_WORKGROUP);
                    LAS int* rec = lrec + (wave * 64 + nrow) * 4; rec[0] = e0; rec[1] = e1; rec[2] = p0; rec[3] = p1;
                    float* rg = (float*)(ws + WS_RTG) + (size_t)m * 2; rg[0] = g0; rg[1] = g1; }
                ++nrow; }
            __syncthreads();
            if (tid < NEXP) lbase[tid] = atomicAdd((unsigned*)(ctl + CW_CNT + tid), lcnt[tid]);
            __syncthreads();
            { int r = 0; for (int m = gw; m < M; m += NGW, ++r) if (lane == 0) { const LAS int* rec = lrec + (wave * 64 + r) * 4; const int e0 = rec[0], e1 = rec[1];
                int* rt = (int*)(ws + WS_RT) + (size_t)m * 4; rt[0] = e0; rt[1] = e1; rt[2] = rec[2] + (int)lbase[e0]; rt[3] = rec[3] + (int)lbase[e1]; } }
            __syncthreads();
        } else {
            f32x4 nv[8]; if (gw < M) ln_load(XRES + (size_t)gw * DM, lane, nv);
            for (int m = gw; m < M; m += NGW) { f32x4 v[8];
#pragma unroll
                for (int j = 0; j < 8; ++j) v[j] = nv[j];
                if (m + NGW < M) ln_load(XRES + (size_t)(m + NGW) * DM, lane, nv);
                ln_row(XRES + (size_t)m * DM, XB + (size_t)m * DM, gG, gB, lane, v, nullptr, nullptr, XRES + (size_t)m * DM, ws + WS_XF8 + (size_t)m * DM); }
        }
    }
    SEAM(pb + 6);
    if constexpr (LAYER == 0) {
        if constexpr (INK(8, 8)) { PH_LOCALS
            pg8::Gemm g{(const bf16*)(ws + WS_XF8), (const bf16*)(ws + WS_WGU), M, 2 * DFF, DM}; pg8::StaticOrder S; S.init(M, 2 * DFF, G, bx);
            pg8::EpiSwigluF8 E{ws + WS_HID, DFF};
            pg8::gemm_phase_f8<pg8::EpiSwigluF8, pg8::StaticOrder, true, true>(lds + RING_OFF, g, S, E, tid, 0x79797979, 0x7f7f7f7f);
        }
        SEAM(8);
        if constexpr (INK(9, 9)) { PH_LOCALS
            pg8::Gemm g{(const bf16*)(ws + WS_HID), (const bf16*)(ws + WS_WDN), M, DM, DFF}; pg8::StaticOrder S; S.init(M, DM, G, bx);
            pg8::EpiResF32 E{XRES, XRES, DM, ALPHA, ZERO_FFN ? 0.f : 1.f};
            pg8::gemm_phase_f8<pg8::EpiResF32, pg8::StaticOrder, true, true>(lds + RING_OFF, g, S, E, tid, 0x77777777, 0x7f7f7f7f);
        }
        SEAM(9);
        if constexpr (INK(10, 10)) { PH_LOCALS
            const float* gG = args.in(I_LN2G); const float* gB = args.in(I_LN2B);
            f32x4 nv[8]; if (gw < M) ln_load(XRES + (size_t)gw * DM, lane, nv);
            for (int m = gw; m < M; m += NGW) { f32x4 v[8];
#pragma unroll
                for (int j = 0; j < 8; ++j) v[j] = nv[j];
                if (m + NGW < M) ln_load(XRES + (size_t)(m + NGW) * DM, lane, nv);
                ln_row(XRES + (size_t)m * DM, XB + (size_t)m * DM, gG, gB, lane, v, nullptr, nullptr, XRES + (size_t)m * DM); }
        }
        SEAM(10);
    }
}

template <int CH, int LO, int HI>
__device__ __forceinline__ void moe_chunk(LAS unsigned char* lds, const XcdBarrier& bar, const Ids& ids) {
    if constexpr (INK(19 + 2 * CH, 19)) { PH_LOCALS
        pg8::MoeOrder S; int acc = 0;
#pragma unroll
        for (int e = 0; e < 8; ++e) { const int c = (int)__hip_atomic_load(ctl + CW_CNT + e, RLX_AGENT); acc += (c + 255) / 256 * 256; S.pend[e] = acc; }
        const int nrb = acc / 256; const int rb0 = CH * MOE_CH_RB; int nrbc = nrb - rb0; nrbc = nrbc < 0 ? 0 : (nrbc > MOE_CH_RB ? MOE_CH_RB : nrbc);
        pg8::Gemm g{(const bf16*)(ws + WS_XS + (size_t)rb0 * 256 * DM), (const bf16*)(ws + WS_MGU), nrbc * 256, 2 * DFFE, DM};
        S.so.init(nrbc * 256, 2 * DFFE, G, bx); S.rb0 = rb0; S.bstride = (long)2 * DFFE * DM;
        pg8::EpiSwigluF8 E{ws + WS_HIDS, DFFE};
        pg8::gemm_phase_f8<pg8::EpiSwigluF8, pg8::MoeOrder, true, true>(lds + RING_OFF, g, S, E, tid, 0x79797979, 0x7f7f7f7f);
    }
    SEAM(19 + 2 * CH);
    if constexpr (INK(20 + 2 * CH, 20)) { PH_LOCALS
        pg8::MoeOrder S; int acc = 0;
#pragma unroll
        for (int e = 0; e < 8; ++e) { const int c = (int)__hip_atomic_load(ctl + CW_CNT + e, RLX_AGENT); acc += (c + 255) / 256 * 256; S.pend[e] = acc; }
        const int nrb = acc / 256; const int rb0 = CH * MOE_CH_RB; int nrbc = nrb - rb0; nrbc = nrbc < 0 ? 0 : (nrbc > MOE_CH_RB ? MOE_CH_RB : nrbc);
        pg8::Gemm g{(const bf16*)(ws + WS_HIDS), (const bf16*)(ws + WS_MDN), nrbc * 256, DM, DFFE};
        S.so.init(nrbc * 256, DM, G, bx); S.rb0 = rb0; S.bstride = (long)DM * DFFE;
        pg8::EpiMoeDown E{(bf16*)(ws + WS_Y0), (long)((WS_Y1 - WS_Y0) / 2), DM, (const int*)(ws + WS_SLOT), (const float*)(ws + WS_SLOTG), rb0 * 256};
        pg8::gemm_phase_f8<pg8::EpiMoeDown, pg8::MoeOrder, true, true>(lds + RING_OFF, g, S, E, tid, 0x77777777, 0x7f7f7f7f);
    }
    SEAM(20 + 2 * CH);
}

template <int LO, int HI>
__global__ void __launch_bounds__(NWAVES * 64, 2) mk_fwd(Args args_unused, int li) {
    extern __shared__ __attribute__((aligned(16))) unsigned char lds_raw[];
    LAS unsigned char* lds = (LAS unsigned char*)lds_raw;
    volatile LAS unsigned* MISC = (volatile LAS unsigned*)(lds + MISC_OFF);
    Ids ids; { const int tid0 = threadIdx.x; ids.wave0 = __builtin_amdgcn_readfirstlane(tid0 >> 6); ids.G0 = gridDim.x; ids.bx0 = blockIdx.x;
        ids.vcu0 = (ids.G0 % 8 == 0) ? (ids.bx0 % 8) * (ids.G0 / 8) + ids.bx0 / 8 : ids.bx0;
        for (int u = tid0; u < (LDS_BYTES - LDSCTL_OFF) / 4; u += NWAVES * 64) ((LAS unsigned*)(lds + LDSCTL_OFF))[u] = 0u; }
    __syncthreads();
    XcdBarrier bar; bar.bar = nullptr; bar.x = 0; bar.st = nullptr;
    if constexpr (HI - LO > 1) { const AP a0 = kargs(); bar = xcd_barrier_post((unsigned*)((gu32*)(a0.ws() + WS_CTL) + CW_BAR) + li * XCD_BAR_WORDS, MISC + 8); }

    STAMP(0);
    if constexpr (INK(0, 0)) { PH_LOCALS
        constexpr int I_WIN_ = 32 * (NINP / 32), I_UQ = 6 * 24, I_UKV = 4 * 32, I_OUT = 32 * 64, I_GU = 32 * (DFF / 32), I_DN = (DFF / 64) * 64;
        constexpr int NIT = 2 * I_WIN_ + 2 * I_UQ + 2 * I_UKV + 2 * I_OUT + 2 * I_GU + I_DN;
        for (int it = gw; it < NIT; it += NGW) { int r = it;
#define TRJ(n, W, K, N, NP, WT, GR, GS, OFF) if (r < (n)) { transpose_item((W), (K), (N), (NP) / 32, (bf16*)(WT), (GR), (GS), (OFF), wscr, r, lane); continue; } r -= (n);
            TRJ(I_WIN_, args.in(I_WIN), DM, NIN, NINP, ws + WS_WIN, 1 << 30, 0, 0)
            TRJ(I_WIN_, args.in(I_WIN) + (size_t)DM * NIN, DM, NIN, NINP, ws + WS_WIN + SZ_WIN, 1 << 30, 0, 0)
            TRJ(I_UQ, args.in(I_WUQ), 384, 768, 768, ws + WS_WUQ, 1 << 30, 0, 0)
            TRJ(I_UQ, args.in(I_WUQ) + 384 * 768, 384, 768, 768, ws + WS_WUQ + SZ_WUQ, 1 << 30, 0, 0)
            TRJ(I_UKV, args.in(I_WUKV), 256, 1024, 1024, ws + WS_WUKV, 1 << 30, 0, 0)
            TRJ(I_UKV, args.in(I_WUKV) + 256 * 1024, 256, 1024, 1024, ws + WS_WUKV + SZ_WUKV, 1 << 30, 0, 0)
            TRJ(I_OUT, args.in(I_WOUT), DM, DM, DM, ws + WS_WOUT, 1 << 30, 0, 0)
            TRJ(I_OUT, args.in(I_WOUT) + (size_t)DM * DM, DM, DM, DM, ws + WS_WOUT + SZ_WOUT, 1 << 30, 0, 0)
            if (r < I_GU) { transpose_item_f8(args.in(I_FFG), DM, DFF, DFF / 32, ws + WS_WGU, 128, 256, 0, 64.0f, wscr, r, lane); continue; } r -= I_GU;
            if (r < I_GU) { transpose_item_f8(args.in(I_FFU), DM, DFF, DFF / 32, ws + WS_WGU, 128, 256, 128, 64.0f, wscr, r, lane); continue; } r -= I_GU;
            transpose_item_f8(args.in(I_FFD), DFF, DM, DM / 32, ws + WS_WDN, 1 << 30, 0, 0, 256.0f, wscr, r, lane);
#undef TRJ
        }
        for (int m = gw; m < M; m += NGW) { const GAS f32x4* xr = (const GAS f32x4*)(args.in(I_X) + (size_t)m * DM) + lane; GAS v2u* xb = (GAS v2u*)(XB + (size_t)m * DM) + lane;
#pragma unroll
            for (int j = 0; j < 8; ++j) { const f32x4 v = xr[64 * j]; v2u w; w.x = pk2(v.x, v.y); w.y = pk2(v.z, v.w); xb[64 * j] = w; } }
        for (int it = gw; it < 2 * SEQ; it += NGW) hyena_filter_item(args, it >> 11, it & (SEQ - 1), (bf16*)(ws + WS_HYG), wscr, lane);
    }
    SEAM(0);
    layer_phases<0, LO, HI>(lds, bar, ids);
    layer_phases<1, LO, HI>(lds, bar, ids);
    if constexpr (INK(18, 18)) { PH_LOCALS
        auto mkjob = [&](int it, TrF8& j, int& r) { const int job = it / 7168, e = job / 3, kind = job - e * 3; r = it - job * 7168;
            if (kind < 2) j = TrF8{args.in(kind == 0 ? I_MOEG : I_MOEU) + (size_t)e * DM * DFFE, DM, DFFE, DFFE / 32, ws + WS_MGU + (size_t)e * 2 * DFFE * DM, 128, 256, kind * 128, 64.0f};
            else j = TrF8{args.in(I_MOED) + (size_t)e * DFFE * DM, DFFE, DM, DM / 32, ws + WS_MDN + (size_t)e * DM * DFFE, 1 << 30, 0, 0, 256.0f}; };
        for (int it = gw; it < 24 * 7168; it += 2 * NGW) { TrF8 ja, jb; int ra, rb; float ta[32], tb[32]; const bool hb = it + NGW < 24 * 7168;
            mkjob(it, ja, ra); tr_f8_load(ja, ra, lane, ta);
            if (hb) { mkjob(it + NGW, jb, rb); tr_f8_load(jb, rb, lane, tb); }
            tr_f8_finish(ja, ra, lane, ta, wscr);
            if (hb) tr_f8_finish(jb, rb, lane, tb, wscr); }
        int pst[8]; { int acc = 0;
#pragma unroll
            for (int e = 0; e < 8; ++e) { pst[e] = acc; const int c = (int)__hip_atomic_load(ctl + CW_CNT + e, RLX_AGENT); acc += (c + 255) / 256 * 256; } }
        for (int it = gw; it < 2 * M; it += NGW) { const int tok = it >> 1, k = it & 1; const int* rt = (const int*)(ws + WS_RT) + (size_t)tok * 4; const int e = rt[k], pos = rt[2 + k];
            int base = 0;
#pragma unroll
            for (int j = 0; j < 8; ++j) base = (e == j) ? pst[j] : base;
            const int slot = base + pos;
            const GAS v4u* src = (const GAS v4u*)(XB + (size_t)tok * DM) + lane; GAS v2u* dst = (GAS v2u*)(ws + WS_XS + (size_t)slot * DM) + lane;
#pragma unroll
            for (int j = 0; j < 4; ++j) { const v4u w = src[64 * j]; v2u o; o.x = pk4_fp8(bflo(w.x), bfhi(w.x), bflo(w.y), bfhi(w.y)); o.y = pk4_fp8(bflo(w.z), bfhi(w.z), bflo(w.w), bfhi(w.w)); dst[64 * j] = o; }
            if (lane == 0) { ((int*)(ws + WS_SLOT))[slot] = tok * 2 + k; ((float*)(ws + WS_SLOTG))[slot] = ((const float*)(ws + WS_RTG))[(size_t)tok * 2 + k]; } }
    }
    SEAM(18);
    moe_chunk<0, LO, HI>(lds, bar, ids);
    SEAM(21); SEAM(22); SEAM(23); SEAM(24);
    if constexpr (INK(25, 25)) { PH_LOCALS
#if MOE_CHECK
        { LAS float* xs = (LAS float*)(lds + RING_OFF); LAS float* hid = xs + DM; LAS float* red = hid + DFFE;
          for (int smp = bx; smp < 48; smp += G) { const int tok = (smp * 683 + 5) % M;
            for (int d = tid; d < DM; d += 512) xs[d] = bf2f(XB[(size_t)tok * DM + d]);
            __syncthreads();
            float accv[4] = {0.f, 0.f, 0.f, 0.f};
            for (int kk = 0; kk < 2; ++kk) { const int e = ((const int*)(ws + WS_RT))[(size_t)tok * 4 + kk]; const float gt = ((const float*)(ws + WS_RTG))[(size_t)tok * 2 + kk];
                const float* Wg = args.in(I_MOEG) + (size_t)e * DM * DFFE; const float* Wu = args.in(I_MOEU) + (size_t)e * DM * DFFE; const float* Wd = args.in(I_MOED) + (size_t)e * DFFE * DM;
                for (int j = tid; j < DFFE; j += 512) { float a = 0.f, b = 0.f; for (int d = 0; d < DM; ++d) { const float xv = xs[d]; a += xv * Wg[(size_t)d * DFFE + j]; b += xv * Wu[(size_t)d * DFFE + j]; } hid[j] = (a / (1.0f + __expf(-a))) * b; }
                __syncthreads();
                for (int q = 0; q < 4; ++q) { const int c = tid + 512 * q; float o = 0.f; for (int j = 0; j < DFFE; ++j) o += hid[j] * Wd[(size_t)j * DM + c]; accv[q] += gt * o; }
                __syncthreads(); }
            float num = 0.f, den = 0.f;
            for (int q = 0; q < 4; ++q) { const int c = tid + 512 * q; const float mine = bf2f(((const bf16*)(ws + WS_Y0))[(size_t)tok * DM + c]) + bf2f(((const bf16*)(ws + WS_Y1))[(size_t)tok * DM + c]); const float df = accv[q] - mine; num += df * df; den += accv[q] * accv[q]; }
            num = wave_sum(num); den = wave_sum(den); if (lane == 0) { red[wave * 2] = num; red[wave * 2 + 1] = den; }
            __syncthreads();
            if (tid == 0) { float n = 0.f, dn = 0.f; for (int w = 0; w < 8; ++w) { n += red[w * 2]; dn += red[w * 2 + 1]; } const float rel = n / (dn + 1e-20f); atomicMax((unsigned*)(ctl + 80), __float_as_uint(rel)); }
            if (wave == 0) { float lg[8]; for (int e = 0; e < 8; ++e) { float s = 0.f; for (int d = lane; d < DM; d += 64) s += xs[d] * args.in(I_ROUTER)[d * 8 + e]; lg[e] = wave_sum(s); }
                int e0 = 0; for (int e = 1; e < 8; ++e) if (lg[e] > lg[e0]) e0 = e; int e1 = -1; for (int e = 0; e < 8; ++e) if (e != e0 && (e1 < 0 || lg[e] > lg[e1])) e1 = e;
                const float ex = __expf(lg[e1] - lg[e0]); const float g0 = 1.f / (1.f + ex);
                const int* rt = (const int*)(ws + WS_RT) + (size_t)tok * 4; const float* rg = (const float*)(ws + WS_RTG) + (size_t)tok * 2;
                const bool bad = (rt[0] != e0) || (rt[1] != e1) || fabsf(rg[0] - g0) > 0.03f || fabsf(rg[0] + rg[1] - 1.f) > 1e-3f;
                if (lane == 0 && bad) atomicAdd((unsigned*)(ctl + 81), 1u); }
            __syncthreads(); } }
        __syncthreads();
        { XcdBarrier bb_ = bar; (void)bb_; }
#endif
        const float* gG = args.in(I_LN2G) + DM; const float* gB = args.in(I_LN2B) + DM;
        f32x4 nv[8]; if (gw < M) ln_load(XRES + (size_t)gw * DM, lane, nv);
        for (int m = gw; m < M; m += NGW) { f32x4 v[8];
#pragma unroll
            for (int j = 0; j < 8; ++j) v[j] = nv[j];
            if (m + NGW < M) ln_load(XRES + (size_t)(m + NGW) * DM, lane, nv);
            ln_row(XRES + (size_t)m * DM, nullptr, gG, gB, lane, v, (const bf16*)(ws + WS_Y0) + (size_t)m * DM, (const bf16*)(ws + WS_Y1) + (size_t)m * DM, XRES + (size_t)m * DM); }
#if TIMING_PROBE
        { XcdBarrier bb_ = bar; asm volatile("" : "+s"(bb_.bar), "+s"(bb_.x)); xcd_barrier(bb_); }
        STAMP(26);
        __syncthreads();
        if (bx == 0) { volatile LAS unsigned* T = (volatile LAS unsigned*)(lds + MISC_OFF) + 16;
            const float t1 = (float)(T[PROBE_A1] - T[PROBE_A0]) * 0.01f, t2 = (float)(T[PROBE_B1] - T[PROBE_B0]) * 0.01f;
            if (tid == 0) XRES[12345] = t1 * PROBE_SCALE + 0.f * t2; }
#endif
#if MOE_CHECK
        __syncthreads(); VM_WAIT();
        if (tid == 0) { __builtin_amdgcn_fence(__ATOMIC_RELEASE, "agent"); const unsigned old_ = atomicAdd((unsigned*)(ctl + 82), 1u); ((volatile LAS unsigned*)(lds + MISC_OFF))[12] = (old_ + 1u == (unsigned)G) ? 1u : 0u; }
        __syncthreads();
        if (((volatile LAS unsigned*)(lds + MISC_OFF))[12]) { __builtin_amdgcn_fence(__ATOMIC_ACQUIRE, "agent");
            const float rel = __uint_as_float(__hip_atomic_load(ctl + 80, RLX_AGENT)); const unsigned nbad = __hip_atomic_load(ctl + 81, RLX_AGENT);
            float code = 0.f; if (rel > 0.03f) code += 10.f; if (rel > 0.3f) code += 10.f; if (nbad > 2u) code += 40.f; if (nbad > 8u) code += 40.f;
            if (code > 0.f) for (size_t i = tid; i < (size_t)M * DM; i += 512) XRES[i] = code; }
#endif
    }
}
#undef IN
#undef INK
#undef SEAM
#undef STAMP

template <int LO, int HI> static void launch_range(int grid, const Args& a, int li, hipStream_t stream) {
    static bool attr = false;
    if (!attr) { if (hipFuncSetAttribute((const void*)mk_fwd<LO, HI>, hipFuncAttributeMaxDynamicSharedMemorySize, LDS_BYTES) != hipSuccess) fprintf(stderr, "kernel_launch: hipFuncSetAttribute failed\n"); attr = true; }
    hipLaunchKernelGGL((mk_fwd<LO, HI>), dim3(grid), dim3(NWAVES * 64), LDS_BYTES, stream, a, li);
}
template <int P> struct PerPhase { static void go(int grid, const Args& a, hipStream_t s) { PerPhase<P - 1>::go(grid, a, s); launch_range<P, P + 1>(grid, a, P, s); } };
template <> struct PerPhase<-1> { static void go(int, const Args&, hipStream_t) {} };

extern "C" void kernel_launch(void* const* d_in, const int* in_sizes, int n_in, void* d_out, int out_size, void* d_ws, size_t ws_size, hipStream_t stream) {
    static int grid = 0;
    if (grid == 0) {
        if (n_in != 35 || out_size != M * DM || ws_size < WS_END) { fprintf(stderr, "kernel_launch: built for 35 inputs, out %d floats, >= %zu bytes of workspace; got n_in %d, out %d, ws %zu; nothing launched\n", M * DM, (size_t)WS_END, n_in, out_size, ws_size); grid = -1; return; }
        int dev = 0, cus = 0;
        if (hipGetDevice(&dev) != hipSuccess || hipDeviceGetAttribute(&cus, hipDeviceAttributeMultiprocessorCount, dev) != hipSuccess) { grid = -1; return; }
        grid = cus;
    }
    if (grid < 0) return;
    if (hipMemsetAsync((char*)d_ws + WS_CTL, 0, CTL_ZERO_BYTES, stream) != hipSuccess) return;
    Args a{};
    for (int i = 0; i < 35; ++i) a.in[i] = (const float*)d_in[i];
    a.out = (float*)d_out; a.ws = (unsigned char*)d_ws; a.ph_lo = 0; a.ph_hi = N_PHASES;
#if MK_CUTS
    PerPhase<N_PHASES - 1>::go(grid, a, stream);
#else
    launch_range<0, N_PHASES>(grid, a, 0, stream);
#endif
    const hipError_t le = hipPeekAtLastError();
    if (le != hipSuccess) fprintf(stderr, "kernel_launch: launch failed: %s\n", hipGetErrorName(le));
}
```

```cpp
#include <hip/hip_runtime.h>
#include <cstdio>
#include <cstdint>
namespace pg8 {
#define PG8_LAS __attribute__((address_space(3)))
typedef unsigned short bf16_t;
typedef short bf16x8 __attribute__((ext_vector_type(8)));
typedef float f32x4 __attribute__((ext_vector_type(4)));
typedef unsigned u32x4 __attribute__((ext_vector_type(4)));
constexpr int BM = 256, BK = 64, HALF = 128, HTB = HALF * BK * 2  , STAGE_BYTES = 8 * HTB, NXCD = 8, WGM = 8;

__host__ __device__ __forceinline__ int lds_byte(int r, int c) { const int st = (r >> 4) * 2 + (c >> 5), rr = r & 15, cc = c & 31, ob = rr * 64 + cc * 2; return st * 1024 + (ob ^ (((ob >> 9) & 1) << 5)); }
__host__ __device__ __forceinline__ void stage_rc(int b, int& R, int& C) { const int st = b / 1024, sb = b % 1024, swz = sb ^ (((sb >> 9) & 1) << 5); R = (st >> 1) * 16 + swz / 64; C = (st & 1) * 32 + (swz % 64) / 2; }
__host__ __device__ __forceinline__ int perm32(int rho) { const int n = rho >> 4, i = rho & 15; return 8 * (i >> 2) + 4 * n + (i & 3); }

struct Unit { int pm, pn; long aoff, boff; int aux; };
struct Gemm { const bf16_t* A; const bf16_t* Bt; int M, N, K; };
__device__ __forceinline__ long rfl64(long v) { const unsigned lo = __builtin_amdgcn_readfirstlane((unsigned)v), hi = __builtin_amdgcn_readfirstlane((unsigned)((unsigned long)v >> 32)); return (long)(((unsigned long)hi << 32) | lo); }
__device__ __forceinline__ void unit_uniform(Unit& u) { u.pm = __builtin_amdgcn_readfirstlane(u.pm); u.pn = __builtin_amdgcn_readfirstlane(u.pn); u.aux = __builtin_amdgcn_readfirstlane(u.aux); u.aoff = rfl64(u.aoff); u.boff = rfl64(u.boff); }

struct StaticOrder {
    int nM, nN, nwg, G, c;
    __host__ __device__ void init(int M, int N, int G_, int c_) { nM = M / BM; nN = N / BM; nwg = nM * nN; G = G_; c = c_; }
    __host__ __device__ bool next(int i, Unit& u) const {
        const long L = (long)i * G + c; if (L >= nwg) return false;
        int wgid = (int)L; { const int q = nwg / NXCD, r = nwg % NXCD, xcd = wgid % NXCD, off = wgid / NXCD; wgid = (xcd < r ? xcd * (q + 1) : r * (q + 1) + (xcd - r) * q) + off; }
        const int nig = WGM * nN, gid = wgid / nig, fm = gid * WGM, gsz = (nM - fm) < WGM ? (nM - fm) : WGM;
        u.pm = fm + ((wgid % nig) % gsz); u.pn = (wgid % nig) / gsz; u.aoff = 0; u.boff = 0; u.aux = 0; return true;
    }
    __device__ __forceinline__ void a_ready(const Unit&) const {}
    __device__ __forceinline__ void done(const Unit&) const {}
};
struct MoeOrder {
    StaticOrder so; int rb0; int pend[8]; long bstride;
    __device__ bool next(int i, Unit& u) const {
        if (!so.next(i, u)) return false;
        const int row = (rb0 + u.pm) * BM; int e = 0;
#pragma unroll
        for (int j = 0; j < 7; ++j) e += (row >= pend[j]) ? 1 : 0;
        u.boff = (long)e * bstride; u.aux = rb0 + u.pm; return true;
    }
    __device__ __forceinline__ void a_ready(const Unit&) const {}
    __device__ __forceinline__ void done(const Unit&) const {}
};

__device__ __forceinline__ unsigned cvt_pk_bf16(float lo, float hi) { unsigned r; asm volatile("v_cvt_pk_bf16_f32 %0, %1, %2" : "=v"(r) : "v"(lo), "v"(hi)); return r; }
__device__ __forceinline__ float silu_f(float v) { return v * __builtin_amdgcn_rcpf(1.0f + __builtin_amdgcn_exp2f(-1.4426950408889634f * v)); }

struct EpiBf16 {
    static constexpr bool PERM = true, AFTER_DRAIN = false;
    bf16_t* O; int ldc; float* F; int fcol0;
    __device__ __forceinline__ void operator()(const f32x4 (&acc)[2][2][4][2], const Unit& u, int wr, int wc, int fr, int fq) const {
        const int row0 = u.pm * BM + wr * 64 + fr; const int col0 = u.pn * BM + wc * 32 + 8 * fq;
#pragma unroll
        for (int ai = 0; ai < 2; ++ai)
#pragma unroll
            for (int m = 0; m < 4; ++m) { bf16_t* rowp = O + (size_t)(row0 + ai * HALF + m * 16) * ldc + col0;
#pragma unroll
                for (int bj = 0; bj < 2; ++bj) { const f32x4 v0 = acc[ai][bj][m][0], v1 = acc[ai][bj][m][1];
                    u32x4 w; w.x = cvt_pk_bf16(v0[0], v0[1]); w.y = cvt_pk_bf16(v0[2], v0[3]); w.z = cvt_pk_bf16(v1[0], v1[1]); w.w = cvt_pk_bf16(v1[2], v1[3]);
                    *(u32x4*)(rowp + bj * HALF) = w;
                    if (F) { const int c = col0 + bj * HALF - fcol0; if (c >= 0 && c < 16) { float* fp = F + (size_t)(row0 + ai * HALF + m * 16) * 16 + c; *(f32x4*)fp = v0; *(f32x4*)(fp + 4) = v1; } }
                } }
    }
};
struct EpiResF32 {
    static constexpr bool PERM = false, AFTER_DRAIN = false;
    const float* Xin; float* X; int ldc; float alpha; float bscale;
    __device__ __forceinline__ void operator()(const f32x4 (&acc)[2][2][4][2], const Unit& u, int wr, int wc, int fr, int fq) const {
        const int row0 = u.pm * BM + wr * 64 + fr, col0 = u.pn * BM + wc * 32 + 4 * fq;
#pragma unroll
        for (int ai = 0; ai < 2; ++ai)
#pragma unroll
            for (int m = 0; m < 4; ++m) { float* rowp = X + (size_t)(row0 + ai * HALF + m * 16) * ldc + col0;
#pragma unroll
                for (int bj = 0; bj < 2; ++bj)
#pragma unroll
                    for (int n = 0; n < 2; ++n) { f32x4* p = (f32x4*)(rowp + bj * HALF + n * 16); const f32x4 x = *(const f32x4*)(Xin + (p - (f32x4*)X) * 4); *p = x * alpha + acc[ai][bj][m][n] * bscale; } }
    }
};
struct EpiSwiglu {
    static constexpr bool PERM = true, AFTER_DRAIN = false;
    bf16_t* H; int ldc;
    __device__ __forceinline__ void operator()(const f32x4 (&acc)[2][2][4][2], const Unit& u, int wr, int wc, int fr, int fq) const {
        const int row0 = u.pm * BM + wr * 64 + fr; const int col0 = u.pn * HALF + wc * 32 + 8 * fq;
#pragma unroll
        for (int ai = 0; ai < 2; ++ai)
#pragma unroll
            for (int m = 0; m < 4; ++m) { bf16_t* rowp = H + (size_t)(row0 + ai * HALF + m * 16) * ldc + col0;
                const f32x4 g0 = acc[ai][0][m][0], g1 = acc[ai][0][m][1], u0 = acc[ai][1][m][0], u1 = acc[ai][1][m][1];
                f32x4 h0, h1;
#pragma unroll
                for (int j = 0; j < 4; ++j) { h0[j] = silu_f(g0[j]) * u0[j]; h1[j] = silu_f(g1[j]) * u1[j]; }
                u32x4 w; w.x = cvt_pk_bf16(h0[0], h0[1]); w.y = cvt_pk_bf16(h0[2], h0[3]); w.z = cvt_pk_bf16(h1[0], h1[1]); w.w = cvt_pk_bf16(h1[2], h1[3]);
                *(u32x4*)rowp = w; }
    }
};
struct EpiSwigluF8 {
    static constexpr bool PERM = true, AFTER_DRAIN = false;
    unsigned char* H; int ldc;
    __device__ __forceinline__ void operator()(const f32x4 (&acc)[2][2][4][2], const Unit& u, int wr, int wc, int fr, int fq) const {
        const int row0 = u.pm * BM + wr * 64 + fr; const int col0 = u.pn * HALF + wc * 32 + 8 * fq;
#pragma unroll
        for (int ai = 0; ai < 2; ++ai)
#pragma unroll
            for (int m = 0; m < 4; ++m) { unsigned char* rowp = H + (size_t)(row0 + ai * HALF + m * 16) * ldc + col0;
                const f32x4 g0 = acc[ai][0][m][0], g1 = acc[ai][0][m][1], u0 = acc[ai][1][m][0], u1 = acc[ai][1][m][1];
                f32x4 h0, h1;
#pragma unroll
                for (int j = 0; j < 4; ++j) { h0[j] = silu_f(g0[j]) * u0[j]; h1[j] = silu_f(g1[j]) * u1[j]; }
                int w0 = 0, w1 = 0;
                w0 = __builtin_amdgcn_cvt_pk_fp8_f32(h0[0], h0[1], w0, false); w0 = __builtin_amdgcn_cvt_pk_fp8_f32(h0[2], h0[3], w0, true);
                w1 = __builtin_amdgcn_cvt_pk_fp8_f32(h1[0], h1[1], w1, false); w1 = __builtin_amdgcn_cvt_pk_fp8_f32(h1[2], h1[3], w1, true);
                typedef int i32x2 __attribute__((ext_vector_type(2))); *(i32x2*)rowp = (i32x2){w0, w1}; __builtin_amdgcn_sched_barrier(0); }
    }
};
struct EpiMoeDown {
    static constexpr bool PERM = true, AFTER_DRAIN = false;
    bf16_t* Y0; long ystride; int ldc; const int* slot_tok2; const float* slot_gate; int rbase;
    __device__ __forceinline__ void operator()(const f32x4 (&acc)[2][2][4][2], const Unit& u, int wr, int wc, int fr, int fq) const {
        const int row0 = rbase + u.pm * BM + wr * 64 + fr; const int col0 = u.pn * BM + wc * 32 + 8 * fq;
#pragma unroll
        for (int ai = 0; ai < 2; ++ai)
#pragma unroll
            for (int m = 0; m < 4; ++m) { const int slot = row0 + ai * HALF + m * 16; const int t2 = slot_tok2[slot]; const float gt = slot_gate[slot];
                if (t2 >= 0) { bf16_t* rowp = Y0 + (size_t)(t2 & 1) * ystride + (size_t)(t2 >> 1) * ldc + col0;
#pragma unroll
                    for (int bj = 0; bj < 2; ++bj) { const f32x4 v0 = acc[ai][bj][m][0] * gt, v1 = acc[ai][bj][m][1] * gt;
                        u32x4 w; w.x = cvt_pk_bf16(v0[0], v0[1]); w.y = cvt_pk_bf16(v0[2], v0[3]); w.z = cvt_pk_bf16(v1[0], v1[1]); w.w = cvt_pk_bf16(v1[2], v1[3]);
                        *(u32x4*)(rowp + bj * HALF) = w; } } __builtin_amdgcn_sched_barrier(0); }
    }
};

template <class Epi, class Sched, bool ALIGN_EPI = false, bool SP2 = false>
__device__ __forceinline__ void gemm_phase(PG8_LAS unsigned char* lds, const Gemm g, const Sched& S, const Epi& E, int tid) {
    asm volatile("" : "+v"(tid));
    const int wid = __builtin_amdgcn_readfirstlane(tid >> 6), lane = tid & 63, wr = wid >> 2, wc = wid & 3, fr = lane & 15, fq = lane >> 4;
    const int K = g.K, nt = K / BK;
    unsigned voffA[2], voffB[2];
#pragma unroll
    for (int i = 0; i < 2; ++i) { int R, C; stage_rc(tid * 16 + i * 8192, R, C); const int Rb = Epi::PERM ? ((R & ~31) + perm32(R & 31)) : R;
        voffA[i] = (unsigned)(R * K + C) * 2u; voffB[i] = (unsigned)(Rb * K + C) * 2u; }
    const size_t kstep = (size_t)(BK * 2);
    const size_t hstep = (size_t)HALF * K * 2;
    const size_t tstep = 2 * hstep;
    const unsigned ldsw = (unsigned)wid * 1024u;
    const int aoff = lds_byte(wr * 64 + fr, fq * 8), boff = lds_byte(wc * 32 + fr, fq * 8);
#define PG8_SA(b, h) (((b) * 2 + (h)) * HTB)
#define PG8_SB(b, h) ((4 + (b) * 2 + (h)) * HTB)
#define PG8_STAGE(bufoff, gbase, voff) do { _Pragma("unroll") for (int _i = 0; _i < 2; ++_i) \
        __builtin_amdgcn_global_load_lds((const unsigned*)((const char*)(gbase) + (voff)[_i]), (PG8_LAS unsigned*)(lds + (bufoff) + ldsw + _i * 8192), 16, 0, 0); } while (0)
#define PG8_LDA(dst, b, h) do { _Pragma("unroll") for (int m = 0; m < 4; ++m) _Pragma("unroll") for (int k = 0; k < 2; ++k) dst[m][k] = *(const PG8_LAS bf16x8*)(lds + PG8_SA(b, h) + aoff + m * 2048 + k * 1024); } while (0)
#define PG8_LDB(dst, b, h) do { _Pragma("unroll") for (int n = 0; n < 2; ++n) _Pragma("unroll") for (int k = 0; k < 2; ++k) dst[n][k] = *(const PG8_LAS bf16x8*)(lds + PG8_SB(b, h) + boff + n * 2048 + k * 1024); } while (0)
#define PG8_MMA(ai, bj, At, Bt) do { __builtin_amdgcn_s_setprio(1); _Pragma("unroll") for (int m = 0; m < 4; ++m) _Pragma("unroll") for (int n = 0; n < 2; ++n) _Pragma("unroll") for (int k = 0; k < 2; ++k) \
        acc[ai][bj][m][n] = __builtin_amdgcn_mfma_f32_16x16x32_bf16(Bt[n][k], At[m][k], acc[ai][bj][m][n], 0, 0, 0); __builtin_amdgcn_s_setprio(0); } while (0)
#define PG8_WAIT_V(n) asm volatile("s_waitcnt vmcnt(" #n ")" ::: "memory")
#define PG8_WAIT_L(n) asm volatile("s_waitcnt lgkmcnt(" #n ")" ::: "memory")
#define PG8_BAR __builtin_amdgcn_s_barrier()
#define PG8_SCHED __builtin_amdgcn_sched_barrier(0)
    Unit cur, nxt; int ui = 0;
    if (!S.next(0, cur)) return;
    f32x4 acc[2][2][4][2];
#pragma unroll
    for (int a = 0; a < 2; ++a)
#pragma unroll
        for (int b = 0; b < 2; ++b)
#pragma unroll
            for (int m = 0; m < 4; ++m)
#pragma unroll
                for (int n = 0; n < 2; ++n) acc[a][b][m][n] = (f32x4){0.f, 0.f, 0.f, 0.f};
    bf16x8 At[4][2], B0[2][2], B1[2][2];
    const char* cA = (const char*)g.A + cur.aoff + (size_t)cur.pm * tstep; const char* cB = (const char*)g.Bt + cur.boff + (size_t)cur.pn * tstep;
    S.a_ready(cur);
    if constexpr (SP2) {
        PG8_STAGE(PG8_SB(0, 0), cB, voffB); PG8_STAGE(PG8_SB(0, 1), cB + hstep, voffB); PG8_STAGE(PG8_SA(0, 0), cA, voffA); PG8_STAGE(PG8_SA(0, 1), cA + hstep, voffA);
        if (wr == 1) PG8_BAR;
        PG8_WAIT_V(2); PG8_BAR;
        PG8_STAGE(PG8_SB(1, 0), cB + kstep, voffB); PG8_STAGE(PG8_SA(1, 0), cA + kstep, voffA); PG8_STAGE(PG8_SB(1, 1), cB + hstep + kstep, voffB);
        PG8_WAIT_V(6); PG8_BAR;
    } else {
        PG8_STAGE(PG8_SB(0, 0), cB, voffB); PG8_STAGE(PG8_SA(0, 0), cA, voffA); PG8_STAGE(PG8_SB(0, 1), cB + hstep, voffB); PG8_STAGE(PG8_SA(0, 1), cA + hstep, voffA);
        if (wr == 1) PG8_BAR;
        PG8_WAIT_V(4); PG8_BAR;
        PG8_STAGE(PG8_SB(1, 0), cB + kstep, voffB); PG8_STAGE(PG8_SA(1, 0), cA + kstep, voffA); PG8_STAGE(PG8_SB(1, 1), cB + hstep + kstep, voffB);
        PG8_WAIT_V(6); PG8_BAR;
    }
    for (;;) {
        const bool has_next = S.next(ui + 1, nxt);
        const char* nA = has_next ? (const char*)g.A + nxt.aoff + (size_t)nxt.pm * tstep : cA; const char* nB = has_next ? (const char*)g.Bt + nxt.boff + (size_t)nxt.pn * tstep : cB;
        for (int t = 0; t < nt; t += 2) {
            const bool last = (t == nt - 2);
            const char* a1 = cA + (size_t)(t + 1) * kstep;
            const char* a2 = last ? nA : cA + (size_t)(t + 2) * kstep; const char* b2 = last ? nB : cB + (size_t)(t + 2) * kstep;
            const char* a3 = a2 + kstep; const char* b3 = b2 + kstep;
            if (last && has_next) S.a_ready(nxt);
            if constexpr (SP2) {
            PG8_LDB(B0, 0, 0); PG8_LDB(B1, 0, 1); PG8_SCHED; PG8_LDA(At, 0, 0); PG8_STAGE(PG8_SA(1, 1), a1 + hstep, voffA);
            PG8_WAIT_V(8); PG8_WAIT_L(0); PG8_BAR; PG8_MMA(0, 0, At, B0); PG8_MMA(0, 1, At, B1); PG8_BAR; PG8_SCHED;
            PG8_LDA(At, 0, 1); PG8_STAGE(PG8_SB(0, 0), b2, voffB); PG8_STAGE(PG8_SB(0, 1), b2 + hstep, voffB); PG8_STAGE(PG8_SA(0, 0), a2, voffA);
            PG8_WAIT_V(8); PG8_WAIT_L(0); PG8_BAR; PG8_MMA(1, 0, At, B0); PG8_MMA(1, 1, At, B1); PG8_BAR; PG8_SCHED;
            PG8_LDB(B0, 1, 0); PG8_LDB(B1, 1, 1); PG8_SCHED; PG8_LDA(At, 1, 0); PG8_STAGE(PG8_SA(0, 1), a2 + hstep, voffA);
            PG8_WAIT_V(8); PG8_WAIT_L(0); PG8_BAR; PG8_MMA(0, 0, At, B0); PG8_MMA(0, 1, At, B1); PG8_BAR; PG8_SCHED;
            PG8_LDA(At, 1, 1); PG8_STAGE(PG8_SB(1, 0), b3, voffB); PG8_STAGE(PG8_SB(1, 1), b3 + hstep, voffB); PG8_STAGE(PG8_SA(1, 0), a3, voffA);
            PG8_WAIT_V(8); PG8_WAIT_L(0); PG8_BAR; PG8_MMA(1, 0, At, B0); PG8_MMA(1, 1, At, B1); PG8_BAR; PG8_SCHED;
            } else {
            PG8_LDB(B0, 0, 0); PG8_SCHED; PG8_LDA(At, 0, 0); PG8_STAGE(PG8_SA(1, 1), a1 + hstep, voffA);
            PG8_WAIT_L(8); PG8_BAR; PG8_WAIT_L(0); PG8_MMA(0, 0, At, B0); PG8_BAR; PG8_SCHED;
            PG8_LDB(B1, 0, 1); PG8_STAGE(PG8_SB(0, 0), b2, voffB);
            PG8_BAR; PG8_WAIT_L(0); PG8_MMA(0, 1, At, B1); PG8_BAR;
            PG8_LDA(At, 0, 1); PG8_STAGE(PG8_SA(0, 0), a2, voffA);
            PG8_BAR; PG8_WAIT_L(0); PG8_MMA(1, 0, At, B0); PG8_BAR; PG8_SCHED;
            PG8_STAGE(PG8_SB(0, 1), b2 + hstep, voffB);
            PG8_WAIT_V(6); PG8_BAR; PG8_MMA(1, 1, At, B1); PG8_BAR;
            PG8_LDB(B0, 1, 0); PG8_SCHED; PG8_LDA(At, 1, 0); PG8_STAGE(PG8_SA(0, 1), a2 + hstep, voffA);
            PG8_WAIT_L(8); PG8_BAR; PG8_WAIT_L(0); PG8_MMA(0, 0, At, B0); PG8_BAR; PG8_SCHED;
            PG8_LDB(B1, 1, 1); PG8_STAGE(PG8_SB(1, 0), b3, voffB);
            PG8_BAR; PG8_WAIT_L(0); PG8_MMA(0, 1, At, B1); PG8_BAR;
            PG8_LDA(At, 1, 1); PG8_STAGE(PG8_SA(1, 0), a3, voffA);
            PG8_BAR; PG8_WAIT_L(0); PG8_MMA(1, 0, At, B0); PG8_BAR; PG8_SCHED;
            PG8_STAGE(PG8_SB(1, 1), b3 + hstep, voffB);
            PG8_WAIT_V(6); PG8_BAR; PG8_MMA(1, 1, At, B1); PG8_BAR;
            }
        }
        if constexpr (ALIGN_EPI) { if (wr == 0) PG8_BAR; }
        if constexpr (!Epi::AFTER_DRAIN) { E(acc, cur, wr, wc, fr, fq); S.done(cur); }
        if (!has_next) break;
#pragma unroll
        for (int a = 0; a < 2; ++a)
#pragma unroll
            for (int b = 0; b < 2; ++b)
#pragma unroll
                for (int m = 0; m < 4; ++m)
#pragma unroll
                    for (int n = 0; n < 2; ++n) acc[a][b][m][n] = (f32x4){0.f, 0.f, 0.f, 0.f};
        cur = nxt; cA = nA; cB = nB; ++ui;
        if constexpr (ALIGN_EPI) { if (wr == 1) PG8_BAR; }
    }
    PG8_WAIT_V(0);
    if constexpr (!ALIGN_EPI) { if (wr == 0) PG8_BAR; }
    PG8_BAR;
#undef PG8_SA
#undef PG8_SB
#undef PG8_STAGE
#undef PG8_LDA
#undef PG8_LDB
#undef PG8_MMA
#undef PG8_WAIT_V
#undef PG8_WAIT_L
#undef PG8_BAR
#undef PG8_SCHED
}
typedef int v8i __attribute__((ext_vector_type(8)));
typedef int v4i __attribute__((ext_vector_type(4)));
typedef int v32i __attribute__((ext_vector_type(32)));
template <class Epi, class Sched, bool ALIGN_EPI = false, bool SP2 = false>
__device__ __forceinline__ void gemm_phase_f8(PG8_LAS unsigned char* lds, const Gemm g, const Sched& S, const Epi& E, int tid, int scaleBt, int scaleA) {
    asm volatile("" : "+v"(tid));
    const int wid = __builtin_amdgcn_readfirstlane(tid >> 6), lane = tid & 63, wr = wid >> 2, wc = wid & 3, fr = lane & 15, fq = lane >> 4;
    const int K = g.K, nt = K / 128;
    unsigned voffA[2], voffB[2];
#pragma unroll
    for (int i = 0; i < 2; ++i) { int R, C; stage_rc(tid * 16 + i * 8192, R, C); const int Rb = Epi::PERM ? ((R & ~31) + perm32(R & 31)) : R;
        voffA[i] = (unsigned)(R * K + C * 2); voffB[i] = (unsigned)(Rb * K + C * 2); }
    const size_t kstep = (size_t)(BK * 2);
    const size_t hstep = (size_t)HALF * K;
    const size_t tstep = 2 * hstep;
    const unsigned ldsw = (unsigned)wid * 1024u;
    const int aoff0 = lds_byte(wr * 64 + fr, fq * 16), aoff1 = lds_byte(wr * 64 + fr, fq * 16 + 8), boff0 = lds_byte(wc * 32 + fr, fq * 16), boff1 = lds_byte(wc * 32 + fr, fq * 16 + 8);
#define PG8_SA(b, h) (((b) * 2 + (h)) * HTB)
#define PG8_SB(b, h) ((4 + (b) * 2 + (h)) * HTB)
#define PG8_STAGE(bufoff, gbase, voff) do { _Pragma("unroll") for (int _i = 0; _i < 2; ++_i) \
        __builtin_amdgcn_global_load_lds((const unsigned*)((const char*)(gbase) + (voff)[_i]), (PG8_LAS unsigned*)(lds + (bufoff) + ldsw + _i * 8192), 16, 0, 0); } while (0)
#define PG8_INS8(big, slot, lo_, hi_) do { const v8i f_ = __builtin_shufflevector(lo_, hi_, 0, 1, 2, 3, 4, 5, 6, 7); \
        const v32i e_ = __builtin_shufflevector(f_, f_, 0, 1, 2, 3, 4, 5, 6, 7, 0, 1, 2, 3, 4, 5, 6, 7, 0, 1, 2, 3, 4, 5, 6, 7, 0, 1, 2, 3, 4, 5, 6, 7); \
        if ((slot) == 0) big = __builtin_shufflevector(big, e_, 32, 33, 34, 35, 36, 37, 38, 39, 8, 9, 10, 11, 12, 13, 14, 15, 16, 17, 18, 19, 20, 21, 22, 23, 24, 25, 26, 27, 28, 29, 30, 31); \
        else if ((slot) == 1) big = __builtin_shufflevector(big, e_, 0, 1, 2, 3, 4, 5, 6, 7, 32, 33, 34, 35, 36, 37, 38, 39, 16, 17, 18, 19, 20, 21, 22, 23, 24, 25, 26, 27, 28, 29, 30, 31); \
        else if ((slot) == 2) big = __builtin_shufflevector(big, e_, 0, 1, 2, 3, 4, 5, 6, 7, 8, 9, 10, 11, 12, 13, 14, 15, 32, 33, 34, 35, 36, 37, 38, 39, 24, 25, 26, 27, 28, 29, 30, 31); \
        else big = __builtin_shufflevector(big, e_, 0, 1, 2, 3, 4, 5, 6, 7, 8, 9, 10, 11, 12, 13, 14, 15, 16, 17, 18, 19, 20, 21, 22, 23, 32, 33, 34, 35, 36, 37, 38, 39); } while (0)
#define PG8_GET8(big, slot) ((slot) == 0 ? __builtin_shufflevector(big, big, 0, 1, 2, 3, 4, 5, 6, 7) : (slot) == 1 ? __builtin_shufflevector(big, big, 8, 9, 10, 11, 12, 13, 14, 15) : (slot) == 2 ? __builtin_shufflevector(big, big, 16, 17, 18, 19, 20, 21, 22, 23) : __builtin_shufflevector(big, big, 24, 25, 26, 27, 28, 29, 30, 31))
#define PG8_LDA(dst, b, h) do { _Pragma("unroll") for (int m = 0; m < 4; ++m) { const v4i lo_ = *(const PG8_LAS v4i*)(lds + PG8_SA(b, h) + aoff0 + m * 2048), hi_ = *(const PG8_LAS v4i*)(lds + PG8_SA(b, h) + aoff1 + m * 2048); PG8_INS8(Afr, m, lo_, hi_); } } while (0)
#define PG8_LDB(dst, b, h) do { _Pragma("unroll") for (int n = 0; n < 2; ++n) { const v4i lo_ = *(const PG8_LAS v4i*)(lds + PG8_SB(b, h) + boff0 + n * 2048), hi_ = *(const PG8_LAS v4i*)(lds + PG8_SB(b, h) + boff1 + n * 2048); PG8_INS8(Bfr, (dst) * 2 + n, lo_, hi_); } } while (0)
#define PG8_F8(x) __builtin_bit_cast(v8i, x)
#define PG8_MMA(ai, bj, At, Bt) do { __builtin_amdgcn_s_setprio(1); _Pragma("unroll") for (int m = 0; m < 4; ++m) _Pragma("unroll") for (int n = 0; n < 2; ++n) { const v8i bop_ = PG8_GET8(Bfr, (Bt) * 2 + n), aop_ = PG8_GET8(Afr, m); \
        asm volatile("v_mfma_scale_f32_16x16x128_f8f6f4 %0, %1, %2, %0, %3, %4 op_sel_hi:[0,0,0]" : "+v"(acc[ai][bj][m][n]) : "v"(bop_), "v"(aop_), "v"(scaleBt), "v"(scaleA)); } __builtin_amdgcn_s_setprio(0); } while (0)
#define PG8_WAIT_V(n) asm volatile("s_waitcnt vmcnt(" #n ")" ::: "memory")
#define PG8_WAIT_L(n) asm volatile("s_waitcnt lgkmcnt(" #n ")" ::: "memory")
#define PG8_BAR __builtin_amdgcn_s_barrier()
#define PG8_SCHED __builtin_amdgcn_sched_barrier(0)
    Unit cur, nxt; int ui = 0;
    if (!S.next(0, cur)) return;
    unit_uniform(cur);
    f32x4 acc[2][2][4][2];
#pragma unroll
    for (int a = 0; a < 2; ++a)
#pragma unroll
        for (int b = 0; b < 2; ++b)
#pragma unroll
            for (int m = 0; m < 4; ++m)
#pragma unroll
                for (int n = 0; n < 2; ++n) acc[a][b][m][n] = (f32x4){0.f, 0.f, 0.f, 0.f};
    v32i Afr, Bfr;
    const char* cA = (const char*)g.A + cur.aoff + (size_t)cur.pm * tstep; const char* cB = (const char*)g.Bt + cur.boff + (size_t)cur.pn * tstep;
    S.a_ready(cur);
    if constexpr (SP2) {
        PG8_STAGE(PG8_SB(0, 0), cB, voffB); PG8_STAGE(PG8_SB(0, 1), cB + hstep, voffB); PG8_STAGE(PG8_SA(0, 0), cA, voffA); PG8_STAGE(PG8_SA(0, 1), cA + hstep, voffA);
        if (wr == 1) PG8_BAR;
        PG8_WAIT_V(2); PG8_BAR;
        PG8_STAGE(PG8_SB(1, 0), cB + kstep, voffB); PG8_STAGE(PG8_SA(1, 0), cA + kstep, voffA); PG8_STAGE(PG8_SB(1, 1), cB + hstep + kstep, voffB);
        PG8_WAIT_V(6); PG8_BAR;
    } else {
        PG8_STAGE(PG8_SB(0, 0), cB, voffB); PG8_STAGE(PG8_SA(0, 0), cA, voffA); PG8_STAGE(PG8_SB(0, 1), cB + hstep, voffB); PG8_STAGE(PG8_SA(0, 1), cA + hstep, voffA);
        if (wr == 1) PG8_BAR;
        PG8_WAIT_V(4); PG8_BAR;
        PG8_STAGE(PG8_SB(1, 0), cB + kstep, voffB); PG8_STAGE(PG8_SA(1, 0), cA + kstep, voffA); PG8_STAGE(PG8_SB(1, 1), cB + hstep + kstep, voffB);
        PG8_WAIT_V(6); PG8_BAR;
    }
    for (;;) {
        const bool has_next = __builtin_amdgcn_readfirstlane((int)S.next(ui + 1, nxt)) != 0; unit_uniform(nxt);
        const char* nA = has_next ? (const char*)g.A + nxt.aoff + (size_t)nxt.pm * tstep : cA; const char* nB = has_next ? (const char*)g.Bt + nxt.boff + (size_t)nxt.pn * tstep : cB;
        for (int t = 0; t < nt; t += 2) {
            const bool last = (t == nt - 2);
            const char* a1 = cA + (size_t)(t + 1) * kstep;
            const char* a2 = last ? nA : cA + (size_t)(t + 2) * kstep; const char* b2 = last ? nB : cB + (size_t)(t + 2) * kstep;
            const char* a3 = a2 + kstep; const char* b3 = b2 + kstep;
            if (last && has_next) S.a_ready(nxt);
            if constexpr (SP2) {
            PG8_LDB(0, 0, 0); PG8_LDB(1, 0, 1); PG8_SCHED; PG8_LDA(0, 0, 0); PG8_STAGE(PG8_SA(1, 1), a1 + hstep, voffA);
            PG8_WAIT_V(8); PG8_WAIT_L(0); PG8_BAR; PG8_MMA(0, 0, 0, 0); PG8_MMA(0, 1, 0, 1); PG8_BAR; PG8_SCHED;
            PG8_LDA(0, 0, 1); PG8_STAGE(PG8_SB(0, 0), b2, voffB); PG8_STAGE(PG8_SB(0, 1), b2 + hstep, voffB); PG8_STAGE(PG8_SA(0, 0), a2, voffA);
            PG8_WAIT_V(8); PG8_WAIT_L(0); PG8_BAR; PG8_MMA(1, 0, 0, 0); PG8_MMA(1, 1, 0, 1); PG8_BAR; PG8_SCHED;
            PG8_LDB(0, 1, 0); PG8_LDB(1, 1, 1); PG8_SCHED; PG8_LDA(0, 1, 0); PG8_STAGE(PG8_SA(0, 1), a2 + hstep, voffA);
            PG8_WAIT_V(8); PG8_WAIT_L(0); PG8_BAR; PG8_MMA(0, 0, 0, 0); PG8_MMA(0, 1, 0, 1); PG8_BAR; PG8_SCHED;
            PG8_LDA(0, 1, 1); PG8_STAGE(PG8_SB(1, 0), b3, voffB); PG8_STAGE(PG8_SB(1, 1), b3 + hstep, voffB); PG8_STAGE(PG8_SA(1, 0), a3, voffA);
            PG8_WAIT_V(8); PG8_WAIT_L(0); PG8_BAR; PG8_MMA(1, 0, 0, 0); PG8_MMA(1, 1, 0, 1); PG8_BAR; PG8_SCHED;
            } else {
            PG8_LDB(0, 0, 0); PG8_SCHED; PG8_LDA(0, 0, 0); PG8_STAGE(PG8_SA(1, 1), a1 + hstep, voffA);
            PG8_WAIT_L(8); PG8_BAR; PG8_WAIT_L(0); PG8_MMA(0, 0, 0, 0); PG8_BAR; PG8_SCHED;
            PG8_LDB(1, 0, 1); PG8_STAGE(PG8_SB(0, 0), b2, voffB);
            PG8_BAR; PG8_WAIT_L(0); PG8_MMA(0, 1, 0, 1); PG8_BAR;
            PG8_LDA(0, 0, 1); PG8_STAGE(PG8_SA(0, 0), a2, voffA);
            PG8_BAR; PG8_WAIT_L(0); PG8_MMA(1, 0, 0, 0); PG8_BAR; PG8_SCHED;
            PG8_STAGE(PG8_SB(0, 1), b2 + hstep, voffB);
            PG8_WAIT_V(6); PG8_BAR; PG8_MMA(1, 1, 0, 1); PG8_BAR;
            PG8_LDB(0, 1, 0); PG8_SCHED; PG8_LDA(0, 1, 0); PG8_STAGE(PG8_SA(0, 1), a2 + hstep, voffA);
            PG8_WAIT_L(8); PG8_BAR; PG8_WAIT_L(0); PG8_MMA(0, 0, 0, 0); PG8_BAR; PG8_SCHED;
            PG8_LDB(1, 1, 1); PG8_STAGE(PG8_SB(1, 0), b3, voffB);
            PG8_BAR; PG8_WAIT_L(0); PG8_MMA(0, 1, 0, 1); PG8_BAR;
            PG8_LDA(0, 1, 1); PG8_STAGE(PG8_SA(1, 0), a3, voffA);
            PG8_BAR; PG8_WAIT_L(0); PG8_MMA(1, 0, 0, 0); PG8_BAR; PG8_SCHED;
            PG8_STAGE(PG8_SB(1, 1), b3 + hstep, voffB);
            PG8_WAIT_V(6); PG8_BAR; PG8_MMA(1, 1, 0, 1); PG8_BAR;
            }
        }
        asm volatile("s_nop 15\n\ts_nop 15" ::: "memory");
        if constexpr (ALIGN_EPI) { if (wr == 0) PG8_BAR; }
        if constexpr (!Epi::AFTER_DRAIN) { E(acc, cur, wr, wc, fr, fq); S.done(cur); }
        if (!has_next) break;
#pragma unroll
        for (int a = 0; a < 2; ++a)
#pragma unroll
            for (int b = 0; b < 2; ++b)
#pragma unroll
                for (int m = 0; m < 4; ++m)
#pragma unroll
                    for (int n = 0; n < 2; ++n) acc[a][b][m][n] = (f32x4){0.f, 0.f, 0.f, 0.f};
        cur = nxt; cA = nA; cB = nB; ++ui;
        if constexpr (ALIGN_EPI) { if (wr == 1) PG8_BAR; }
    }
    PG8_WAIT_V(0);
    if constexpr (!ALIGN_EPI) { if (wr == 0) PG8_BAR; }
    PG8_BAR;
#undef PG8_SA
#undef PG8_SB
#undef PG8_STAGE
#undef PG8_LDA
#undef PG8_LDB
#undef PG8_MMA
#undef PG8_F8
#undef PG8_INS8
#undef PG8_GET8
#undef PG8_WAIT_V
#undef PG8_WAIT_L
#undef PG8_BAR
#undef PG8_SCHED
}
}

#ifndef FARFIELD
#define FARFIELD 1
#endif
#ifndef ZERO_MOE
#define ZERO_MOE 0
#endif
#ifndef ZERO_FFN
#define ZERO_FFN 0
#endif
#ifndef ZERO_A
#define ZERO_A 0
#endif
#ifndef ZERO_B
#define ZERO_B 0
#endif
#ifndef ZERO_C
#define ZERO_C 0
#endif
#ifndef ZERO_D
#define ZERO_D 0
#endif
constexpr int NWAVES = 8;
constexpr int NB = 16, SEQ = 2048, DM = 2048, M = NB * SEQ;
constexpr int NIN = 5328, NINP = 5376;
constexpr int C_QC = 0, C_KVC = 384, C_KPE = 640, C_RQ = 704, C_RK = 960, C_RV = 1216, C_RG = 1728, C_MZ = 2240, C_XBC = 2752, C_DT = 3776, C_HU = 3792;
constexpr int DFF = 5632, DFFE = 7168, NEXP = 8;
constexpr int CAP_ROWS = 2 * M + NEXP * 256, CAP_RB = CAP_ROWS / 256;
constexpr int MOE_CH = 1, MOE_CH_RB = CAP_RB / MOE_CH;
constexpr float ALPHA = 1.4142135623730951f;
constexpr int HY_OFF = 2055, HY_GLEN = 4112;

constexpr size_t al256(size_t x) { return (x + 255) / 256 * 256; }
constexpr size_t WS_CTL = 0, CTL_ZERO_BYTES = 1u << 20;
constexpr size_t SZ_WIN = (size_t)NINP * DM * 2, SZ_WUQ = (size_t)768 * 384 * 2, SZ_WUKV = (size_t)1024 * 256 * 2, SZ_WOUT = (size_t)DM * DM * 2;
constexpr size_t WS_WIN = CTL_ZERO_BYTES;
constexpr size_t WS_WUQ = WS_WIN + 2 * SZ_WIN;
constexpr size_t WS_WUKV = WS_WUQ + 2 * SZ_WUQ;
constexpr size_t WS_WOUT = WS_WUKV + 2 * SZ_WUKV;
constexpr size_t WS_WGU = WS_WOUT + 2 * SZ_WOUT;
constexpr size_t WS_WDN = WS_WGU + (size_t)2 * DFF * DM * 2;
constexpr size_t WS_HYG = WS_WDN + (size_t)DM * DFF * 2;
constexpr size_t WS_XB = al256(WS_HYG + (size_t)2 * 2 * 512 * HY_GLEN * 2);
constexpr size_t WS_XF8 = WS_XB + (size_t)M * DM * 2;
constexpr size_t WS_RT = WS_XF8 + (size_t)M * DM;
constexpr size_t WS_RTG = WS_RT + (size_t)M * 16;
constexpr size_t WS_SLOT = WS_RTG + (size_t)M * 8;
constexpr size_t WS_SLOTG = WS_SLOT + (size_t)CAP_ROWS * 4;
constexpr size_t WS_SCR = al256(WS_SLOTG + (size_t)CAP_ROWS * 4);
constexpr size_t WS_PROJ = WS_SCR;
constexpr size_t WS_DTF = WS_PROJ + (size_t)M * NINP * 2;
constexpr size_t WS_QN = WS_DTF + (size_t)M * 16 * 4;
constexpr size_t WS_KVN = WS_QN + (size_t)M * 384 * 2;
constexpr size_t WS_KPE = WS_KVN + (size_t)M * 256 * 2;
constexpr size_t WS_RQ = WS_KPE + (size_t)M * 64 * 2;
constexpr size_t WS_RK = WS_RQ + (size_t)M * 256 * 2;
constexpr size_t WS_XBC = WS_RK + (size_t)M * 256 * 2;
constexpr size_t WS_SSDP = WS_XBC + (size_t)M * 1024 * 2;
constexpr size_t WS_UT = WS_SSDP + (size_t)M * 8 * 16;
constexpr size_t WS_QB = WS_UT + (size_t)3 * 512 * M * 2;
constexpr size_t WS_KVB = WS_QB + (size_t)M * 768 * 2;
constexpr size_t WS_ATT = WS_KVB + (size_t)M * 1024 * 2;
constexpr size_t WS_YC = WS_ATT + (size_t)M * 512 * 2;
constexpr size_t WS_ZT = WS_YC + (size_t)M * 512 * 2;
constexpr size_t WS_MIX = WS_ZT + (size_t)512 * M * 2;
constexpr size_t WS_STR = WS_MIX + (size_t)M * DM * 2;
constexpr size_t WS_STS = WS_STR + (size_t)NB * 4 * 8 * 2 * 8192 * 2;
constexpr size_t WS_MIX_END = WS_STS + (size_t)NB * 8 * 8 * 2 * 8192 * 2;
constexpr size_t WS_HID = WS_SCR;
constexpr size_t WS_MGU = WS_SCR;
constexpr size_t WS_MDN = WS_MGU + (size_t)NEXP * 2 * DFFE * DM;
constexpr size_t WS_XS = WS_MDN + (size_t)NEXP * DM * DFFE;
constexpr size_t WS_HIDS = WS_XS + (size_t)CAP_ROWS * DM;
constexpr size_t WS_Y0 = WS_HIDS + (size_t)MOE_CH_RB * 256 * DFFE;
constexpr size_t WS_Y1 = WS_Y0 + (size_t)M * DM * 2;
constexpr size_t WS_END = WS_Y1 + (size_t)M * DM * 2;
static_assert(WS_MIX_END <= WS_END && WS_HID + (size_t)M * DFF * 2 <= WS_END, "d_ws map");
static_assert(WS_END <= 1942000000ull, "d_ws map exceeds the guaranteed workspace");
constexpr int CW_TMO = 0, CW_CODE = 1;
constexpr int CW_CNT = 64;
constexpr int CW_MIXQ = 1024;
constexpr int CW_BAR = 4096;

constexpr int RING_OFF = 0, RING_BYTES = 131072;
constexpr int LDSCTL_OFF = RING_BYTES, MISC_OFF = LDSCTL_OFF + 320;
constexpr int LDS_BYTES = 147456;

#define GAS __attribute__((address_space(1)))
#define LAS __attribute__((address_space(3)))
typedef unsigned short bf16;
typedef unsigned v4u __attribute__((ext_vector_type(4)));
typedef unsigned v2u __attribute__((ext_vector_type(2)));
typedef float f32x4 __attribute__((ext_vector_type(4)));
typedef float f32x2 __attribute__((ext_vector_type(2)));
typedef float f32x16 __attribute__((ext_vector_type(16)));
typedef short bf16x8 __attribute__((ext_vector_type(8)));
typedef short s16x4 __attribute__((ext_vector_type(4)));
typedef GAS unsigned gu32;
#define RLX_AGENT __ATOMIC_RELAXED, __HIP_MEMORY_SCOPE_AGENT
#define LDS_WAIT() asm volatile("s_waitcnt lgkmcnt(0)" ::: "memory")
#define VM_WAIT() asm volatile("s_waitcnt vmcnt(0)" ::: "memory")
__device__ __forceinline__ unsigned f2bf(float f) { unsigned u = __builtin_bit_cast(unsigned, f); return (u + 0x7fffu + ((u >> 16) & 1u)) >> 16; }
__device__ __forceinline__ unsigned pk2(float lo, float hi) { return f2bf(lo) | (f2bf(hi) << 16); }
__device__ __forceinline__ float bf2f(unsigned b) { return __builtin_bit_cast(float, b << 16); }
__device__ __forceinline__ float bflo(unsigned w) { return __builtin_bit_cast(float, w << 16); }
__device__ __forceinline__ float bfhi(unsigned w) { return __builtin_bit_cast(float, w & 0xffff0000u); }
__device__ __forceinline__ float silu(float v) { return v / (1.0f + __expf(-v)); }
template <int K> __device__ __forceinline__ float swz_xor(float v) { return __builtin_bit_cast(float, __builtin_amdgcn_ds_swizzle(__builtin_bit_cast(int, v), (K << 10) | 0x1f)); }
__device__ __forceinline__ float half_sum(float v) { v += swz_xor<1>(v); v += swz_xor<2>(v); v += swz_xor<4>(v); v += swz_xor<8>(v); v += swz_xor<16>(v); return v; }
__device__ __forceinline__ float wave_sum(float v) { v = half_sum(v);
    auto rr = __builtin_amdgcn_permlane32_swap(__builtin_bit_cast(unsigned, v), __builtin_bit_cast(unsigned, v), false, false);
    const unsigned r0 = rr[0], r1 = rr[1];
    return __uint_as_float(r0) + __uint_as_float(r1); }

#define XB_TMO      128
#define XB_XCNT(j)  (256  + 64 * (j))
#define XB_XSUB(j)  (1280 + 64 * (j))
#define XB_XGEN(j)  (2304 + 64 * (j))
#define XB_TOP      3328
#define XB_TOPGEN   3392
#define XCD_BAR_WORDS 3456
#define XB_SPIN_CAP (1u << 18)
__device__ __forceinline__ unsigned xb_ld(unsigned* p)              { return __hip_atomic_load(p, __ATOMIC_RELAXED, __HIP_MEMORY_SCOPE_AGENT); }
__device__ __forceinline__ unsigned xb_add(unsigned* p, unsigned v) { return __hip_atomic_fetch_add(p, v, __ATOMIC_RELAXED, __HIP_MEMORY_SCOPE_AGENT); }
__device__ __forceinline__ unsigned xb_xcc_id() { return (unsigned)__builtin_amdgcn_s_getreg((3 << 11) | 20) & 0xFu; }
#define XB_SPIN(cond, bar) do { unsigned _sp = 0; while (cond) { __builtin_amdgcn_s_sleep(1); \
    if ((++_sp & 255u) == 0u) { if (xb_ld(&(bar)[XB_TMO])) break; if (_sp > XB_SPIN_CAP) { atomicAdd(&(bar)[XB_TMO], 1u); break; } } } } while (0)
struct XcdBarrier { unsigned* bar; unsigned x; volatile LAS unsigned* st; };
__device__ __forceinline__ XcdBarrier xcd_barrier_post(unsigned* bar, volatile LAS unsigned* st) {
    XcdBarrier b; b.bar = bar; b.x = xb_xcc_id(); b.st = st;
    if (threadIdx.x == 0) (void)xb_add(&bar[XB_XCNT(b.x)], 1u);
    return b;
}
__device__ __forceinline__ void xcd_barrier_complete(unsigned* bar, unsigned x, unsigned& nloc, unsigned& nx) {
    const unsigned G = gridDim.x * gridDim.y * gridDim.z;
    unsigned sum, cnt, mine, sp = 0u;
    for (;;) {
        sum = 0u; cnt = 0u; mine = 0u;
#pragma unroll
        for (unsigned j = 0; j < 16; ++j) { const unsigned c = xb_ld(&bar[XB_XCNT(j)]); sum += c; cnt += (c > 0u) ? 1u : 0u; mine = (j == x) ? c : mine; }
        if (sum == G) break;
        __builtin_amdgcn_s_sleep(1);
        if ((++sp & 255u) == 0u) { if (xb_ld(&bar[XB_TMO])) break; if (sp > XB_SPIN_CAP) { atomicAdd(&bar[XB_TMO], 1u); break; } }
    }
    nloc = mine > 0u ? mine : 1u; nx = cnt > 0u ? cnt : 1u;
}
__device__ __forceinline__ void xcd_barrier(const XcdBarrier& b) {
    asm volatile("s_waitcnt vmcnt(0)" ::: "memory");
    __syncthreads();
    if (threadIdx.x == 0) {
        unsigned* bar = b.bar;
        __builtin_amdgcn_s_waitcnt(0);
        unsigned nloc = b.st[0], nx = b.st[1];
        if (nloc == 0u) { xcd_barrier_complete(bar, b.x, nloc, nx); b.st[0] = nloc; b.st[1] = nx; }
        const unsigned old = xb_add(&bar[XB_XSUB(b.x)], 1u);
        const unsigned gen = old / nloc;
        if (old + 1u == (gen + 1u) * nloc) {
            __builtin_amdgcn_fence(__ATOMIC_RELEASE, "agent");
            asm volatile("s_waitcnt vmcnt(0)" ::: "memory");
            const unsigned og = xb_add(&bar[XB_TOP], 1u);
            const unsigned tg = og / nx;
            if (og + 1u == (tg + 1u) * nx) xb_add(&bar[XB_TOPGEN], 1u);
            else XB_SPIN(xb_ld(&bar[XB_TOPGEN]) == tg, bar);
            __builtin_amdgcn_fence(__ATOMIC_ACQUIRE, "agent");
            xb_add(&bar[XB_XGEN(b.x)], 1u);
            asm volatile("s_waitcnt vmcnt(0)" ::: "memory");
        } else {
            XB_SPIN(xb_ld(&bar[XB_XGEN(b.x)]) == gen, bar);
            __builtin_amdgcn_fence(__ATOMIC_ACQUIRE, "agent");
            asm volatile("s_waitcnt vmcnt(0)" ::: "memory");
        }
    }
    __syncthreads();
}

struct Args {
    const float* in[35]; float* out; unsigned char* ws; int ph_lo, ph_hi;
};
enum { I_X = 0, I_WIN, I_QNORM, I_WUQ, I_KVNORM, I_WUKV, I_OUTNORM, I_CONVW, I_CONVB, I_DTBIAS, I_ALOG, I_SSDD, I_SSDNORM, I_HYCW, I_HYCB, I_HYW1, I_HYB1, I_HYW2, I_HYB2, I_HYW3, I_HYFREQ, I_HYBIAS, I_HYNORM,
       I_WOUT, I_LN1G, I_LN1B, I_LN2G, I_LN2B, I_FFG, I_FFU, I_FFD, I_ROUTER, I_MOEG, I_MOEU, I_MOED };

typedef __attribute__((address_space(4))) const Args CArgs;
struct AP { const CArgs* p;
    __device__ __forceinline__ const float* in(int i) const { return p->in[i]; }
    __device__ __forceinline__ float* out() const { return p->out; }
    __device__ __forceinline__ unsigned char* ws() const { return p->ws; } };
__device__ __forceinline__ AP kargs() { const CArgs* p = (const CArgs*)__builtin_amdgcn_kernarg_segment_ptr(); asm volatile("" : "+s"(p)); AP a; a.p = p; return a; }

__device__ __forceinline__ void transpose_item(const float* W, int K, int N, int nblk, bf16* WT, int GR, int GS, int off, LAS float* scr, int item, int lane) {
    const int kb = item / nblk, nb = item % nblk, k0 = 64 * kb, n0 = 32 * nb;
    const int nr = n0 + (lane & 31); const bool ok = nr < N;
    float tv[32]; const int nrc = ok ? nr : N - 1;
#pragma unroll
    for (int i = 0; i < 32; ++i) { const int kk = 2 * i + (lane >> 5); tv[i] = __builtin_nontemporal_load(W + (size_t)(k0 + kk) * N + nrc); }
#pragma unroll
    for (int i = 0; i < 32; ++i) { const int kk = 2 * i + (lane >> 5); scr[kk * 33 + (lane & 31)] = ok ? tv[i] : 0.f; }
    LDS_WAIT(); asm volatile("" ::: "memory");
    const int c = lane & 7;
#pragma unroll
    for (int j = 0; j < 4; ++j) { const int nl = (lane >> 3) + 8 * j; const int n = n0 + nl; const LAS float* s = scr + (8 * c) * 33 + nl;
        v4u o; o.x = pk2(s[0 * 33], s[1 * 33]); o.y = pk2(s[2 * 33], s[3 * 33]); o.z = pk2(s[4 * 33], s[5 * 33]); o.w = pk2(s[6 * 33], s[7 * 33]);
        const int dest = (n / GR) * GS + (n % GR) + off;
        *(GAS v4u*)(WT + (size_t)dest * K + k0 + 8 * c) = o; }
    LDS_WAIT(); asm volatile("" ::: "memory");
}
__device__ __forceinline__ unsigned pk4_fp8(float a, float b, float c, float d) { int w = 0; w = __builtin_amdgcn_cvt_pk_fp8_f32(a, b, w, false); w = __builtin_amdgcn_cvt_pk_fp8_f32(c, d, w, true); return (unsigned)w; }
struct TrF8 { const float* W; int K, N, nblk; unsigned char* WT; int GR, GS, off; float scl; };
__device__ __forceinline__ void tr_f8_load(const TrF8& j, int item, int lane, float (&tv)[32]) {
    const int kb = item / j.nblk, nb = item % j.nblk, k0 = 64 * kb, n0 = 32 * nb; const int nr = n0 + (lane & 31);
#pragma unroll
    for (int i = 0; i < 32; ++i) { const int kk = 2 * i + (lane >> 5); tv[i] = __builtin_nontemporal_load(j.W + (size_t)(k0 + kk) * j.N + nr); }
}
__device__ __forceinline__ void tr_f8_finish(const TrF8& j, int item, int lane, const float (&tv)[32], LAS float* scr) {
    const int kb = item / j.nblk, nb = item % j.nblk, k0 = 64 * kb, n0 = 32 * nb;
#pragma unroll
    for (int i = 0; i < 32; ++i) { const int kk = 2 * i + (lane >> 5); scr[kk * 33 + (lane & 31)] = tv[i] * j.scl; }
    LDS_WAIT(); asm volatile("" ::: "memory");
    const int nl = lane >> 1, hf = lane & 1, n = n0 + nl; const LAS float* sp = scr + (32 * hf) * 33 + nl;
    v4u o0, o1;
    o0.x = pk4_fp8(sp[0 * 33], sp[1 * 33], sp[2 * 33], sp[3 * 33]); o0.y = pk4_fp8(sp[4 * 33], sp[5 * 33], sp[6 * 33], sp[7 * 33]);
    o0.z = pk4_fp8(sp[8 * 33], sp[9 * 33], sp[10 * 33], sp[11 * 33]); o0.w = pk4_fp8(sp[12 * 33], sp[13 * 33], sp[14 * 33], sp[15 * 33]);
    o1.x = pk4_fp8(sp[16 * 33], sp[17 * 33], sp[18 * 33], sp[19 * 33]); o1.y = pk4_fp8(sp[20 * 33], sp[21 * 33], sp[22 * 33], sp[23 * 33]);
    o1.z = pk4_fp8(sp[24 * 33], sp[25 * 33], sp[26 * 33], sp[27 * 33]); o1.w = pk4_fp8(sp[28 * 33], sp[29 * 33], sp[30 * 33], sp[31 * 33]);
    const int dest = (n / j.GR) * j.GS + (n % j.GR) + j.off;
    GAS v4u* dp = (GAS v4u*)(j.WT + (size_t)dest * j.K + k0 + 32 * hf); dp[0] = o0; dp[1] = o1;
    LDS_WAIT(); asm volatile("" ::: "memory");
}
__device__ __forceinline__ void transpose_item_f8(const float* W, int K, int N, int nblk, unsigned char* WT, int GR, int GS, int off, float scl, LAS float* scr, int item, int lane) {
    TrF8 j{W, K, N, nblk, WT, GR, GS, off, scl}; float tv[32]; tr_f8_load(j, item, lane, tv); tr_f8_finish(j, item, lane, tv, scr);
}
struct TrJob { const float* W; int K, N, nblk; bf16* WT; int GR, GS, off; int items; };
__device__ __forceinline__ TrJob mk_job(const float* W, int K, int N, int Npad, bf16* WT, int GR, int GS, int off) { TrJob j; j.W = W; j.K = K; j.N = N; j.nblk = Npad / 32; j.WT = WT; j.GR = GR; j.GS = GS; j.off = off; j.items = (K / 64) * (Npad / 32); return j; }

__device__ __forceinline__ void hyena_filter_item(const AP& a, int layer, int pos, bf16* HYG, LAS float* scr, int lane) {
    const float* w1 = a.in(I_HYW1) + layer * 33 * 64; const float* b1 = a.in(I_HYB1) + layer * 64;
    const float* w2 = a.in(I_HYW2) + layer * 64 * 64; const float* b2 = a.in(I_HYB2) + layer * 64;
    const float* w3 = a.in(I_HYW3) + (size_t)layer * 64 * 2048; const float* fr = a.in(I_HYFREQ) + layer * 128;
    const float t = (float)pos / 2047.0f; const float ang = 6.283185307179586f * (float)pos / 2048.0f;
    if (lane < 33) { float z;
        if (lane == 0) z = t;
        else { const int k = (lane - 1) & 15; const float f = 1e-4f + (float)k * ((15.0f - 1e-4f) / 15.0f); z = (lane <= 16) ? cosf(f * ang) : -sinf(f * ang); }
        scr[lane] = z; }
    LDS_WAIT(); asm volatile("" ::: "memory");
    float s = b1[lane];
    for (int i = 0; i < 33; ++i) s += scr[i] * w1[i * 64 + lane];
    const float h1 = sinf(fr[lane] * s);
    scr[64 + lane] = h1;
    LDS_WAIT(); asm volatile("" ::: "memory");
    float s2 = b2[lane];
    for (int i = 0; i < 64; ++i) s2 += scr[64 + i] * w2[i * 64 + lane];
    const float h2 = sinf(fr[64 + lane] * s2);
    scr[128 + lane] = h2;
    LDS_WAIT(); asm volatile("" ::: "memory");
    for (int m = 0; m < 32; ++m) { const int col = lane + 64 * m; float v = 0.f;
        for (int i = 0; i < 64; ++i) v += scr[128 + i] * w3[(size_t)i * 2048 + col];
        const int o = col >> 10, dir = (col >> 9) & 1, c = col & 511;
        const float delta = fabsf(-3.0701134573253945f + (float)c * ((-15.350567286626973f + 3.0701134573253945f) / 511.0f));
        v *= expf(-t * delta);
        if (dir == 0 || pos > 0) { const int n = dir == 0 ? HY_OFF - pos : HY_OFF + pos;
            HYG[(((size_t)layer * 2 + o) * 512 + c) * HY_GLEN + n] = (bf16)f2bf(v); } }
    LDS_WAIT(); asm volatile("" ::: "memory");
}

__device__ __forceinline__ void ln_load(const float* xrow, int lane, f32x4 (&v)[8]) { const GAS f32x4* xr = (const GAS f32x4*)xrow + lane;
#pragma unroll
    for (int j = 0; j < 8; ++j) v[j] = xr[64 * j]; }
__device__ __forceinline__ void ln_row(float* xrow, bf16* brow, const float* g, const float* b, int lane, f32x4 (&v)[8], const bf16* y0, const bf16* y1, float* orow, unsigned char* frow = nullptr) {
    float s = 0.f; (void)xrow;
#pragma unroll
    for (int j = 0; j < 8; ++j) {
        if (y0) { v2u a0 = *((const GAS v2u*)y0 + lane + 64 * j), a1 = *((const GAS v2u*)y1 + lane + 64 * j); if (ZERO_MOE) { a0.x = a0.y = a1.x = a1.y = 0u; }
            v[j].x = ALPHA * v[j].x + bflo(a0.x) + bflo(a1.x); v[j].y = ALPHA * v[j].y + bfhi(a0.x) + bfhi(a1.x); v[j].z = ALPHA * v[j].z + bflo(a0.y) + bflo(a1.y); v[j].w = ALPHA * v[j].w + bfhi(a0.y) + bfhi(a1.y); }
        s += (v[j].x + v[j].y) + (v[j].z + v[j].w); }
    const float mean = wave_sum(s) * (1.f / DM); float s2 = 0.f;
#pragma unroll
    for (int j = 0; j < 8; ++j) { v[j] = v[j] - mean; s2 += (v[j].x * v[j].x + v[j].y * v[j].y) + (v[j].z * v[j].z + v[j].w * v[j].w); }
    const float rstd = 1.f / sqrtf(wave_sum(s2) * (1.f / DM) + 1e-5f);
    GAS f32x4* xo = (GAS f32x4*)orow + lane;
#pragma unroll
    for (int j = 0; j < 8; ++j) { const f32x4 gg = *((const GAS f32x4*)g + lane + 64 * j), bb = *((const GAS f32x4*)b + lane + 64 * j);
        v[j] = v[j] * rstd * gg + bb; xo[64 * j] = v[j];
        if (brow) { v2u w; w.x = pk2(v[j].x, v[j].y); w.y = pk2(v[j].z, v[j].w); *((GAS v2u*)brow + lane + 64 * j) = w; }
        if (frow) *((GAS unsigned*)frow + lane + 64 * j) = pk4_fp8(v[j].x, v[j].y, v[j].z, v[j].w); }
}

__device__ __forceinline__ void ld8bf(const bf16* p, float (&f)[8]) { const v4u w = *(const GAS v4u*)p; f[0] = bflo(w.x); f[1] = bfhi(w.x); f[2] = bflo(w.y); f[3] = bfhi(w.y); f[4] = bflo(w.z); f[5] = bfhi(w.z); f[6] = bflo(w.w); f[7] = bfhi(w.w); }
__device__ __forceinline__ void st8bf(bf16* p, const float (&f)[8]) { v4u w; w.x = pk2(f[0], f[1]); w.y = pk2(f[2], f[3]); w.z = pk2(f[4], f[5]); w.w = pk2(f[6], f[7]); *(GAS v4u*)p = w; }

__device__ __forceinline__ float sum8(float v) { v += swz_xor<1>(v); v += swz_xor<2>(v); v += swz_xor<4>(v); return v; }
__device__ __forceinline__ void prep_rows8(const AP& a, int layer, int item, int lane, unsigned char* ws, const LAS float* cwl) {
    const int rr = lane >> 3, sub = lane & 7, row = item * 8 + rr, t = row & (SEQ - 1);
    const bf16* pr = (const bf16*)(ws + WS_PROJ) + (size_t)row * NINP;
    { float f[6][8]; float ss = 0.f;
#pragma unroll
      for (int i = 0; i < 6; ++i) { ld8bf(pr + C_QC + (sub + 8 * i) * 8, f[i]);
#pragma unroll
          for (int j = 0; j < 8; ++j) ss += f[i][j] * f[i][j]; }
      const float rs = 1.0f / sqrtf(sum8(ss) * (1.f / 384.f) + 1e-6f);
#pragma unroll
      for (int i = 0; i < 6; ++i) { const float* w = a.in(I_QNORM) + layer * 384 + (sub + 8 * i) * 8;
#pragma unroll
          for (int j = 0; j < 8; ++j) f[i][j] = f[i][j] * rs * w[j];
          st8bf((bf16*)(ws + WS_QN) + (size_t)row * 384 + (sub + 8 * i) * 8, f[i]); } }
    { float f[4][8]; float ss = 0.f;
#pragma unroll
      for (int i = 0; i < 4; ++i) { ld8bf(pr + C_KVC + (sub + 8 * i) * 8, f[i]);
#pragma unroll
          for (int j = 0; j < 8; ++j) ss += f[i][j] * f[i][j]; }
      const float rs = 1.0f / sqrtf(sum8(ss) * (1.f / 256.f) + 1e-6f);
#pragma unroll
      for (int i = 0; i < 4; ++i) { const float* w = a.in(I_KVNORM) + layer * 256 + (sub + 8 * i) * 8;
#pragma unroll
          for (int j = 0; j < 8; ++j) f[i][j] = f[i][j] * rs * w[j];
          st8bf((bf16*)(ws + WS_KVN) + (size_t)row * 256 + (sub + 8 * i) * 8, f[i]); } }
    { float sn[4], cs[4];
#pragma unroll
      for (int j = 0; j < 4; ++j) { const float inv = exp2f(-(float)(4 * sub + j) * (13.287712379549449f / 32.0f)); sincosf((float)t * inv, &sn[j], &cs[j]); }
#pragma unroll
      for (int g = 0; g < 9; ++g) { int src; bf16* dst; float sc = 1.f;
          if (g == 0) { src = C_KPE; dst = (bf16*)(ws + WS_KPE) + (size_t)row * 64; }
          else if (g < 5) { src = C_RQ + (g - 1) * 64; dst = (bf16*)(ws + WS_RQ) + (size_t)row * 256 + (g - 1) * 64; }
          else { src = C_RK + (g - 5) * 64; dst = (bf16*)(ws + WS_RK) + (size_t)row * 256 + (g - 5) * 64; sc = 0.125f; }
          const v2u a1 = *(const GAS v2u*)(pr + src + 4 * sub), a2 = *(const GAS v2u*)(pr + src + 32 + 4 * sub);
          const float x1[4] = {bflo(a1.x), bfhi(a1.x), bflo(a1.y), bfhi(a1.y)}, x2[4] = {bflo(a2.x), bfhi(a2.x), bflo(a2.y), bfhi(a2.y)};
          float y1[4], y2[4];
#pragma unroll
          for (int j = 0; j < 4; ++j) { y1[j] = (x1[j] * cs[j] - x2[j] * sn[j]) * sc; y2[j] = (x2[j] * cs[j] + x1[j] * sn[j]) * sc; }
          v2u o1, o2; o1.x = pk2(y1[0], y1[1]); o1.y = pk2(y1[2], y1[3]); o2.x = pk2(y2[0], y2[1]); o2.y = pk2(y2[2], y2[3]);
          *(GAS v2u*)(dst + 4 * sub) = o1; *(GAS v2u*)(dst + 32 + 4 * sub) = o2; } }
#pragma unroll 4
    for (int i = 0; i < 16; ++i) { const int c0 = (sub + 8 * i) * 8; float acc[8];
        { const f32x4 b0 = *(const LAS f32x4*)(cwl + 5 * 1024 + c0), b1 = *(const LAS f32x4*)(cwl + 5 * 1024 + c0 + 4); acc[0] = b0.x; acc[1] = b0.y; acc[2] = b0.z; acc[3] = b0.w; acc[4] = b1.x; acc[5] = b1.y; acc[6] = b1.z; acc[7] = b1.w; }
#pragma unroll
        for (int k = 0; k < 5; ++k) { const int tt = t + k - 2;
            if (tt >= 0 && tt < SEQ) { float f[8]; ld8bf(pr + (long)(k - 2) * NINP + C_XBC + c0, f);
                const f32x4 w0 = *(const LAS f32x4*)(cwl + k * 1024 + c0), w1 = *(const LAS f32x4*)(cwl + k * 1024 + c0 + 4);
                acc[0] += w0.x * f[0]; acc[1] += w0.y * f[1]; acc[2] += w0.z * f[2]; acc[3] += w0.w * f[3]; acc[4] += w1.x * f[4]; acc[5] += w1.y * f[5]; acc[6] += w1.z * f[6]; acc[7] += w1.w * f[7]; } }
#pragma unroll
        for (int j = 0; j < 8; ++j) acc[j] = silu(acc[j]);
        st8bf((bf16*)(ws + WS_XBC) + (size_t)row * 1024 + c0, acc); }
}
__device__ __forceinline__ void prep_scan(const AP& a, int layer, int item, int lane, unsigned char* ws, LAS float* scr) {
    const int b = item >> 4, dir = (item >> 3) & 1, hh = item & 7;
    const float* DTF = (const float*)(ws + WS_DTF); float* SSDP = (float*)(ws + WS_SSDP);
    const float bias = a.in(I_DTBIAS)[layer * 16 + dir * 8 + hh]; const float av = -expf(a.in(I_ALOG)[layer * 16 + dir * 8 + hh]);
    float dt[32]; float tot = 0.f;
#pragma unroll
    for (int j = 0; j < 32; ++j) { const int row = b * SEQ + lane * 32 + j; const float x = DTF[(size_t)row * 16 + dir * 8 + hh] + bias;
        dt[j] = x > 20.f ? x : log1pf(expf(x)); tot += dt[j] * av; }
    scr[lane] = tot; LDS_WAIT(); asm volatile("" ::: "memory");
    float excl = 0.f, T = 0.f;
#pragma unroll 2
    for (int l = 0; l < 64; ++l) { const float v = scr[l]; T += v; excl += (l < lane) ? v : 0.f; }
    LDS_WAIT(); asm volatile("" ::: "memory");
    float run = excl;
#pragma unroll
    for (int j = 0; j < 32; ++j) { const int row = b * SEQ + lane * 32 + j; const float la = dt[j] * av; float c;
        if (dir == 0) { run += la; c = run; } else { c = T - run; run += la; }
        f32x2 o; o.x = c * 1.4426950408889634f; o.y = log2f(dt[j]) - o.x;
        *(GAS f32x2*)(SSDP + ((size_t)row * 8 + hh) * 4 + dir * 2) = o; }
}
__device__ __forceinline__ void prep_hyconv(const AP& a, int layer, int item, int lane, unsigned char* ws, LAS bf16* scr) {
    const int cg = item % 24, tt = (item / 24) & 31, b = item / (24 * 32);
    const int ch = cg * 64 + lane, part = ch >> 9, c = ch & 511, t0 = tt * 64;
    const bf16* PROJ = (const bf16*)(ws + WS_PROJ); const bf16* tile = PROJ + (size_t)(b * SEQ) * NINP + C_HU + cg * 64;
    v4u ld[9];
#pragma unroll
    for (int i = 0; i < 9; ++i) { const int id = lane + 64 * i, r = id >> 3, c8 = id & 7, t = t0 - 1 + r;
        ld[i] = (id < 66 * 8 && t >= 0 && t < SEQ) ? *(const GAS v4u*)(tile + (size_t)t * NINP + c8 * 8) : (v4u){0u, 0u, 0u, 0u}; }
#pragma unroll
    for (int i = 0; i < 9; ++i) { const int id = lane + 64 * i, r = id >> 3, c8 = id & 7; if (id < 66 * 8) *(LAS v4u*)(scr + r * 72 + c8 * 8) = ld[i]; }
    const float* cw = a.in(I_HYCW) + layer * 3 * 1536; const float w0 = cw[ch], w1 = cw[1536 + ch], w2 = cw[3072 + ch], bs = a.in(I_HYCB)[layer * 1536 + ch];
    LDS_WAIT(); asm volatile("" ::: "memory");
    float xm = bf2f(scr[lane]), x0 = bf2f(scr[72 + lane]);
    bf16* dst = (bf16*)(ws + WS_UT) + (((size_t)part * 512 + c) * NB + b) * SEQ + t0;
#pragma unroll
    for (int q = 0; q < 8; ++q) { float u[8];
#pragma unroll
        for (int j = 0; j < 8; ++j) { const float xp = bf2f(scr[(q * 8 + j + 2) * 72 + lane]);
            u[j] = bs + w0 * xm + w1 * x0 + w2 * xp; xm = x0; x0 = xp; }
        st8bf(dst + q * 8, u); }
    LDS_WAIT(); asm volatile("" ::: "memory");
}

__device__ __forceinline__ void post_row(const AP& a, int layer, int row, int lane, unsigned char* ws) {
    bf16* MIX = (bf16*)(ws + WS_MIX) + (size_t)row * DM;
    { float f[8]; ld8bf((const bf16*)(ws + WS_ATT) + (size_t)row * 512 + lane * 8, f); float ss = 0.f;
#pragma unroll
      for (int j = 0; j < 8; ++j) ss += f[j] * f[j];
      const float rs = 1.0f / sqrtf(wave_sum(ss) * (1.f / 512.f) + 1e-6f); const float* w = a.in(I_OUTNORM) + layer * 512 + lane * 8;
#pragma unroll
      for (int j = 0; j < 8; ++j) f[j] = ZERO_A ? 0.f : f[j] * rs * w[j];
      st8bf(MIX + lane * 8, f); }
    { float f[8], z[8]; ld8bf((const bf16*)(ws + WS_YC) + (size_t)row * 512 + lane * 8, f); ld8bf((const bf16*)(ws + WS_PROJ) + (size_t)row * NINP + C_MZ + lane * 8, z); float ss = 0.f;
#pragma unroll
      for (int j = 0; j < 8; ++j) { f[j] = f[j] * silu(z[j]); ss += f[j] * f[j]; }
      const float rs = 1.0f / sqrtf(wave_sum(ss) * (1.f / 512.f) + 1e-6f); const float* w = a.in(I_SSDNORM) + layer * 512 + lane * 8;
#pragma unroll
      for (int j = 0; j < 8; ++j) f[j] = ZERO_C ? 0.f : f[j] * rs * w[j];
      st8bf(MIX + 1024 + lane * 8, f); }
}
__device__ __forceinline__ void post_hy(const AP& a, int layer, int item, int lane, unsigned char* ws, LAS bf16* scr) {
    const int b = item >> 7, t0 = (item & 127) * 16, tl = lane & 15, cs = lane >> 4;
    const bf16* ZT = (const bf16*)(ws + WS_ZT) + (size_t)b * SEQ + t0 + tl; const float* w = a.in(I_HYNORM) + layer * 512;
    float ss = 0.f;
#pragma unroll 16
    for (int cc = 0; cc < 128; ++cc) { const float v = bf2f(ZT[(size_t)(cc * 4 + cs) * M]); ss += v * v; }
    ss += swz_xor<16>(ss);
    { auto rr = __builtin_amdgcn_permlane32_swap(__float_as_uint(ss), __float_as_uint(ss), false, false); const unsigned r0 = rr[0], r1 = rr[1]; ss = __uint_as_float(r0) + __uint_as_float(r1); }
    const float rs = 1.0f / sqrtf(ss * (1.f / 512.f) + 1e-6f);
    for (int cg = 0; cg < 8; ++cg) {
#pragma unroll
        for (int jj = 0; jj < 16; ++jj) { const int cl = jj * 4 + cs, c = cg * 64 + cl; scr[tl * 72 + cl] = (bf16)f2bf(ZERO_D ? 0.f : bf2f(ZT[(size_t)c * M]) * rs * w[c]); }
        LDS_WAIT(); asm volatile("" ::: "memory");
#pragma unroll
        for (int i = 0; i < 2; ++i) { const int t2 = (lane >> 3) + 8 * i, c8 = lane & 7; const v4u v = *(const LAS v4u*)(scr + t2 * 72 + c8 * 8);
            *(GAS v4u*)((bf16*)(ws + WS_MIX) + (size_t)(b * SEQ + t0 + t2) * DM + 1536 + cg * 64 + c8 * 8) = v; }
        LDS_WAIT(); asm volatile("" ::: "memory");
    }
}

namespace mixb {
#define SBAR() __builtin_amdgcn_sched_barrier(0)
__device__ __forceinline__ int crow(int r, int hi) { return (r & 3) + 8 * (r >> 2) + 4 * hi; }
__device__ __forceinline__ unsigned cvtpk(float lo, float hi) { unsigned r; asm volatile("v_cvt_pk_bf16_f32 %0, %1, %2" : "=v"(r) : "v"(lo), "v"(hi)); return r; }
__device__ __forceinline__ int v_st(int k, int c) { const int kk = (k & ~0xC) | ((k & 4) << 1) | ((k & 8) >> 1); return ((kk >> 3) * 4 + (c >> 5)) * 512 + ((kk & 7) * 32 + (c & 31)) * 2; }
__device__ __forceinline__ int v_rd_base(int lane) { return ((lane & 3) << 3) | (((lane >> 2) & 3) << 6) | (((lane >> 4) & 1) << 5) | (((lane >> 5) & 1) << 8); }
constexpr int v_rd_off(int d0, int ks, int half) { return d0 * 512 + ks * 4096 + half * 2048; }
template <int OFF> __device__ __forceinline__ s16x4 tr_read(int vb) { s16x4 r; asm volatile("ds_read_b64_tr_b16 %0, %1 offset:%2" : "=&v"(r) : "v"(vb), "i"(OFF) : "memory"); return r; }
template <int D0> __device__ __forceinline__ void pv_one(f32x16& od, int vb, bf16x8 pa0, bf16x8 pa1, bf16x8 pa2, bf16x8 pa3) {
    const s16x4 l0 = tr_read<v_rd_off(D0, 0, 0)>(vb), h0 = tr_read<v_rd_off(D0, 0, 1)>(vb), l1 = tr_read<v_rd_off(D0, 1, 0)>(vb), h1 = tr_read<v_rd_off(D0, 1, 1)>(vb);
    const s16x4 l2 = tr_read<v_rd_off(D0, 2, 0)>(vb), h2 = tr_read<v_rd_off(D0, 2, 1)>(vb), l3 = tr_read<v_rd_off(D0, 3, 0)>(vb), h3 = tr_read<v_rd_off(D0, 3, 1)>(vb);
    asm volatile("s_waitcnt lgkmcnt(0)" ::: "memory"); SBAR();
#define PKV(L, H) (bf16x8){L[0], L[1], L[2], L[3], H[0], H[1], H[2], H[3]}
    od = __builtin_amdgcn_mfma_f32_32x32x16_bf16(pa0, PKV(l0, h0), od, 0, 0, 0);
    od = __builtin_amdgcn_mfma_f32_32x32x16_bf16(pa1, PKV(l1, h1), od, 0, 0, 0);
    od = __builtin_amdgcn_mfma_f32_32x32x16_bf16(pa2, PKV(l2, h2), od, 0, 0, 0);
    od = __builtin_amdgcn_mfma_f32_32x32x16_bf16(pa3, PKV(l3, h3), od, 0, 0, 0);
#undef PKV
}
__device__ __forceinline__ void fast_sincos(float x, float& s, float& c) { float r = x * 0.15915494309189535f; r = r - floorf(r); s = __builtin_amdgcn_sinf(r); c = __builtin_amdgcn_cosf(r); }

struct MixP {
    const bf16* q; int ldq;
    const bf16* k0; int ldk0; const bf16* k1; int ldk1;
    const bf16* v; int ldv;
    bf16* o; int ldo;
    float lf, lb;
    const float* ssdp;
    const bf16* aux; int ldaux; float dh;
    const bf16* st;
};
constexpr int V_BYTES = 16384, V_OFF = 0, K_OFF = 2 * V_BYTES;
template <int DQK> struct KL { static constexpr int PITCH = DQK * 2, BYTES = 64 * PITCH, WK_OFF = K_OFF + 2 * BYTES, SCR_OFF = WK_OFF + 2176, END = SCR_OFF + NWAVES * 256; };

template <int MODE, int DQK, int DV>
__device__ __forceinline__ void mix_unit(const MixP& P, int q0, LAS unsigned char* lds, int tid) {
    typedef KL<DQK> L;
    constexpr int ND = DQK / 16, NV = DV / 32, CPR = DQK / 8, KCH = 64 * CPR / 512, VPR = DV / 8, VCH = (64 * VPR + 511) / 512;
    constexpr float SCALE = 0.07216878364870322f;
    constexpr float C = SCALE * 1.4426950408889634f, THR = 8.f;
    asm volatile("" : "+v"(tid));
    const int wid = tid >> 6, lane = tid & 63, r32 = lane & 31, hi = lane >> 5;
    const int qrow = q0 + wid * 32 + r32;
    LAS unsigned char* Vl = lds + V_OFF; LAS unsigned char* Kl = lds + K_OFF;
    LAS float* wsc = (LAS float*)(lds + L::SCR_OFF) + wid * 64; LAS float* li_l = wsc; LAS float* al_l = wsc + 32;
    LAS f32x4* wk_l = (LAS f32x4*)(lds + L::WK_OFF);
    LAS f32x2* wkref_l = (LAS f32x2*)(lds + L::WK_OFF + 2048);
    const int wq0 = q0 + __builtin_amdgcn_readfirstlane(wid) * 32;
    bf16x8 qr[ND];
    { const bf16* Qw = P.q + (long)qrow * P.ldq + hi * 8;
#pragma unroll
      for (int d0 = 0; d0 < ND; ++d0) qr[d0] = *(const GAS bf16x8*)(Qw + d0 * 16); }
    if constexpr (MODE == 0) {
#pragma unroll
        for (int dd = 0; dd < 2; ++dd)
#pragma unroll
            for (int j = 0; j < 8; ++j) { const int i = dd * 16 + hi * 8 + j; const float inv = exp2f(-(float)i * (13.287712379549449f / 32.0f)); float sn, cs; fast_sincos((float)qrow * inv, sn, cs);
                const float x1 = bf2f((unsigned short)qr[8 + dd][j]), x2 = bf2f((unsigned short)qr[10 + dd][j]);
                qr[8 + dd][j] = (short)f2bf(x1 * cs - x2 * sn); qr[10 + dd][j] = (short)f2bf(x2 * cs + x1 * sn); }
    }
    float cf_i = 0.f, rb_i = 0.f;
    if constexpr (MODE == 2) { const f32x4 w = *(const GAS f32x4*)(P.ssdp + (size_t)qrow * 32); cf_i = w.x; rb_i = w.z; }
    bf16x8 ks[KCH], vs[VCH]; f32x4 wkreg = {0.f, 0.f, 0.f, 0.f}; float crf = 0.f, rrf = 0.f;
#define MX_SLOAD(kr0) do { \
    _Pragma("unroll") for (int i = 0; i < KCH; ++i) { const int cid = tid + 512 * i, row = cid / CPR, c8 = cid % CPR; \
        const bf16* src = (MODE == 0 && c8 >= 16) ? P.k1 + (long)((kr0) + row) * P.ldk1 + (c8 - 16) * 8 : P.k0 + (long)((kr0) + row) * P.ldk0 + c8 * 8; \
        ks[i] = *(const GAS bf16x8*)src; } \
    _Pragma("unroll") for (int i = 0; i < VCH; ++i) { const int cid = tid + 512 * i, row = cid / VPR, c8 = cid % VPR; \
        if (VCH * 512 == 64 * VPR || cid < 64 * VPR) vs[i] = *(const GAS bf16x8*)(P.v + (long)((kr0) + row) * P.ldv + c8 * 8); } \
    if (MODE == 2) { if (tid < 64) { wkreg = *(const GAS f32x4*)(P.ssdp + (size_t)((kr0) + tid) * 32); crf = P.ssdp[(size_t)((kr0) + 63) * 32]; rrf = P.ssdp[(size_t)(kr0) * 32 + 2]; } } } while (0)
#define MX_SWRITE(b) do { \
    _Pragma("unroll") for (int i = 0; i < KCH; ++i) { const int cid = tid + 512 * i, row = cid / CPR, c8 = cid % CPR; \
        *(LAS bf16x8*)(Kl + (b) * L::BYTES + row * L::PITCH + ((c8 * 16) ^ ((row & 7) << 4))) = ks[i]; } \
    _Pragma("unroll") for (int i = 0; i < VCH; ++i) { const int cid = tid + 512 * i, row = cid / VPR, c8 = cid % VPR; \
        if (VCH * 512 == 64 * VPR || cid < 64 * VPR) *(LAS bf16x8*)(Vl + (b) * V_BYTES + v_st(row, c8 * 8)) = vs[i]; } \
    if (MODE == 2) { if (tid < 64) { wk_l[(b) * 64 + tid] = (f32x4){wkreg.y, wkreg.w, __builtin_amdgcn_exp2f(wkreg.y + crf), __builtin_amdgcn_exp2f(wkreg.w + rrf)}; if (tid == 0) wkref_l[(b)] = (f32x2){crf, rrf}; } } } while (0)
    float bfw0[16], bbw0[16]; float c32f = 1.f, c32b = 1.f;
    if constexpr (MODE == 1) {
#pragma unroll
        for (int r = 0; r < 16; ++r) { const int j0 = crow(r, hi);
            bfw0[r] = __builtin_amdgcn_exp2f((float)(63 - j0) * P.lf); bbw0[r] = __builtin_amdgcn_exp2f((float)j0 * P.lb); }
        c32f = __builtin_amdgcn_exp2f(-32.f * P.lf); c32b = __builtin_amdgcn_exp2f(32.f * P.lb);
    }
    float m_reg = -1e30f, l_reg = 0.f; f32x16 o[NV];
#pragma unroll
    for (int d = 0; d < NV; ++d) o[d] = f32x16{};
    const int vb0 = (int)(uintptr_t)(Vl) + v_rd_base(lane);
    constexpr int NT = SEQ / 64;
    int jlo = 0, jhi = NT - 1;
#if FARFIELD
    if constexpr (MODE != 0) {
        const int Bq = q0 >> 8; jlo = 4 * Bq; jhi = jlo + 3;
        for (int Bp = 0; Bp < 8; ++Bp) { if (Bp == Bq) continue;
            float f;
            if constexpr (MODE == 1) f = (Bp < Bq) ? __builtin_amdgcn_exp2f((float)(qrow - 256 * (Bp + 1)) * P.lf) : __builtin_amdgcn_exp2f((float)(256 * Bp - qrow) * P.lb);
            else f = (Bp < Bq) ? __builtin_amdgcn_exp2f(cf_i - P.ssdp[(size_t)(256 * Bp + 255) * 32 + 0]) : __builtin_amdgcn_exp2f(rb_i - P.ssdp[(size_t)(256 * Bp) * 32 + 2]);
            if (!__any(f > 5.9e-8f)) continue;
            bf16x8 qs[ND];
#pragma unroll
            for (int d0 = 0; d0 < ND; ++d0) { v4u w;
                w.x = cvtpk(bf2f((unsigned short)qr[d0][0]) * f, bf2f((unsigned short)qr[d0][1]) * f); w.y = cvtpk(bf2f((unsigned short)qr[d0][2]) * f, bf2f((unsigned short)qr[d0][3]) * f);
                w.z = cvtpk(bf2f((unsigned short)qr[d0][4]) * f, bf2f((unsigned short)qr[d0][5]) * f); w.w = cvtpk(bf2f((unsigned short)qr[d0][6]) * f, bf2f((unsigned short)qr[d0][7]) * f);
                qs[d0] = __builtin_bit_cast(bf16x8, w); }
            const bf16* S = P.st + ((size_t)Bp * 2 + (Bp < Bq ? 0 : 1)) * (DV * DQK) + (size_t)r32 * DQK + hi * 8;
#pragma unroll
            for (int d0v = 0; d0v < NV; ++d0v)
#pragma unroll
                for (int ks = 0; ks < ND; ++ks) { const bf16x8 sf = *(const GAS bf16x8*)(S + (size_t)(32 * d0v) * DQK + ks * 16);
                    o[d0v] = __builtin_amdgcn_mfma_f32_32x32x16_bf16(qs[ks], sf, o[d0v], 0, 0, 0); }
        }
    }
#else
    if constexpr (MODE == 2) {
        const int l = lane & 31, qt = q0 >> 6;
        const float cfq = P.ssdp[(size_t)q0 * 32 + 0], rbq = P.ssdp[(size_t)(q0 + 255) * 32 + 2];
        const float cfe = P.ssdp[(size_t)(64 * l + 63) * 32 + 0], rbs = P.ssdp[(size_t)(64 * l) * 32 + 2];
        const bool keep = (l < qt) ? (cfq - cfe > -24.f) : ((l > qt + 3) ? (rbq - rbs > -24.f) : true);
        const unsigned m32 = (unsigned)__ballot(keep);
        jlo = __builtin_amdgcn_readfirstlane(__builtin_ctz(m32)); jhi = __builtin_amdgcn_readfirstlane(31 - __builtin_clz(m32));
    } else if constexpr (MODE == 1) {
        const float dmf = 24.f / (-P.lf), dmb = 24.f / (-P.lb);
        int a = (int)floorf(((float)(q0 - 63) - dmf) * (1.f / 64.f)) + 1; int b = (int)ceilf(((float)(q0 + 255) + dmb) * (1.f / 64.f)) - 1;
        jlo = a < 0 ? 0 : a; jhi = b > NT - 1 ? NT - 1 : b;
        jlo = __builtin_amdgcn_readfirstlane(jlo); jhi = __builtin_amdgcn_readfirstlane(jhi);
    }
#endif
    MX_SLOAD(jlo * 64); VM_WAIT(); MX_SWRITE(0); __syncthreads();
    for (int j = jlo; j <= jhi; ++j) {
        const int buf = (j - jlo) & 1; const int kr0 = j * 64;
        if (j < jhi) MX_SLOAD(kr0 + 64);
        f32x16 p0 = f32x16{}, p1 = f32x16{};
        { LAS unsigned char* Kb = Kl + buf * L::BYTES;
#pragma unroll
          for (int dg = 0; dg < ND / 4; ++dg) { bf16x8 kb0[4], kb1[4];
#pragma unroll
              for (int dd = 0; dd < 4; ++dd) { const int cb = ((dg * 4 + dd) * 16 + hi * 8) * 2;
                  kb0[dd] = *(const LAS bf16x8*)(Kb + r32 * L::PITCH + (cb ^ ((r32 & 7) << 4)));
                  kb1[dd] = *(const LAS bf16x8*)(Kb + (32 + r32) * L::PITCH + (cb ^ ((r32 & 7) << 4))); }
              LDS_WAIT(); SBAR();
#pragma unroll
              for (int dd = 0; dd < 4; ++dd) { p0 = __builtin_amdgcn_mfma_f32_32x32x16_bf16(kb0[dd], qr[dg * 4 + dd], p0, 0, 0, 0);
                  p1 = __builtin_amdgcn_mfma_f32_32x32x16_bf16(kb1[dd], qr[dg * 4 + dd], p1, 0, 0, 0); }
              SBAR(); } }
        if constexpr (MODE == 0) {
            float pmax = p0[0];
#pragma unroll
            for (int r = 1; r < 16; ++r) pmax = fmaxf(pmax, p0[r]);
#pragma unroll
            for (int r = 0; r < 16; ++r) pmax = fmaxf(pmax, p1[r]);
            { auto rr = __builtin_amdgcn_permlane32_swap(__float_as_uint(pmax), __float_as_uint(pmax), false, false); pmax = fmaxf(__uint_as_float(rr[0]), __uint_as_float(rr[1])); }
            float mn, alpha;
            if (__all(pmax - m_reg <= THR / SCALE)) { mn = m_reg; alpha = 1.f; }
            else { mn = fmaxf(m_reg, pmax); alpha = __builtin_amdgcn_exp2f((m_reg - mn) * C); m_reg = mn; }
            const float mnC = -mn * C;
#pragma unroll
            for (int r = 0; r < 16; ++r) { p0[r] = __builtin_amdgcn_exp2f(fmaf(p0[r], C, mnC)); p1[r] = __builtin_amdgcn_exp2f(fmaf(p1[r], C, mnC)); }
            if (__any(alpha < 1.f)) { if (hi == 0) al_l[r32] = alpha; LDS_WAIT();
#pragma unroll
                for (int r = 0; r < 16; ++r) { const float av = al_l[crow(r, hi)];
#pragma unroll
                    for (int d = 0; d < NV; ++d) o[d][r] *= av; } }
            float ps = 0.f;
#pragma unroll
            for (int r = 0; r < 16; ++r) ps += p0[r] + p1[r];
            { auto rr = __builtin_amdgcn_permlane32_swap(__float_as_uint(ps), __float_as_uint(ps), false, false); ps = __uint_as_float(rr[0]) + __uint_as_float(rr[1]); }
            l_reg = l_reg * alpha + ps;
        } else if constexpr (MODE == 1) {
            if (kr0 + 63 <= wq0) {
                const float ai = __builtin_amdgcn_exp2f((float)(qrow - kr0 - 63) * P.lf);
                const float ai1 = ai * c32f;
#pragma unroll
                for (int r = 0; r < 16; ++r) { p0[r] *= ai * bfw0[r]; p1[r] *= ai1 * bfw0[r]; }
            } else if (kr0 > wq0 + 31) {
                const float ai = __builtin_amdgcn_exp2f((float)(kr0 - qrow) * P.lb);
                const float ai1 = ai * c32b;
#pragma unroll
                for (int r = 0; r < 16; ++r) { p0[r] *= ai * bbw0[r]; p1[r] *= ai1 * bbw0[r]; }
            } else {
#pragma unroll
                for (int r = 0; r < 16; ++r) { const int k0 = kr0 + crow(r, hi), k1 = k0 + 32;
                    const float e0 = (k0 <= qrow) ? (float)(qrow - k0) * P.lf : (float)(k0 - qrow) * P.lb;
                    const float e1 = (k1 <= qrow) ? (float)(qrow - k1) * P.lf : (float)(k1 - qrow) * P.lb;
                    p0[r] *= __builtin_amdgcn_exp2f(e0); p1[r] *= __builtin_amdgcn_exp2f(e1); }
            }
        } else {
            if (kr0 + 63 <= wq0) {
                const float ai = __builtin_amdgcn_exp2f(cf_i - wkref_l[buf].x);
#pragma unroll
                for (int r = 0; r < 16; ++r) { const int kk = crow(r, hi); p0[r] *= ai * wk_l[buf * 64 + kk].z; p1[r] *= ai * wk_l[buf * 64 + 32 + kk].z; }
            } else if (kr0 > wq0 + 31) {
                const float ai = __builtin_amdgcn_exp2f(rb_i - wkref_l[buf].y);
#pragma unroll
                for (int r = 0; r < 16; ++r) { const int kk = crow(r, hi); p0[r] *= ai * wk_l[buf * 64 + kk].w; p1[r] *= ai * wk_l[buf * 64 + 32 + kk].w; }
            } else {
#pragma unroll
                for (int r = 0; r < 16; ++r) { const int kk = crow(r, hi); const f32x4 w0 = wk_l[buf * 64 + kk], w1 = wk_l[buf * 64 + 32 + kk];
                    const int k0 = kr0 + kk, k1 = k0 + 32;
                    const float e0 = (k0 <= qrow) ? cf_i + w0.x : rb_i + w0.y;
                    const float e1 = (k1 <= qrow) ? cf_i + w1.x : rb_i + w1.y;
                    p0[r] *= __builtin_amdgcn_exp2f(e0); p1[r] *= __builtin_amdgcn_exp2f(e1); }
            }
        }
        bf16x8 pa0, pa1, pa2, pa3;
#define MX_PK4(PP, BASE, OUT) do { const unsigned a0 = cvtpk(PP[BASE + 0], PP[BASE + 1]), a1 = cvtpk(PP[BASE + 2], PP[BASE + 3]); \
    const unsigned b0 = cvtpk(PP[BASE + 4], PP[BASE + 5]), b1 = cvtpk(PP[BASE + 6], PP[BASE + 7]); \
    auto r0 = __builtin_amdgcn_permlane32_swap(a0, b0, false, false); auto r1 = __builtin_amdgcn_permlane32_swap(a1, b1, false, false); \
    v4u w = {r0[0], r1[0], r0[1], r1[1]}; OUT = __builtin_bit_cast(bf16x8, w); } while (0)
        MX_PK4(p0, 0, pa0); MX_PK4(p0, 8, pa1); MX_PK4(p1, 0, pa2); MX_PK4(p1, 8, pa3);
#undef MX_PK4
        { const int vb = vb0 + buf * V_BYTES;
          pv_one<0>(o[0], vb, pa0, pa1, pa2, pa3); pv_one<1>(o[1], vb, pa0, pa1, pa2, pa3);
          if constexpr (NV == 4) { pv_one<2>(o[2], vb, pa0, pa1, pa2, pa3); pv_one<3>(o[3], vb, pa0, pa1, pa2, pa3); } }
        if (j < jhi) { VM_WAIT(); MX_SWRITE(buf ^ 1); }
        __syncthreads();
    }
#undef MX_SLOAD
#undef MX_SWRITE
    const int orow0 = q0 + wid * 32;
    if constexpr (MODE == 0) {
        if (hi == 0) li_l[r32] = l_reg; LDS_WAIT();
#pragma unroll
        for (int r = 0; r < 16; ++r) { const int rr = crow(r, hi); const float rl = __builtin_amdgcn_rcpf(li_l[rr]);
#pragma unroll
            for (int d0 = 0; d0 < NV; ++d0) P.o[(long)(orow0 + rr) * P.ldo + d0 * 32 + r32] = (bf16)f2bf(o[d0][r] * rl); }
    } else if constexpr (MODE == 1) {
#pragma unroll
        for (int r = 0; r < 16; ++r) { const int rr = crow(r, hi);
            float s = 0.f;
#pragma unroll
            for (int d0 = 0; d0 < NV; ++d0) s += o[d0][r];
            s = half_sum(s);
            const float mean = s * (1.f / 128.f); float qv = 0.f;
#pragma unroll
            for (int d0 = 0; d0 < NV; ++d0) { const float dlt = o[d0][r] - mean; qv += dlt * dlt; }
            qv = half_sum(qv);
            const float rs = 1.0f / sqrtf(qv * (1.f / 128.f) + 1e-6f);
#pragma unroll
            for (int d0 = 0; d0 < NV; ++d0) { const float gt = bf2f(P.aux[(long)(orow0 + rr) * P.ldaux + d0 * 32 + r32]);
                P.o[(long)(orow0 + rr) * P.ldo + d0 * 32 + r32] = (bf16)f2bf(ZERO_B ? 0.f : (o[d0][r] - mean) * rs * silu(gt)); } }
    } else {
#pragma unroll
        for (int r = 0; r < 16; ++r) { const int rr = crow(r, hi);
#pragma unroll
            for (int d0 = 0; d0 < NV; ++d0) { const float xv = bf2f(P.aux[(long)(orow0 + rr) * P.ldaux + d0 * 32 + r32]);
                P.o[(long)(orow0 + rr) * P.ldo + d0 * 32 + r32] = (bf16)f2bf(o[d0][r] + xv * P.dh); } }
    }
    __syncthreads();
}
template <int MODE, int DK, int DV>
__device__ __forceinline__ void state_unit(const MixP& P, int Bk, bf16* ST, LAS unsigned char* lds, int tid) {
    asm volatile("" : "+v"(tid));
    const int wid = __builtin_amdgcn_readfirstlane(tid >> 6), lane = tid & 63, r32 = lane & 31, hi = lane >> 5;
    constexpr int KPR = DK / 8, VPR = DV / 8, KCH = 64 * KPR / 512, VCH = 64 * VPR / 512;
    LAS unsigned char* Vt = lds; LAS unsigned char* Kf = lds + 16384; LAS unsigned char* Kb = lds + 32768;
    const int dvb = wid / (DK / 32), dkb = wid % (DK / 32); const int r0 = Bk * 256;
    float cfe = 0.f, rbs = 0.f;
    if constexpr (MODE == 2) { cfe = P.ssdp[(size_t)(r0 + 255) * 32 + 0]; rbs = P.ssdp[(size_t)r0 * 32 + 2]; }
    f32x16 accf = f32x16{}, accb = f32x16{};
    const int vbV = (int)(uintptr_t)Vt + v_rd_base(lane) + dvb * 512, vbF = (int)(uintptr_t)Kf + v_rd_base(lane) + dkb * 512, vbB = (int)(uintptr_t)Kb + v_rd_base(lane) + dkb * 512;
    for (int tl = 0; tl < 4; ++tl) { const int kr0 = r0 + tl * 64;
        bf16x8 kc[KCH], vc[VCH]; float sf[KCH], sb[KCH];
#pragma unroll
        for (int i = 0; i < KCH; ++i) { const int cid = tid + 512 * i, row = cid / KPR, c8 = cid % KPR; kc[i] = *(const GAS bf16x8*)(P.k0 + (long)(kr0 + row) * P.ldk0 + c8 * 8);
            if constexpr (MODE == 1) { const int jj = tl * 64 + row; sf[i] = __builtin_amdgcn_exp2f((float)(256 - jj) * P.lf); sb[i] = __builtin_amdgcn_exp2f((float)jj * P.lb); }
            else { const f32x4 w = *(const GAS f32x4*)(P.ssdp + (size_t)(kr0 + row) * 32); sf[i] = __builtin_amdgcn_exp2f(cfe + w.y); sb[i] = __builtin_amdgcn_exp2f(rbs + w.w); } }
#pragma unroll
        for (int i = 0; i < VCH; ++i) { const int cid = tid + 512 * i, row = cid / VPR, c8 = cid % VPR; vc[i] = *(const GAS bf16x8*)(P.v + (long)(kr0 + row) * P.ldv + c8 * 8); }
#pragma unroll
        for (int i = 0; i < KCH; ++i) { const int cid = tid + 512 * i, row = cid / KPR, c8 = cid % KPR; v4u wf, wb;
            wf.x = cvtpk(bf2f((unsigned short)kc[i][0]) * sf[i], bf2f((unsigned short)kc[i][1]) * sf[i]); wf.y = cvtpk(bf2f((unsigned short)kc[i][2]) * sf[i], bf2f((unsigned short)kc[i][3]) * sf[i]);
            wf.z = cvtpk(bf2f((unsigned short)kc[i][4]) * sf[i], bf2f((unsigned short)kc[i][5]) * sf[i]); wf.w = cvtpk(bf2f((unsigned short)kc[i][6]) * sf[i], bf2f((unsigned short)kc[i][7]) * sf[i]);
            wb.x = cvtpk(bf2f((unsigned short)kc[i][0]) * sb[i], bf2f((unsigned short)kc[i][1]) * sb[i]); wb.y = cvtpk(bf2f((unsigned short)kc[i][2]) * sb[i], bf2f((unsigned short)kc[i][3]) * sb[i]);
            wb.z = cvtpk(bf2f((unsigned short)kc[i][4]) * sb[i], bf2f((unsigned short)kc[i][5]) * sb[i]); wb.w = cvtpk(bf2f((unsigned short)kc[i][6]) * sb[i], bf2f((unsigned short)kc[i][7]) * sb[i]);
            *(LAS v4u*)(Kf + v_st(row, c8 * 8)) = wf; *(LAS v4u*)(Kb + v_st(row, c8 * 8)) = wb; }
#pragma unroll
        for (int i = 0; i < VCH; ++i) { const int cid = tid + 512 * i, row = cid / VPR, c8 = cid % VPR; *(LAS bf16x8*)(Vt + v_st(row, c8 * 8)) = vc[i]; }
        __syncthreads();
#define ST_FR(vb, ks) ({ const s16x4 l_ = tr_read<v_rd_off(0, ks, 0)>(vb), h_ = tr_read<v_rd_off(0, ks, 1)>(vb); (bf16x8){l_[0], l_[1], l_[2], l_[3], h_[0], h_[1], h_[2], h_[3]}; })
        { const bf16x8 a0 = ST_FR(vbV, 0), a1 = ST_FR(vbV, 1), a2 = ST_FR(vbV, 2), a3 = ST_FR(vbV, 3);
          const bf16x8 f0 = ST_FR(vbF, 0), f1 = ST_FR(vbF, 1), f2 = ST_FR(vbF, 2), f3 = ST_FR(vbF, 3);
          const bf16x8 b0 = ST_FR(vbB, 0), b1 = ST_FR(vbB, 1), b2 = ST_FR(vbB, 2), b3 = ST_FR(vbB, 3);
          asm volatile("s_waitcnt lgkmcnt(0)" ::: "memory"); SBAR();
          accf = __builtin_amdgcn_mfma_f32_32x32x16_bf16(a0, f0, accf, 0, 0, 0); accf = __builtin_amdgcn_mfma_f32_32x32x16_bf16(a1, f1, accf, 0, 0, 0);
          accf = __builtin_amdgcn_mfma_f32_32x32x16_bf16(a2, f2, accf, 0, 0, 0); accf = __builtin_amdgcn_mfma_f32_32x32x16_bf16(a3, f3, accf, 0, 0, 0);
          accb = __builtin_amdgcn_mfma_f32_32x32x16_bf16(a0, b0, accb, 0, 0, 0); accb = __builtin_amdgcn_mfma_f32_32x32x16_bf16(a1, b1, accb, 0, 0, 0);
          accb = __builtin_amdgcn_mfma_f32_32x32x16_bf16(a2, b2, accb, 0, 0, 0); accb = __builtin_amdgcn_mfma_f32_32x32x16_bf16(a3, b3, accb, 0, 0, 0); }
#undef ST_FR
        __syncthreads();
    }
#pragma unroll
    for (int r = 0; r < 16; ++r) { const size_t e = (size_t)(32 * dvb + crow(r, hi)) * DK + 32 * dkb + r32;
        ST[e] = (bf16)f2bf(accf[r]); ST[(size_t)DV * DK + e] = (bf16)f2bf(accb[r]); }
}
#undef SBAR
}

namespace hyb {
constexpr int U_PITCH = 4112, U_BYTES = 16 * U_PITCH, FC_OFF = U_BYTES, FC_PITCH = 8256;
typedef float f32x4v __attribute__((ext_vector_type(4)));
__device__ __forceinline__ void hyena_unit(const AP& a, int layer, int c, unsigned char* ws, LAS unsigned char* lds, int tid) {
    asm volatile("" : "+v"(tid));
    const int wid = tid >> 6, lane = tid & 63, fr = lane & 15, fq = lane >> 4;
    const bf16* UT = (const bf16*)(ws + WS_UT); bf16* ZT = (bf16*)(ws + WS_ZT);
    LAS unsigned char* Ul = lds; LAS unsigned char* FC = lds + FC_OFF;
    const int ksh = (3 - fr) & 3;
    for (int o = 0; o < 2; ++o) {
        const bf16* G = (const bf16*)(ws + WS_HYG) + (((size_t)layer * 2 + o) * 512 + c) * HY_GLEN;
        for (int id = tid; id < HY_GLEN / 8; id += 512) *(LAS v4u*)(FC + id * 16) = *(const GAS v4u*)(G + id * 8);
        if (o == 0) {
#pragma unroll
            for (int i = 0; i < 8; ++i) { const int id = tid + 512 * i, b = id >> 8, t8 = id & 255;
                *(LAS v4u*)(Ul + b * U_PITCH + t8 * 16) = *(const GAS v4u*)(UT + ((size_t)c * NB + b) * SEQ + t8 * 8); } }
        __syncthreads();
        for (int idx = tid; idx < 4104; idx += 512) { const LAS bf16* g0 = (const LAS bf16*)FC + idx;
#pragma unroll
            for (int k = 1; k < 4; ++k) *(LAS bf16*)(FC + k * FC_PITCH + idx * 2) = g0[k]; }
        const bf16* X = UT + (((size_t)(1 + o) * 512 + c) * NB + fr) * SEQ;
        v2u xg[16];
#pragma unroll
        for (int al = 0; al < 16; ++al) xg[al] = *(const GAS v2u*)(X + 16 * (16 * wid + al) + 4 * fq);
        __syncthreads();
        f32x4v acc[16];
#pragma unroll
        for (int i = 0; i < 16; ++i) acc[i] = (f32x4v){0.f, 0.f, 0.f, 0.f};
        for (int kb = 0; kb < 8; ++kb) {
            bf16x8 bfr[8];
#pragma unroll
            for (int kl = 0; kl < 8; ++kl) bfr[kl] = *(const LAS bf16x8*)(Ul + fr * U_PITCH + ((kb * 8 + kl) * 32 + fq * 8) * 2);
            const int n0 = HY_OFF - 16 * (16 * wid - 16 * kb + 15) - fr + 8 * fq;
            const LAS unsigned char* ab = FC + ksh * FC_PITCH + (n0 - ksh) * 2;
#pragma unroll
            for (int hb = 0; hb < 2; ++hb) {
                v2u alo[15], ahi[15];
#pragma unroll
                for (int d = 0; d < 15; ++d) { alo[d] = *(const LAS v2u*)(ab + (29 - (hb * 15 + d)) * 32); ahi[d] = *(const LAS v2u*)(ab + (29 - (hb * 15 + d)) * 32 + 8); }
                LDS_WAIT(); __builtin_amdgcn_sched_barrier(0);
#pragma unroll
                for (int d = 0; d < 15; ++d) { const int ddrel = hb * 15 + d - 14;
                    const v4u w = {alo[d].x, alo[d].y, ahi[d].x, ahi[d].y}; const bf16x8 af = __builtin_bit_cast(bf16x8, w);
#pragma unroll
                    for (int kl = 0; kl < 8; ++kl) { const int al = ddrel + 2 * kl; if (al >= 0 && al < 16) acc[al] = __builtin_amdgcn_mfma_f32_16x16x32_bf16(af, bfr[kl], acc[al], 0, 0, 0); }
                }
                __builtin_amdgcn_sched_barrier(0);
            }
        }
        __syncthreads();
        const float bias = a.in(I_HYBIAS)[(layer * 2 + o) * 512 + c];
#pragma unroll
        for (int al = 0; al < 16; ++al) { const int t = 16 * (16 * wid + al) + 4 * fq;
            const v2u uu = *(const LAS v2u*)(Ul + fr * U_PITCH + t * 2); const v2u xx = xg[al];
            const float r0 = bflo(xx.x) * (acc[al][0] + bflo(uu.x) * bias), r1 = bfhi(xx.x) * (acc[al][1] + bfhi(uu.x) * bias);
            const float r2 = bflo(xx.y) * (acc[al][2] + bflo(uu.y) * bias), r3 = bfhi(xx.y) * (acc[al][3] + bfhi(uu.y) * bias);
            v2u z; z.x = pk2(r0, r1); z.y = pk2(r2, r3);
            if (o == 0) *(LAS v2u*)(Ul + fr * U_PITCH + t * 2) = z;
            else *(GAS v2u*)(ZT + ((size_t)c * NB + fr) * SEQ + t) = z; }
        __syncthreads();
    }
}
}

constexpr int N_PHASES = 26;
#ifndef MK_CUTS
#define MK_CUTS 0
#endif
#ifndef MIXSKIP
#define MIXSKIP 0
#endif
#ifndef MOE_CHECK
#define MOE_CHECK 0
#endif
#ifndef ONLYKIND
#define ONLYKIND -1
#endif
#define KSEL(kind) (ONLYKIND < 0 || ONLYKIND == (kind))
#define IN(k) (LO <= (k) && (k) < HI)
#define INK(k, kind) (KSEL(kind) && LO <= (k) && (k) < HI)
struct Ids { int wave0, G0, bx0, vcu0; };
#define PH_LOCALS int wave = ids.wave0, G = ids.G0, bx = ids.bx0, vcu = ids.vcu0; asm volatile("" : "+s"(wave), "+s"(G), "+s"(bx), "+s"(vcu)); \
    int tid; asm volatile("v_mbcnt_lo_u32_b32 %0, -1, 0\n\tv_mbcnt_hi_u32_b32 %0, -1, %0" : "=v"(tid)); tid += wave * 64; \
    const int lane = tid & 63, gw = wave * G + vcu, NGW = G * NWAVES; LAS float* wscr = (LAS float*)(lds + RING_OFF + wave * 16384); (void)lane; (void)gw; (void)NGW; (void)wscr; (void)bx; \
    const AP args = kargs(); unsigned char* ws = args.ws(); float* XRES = args.out(); bf16* XB = (bf16*)(ws + WS_XB); gu32* ctl = (gu32*)(ws + WS_CTL); (void)XRES; (void)XB; (void)ctl;
#ifndef PROBE_SCALE
#define PROBE_SCALE 0.0025f
#endif
#ifndef TIMING_PROBE
#define TIMING_PROBE 0
#endif
#ifndef PROBE_A0
#define PROBE_A0 0
#define PROBE_A1 1
#define PROBE_B0 1
#define PROBE_B1 2
#endif
#if TIMING_PROBE
#define STAMP(idx) do { if (ids.bx0 == 0 && threadIdx.x == 0) ((volatile LAS unsigned*)(lds + MISC_OFF))[16 + (idx)] = (unsigned)wall_clock64(); } while (0)
#else
#define STAMP(idx) do { } while (0)
#endif
#define SEAM(k) do { if constexpr (IN(k) && IN((k) + 1)) { XcdBarrier bb_ = bar; asm volatile("" : "+s"(bb_.bar), "+s"(bb_.x)); xcd_barrier(bb_); } STAMP((k) + 1); } while (0)

template <int LAYER, int LO, int HI>
__device__ __forceinline__ void layer_phases(LAS unsigned char* lds, const XcdBarrier& bar, const Ids& ids) {
    constexpr int layer = LAYER, pb = 1 + LAYER * 10;
    if constexpr (INK(pb + 0, 1)) { PH_LOCALS
        pg8::Gemm g{XB, (const bf16*)(ws + WS_WIN + layer * SZ_WIN), M, NINP, DM}; pg8::StaticOrder S; S.init(M, NINP, G, bx);
        pg8::EpiBf16 E{(bf16*)(ws + WS_PROJ), NINP, (float*)(ws + WS_DTF), C_DT};
        pg8::gemm_phase<pg8::EpiBf16, pg8::StaticOrder, true, true>(lds + RING_OFF, g, S, E, tid);
    }
    SEAM(pb + 0);
    if constexpr (INK(pb + 1, 2)) { PH_LOCALS
        LAS float* cwl = (LAS float*)(lds + RING_OFF);
        for (int i = tid; i < 6 * 1024; i += NWAVES * 64) cwl[i] = i < 5 * 1024 ? args.in(I_CONVW)[layer * 5 * 1024 + i] : args.in(I_CONVB)[layer * 1024 + i - 5 * 1024];
        __syncthreads();
        LAS float* pscr = (LAS float*)(lds + RING_OFF + 32768 + wave * 12288);
        for (int it = gw; it < M / 8; it += NGW) prep_rows8(args, layer, it, lane, ws, cwl);
        for (int it = gw; it < 256; it += NGW) prep_scan(args, layer, it, lane, ws, pscr);
        for (int it = gw; it < NB * 32 * 24; it += NGW) prep_hyconv(args, layer, it, lane, ws, (LAS bf16*)pscr);
        __syncthreads();
    }
    SEAM(pb + 1);
    if constexpr (INK(pb + 2, 3)) {
        { PH_LOCALS pg8::Gemm g{(const bf16*)(ws + WS_QN), (const bf16*)(ws + WS_WUQ + layer * SZ_WUQ), M, 768, 384}; pg8::StaticOrder S; S.init(M, 768, G, bx);
          pg8::EpiBf16 E{(bf16*)(ws + WS_QB), 768, nullptr, 0};
          pg8::gemm_phase<pg8::EpiBf16, pg8::StaticOrder, true, true>(lds + RING_OFF, g, S, E, tid); }
        { PH_LOCALS pg8::Gemm g{(const bf16*)(ws + WS_KVN), (const bf16*)(ws + WS_WUKV + layer * SZ_WUKV), M, 1024, 256}; pg8::StaticOrder S; S.init(M, 1024, G, bx);
          pg8::EpiBf16 E{(bf16*)(ws + WS_KVB), 1024, nullptr, 0};
          pg8::gemm_phase<pg8::EpiBf16, pg8::StaticOrder, true, true>(lds + RING_OFF, g, S, E, tid); }
#if FARFIELD
        { PH_LOCALS for (int u = vcu; u < NB * 4 * 8; u += G) { const int b = u >> 5, h = (u >> 3) & 3, Bk = u & 7; const size_t r0 = (size_t)b * SEQ;
            mixb::MixP P{}; P.k0 = (const bf16*)(ws + WS_RK) + r0 * 256 + h * 64; P.ldk0 = 256; P.v = (const bf16*)(ws + WS_PROJ) + r0 * NINP + C_RV + h * 128; P.ldv = NINP;
            P.lf = log2f(1.0f - exp2f(-5.0f - (float)h)); P.lb = log2f(1.0f - exp2f(-5.5f - (float)h));
            mixb::state_unit<1, 64, 128>(P, Bk, (bf16*)(ws + WS_STR) + ((size_t)(b * 4 + h) * 8 + Bk) * 2 * 8192, lds + RING_OFF, tid); } }
        { PH_LOCALS for (int u = vcu; u < NB * 8 * 8; u += G) { const int b = u >> 6, hh = (u >> 3) & 7, Bk = u & 7, gq = hh >> 2; const size_t r0 = (size_t)b * SEQ;
            mixb::MixP P{}; const bf16* XBC = (const bf16*)(ws + WS_XBC) + r0 * 1024; P.k0 = XBC + 512 + gq * 128; P.ldk0 = 1024; P.v = XBC + hh * 64; P.ldv = 1024;
            P.ssdp = (const float*)(ws + WS_SSDP) + r0 * 32 + hh * 4;
            mixb::state_unit<2, 128, 64>(P, Bk, (bf16*)(ws + WS_STS) + ((size_t)(b * 8 + hh) * 8 + Bk) * 2 * 8192, lds + RING_OFF, tid); } }
#endif
    }
    SEAM(pb + 2);
    if constexpr (IN(pb + 3)) {
        if constexpr (KSEL(40)) { PH_LOCALS for (int u = vcu; u < NB * 4 * 8; u += G) { const int b = u >> 5, h = (u >> 3) & 3, qb = u & 7; const size_t r0 = (size_t)b * SEQ;
            mixb::MixP P{}; P.q = (const bf16*)(ws + WS_QB) + r0 * 768 + h * 192; P.ldq = 768; P.k0 = (const bf16*)(ws + WS_KVB) + r0 * 1024 + h * 256; P.ldk0 = 1024;
            P.k1 = (const bf16*)(ws + WS_KPE) + r0 * 64; P.ldk1 = 64; P.v = (const bf16*)(ws + WS_KVB) + r0 * 1024 + h * 256 + 128; P.ldv = 1024;
            P.o = (bf16*)(ws + WS_ATT) + r0 * 512 + h * 128; P.ldo = 512;
            mixb::mix_unit<0, 192, 128>(P, qb * 256, lds + RING_OFF, tid); } }
        STAMP(32 + LAYER * 4 + 0);
        if constexpr (KSEL(41)) { PH_LOCALS for (int u = vcu; u < NB * 4 * 8; u += G) { const int rnd = u / G; const int b = u >> 5, h0 = (u >> 3) & 3, h = (rnd & 1) ? 3 - h0 : h0, qb = u & 7; const size_t r0 = (size_t)b * SEQ;
            mixb::MixP P{}; P.q = (const bf16*)(ws + WS_RQ) + r0 * 256 + h * 64; P.ldq = 256; P.k0 = (const bf16*)(ws + WS_RK) + r0 * 256 + h * 64; P.ldk0 = 256; P.k1 = P.k0; P.ldk1 = 256;
            P.v = (const bf16*)(ws + WS_PROJ) + r0 * NINP + C_RV + h * 128; P.ldv = NINP; P.aux = (const bf16*)(ws + WS_PROJ) + r0 * NINP + C_RG + h * 128; P.ldaux = NINP;
            P.o = (bf16*)(ws + WS_MIX) + r0 * DM + 512 + h * 128; P.ldo = DM;
            P.lf = log2f(1.0f - exp2f(-5.0f - (float)h)); P.lb = log2f(1.0f - exp2f(-5.5f - (float)h)); P.st = (const bf16*)(ws + WS_STR) + (size_t)(b * 4 + h) * 8 * 2 * 8192;
            mixb::mix_unit<1, 64, 128>(P, qb * 256, lds + RING_OFF, tid); } }
        STAMP(32 + LAYER * 4 + 1);
        if constexpr (KSEL(42)) { PH_LOCALS for (int u = vcu; u < NB * 8 * 8; u += G) { const int rnd = u / G; const int b = u >> 6, hh = (((u >> 3) & 7) + 2 * rnd) & 7, qb = u & 7, gq = hh >> 2; const size_t r0 = (size_t)b * SEQ;
            mixb::MixP P{}; const bf16* XBC = (const bf16*)(ws + WS_XBC) + r0 * 1024;
            P.q = XBC + 768 + gq * 128; P.ldq = 1024; P.k0 = XBC + 512 + gq * 128; P.ldk0 = 1024; P.k1 = P.k0; P.ldk1 = 1024; P.v = XBC + hh * 64; P.ldv = 1024; P.aux = P.v; P.ldaux = 1024;
            P.ssdp = (const float*)(ws + WS_SSDP) + r0 * 32 + hh * 4; P.dh = args.in(I_SSDD)[layer * 8 + hh];
            P.o = (bf16*)(ws + WS_YC) + r0 * 512 + hh * 64; P.ldo = 512; P.st = (const bf16*)(ws + WS_STS) + (size_t)(b * 8 + hh) * 8 * 2 * 8192;
            mixb::mix_unit<2, 128, 64>(P, qb * 256, lds + RING_OFF, tid); } }
        STAMP(32 + LAYER * 4 + 2);
        if constexpr (KSEL(43)) { PH_LOCALS for (int u = vcu; u < 512; u += G) hyb::hyena_unit(args, layer, u, ws, lds + RING_OFF, tid); }
        STAMP(32 + LAYER * 4 + 3);
    }
    SEAM(pb + 3);
    if constexpr (INK(pb + 4, 5)) { PH_LOCALS
        for (int m = gw; m < M; m += NGW) post_row(args, layer, m, lane, ws);
        for (int it = gw; it < NB * 128; it += NGW) post_hy(args, layer, it, lane, ws, (LAS bf16*)wscr);
    }
    SEAM(pb + 4);
    if constexpr (INK(pb + 5, 6)) { PH_LOCALS
        pg8::Gemm g{(const bf16*)(ws + WS_MIX), (const bf16*)(ws + WS_WOUT + layer * SZ_WOUT), M, DM, DM}; pg8::StaticOrder S; S.init(M, DM, G, bx);
        pg8::EpiResF32 E{LAYER == 0 ? args.in(I_X) : (const float*)XRES, XRES, DM, ALPHA, 1.f};
        pg8::gemm_phase<pg8::EpiResF32, pg8::StaticOrder, true, true>(lds + RING_OFF, g, S, E, tid);
    }
    SEAM(pb + 5);
    if constexpr (INK(pb + 6, 7)) { PH_LOCALS
        const float* gG = args.in(I_LN1G) + layer * DM; const float* gB = args.in(I_LN1B) + layer * DM;
        if constexpr (LAYER == 1) {
            LAS float* WrT = (LAS float*)(lds + RING_OFF);
            for (int i = tid; i < DM * NEXP; i += NWAVES * 64) WrT[(i & 7) * DM + (i >> 3)] = args.in(I_ROUTER)[i];
            for (int i = bx * NWAVES * 64 + tid; i < CAP_ROWS; i += G * NWAVES * 64) ((int*)(ws + WS_SLOT))[i] = -1;
            LAS unsigned* lcnt = (LAS unsigned*)(lds + RING_OFF + 65536); LAS unsigned* lbase = lcnt + 8; LAS int* lrec = (LAS int*)(lcnt + 16);
            if (tid < 16) lcnt[tid] = 0u;
            __syncthreads();
            int nrow = 0;
            f32x4 nv[8]; if (gw < M) ln_load(XRES + (size_t)gw * DM, lane, nv);
            for (int m = gw; m < M; m += NGW) { f32x4 v[8];
#pragma unroll
                for (int j = 0; j < 8; ++j) v[j] = nv[j];
                if (m + NGW < M) ln_load(XRES + (size_t)(m + NGW) * DM, lane, nv);
                ln_row(XRES + (size_t)m * DM, XB + (size_t)m * DM, gG, gB, lane, v, nullptr, nullptr, XRES + (size_t)m * DM);
                float lg[8];
#pragma unroll
                for (int e = 0; e < 8; ++e) { float s = 0.f;
#pragma unroll
                    for (int j = 0; j < 8; ++j) { const f32x4 w = *((const LAS f32x4*)(WrT + e * DM) + lane + 64 * j); s += (v[j].x * w.x + v[j].y * w.y) + (v[j].z * w.z + v[j].w * w.w); }
                    lg[e] = wave_sum(s); __builtin_amdgcn_sched_barrier(0); }
                int e0 = 0; float v0 = lg[0];
#pragma unroll
                for (int e = 1; e < 8; ++e) if (lg[e] > v0) { v0 = lg[e]; e0 = e; }
                int e1 = -1; float v1 = -3.0e38f;
#pragma unroll
                for (int e = 0; e < 8; ++e) if (e != e0 && lg[e] > v1) { v1 = lg[e]; e1 = e; }
                if (lane == 0) { const float ex = __expf(v1 - v0); const float g0 = 1.0f / (1.0f + ex), g1 = ex / (1.0f + ex);
                    const int p0 = (int)__hip_atomic_fetch_add(lcnt + e0, 1u, __ATOMIC_RELAXED, __HIP_MEMORY_SCOPE_WORKGROUP), p1 = (int)__hip_atomic_fetch_add(lcnt + e1, 1u, __ATOMIC_RELAXED, __HIP_MEMORY_SCOPE_WORKGROUP);
                    LAS int* rec = lrec + (wave * 64 + nrow) * 4; rec[0] = e0; rec[1] = e1; rec[2] = p0; rec[3] = p1;
                    float* rg = (float*)(ws + WS_RTG) + (size_t)m * 2; rg[0] = g0; rg[1] = g1; }
                ++nrow; }
            __syncthreads();
            if (tid < NEXP) lbase[tid] = atomicAdd((unsigned*)(ctl + CW_CNT + tid), lcnt[tid]);
            __syncthreads();
            { int r = 0; for (int m = gw; m < M; m += NGW, ++r) if (lane == 0) { const LAS int* rec = lrec + (wave * 64 + r) * 4; const int e0 = rec[0], e1 = rec[1];
                int* rt = (int*)(ws + WS_RT) + (size_t)m * 4; rt[0] = e0; rt[1] = e1; rt[2] = rec[2] + (int)lbase[e0]; rt[3] = rec[3] + (int)lbase[e1]; } }
            __syncthreads();
        } else {
            f32x4 nv[8]; if (gw < M) ln_load(XRES + (size_t)gw * DM, lane, nv);
            for (int m = gw; m < M; m += NGW) { f32x4 v[8];
#pragma unroll
                for (int j = 0; j < 8; ++j) v[j] = nv[j];
                if (m + NGW < M) ln_load(XRES + (size_t)(m + NGW) * DM, lane, nv);
                ln_row(XRES + (size_t)m * DM, XB + (size_t)m * DM, gG, gB, lane, v, nullptr, nullptr, XRES + (size_t)m * DM, ws + WS_XF8 + (size_t)m * DM); }
        }
    }
    SEAM(pb + 6);
    if constexpr (LAYER == 0) {
        if constexpr (INK(8, 8)) { PH_LOCALS
            pg8::Gemm g{(const bf16*)(ws + WS_XF8), (const bf16*)(ws + WS_WGU), M, 2 * DFF, DM}; pg8::StaticOrder S; S.init(M, 2 * DFF, G, bx);
            pg8::EpiSwigluF8 E{ws + WS_HID, DFF};
            pg8::gemm_phase_f8<pg8::EpiSwigluF8, pg8::StaticOrder, true, true>(lds + RING_OFF, g, S, E, tid, 0x79797979, 0x7f7f7f7f);
        }
        SEAM(8);
        if constexpr (INK(9, 9)) { PH_LOCALS
            pg8::Gemm g{(const bf16*)(ws + WS_HID), (const bf16*)(ws + WS_WDN), M, DM, DFF}; pg8::StaticOrder S; S.init(M, DM, G, bx);
            pg8::EpiResF32 E{XRES, XRES, DM, ALPHA, ZERO_FFN ? 0.f : 1.f};
            pg8::gemm_phase_f8<pg8::EpiResF32, pg8::StaticOrder, true, true>(lds + RING_OFF, g, S, E, tid, 0x77777777, 0x7f7f7f7f);
        }
        SEAM(9);
        if constexpr (INK(10, 10)) { PH_LOCALS
            const float* gG = args.in(I_LN2G); const float* gB = args.in(I_LN2B);
            f32x4 nv[8]; if (gw < M) ln_load(XRES + (size_t)gw * DM, lane, nv);
            for (int m = gw; m < M; m += NGW) { f32x4 v[8];
#pragma unroll
                for (int j = 0; j < 8; ++j) v[j] = nv[j];
                if (m + NGW < M) ln_load(XRES + (size_t)(m + NGW) * DM, lane, nv);
                ln_row(XRES + (size_t)m * DM, XB + (size_t)m * DM, gG, gB, lane, v, nullptr, nullptr, XRES + (size_t)m * DM); }
        }
        SEAM(10);
    }
}

template <int CH, int LO, int HI>
__device__ __forceinline__ void moe_chunk(LAS unsigned char* lds, const XcdBarrier& bar, const Ids& ids) {
    if constexpr (INK(19 + 2 * CH, 19)) { PH_LOCALS
        pg8::MoeOrder S; int acc = 0;
#pragma unroll
        for (int e = 0; e < 8; ++e) { const int c = (int)__hip_atomic_load(ctl + CW_CNT + e, RLX_AGENT); acc += (c + 255) / 256 * 256; S.pend[e] = acc; }
        const int nrb = acc / 256; const int rb0 = CH * MOE_CH_RB; int nrbc = nrb - rb0; nrbc = nrbc < 0 ? 0 : (nrbc > MOE_CH_RB ? MOE_CH_RB : nrbc);
        pg8::Gemm g{(const bf16*)(ws + WS_XS + (size_t)rb0 * 256 * DM), (const bf16*)(ws + WS_MGU), nrbc * 256, 2 * DFFE, DM};
        S.so.init(nrbc * 256, 2 * DFFE, G, bx); S.rb0 = rb0; S.bstride = (long)2 * DFFE * DM;
        pg8::EpiSwigluF8 E{ws + WS_HIDS, DFFE};
        pg8::gemm_phase_f8<pg8::EpiSwigluF8, pg8::MoeOrder, true, true>(lds + RING_OFF, g, S, E, tid, 0x79797979, 0x7f7f7f7f);
    }
    SEAM(19 + 2 * CH);
    if constexpr (INK(20 + 2 * CH, 20)) { PH_LOCALS
        pg8::MoeOrder S; int acc = 0;
#pragma unroll
        for (int e = 0; e < 8; ++e) { const int c = (int)__hip_atomic_load(ctl + CW_CNT + e, RLX_AGENT); acc += (c + 255) / 256 * 256; S.pend[e] = acc; }
        const int nrb = acc / 256; const int rb0 = CH * MOE_CH_RB; int nrbc = nrb - rb0; nrbc = nrbc < 0 ? 0 : (nrbc > MOE_CH_RB ? MOE_CH_RB : nrbc);
        pg8::Gemm g{(const bf16*)(ws + WS_HIDS), (const bf16*)(ws + WS_MDN), nrbc * 256, DM, DFFE};
        S.so.init(nrbc * 256, DM, G, bx); S.rb0 = rb0; S.bstride = (long)DM * DFFE;
        pg8::EpiMoeDown E{(bf16*)(ws + WS_Y0), (long)((WS_Y1 - WS_Y0) / 2), DM, (const int*)(ws + WS_SLOT), (const float*)(ws + WS_SLOTG), rb0 * 256};
        pg8::gemm_phase_f8<pg8::EpiMoeDown, pg8::MoeOrder, true, true>(lds + RING_OFF, g, S, E, tid, 0x77777777, 0x7f7f7f7f);
    }
    SEAM(20 + 2 * CH);
}

template <int LO, int HI>
__global__ void __launch_bounds__(NWAVES * 64, 2) mk_fwd(Args args_unused, int li) {
    extern __shared__ __attribute__((aligned(16))) unsigned char lds_raw[];
    LAS unsigned char* lds = (LAS unsigned char*)lds_raw;
    volatile LAS unsigned* MISC = (volatile LAS unsigned*)(lds + MISC_OFF);
    Ids ids; { const int tid0 = threadIdx.x; ids.wave0 = __builtin_amdgcn_readfirstlane(tid0 >> 6); ids.G0 = gridDim.x; ids.bx0 = blockIdx.x;
        ids.vcu0 = (ids.G0 % 8 == 0) ? (ids.bx0 % 8) * (ids.G0 / 8) + ids.bx0 / 8 : ids.bx0;
        for (int u = tid0; u < (LDS_BYTES - LDSCTL_OFF) / 4; u += NWAVES * 64) ((LAS unsigned*)(lds + LDSCTL_OFF))[u] = 0u; }
    __syncthreads();
    XcdBarrier bar; bar.bar = nullptr; bar.x = 0; bar.st = nullptr;
    if constexpr (HI - LO > 1) { const AP a0 = kargs(); bar = xcd_barrier_post((unsigned*)((gu32*)(a0.ws() + WS_CTL) + CW_BAR) + li * XCD_BAR_WORDS, MISC + 8); }

    STAMP(0);
    if constexpr (INK(0, 0)) { PH_LOCALS
        constexpr int I_WIN_ = 32 * (NINP / 32), I_UQ = 6 * 24, I_UKV = 4 * 32, I_OUT = 32 * 64, I_GU = 32 * (DFF / 32), I_DN = (DFF / 64) * 64;
        constexpr int NIT = 2 * I_WIN_ + 2 * I_UQ + 2 * I_UKV + 2 * I_OUT + 2 * I_GU + I_DN;
        for (int it = gw; it < NIT; it += NGW) { int r = it;
#define TRJ(n, W, K, N, NP, WT, GR, GS, OFF) if (r < (n)) { transpose_item((W), (K), (N), (NP) / 32, (bf16*)(WT), (GR), (GS), (OFF), wscr, r, lane); continue; } r -= (n);
            TRJ(I_WIN_, args.in(I_WIN), DM, NIN, NINP, ws + WS_WIN, 1 << 30, 0, 0)
            TRJ(I_WIN_, args.in(I_WIN) + (size_t)DM * NIN, DM, NIN, NINP, ws + WS_WIN + SZ_WIN, 1 << 30, 0, 0)
            TRJ(I_UQ, args.in(I_WUQ), 384, 768, 768, ws + WS_WUQ, 1 << 30, 0, 0)
            TRJ(I_UQ, args.in(I_WUQ) + 384 * 768, 384, 768, 768, ws + WS_WUQ + SZ_WUQ, 1 << 30, 0, 0)
            TRJ(I_UKV, args.in(I_WUKV), 256, 1024, 1024, ws + WS_WUKV, 1 << 30, 0, 0)
            TRJ(I_UKV, args.in(I_WUKV) + 256 * 1024, 256, 1024, 1024, ws + WS_WUKV + SZ_WUKV, 1 << 30, 0, 0)
            TRJ(I_OUT, args.in(I_WOUT), DM, DM, DM, ws + WS_WOUT, 1 << 30, 0, 0)
            TRJ(I_OUT, args.in(I_WOUT) + (size_t)DM * DM, DM, DM, DM, ws + WS_WOUT + SZ_WOUT, 1 << 30, 0, 0)
            if (r < I_GU) { transpose_item_f8(args.in(I_FFG), DM, DFF, DFF / 32, ws + WS_WGU, 128, 256, 0, 64.0f, wscr, r, lane); continue; } r -= I_GU;
            if (r < I_GU) { transpose_item_f8(args.in(I_FFU), DM, DFF, DFF / 32, ws + WS_WGU, 128, 256, 128, 64.0f, wscr, r, lane); continue; } r -= I_GU;
            transpose_item_f8(args.in(I_FFD), DFF, DM, DM / 32, ws + WS_WDN, 1 << 30, 0, 0, 256.0f, wscr, r, lane);
#undef TRJ
        }
        for (int m = gw; m < M; m += NGW) { const GAS f32x4* xr = (const GAS f32x4*)(args.in(I_X) + (size_t)m * DM) + lane; GAS v2u* xb = (GAS v2u*)(XB + (size_t)m * DM) + lane;
#pragma unroll
            for (int j = 0; j < 8; ++j) { const f32x4 v = xr[64 * j]; v2u w; w.x = pk2(v.x, v.y); w.y = pk2(v.z, v.w); xb[64 * j] = w; } }
        for (int it = gw; it < 2 * SEQ; it += NGW) hyena_filter_item(args, it >> 11, it & (SEQ - 1), (bf16*)(ws + WS_HYG), wscr, lane);
    }
    SEAM(0);
    layer_phases<0, LO, HI>(lds, bar, ids);
    layer_phases<1, LO, HI>(lds, bar, ids);
    if constexpr (INK(18, 18)) { PH_LOCALS
        auto mkjob = [&](int it, TrF8& j, int& r) { const int job = it / 7168, e = job / 3, kind = job - e * 3; r = it - job * 7168;
            if (kind < 2) j = TrF8{args.in(kind == 0 ? I_MOEG : I_MOEU) + (size_t)e * DM * DFFE, DM, DFFE, DFFE / 32, ws + WS_MGU + (size_t)e * 2 * DFFE * DM, 128, 256, kind * 128, 64.0f};
            else j = TrF8{args.in(I_MOED) + (size_t)e * DFFE * DM, DFFE, DM, DM / 32, ws + WS_MDN + (size_t)e * DM * DFFE, 1 << 30, 0, 0, 256.0f}; };
        for (int it = gw; it < 24 * 7168; it += 2 * NGW) { TrF8 ja, jb; int ra, rb; float ta[32], tb[32]; const bool hb = it + NGW < 24 * 7168;
            mkjob(it, ja, ra); tr_f8_load(ja, ra, lane, ta);
            if (hb) { mkjob(it + NGW, jb, rb); tr_f8_load(jb, rb, lane, tb); }
            tr_f8_finish(ja, ra, lane, ta, wscr);
            if (hb) tr_f8_finish(jb, rb, lane, tb, wscr); }
        int pst[8]; { int acc = 0;
#pragma unroll
            for (int e = 0; e < 8; ++e) { pst[e] = acc; const int c = (int)__hip_atomic_load(ctl + CW_CNT + e, RLX_AGENT); acc += (c + 255) / 256 * 256; } }
        for (int it = gw; it < 2 * M; it += NGW) { const int tok = it >> 1, k = it & 1; const int* rt = (const int*)(ws + WS_RT) + (size_t)tok * 4; const int e = rt[k], pos = rt[2 + k];
            int base = 0;
#pragma unroll
            for (int j = 0; j < 8; ++j) base = (e == j) ? pst[j] : base;
            const int slot = base + pos;
            const GAS v4u* src = (const GAS v4u*)(XB + (size_t)tok * DM) + lane; GAS v2u* dst = (GAS v2u*)(ws + WS_XS + (size_t)slot * DM) + lane;
#pragma unroll
            for (int j = 0; j < 4; ++j) { const v4u w = src[64 * j]; v2u o; o.x = pk4_fp8(bflo(w.x), bfhi(w.x), bflo(w.y), bfhi(w.y)); o.y = pk4_fp8(bflo(w.z), bfhi(w.z), bflo(w.w), bfhi(w.w)); dst[64 * j] = o; }
            if (lane == 0) { ((int*)(ws + WS_SLOT))[slot] = tok * 2 + k; ((float*)(ws + WS_SLOTG))[slot] = ((const float*)(ws + WS_RTG))[(size_t)tok * 2 + k]; } }
    }
    SEAM(18);
    moe_chunk<0, LO, HI>(lds, bar, ids);
    SEAM(21); SEAM(22); SEAM(23); SEAM(24);
    if constexpr (INK(25, 25)) { PH_LOCALS
#if MOE_CHECK
        { LAS float* xs = (LAS float*)(lds + RING_OFF); LAS float* hid = xs + DM; LAS float* red = hid + DFFE;
          for (int smp = bx; smp < 48; smp += G) { const int tok = (smp * 683 + 5) % M;
            for (int d = tid; d < DM; d += 512) xs[d] = bf2f(XB[(size_t)tok * DM + d]);
            __syncthreads();
            float accv[4] = {0.f, 0.f, 0.f, 0.f};
            for (int kk = 0; kk < 2; ++kk) { const int e = ((const int*)(ws + WS_RT))[(size_t)tok * 4 + kk]; const float gt = ((const float*)(ws + WS_RTG))[(size_t)tok * 2 + kk];
                const float* Wg = args.in(I_MOEG) + (size_t)e * DM * DFFE; const float* Wu = args.in(I_MOEU) + (size_t)e * DM * DFFE; const float* Wd = args.in(I_MOED) + (size_t)e * DFFE * DM;
                for (int j = tid; j < DFFE; j += 512) { float a = 0.f, b = 0.f; for (int d = 0; d < DM; ++d) { const float xv = xs[d]; a += xv * Wg[(size_t)d * DFFE + j]; b += xv * Wu[(size_t)d * DFFE + j]; } hid[j] = (a / (1.0f + __expf(-a))) * b; }
                __syncthreads();
                for (int q = 0; q < 4; ++q) { const int c = tid + 512 * q; float o = 0.f; for (int j = 0; j < DFFE; ++j) o += hid[j] * Wd[(size_t)j * DM + c]; accv[q] += gt * o; }
                __syncthreads(); }
            float num = 0.f, den = 0.f;
            for (int q = 0; q < 4; ++q) { const int c = tid + 512 * q; const float mine = bf2f(((const bf16*)(ws + WS_Y0))[(size_t)tok * DM + c]) + bf2f(((const bf16*)(ws + WS_Y1))[(size_t)tok * DM + c]); const float df = accv[q] - mine; num += df * df; den += accv[q] * accv[q]; }
            num = wave_sum(num); den = wave_sum(den); if (lane == 0) { red[wave * 2] = num; red[wave * 2 + 1] = den; }
            __syncthreads();
            if (tid == 0) { float n = 0.f, dn = 0.f; for (int w = 0; w < 8; ++w) { n += red[w * 2]; dn += red[w * 2 + 1]; } const float rel = n / (dn + 1e-20f); atomicMax((unsigned*)(ctl + 80), __float_as_uint(rel)); }
            if (wave == 0) { float lg[8]; for (int e = 0; e < 8; ++e) { float s = 0.f; for (int d = lane; d < DM; d += 64) s += xs[d] * args.in(I_ROUTER)[d * 8 + e]; lg[e] = wave_sum(s); }
                int e0 = 0; for (int e = 1; e < 8; ++e) if (lg[e] > lg[e0]) e0 = e; int e1 = -1; for (int e = 0; e < 8; ++e) if (e != e0 && (e1 < 0 || lg[e] > lg[e1])) e1 = e;
                const float ex = __expf(lg[e1] - lg[e0]); const float g0 = 1.f / (1.f + ex);
                const int* rt = (const int*)(ws + WS_RT) + (size_t)tok * 4; const float* rg = (const float*)(ws + WS_RTG) + (size_t)tok * 2;
                const bool bad = (rt[0] != e0) || (rt[1] != e1) || fabsf(rg[0] - g0) > 0.03f || fabsf(rg[0] + rg[1] - 1.f) > 1e-3f;
                if (lane == 0 && bad) atomicAdd((unsigned*)(ctl + 81), 1u); }
            __syncthreads(); } }
        __syncthreads();
        { XcdBarrier bb_ = bar; (void)bb_; }
#endif
        const float* gG = args.in(I_LN2G) + DM; const float* gB = args.in(I_LN2B) + DM;
        f32x4 nv[8]; if (gw < M) ln_load(XRES + (size_t)gw * DM, lane, nv);
        for (int m = gw; m < M; m += NGW) { f32x4 v[8];
#pragma unroll
            for (int j = 0; j < 8; ++j) v[j] = nv[j];
            if (m + NGW < M) ln_load(XRES + (size_t)(m + NGW) * DM, lane, nv);
            ln_row(XRES + (size_t)m * DM, nullptr, gG, gB, lane, v, (const bf16*)(ws + WS_Y0) + (size_t)m * DM, (const bf16*)(ws + WS_Y1) + (size_t)m * DM, XRES + (size_t)m * DM); }
#if TIMING_PROBE
        { XcdBarrier bb_ = bar; asm volatile("" : "+s"(bb_.bar), "+s"(bb_.x)); xcd_barrier(bb_); }
        STAMP(26);
        __syncthreads();
        if (bx == 0) { volatile LAS unsigned* T = (volatile LAS unsigned*)(lds + MISC_OFF) + 16;
            const float t1 = (float)(T[PROBE_A1] - T[PROBE_A0]) * 0.01f, t2 = (float)(T[PROBE_B1] - T[PROBE_B0]) * 0.01f;
            if (tid == 0) XRES[12345] = t1 * PROBE_SCALE + 0.f * t2; }
#endif
#if MOE_CHECK
        __syncthreads(); VM_WAIT();
        if (tid == 0) { __builtin_amdgcn_fence(__ATOMIC_RELEASE, "agent"); const unsigned old_ = atomicAdd((unsigned*)(ctl + 82), 1u); ((volatile LAS unsigned*)(lds + MISC_OFF))[12] = (old_ + 1u == (unsigned)G) ? 1u : 0u; }
        __syncthreads();
        if (((volatile LAS unsigned*)(lds + MISC_OFF))[12]) { __builtin_amdgcn_fence(__ATOMIC_ACQUIRE, "agent");
            const float rel = __uint_as_float(__hip_atomic_load(ctl + 80, RLX_AGENT)); const unsigned nbad = __hip_atomic_load(ctl + 81, RLX_AGENT);
            float code = 0.f; if (rel > 0.03f) code += 10.f; if (rel > 0.3f) code += 10.f; if (nbad > 2u) code += 40.f; if (nbad > 8u) code += 40.f;
            if (code > 0.f) for (size_t i = tid; i < (size_t)M * DM; i += 512) XRES[i] = code; }
#endif
    }
}
#undef IN
#undef INK
#undef SEAM
#undef STAMP

template <int LO, int HI> static void launch_range(int grid, const Args& a, int li, hipStream_t stream) {
    static bool attr = false;
    if (!attr) { if (hipFuncSetAttribute((const void*)mk_fwd<LO, HI>, hipFuncAttributeMaxDynamicSharedMemorySize, LDS_BYTES) != hipSuccess) fprintf(stderr, "kernel_launch: hipFuncSetAttribute failed\n"); attr = true; }
    hipLaunchKernelGGL((mk_fwd<LO, HI>), dim3(grid), dim3(NWAVES * 64), LDS_BYTES, stream, a, li);
}
template <int P> struct PerPhase { static void go(int grid, const Args& a, hipStream_t s) { PerPhase<P - 1>::go(grid, a, s); launch_range<P, P + 1>(grid, a, P, s); } };
template <> struct PerPhase<-1> { static void go(int, const Args&, hipStream_t) {} };

extern "C" void kernel_launch(void* const* d_in, const int* in_sizes, int n_in, void* d_out, int out_size, void* d_ws, size_t ws_size, hipStream_t stream) {
    static int grid = 0;
    if (grid == 0) {
        if (n_in != 35 || out_size != M * DM || ws_size < WS_END) { fprintf(stderr, "kernel_launch: built for 35 inputs, out %d floats, >= %zu bytes of workspace; got n_in %d, out %d, ws %zu; nothing launched\n", M * DM, (size_t)WS_END, n_in, out_size, ws_size); grid = -1; return; }
        int dev = 0, cus = 0;
        if (hipGetDevice(&dev) != hipSuccess || hipDeviceGetAttribute(&cus, hipDeviceAttributeMultiprocessorCount, dev) != hipSuccess) { grid = -1; return; }
        grid = cus;
    }
    if (grid < 0) return;
    if (hipMemsetAsync((char*)d_ws + WS_CTL, 0, CTL_ZERO_BYTES, stream) != hipSuccess) return;
    Args a{};
    for (int i = 0; i < 35; ++i) a.in[i] = (const float*)d_in[i];
    a.out = (float*)d_out; a.ws = (unsigned char*)d_ws; a.ph_lo = 0; a.ph_hi = N_PHASES;
#if MK_CUTS
    PerPhase<N_PHASES - 1>::go(grid, a, stream);
#else
    launch_range<0, N_PHASES>(grid, a, 0, stream);
#endif
    const hipError_t le = hipPeekAtLastError();
    if (le != hipSuccess) fprintf(stderr, "kernel_launch: launch failed: %s\n", hipGetErrorName(le));
}
```

```cpp
#include <hip/hip_runtime.h>
#include <cstdio>
#include <cstdint>
namespace pg8 {
#define PG8_LAS __attribute__((address_space(3)))
typedef unsigned short bf16_t;
typedef short bf16x8 __attribute__((ext_vector_type(8)));
typedef float f32x4 __attribute__((ext_vector_type(4)));
typedef unsigned u32x4 __attribute__((ext_vector_type(4)));
constexpr int BM = 256, BK = 64, HALF = 128, HTB = HALF * BK * 2  , STAGE_BYTES = 8 * HTB, NXCD = 8, WGM = 8;

__host__ __device__ __forceinline__ int lds_byte(int r, int c) { const int st = (r >> 4) * 2 + (c >> 5), rr = r & 15, cc = c & 31, ob = rr * 64 + cc * 2; return st * 1024 + (ob ^ (((ob >> 9) & 1) << 5)); }
__host__ __device__ __forceinline__ void stage_rc(int b, int& R, int& C) { const int st = b / 1024, sb = b % 1024, swz = sb ^ (((sb >> 9) & 1) << 5); R = (st >> 1) * 16 + swz / 64; C = (st & 1) * 32 + (swz % 64) / 2; }
__host__ __device__ __forceinline__ int perm32(int rho) { const int n = rho >> 4, i = rho & 15; return 8 * (i >> 2) + 4 * n + (i & 3); }

struct Unit { int pm, pn; long aoff, boff; int aux; };
struct Gemm { const bf16_t* A; const bf16_t* Bt; int M, N, K; };
__device__ __forceinline__ long rfl64(long v) { const unsigned lo = __builtin_amdgcn_readfirstlane((unsigned)v), hi = __builtin_amdgcn_readfirstlane((unsigned)((unsigned long)v >> 32)); return (long)(((unsigned long)hi << 32) | lo); }
__device__ __forceinline__ void unit_uniform(Unit& u) { u.pm = __builtin_amdgcn_readfirstlane(u.pm); u.pn = __builtin_amdgcn_readfirstlane(u.pn); u.aux = __builtin_amdgcn_readfirstlane(u.aux); u.aoff = rfl64(u.aoff); u.boff = rfl64(u.boff); }

struct StaticOrder {
    int nM, nN, nwg, G, c;
    __host__ __device__ void init(int M, int N, int G_, int c_) { nM = M / BM; nN = N / BM; nwg = nM * nN; G = G_; c = c_; }
    __host__ __device__ bool next(int i, Unit& u) const {
        const long L = (long)i * G + c; if (L >= nwg) return false;
        int wgid = (int)L; { const int q = nwg / NXCD, r = nwg % NXCD, xcd = wgid % NXCD, off = wgid / NXCD; wgid = (xcd < r ? xcd * (q + 1) : r * (q + 1) + (xcd - r) * q) + off; }
        const int nig = WGM * nN, gid = wgid / nig, fm = gid * WGM, gsz = (nM - fm) < WGM ? (nM - fm) : WGM;
        u.pm = fm + ((wgid % nig) % gsz); u.pn = (wgid % nig) / gsz; u.aoff = 0; u.boff = 0; u.aux = 0; return true;
    }
    __device__ __forceinline__ void a_ready(const Unit&) const {}
    __device__ __forceinline__ void done(const Unit&) const {}
};
struct MoeOrder {
    StaticOrder so; int rb0; int pend[8]; long bstride;
    __device__ bool next(int i, Unit& u) const {
        if (!so.next(i, u)) return false;
        const int row = (rb0 + u.pm) * BM; int e = 0;
#pragma unroll
        for (int j = 0; j < 7; ++j) e += (row >= pend[j]) ? 1 : 0;
        u.boff = (long)e * bstride; u.aux = rb0 + u.pm; return true;
    }
    __device__ __forceinline__ void a_ready(const Unit&) const {}
    __device__ __forceinline__ void done(const Unit&) const {}
};

__device__ __forceinline__ unsigned cvt_pk_bf16(float lo, float hi) { unsigned r; asm volatile("v_cvt_pk_bf16_f32 %0, %1, %2" : "=v"(r) : "v"(lo), "v"(hi)); return r; }
__device__ __forceinline__ float silu_f(float v) { return v * __builtin_amdgcn_rcpf(1.0f + __builtin_amdgcn_exp2f(-1.4426950408889634f * v)); }

struct EpiBf16 {
    static constexpr bool PERM = true, AFTER_DRAIN = false;
    bf16_t* O; int ldc; float* F; int fcol0;
    __device__ __forceinline__ void operator()(const f32x4 (&acc)[2][2][4][2], const Unit& u, int wr, int wc, int fr, int fq) const {
        const int row0 = u.pm * BM + wr * 64 + fr; const int col0 = u.pn * BM + wc * 32 + 8 * fq;
#pragma unroll
        for (int ai = 0; ai < 2; ++ai)
#pragma unroll
            for (int m = 0; m < 4; ++m) { bf16_t* rowp = O + (size_t)(row0 + ai * HALF + m * 16) * ldc + col0;
#pragma unroll
                for (int bj = 0; bj < 2; ++bj) { const f32x4 v0 = acc[ai][bj][m][0], v1 = acc[ai][bj][m][1];
                    u32x4 w; w.x = cvt_pk_bf16(v0[0], v0[1]); w.y = cvt_pk_bf16(v0[2], v0[3]); w.z = cvt_pk_bf16(v1[0], v1[1]); w.w = cvt_pk_bf16(v1[2], v1[3]);
                    *(u32x4*)(rowp + bj * HALF) = w;
                    if (F) { const int c = col0 + bj * HALF - fcol0; if (c >= 0 && c < 16) { float* fp = F + (size_t)(row0 + ai * HALF + m * 16) * 16 + c; *(f32x4*)fp = v0; *(f32x4*)(fp + 4) = v1; } }
                } }
    }
};
struct EpiResF32 {
    static constexpr bool PERM = false, AFTER_DRAIN = false;
    const float* Xin; float* X; int ldc; float alpha; float bscale;
    __device__ __forceinline__ void operator()(const f32x4 (&acc)[2][2][4][2], const Unit& u, int wr, int wc, int fr, int fq) const {
        const int row0 = u.pm * BM + wr * 64 + fr, col0 = u.pn * BM + wc * 32 + 4 * fq;
#pragma unroll
        for (int ai = 0; ai < 2; ++ai)
#pragma unroll
            for (int m = 0; m < 4; ++m) { float* rowp = X + (size_t)(row0 + ai * HALF + m * 16) * ldc + col0;
#pragma unroll
                for (int bj = 0; bj < 2; ++bj)
#pragma unroll
                    for (int n = 0; n < 2; ++n) { f32x4* p = (f32x4*)(rowp + bj * HALF + n * 16); const f32x4 x = *(const f32x4*)(Xin + (p - (f32x4*)X) * 4); *p = x * alpha + acc[ai][bj][m][n] * bscale; } }
    }
};
struct EpiSwiglu {
    static constexpr bool PERM = true, AFTER_DRAIN = false;
    bf16_t* H; int ldc;
    __device__ __forceinline__ void operator()(const f32x4 (&acc)[2][2][4][2], const Unit& u, int wr, int wc, int fr, int fq) const {
        const int row0 = u.pm * BM + wr * 64 + fr; const int col0 = u.pn * HALF + wc * 32 + 8 * fq;
#pragma unroll
        for (int ai = 0; ai < 2; ++ai)
#pragma unroll
            for (int m = 0; m < 4; ++m) { bf16_t* rowp = H + (size_t)(row0 + ai * HALF + m * 16) * ldc + col0;
                const f32x4 g0 = acc[ai][0][m][0], g1 = acc[ai][0][m][1], u0 = acc[ai][1][m][0], u1 = acc[ai][1][m][1];
                f32x4 h0, h1;
#pragma unroll
                for (int j = 0; j < 4; ++j) { h0[j] = silu_f(g0[j]) * u0[j]; h1[j] = silu_f(g1[j]) * u1[j]; }
                u32x4 w; w.x = cvt_pk_bf16(h0[0], h0[1]); w.y = cvt_pk_bf16(h0[2], h0[3]); w.z = cvt_pk_bf16(h1[0], h1[1]); w.w = cvt_pk_bf16(h1[2], h1[3]);
                *(u32x4*)rowp = w; }
    }
};
struct EpiSwigluF8 {
    static constexpr bool PERM = true, AFTER_DRAIN = false;
    unsigned char* H; int ldc;
    __device__ __forceinline__ void operator()(const f32x4 (&acc)[2][2][4][2], const Unit& u, int wr, int wc, int fr, int fq) const {
        const int row0 = u.pm * BM + wr * 64 + fr; const int col0 = u.pn * HALF + wc * 32 + 8 * fq;
#pragma unroll
        for (int ai = 0; ai < 2; ++ai)
#pragma unroll
            for (int m = 0; m < 4; ++m) { unsigned char* rowp = H + (size_t)(row0 + ai * HALF + m * 16) * ldc + col0;
                const f32x4 g0 = acc[ai][0][m][0], g1 = acc[ai][0][m][1], u0 = acc[ai][1][m][0], u1 = acc[ai][1][m][1];
                f32x4 h0, h1;
#pragma unroll
                for (int j = 0; j < 4; ++j) { h0[j] = silu_f(g0[j]) * u0[j]; h1[j] = silu_f(g1[j]) * u1[j]; }
                int w0 = 0, w1 = 0;
                w0 = __builtin_amdgcn_cvt_pk_fp8_f32(h0[0], h0[1], w0, false); w0 = __builtin_amdgcn_cvt_pk_fp8_f32(h0[2], h0[3], w0, true);
                w1 = __builtin_amdgcn_cvt_pk_fp8_f32(h1[0], h1[1], w1, false); w1 = __builtin_amdgcn_cvt_pk_fp8_f32(h1[2], h1[3], w1, true);
                typedef int i32x2 __attribute__((ext_vector_type(2))); *(i32x2*)rowp = (i32x2){w0, w1}; __builtin_amdgcn_sched_barrier(0); }
    }
};
struct EpiMoeDown {
    static constexpr bool PERM = true, AFTER_DRAIN = false;
    bf16_t* Y0; long ystride; int ldc; const int* slot_tok2; const float* slot_gate; int rbase;
    __device__ __forceinline__ void operator()(const f32x4 (&acc)[2][2][4][2], const Unit& u, int wr, int wc, int fr, int fq) const {
        const int row0 = rbase + u.pm * BM + wr * 64 + fr; const int col0 = u.pn * BM + wc * 32 + 8 * fq;
#pragma unroll
        for (int ai = 0; ai < 2; ++ai)
#pragma unroll
            for (int m = 0; m < 4; ++m) { const int slot = row0 + ai * HALF + m * 16; const int t2 = slot_tok2[slot]; const float gt = slot_gate[slot];
                if (t2 >= 0) { bf16_t* rowp = Y0 + (size_t)(t2 & 1) * ystride + (size_t)(t2 >> 1) * ldc + col0;
#pragma unroll
                    for (int bj = 0; bj < 2; ++bj) { const f32x4 v0 = acc[ai][bj][m][0] * gt, v1 = acc[ai][bj][m][1] * gt;
                        u32x4 w; w.x = cvt_pk_bf16(v0[0], v0[1]); w.y = cvt_pk_bf16(v0[2], v0[3]); w.z = cvt_pk_bf16(v1[0], v1[1]); w.w = cvt_pk_bf16(v1[2], v1[3]);
                        *(u32x4*)(rowp + bj * HALF) = w; } } __builtin_amdgcn_sched_barrier(0); }
    }
};

template <class Epi, class Sched, bool ALIGN_EPI = false, bool SP2 = false>
__device__ __forceinline__ void gemm_phase(PG8_LAS unsigned char* lds, const Gemm g, const Sched& S, const Epi& E, int tid) {
    asm volatile("" : "+v"(tid));
    const int wid = __builtin_amdgcn_readfirstlane(tid >> 6), lane = tid & 63, wr = wid >> 2, wc = wid & 3, fr = lane & 15, fq = lane >> 4;
    const int K = g.K, nt = K / BK;
    unsigned voffA[2], voffB[2];
#pragma unroll
    for (int i = 0; i < 2; ++i) { int R, C; stage_rc(tid * 16 + i * 8192, R, C); const int Rb = Epi::PERM ? ((R & ~31) + perm32(R & 31)) : R;
        voffA[i] = (unsigned)(R * K + C) * 2u; voffB[i] = (unsigned)(Rb * K + C) * 2u; }
    const size_t kstep = (size_t)(BK * 2);
    const size_t hstep = (size_t)HALF * K * 2;
    const size_t tstep = 2 * hstep;
    const unsigned ldsw = (unsigned)wid * 1024u;
    const int aoff = lds_byte(wr * 64 + fr, fq * 8), boff = lds_byte(wc * 32 + fr, fq * 8);
#define PG8_SA(b, h) (((b) * 2 + (h)) * HTB)
#define PG8_SB(b, h) ((4 + (b) * 2 + (h)) * HTB)
#define PG8_STAGE(bufoff, gbase, voff) do { _Pragma("unroll") for (int _i = 0; _i < 2; ++_i) \
        __builtin_amdgcn_global_load_lds((const unsigned*)((const char*)(gbase) + (voff)[_i]), (PG8_LAS unsigned*)(lds + (bufoff) + ldsw + _i * 8192), 16, 0, 0); } while (0)
#define PG8_LDA(dst, b, h) do { _Pragma("unroll") for (int m = 0; m < 4; ++m) _Pragma("unroll") for (int k = 0; k < 2; ++k) dst[m][k] = *(const PG8_LAS bf16x8*)(lds + PG8_SA(b, h) + aoff + m * 2048 + k * 1024); } while (0)
#define PG8_LDB(dst, b, h) do { _Pragma("unroll") for (int n = 0; n < 2; ++n) _Pragma("unroll") for (int k = 0; k < 2; ++k) dst[n][k] = *(const PG8_LAS bf16x8*)(lds + PG8_SB(b, h) + boff + n * 2048 + k * 1024); } while (0)
#define PG8_MMA(ai, bj, At, Bt) do { __builtin_amdgcn_s_setprio(1); _Pragma("unroll") for (int m = 0; m < 4; ++m) _Pragma("unroll") for (int n = 0; n < 2; ++n) _Pragma("unroll") for (int k = 0; k < 2; ++k) \
        acc[ai][bj][m][n] = __builtin_amdgcn_mfma_f32_16x16x32_bf16(Bt[n][k], At[m][k], acc[ai][bj][m][n], 0, 0, 0); __builtin_amdgcn_s_setprio(0); } while (0)
#define PG8_WAIT_V(n) asm volatile("s_waitcnt vmcnt(" #n ")" ::: "memory")
#define PG8_WAIT_L(n) asm volatile("s_waitcnt lgkmcnt(" #n ")" ::: "memory")
#define PG8_BAR __builtin_amdgcn_s_barrier()
#define PG8_SCHED __builtin_amdgcn_sched_barrier(0)
    Unit cur, nxt; int ui = 0;
    if (!S.next(0, cur)) return;
    f32x4 acc[2][2][4][2];
#pragma unroll
    for (int a = 0; a < 2; ++a)
#pragma unroll
        for (int b = 0; b < 2; ++b)
#pragma unroll
            for (int m = 0; m < 4; ++m)
#pragma unroll
                for (int n = 0; n < 2; ++n) acc[a][b][m][n] = (f32x4){0.f, 0.f, 0.f, 0.f};
    bf16x8 At[4][2], B0[2][2], B1[2][2];
    const char* cA = (const char*)g.A + cur.aoff + (size_t)cur.pm * tstep; const char* cB = (const char*)g.Bt + cur.boff + (size_t)cur.pn * tstep;
    S.a_ready(cur);
    if constexpr (SP2) {
        PG8_STAGE(PG8_SB(0, 0), cB, voffB); PG8_STAGE(PG8_SB(0, 1), cB + hstep, voffB); PG8_STAGE(PG8_SA(0, 0), cA, voffA); PG8_STAGE(PG8_SA(0, 1), cA + hstep, voffA);
        if (wr == 1) PG8_BAR;
        PG8_WAIT_V(2); PG8_BAR;
        PG8_STAGE(PG8_SB(1, 0), cB + kstep, voffB); PG8_STAGE(PG8_SA(1, 0), cA + kstep, voffA); PG8_STAGE(PG8_SB(1, 1), cB + hstep + kstep, voffB);
        PG8_WAIT_V(6); PG8_BAR;
    } else {
        PG8_STAGE(PG8_SB(0, 0), cB, voffB); PG8_STAGE(PG8_SA(0, 0), cA, voffA); PG8_STAGE(PG8_SB(0, 1), cB + hstep, voffB); PG8_STAGE(PG8_SA(0, 1), cA + hstep, voffA);
        if (wr == 1) PG8_BAR;
        PG8_WAIT_V(4); PG8_BAR;
        PG8_STAGE(PG8_SB(1, 0), cB + kstep, voffB); PG8_STAGE(PG8_SA(1, 0), cA + kstep, voffA); PG8_STAGE(PG8_SB(1, 1), cB + hstep + kstep, voffB);
        PG8_WAIT_V(6); PG8_BAR;
    }
    for (;;) {
        const bool has_next = S.next(ui + 1, nxt);
        const char* nA = has_next ? (const char*)g.A + nxt.aoff + (size_t)nxt.pm * tstep : cA; const char* nB = has_next ? (const char*)g.Bt + nxt.boff + (size_t)nxt.pn * tstep : cB;
        for (int t = 0; t < nt; t += 2) {
            const bool last = (t == nt - 2);
            const char* a1 = cA + (size_t)(t + 1) * kstep;
            const char* a2 = last ? nA : cA + (size_t)(t + 2) * kstep; const char* b2 = last ? nB : cB + (size_t)(t + 2) * kstep;
            const char* a3 = a2 + kstep; const char* b3 = b2 + kstep;
            if (last && has_next) S.a_ready(nxt);
            if constexpr (SP2) {
            PG8_LDB(B0, 0, 0); PG8_LDB(B1, 0, 1); PG8_SCHED; PG8_LDA(At, 0, 0); PG8_STAGE(PG8_SA(1, 1), a1 + hstep, voffA);
            PG8_WAIT_V(8); PG8_WAIT_L(0); PG8_BAR; PG8_MMA(0, 0, At, B0); PG8_MMA(0, 1, At, B1); PG8_BAR; PG8_SCHED;
            PG8_LDA(At, 0, 1); PG8_STAGE(PG8_SB(0, 0), b2, voffB); PG8_STAGE(PG8_SB(0, 1), b2 + hstep, voffB); PG8_STAGE(PG8_SA(0, 0), a2, voffA);
            PG8_WAIT_V(8); PG8_WAIT_L(0); PG8_BAR; PG8_MMA(1, 0, At, B0); PG8_MMA(1, 1, At, B1); PG8_BAR; PG8_SCHED;
            PG8_LDB(B0, 1, 0); PG8_LDB(B1, 1, 1); PG8_SCHED; PG8_LDA(At, 1, 0); PG8_STAGE(PG8_SA(0, 1), a2 + hstep, voffA);
            PG8_WAIT_V(8); PG8_WAIT_L(0); PG8_BAR; PG8_MMA(0, 0, At, B0); PG8_MMA(0, 1, At, B1); PG8_BAR; PG8_SCHED;
            PG8_LDA(At, 1, 1); PG8_STAGE(PG8_SB(1, 0), b3, voffB); PG8_STAGE(PG8_SB(1, 1), b3 + hstep, voffB); PG8_STAGE(PG8_SA(1, 0), a3, voffA);
            PG8_WAIT_V(8); PG8_WAIT_L(0); PG8_BAR; PG8_MMA(1, 0, At, B0); PG8_MMA(1, 1, At, B1); PG8_BAR; PG8_SCHED;
            } else {
            PG8_LDB(B0, 0, 0); PG8_SCHED; PG8_LDA(At, 0, 0); PG8_STAGE(PG8_SA(1, 1), a1 + hstep, voffA);
            PG8_WAIT_L(8); PG8_BAR; PG8_WAIT_L(0); PG8_MMA(0, 0, At, B0); PG8_BAR; PG8_SCHED;
            PG8_LDB(B1, 0, 1); PG8_STAGE(PG8_SB(0, 0), b2, voffB);
            PG8_BAR; PG8_WAIT_L(0); PG8_MMA(0, 1, At, B1); PG8_BAR;
            PG8_LDA(At, 0, 1); PG8_STAGE(PG8_SA(0, 0), a2, voffA);
            PG8_BAR; PG8_WAIT_L(0); PG8_MMA(1, 0, At, B0); PG8_BAR; PG8_SCHED;
            PG8_STAGE(PG8_SB(0, 1), b2 + hstep, voffB);
            PG8_WAIT_V(6); PG8_BAR; PG8_MMA(1, 1, At, B1); PG8_BAR;
            PG8_LDB(B0, 1, 0); PG8_SCHED; PG8_LDA(At, 1, 0); PG8_STAGE(PG8_SA(0, 1), a2 + hstep, voffA);
            PG8_WAIT_L(8); PG8_BAR; PG8_WAIT_L(0); PG8_MMA(0, 0, At, B0); PG8_BAR; PG8_SCHED;
            PG8_LDB(B1, 1, 1); PG8_STAGE(PG8_SB(1, 0), b3, voffB);
            PG8_BAR; PG8_WAIT_L(0); PG8_MMA(0, 1, At, B1); PG8_BAR;
            PG8_LDA(At, 1, 1); PG8_STAGE(PG8_SA(1, 0), a3, voffA);
            PG8_BAR; PG8_WAIT_L(0); PG8_MMA(1, 0, At, B0); PG8_BAR; PG8_SCHED;
            PG8_STAGE(PG8_SB(1, 1), b3 + hstep, voffB);
            PG8_WAIT_V(6); PG8_BAR; PG8_MMA(1, 1, At, B1); PG8_BAR;
            }
        }
        if constexpr (ALIGN_EPI) { if (wr == 0) PG8_BAR; }
        if constexpr (!Epi::AFTER_DRAIN) { E(acc, cur, wr, wc, fr, fq); S.done(cur); }
        if (!has_next) break;
#pragma unroll
        for (int a = 0; a < 2; ++a)
#pragma unroll
            for (int b = 0; b < 2; ++b)
#pragma unroll
                for (int m = 0; m < 4; ++m)
#pragma unroll
                    for (int n = 0; n < 2; ++n) acc[a][b][m][n] = (f32x4){0.f, 0.f, 0.f, 0.f};
        cur = nxt; cA = nA; cB = nB; ++ui;
        if constexpr (ALIGN_EPI) { if (wr == 1) PG8_BAR; }
    }
    PG8_WAIT_V(0);
    if constexpr (!ALIGN_EPI) { if (wr == 0) PG8_BAR; }
    PG8_BAR;
#undef PG8_SA
#undef PG8_SB
#undef PG8_STAGE
#undef PG8_LDA
#undef PG8_LDB
#undef PG8_MMA
#undef PG8_WAIT_V
#undef PG8_WAIT_L
#undef PG8_BAR
#undef PG8_SCHED
}
typedef int v8i __attribute__((ext_vector_type(8)));
typedef int v4i __attribute__((ext_vector_type(4)));
typedef int v32i __attribute__((ext_vector_type(32)));
template <class Epi, class Sched, bool ALIGN_EPI = false, bool SP2 = false>
__device__ __forceinline__ void gemm_phase_f8(PG8_LAS unsigned char* lds, const Gemm g, const Sched& S, const Epi& E, int tid, int scaleBt, int scaleA) {
    asm volatile("" : "+v"(tid));
    const int wid = __builtin_amdgcn_readfirstlane(tid >> 6), lane = tid & 63, wr = wid >> 2, wc = wid & 3, fr = lane & 15, fq = lane >> 4;
    const int K = g.K, nt = K / 128;
    unsigned voffA[2], voffB[2];
#pragma unroll
    for (int i = 0; i < 2; ++i) { int R, C; stage_rc(tid * 16 + i * 8192, R, C); const int Rb = Epi::PERM ? ((R & ~31) + perm32(R & 31)) : R;
        voffA[i] = (unsigned)(R * K + C * 2); voffB[i] = (unsigned)(Rb * K + C * 2); }
    const size_t kstep = (size_t)(BK * 2);
    const size_t hstep = (size_t)HALF * K;
    const size_t tstep = 2 * hstep;
    const unsigned ldsw = (unsigned)wid * 1024u;
    const int aoff0 = lds_byte(wr * 64 + fr, fq * 16), aoff1 = lds_byte(wr * 64 + fr, fq * 16 + 8), boff0 = lds_byte(wc * 32 + fr, fq * 16), boff1 = lds_byte(wc * 32 + fr, fq * 16 + 8);
#define PG8_SA(b, h) (((b) * 2 + (h)) * HTB)
#define PG8_SB(b, h) ((4 + (b) * 2 + (h)) * HTB)
#define PG8_STAGE(bufoff, gbase, voff) do { _Pragma("unroll") for (int _i = 0; _i < 2; ++_i) \
        __builtin_amdgcn_global_load_lds((const unsigned*)((const char*)(gbase) + (voff)[_i]), (PG8_LAS unsigned*)(lds + (bufoff) + ldsw + _i * 8192), 16, 0, 0); } while (0)
#define PG8_INS8(big, slot, lo_, hi_) do { const v8i f_ = __builtin_shufflevector(lo_, hi_, 0, 1, 2, 3, 4, 5, 6, 7); \
        const v32i e_ = __builtin_shufflevector(f_, f_, 0, 1, 2, 3, 4, 5, 6, 7, 0, 1, 2, 3, 4, 5, 6, 7, 0, 1, 2, 3, 4, 5, 6, 7, 0, 1, 2, 3, 4, 5, 6, 7); \
        if ((slot) == 0) big = __builtin_shufflevector(big, e_, 32, 33, 34, 35, 36, 37, 38, 39, 8, 9, 10, 11, 12, 13, 14, 15, 16, 17, 18, 19, 20, 21, 22, 23, 24, 25, 26, 27, 28, 29, 30, 31); \
        else if ((slot) == 1) big = __builtin_shufflevector(big, e_, 0, 1, 2, 3, 4, 5, 6, 7, 32, 33, 34, 35, 36, 37, 38, 39, 16, 17, 18, 19, 20, 21, 22, 23, 24, 25, 26, 27, 28, 29, 30, 31); \
        else if ((slot) == 2) big = __builtin_shufflevector(big, e_, 0, 1, 2, 3, 4, 5, 6, 7, 8, 9, 10, 11, 12, 13, 14, 15, 32, 33, 34, 35, 36, 37, 38, 39, 24, 25, 26, 27, 28, 29, 30, 31); \
        else big = __builtin_shufflevector(big, e_, 0, 1, 2, 3, 4, 5, 6, 7, 8, 9, 10, 11, 12, 13, 14, 15, 16, 17, 18, 19, 20, 21, 22, 23, 32, 33, 34, 35, 36, 37, 38, 39); } while (0)
#define PG8_GET8(big, slot) ((slot) == 0 ? __builtin_shufflevector(big, big, 0, 1, 2, 3, 4, 5, 6, 7) : (slot) == 1 ? __builtin_shufflevector(big, big, 8, 9, 10, 11, 12, 13, 14, 15) : (slot) == 2 ? __builtin_shufflevector(big, big, 16, 17, 18, 19, 20, 21, 22, 23) : __builtin_shufflevector(big, big, 24, 25, 26, 27, 28, 29, 30, 31))
#define PG8_LDA(dst, b, h) do { _Pragma("unroll") for (int m = 0; m < 4; ++m) { const v4i lo_ = *(const PG8_LAS v4i*)(lds + PG8_SA(b, h) + aoff0 + m * 2048), hi_ = *(const PG8_LAS v4i*)(lds + PG8_SA(b, h) + aoff1 + m * 2048); PG8_INS8(Afr, m, lo_, hi_); } } while (0)
#define PG8_LDB(dst, b, h) do { _Pragma("unroll") for (int n = 0; n < 2; ++n) { const v4i lo_ = *(const PG8_LAS v4i*)(lds + PG8_SB(b, h) + boff0 + n * 2048), hi_ = *(const PG8_LAS v4i*)(lds + PG8_SB(b, h) + boff1 + n * 2048); PG8_INS8(Bfr, (dst) * 2 + n, lo_, hi_); } } while (0)
#define PG8_F8(x) __builtin_bit_cast(v8i, x)
#define PG8_MMA(ai, bj, At, Bt) do { __builtin_amdgcn_s_setprio(1); _Pragma("unroll") for (int m = 0; m < 4; ++m) _Pragma("unroll") for (int n = 0; n < 2; ++n) { const v8i bop_ = PG8_GET8(Bfr, (Bt) * 2 + n), aop_ = PG8_GET8(Afr, m); \
        asm volatile("v_mfma_scale_f32_16x16x128_f8f6f4 %0, %1, %2, %0, %3, %4 op_sel_hi:[0,0,0]" : "+v"(acc[ai][bj][m][n]) : "v"(bop_), "v"(aop_), "v"(scaleBt), "v"(scaleA)); } __builtin_amdgcn_s_setprio(0); } while (0)
#define PG8_WAIT_V(n) asm volatile("s_waitcnt vmcnt(" #n ")" ::: "memory")
#define PG8_WAIT_L(n) asm volatile("s_waitcnt lgkmcnt(" #n ")" ::: "memory")
#define PG8_BAR __builtin_amdgcn_s_barrier()
#define PG8_SCHED __builtin_amdgcn_sched_barrier(0)
    Unit cur, nxt; int ui = 0;
    if (!S.next(0, cur)) return;
    unit_uniform(cur);
    f32x4 acc[2][2][4][2];
#pragma unroll
    for (int a = 0; a < 2; ++a)
#pragma unroll
        for (int b = 0; b < 2; ++b)
#pragma unroll
            for (int m = 0; m < 4; ++m)
#pragma unroll
                for (int n = 0; n < 2; ++n) acc[a][b][m][n] = (f32x4){0.f, 0.f, 0.f, 0.f};
    v32i Afr, Bfr;
    const char* cA = (const char*)g.A + cur.aoff + (size_t)cur.pm * tstep; const char* cB = (const char*)g.Bt + cur.boff + (size_t)cur.pn * tstep;
    S.a_ready(cur);
    if constexpr (SP2) {
        PG8_STAGE(PG8_SB(0, 0), cB, voffB); PG8_STAGE(PG8_SB(0, 1), cB + hstep, voffB); PG8_STAGE(PG8_SA(0, 0), cA, voffA); PG8_STAGE(PG8_SA(0, 1), cA + hstep, voffA);
        if (wr == 1) PG8_BAR;
        PG8_WAIT_V(2); PG8_BAR;
        PG8_STAGE(PG8_SB(1, 0), cB + kstep, voffB); PG8_STAGE(PG8_SA(1, 0), cA + kstep, voffA); PG8_STAGE(PG8_SB(1, 1), cB + hstep + kstep, voffB);
        PG8_WAIT_V(6); PG8_BAR;
    } else {
        PG8_STAGE(PG8_SB(0, 0), cB, voffB); PG8_STAGE(PG8_SA(0, 0), cA, voffA); PG8_STAGE(PG8_SB(0, 1), cB + hstep, voffB); PG8_STAGE(PG8_SA(0, 1), cA + hstep, voffA);
        if (wr == 1) PG8_BAR;
        PG8_WAIT_V(4); PG8_BAR;
        PG8_STAGE(PG8_SB(1, 0), cB + kstep, voffB); PG8_STAGE(PG8_SA(1, 0), cA + kstep, voffA); PG8_STAGE(PG8_SB(1, 1), cB + hstep + kstep, voffB);
        PG8_WAIT_V(6); PG8_BAR;
    }
    for (;;) {
        const bool has_next = __builtin_amdgcn_readfirstlane((int)S.next(ui + 1, nxt)) != 0; unit_uniform(nxt);
        const char* nA = has_next ? (const char*)g.A + nxt.aoff + (size_t)nxt.pm * tstep : cA; const char* nB = has_next ? (const char*)g.Bt + nxt.boff + (size_t)nxt.pn * tstep : cB;
        for (int t = 0; t < nt; t += 2) {
            const bool last = (t == nt - 2);
            const char* a1 = cA + (size_t)(t + 1) * kstep;
            const char* a2 = last ? nA : cA + (size_t)(t + 2) * kstep; const char* b2 = last ? nB : cB + (size_t)(t + 2) * kstep;
            const char* a3 = a2 + kstep; const char* b3 = b2 + kstep;
            if (last && has_next) S.a_ready(nxt);
            if constexpr (SP2) {
            PG8_LDB(0, 0, 0); PG8_LDB(1, 0, 1); PG8_SCHED; PG8_LDA(0, 0, 0); PG8_STAGE(PG8_SA(1, 1), a1 + hstep, voffA);
            PG8_WAIT_V(8); PG8_WAIT_L(0); PG8_BAR; PG8_MMA(0, 0, 0, 0); PG8_MMA(0, 1, 0, 1); PG8_BAR; PG8_SCHED;
            PG8_LDA(0, 0, 1); PG8_STAGE(PG8_SB(0, 0), b2, voffB); PG8_STAGE(PG8_SB(0, 1), b2 + hstep, voffB); PG8_STAGE(PG8_SA(0, 0), a2, voffA);
            PG8_WAIT_V(8); PG8_WAIT_L(0); PG8_BAR; PG8_MMA(1, 0, 0, 0); PG8_MMA(1, 1, 0, 1); PG8_BAR; PG8_SCHED;
            PG8_LDB(0, 1, 0); PG8_LDB(1, 1, 1); PG8_SCHED; PG8_LDA(0, 1, 0); PG8_STAGE(PG8_SA(0, 1), a2 + hstep, voffA);
            PG8_WAIT_V(8); PG8_WAIT_L(0); PG8_BAR; PG8_MMA(0, 0, 0, 0); PG8_MMA(0, 1, 0, 1); PG8_BAR; PG8_SCHED;
            PG8_LDA(0, 1, 1); PG8_STAGE(PG8_SB(1, 0), b3, voffB); PG8_STAGE(PG8_SB(1, 1), b3 + hstep, voffB); PG8_STAGE(PG8_SA(1, 0), a3, voffA);
            PG8_WAIT_V(8); PG8_WAIT_L(0); PG8_BAR; PG8_MMA(1, 0, 0, 0); PG8_MMA(1, 1, 0, 1); PG8_BAR; PG8_SCHED;
            } else {
            PG8_LDB(0, 0, 0); PG8_SCHED; PG8_LDA(0, 0, 0); PG8_STAGE(PG8_SA(1, 1), a1 + hstep, voffA);
            PG8_WAIT_L(8); PG8_BAR; PG8_WAIT_L(0); PG8_MMA(0, 0, 0, 0); PG8_BAR; PG8_SCHED;
            PG8_LDB(1, 0, 1); PG8_STAGE(PG8_SB(0, 0), b2, voffB);
            PG8_BAR; PG8_WAIT_L(0); PG8_MMA(0, 1, 0, 1); PG8_BAR;
            PG8_LDA(0, 0, 1); PG8_STAGE(PG8_SA(0, 0), a2, voffA);
            PG8_BAR; PG8_WAIT_L(0); PG8_MMA(1, 0, 0, 0); PG8_BAR; PG8_SCHED;
            PG8_STAGE(PG8_SB(0, 1), b2 + hstep, voffB);
            PG8_WAIT_V(6); PG8_BAR; PG8_MMA(1, 1, 0, 1); PG8_BAR;
            PG8_LDB(0, 1, 0); PG8_SCHED; PG8_LDA(0, 1, 0); PG8_STAGE(PG8_SA(0, 1), a2 + hstep, voffA);
            PG8_WAIT_L(8); PG8_BAR; PG8_WAIT_L(0); PG8_MMA(0, 0, 0, 0); PG8_BAR; PG8_SCHED;
            PG8_LDB(1, 1, 1); PG8_STAGE(PG8_SB(1, 0), b3, voffB);
            PG8_BAR; PG8_WAIT_L(0); PG8_MMA(0, 1, 0, 1); PG8_BAR;
            PG8_LDA(0, 1, 1); PG8_STAGE(PG8_SA(1, 0), a3, voffA);
            PG8_BAR; PG8_WAIT_L(0); PG8_MMA(1, 0, 0, 0); PG8_BAR; PG8_SCHED;
            PG8_STAGE(PG8_SB(1, 1), b3 + hstep, voffB);
            PG8_WAIT_V(6); PG8_BAR; PG8_MMA(1, 1, 0, 1); PG8_BAR;
            }
        }
        asm volatile("s_nop 15\n\ts_nop 15" ::: "memory");
        if constexpr (ALIGN_EPI) { if (wr == 0) PG8_BAR; }
        if constexpr (!Epi::AFTER_DRAIN) { E(acc, cur, wr, wc, fr, fq); S.done(cur); }
        if (!has_next) break;
#pragma unroll
        for (int a = 0; a < 2; ++a)
#pragma unroll
            for (int b = 0; b < 2; ++b)
#pragma unroll
                for (int m = 0; m < 4; ++m)
#pragma unroll
                    for (int n = 0; n < 2; ++n) acc[a][b][m][n] = (f32x4){0.f, 0.f, 0.f, 0.f};
        cur = nxt; cA = nA; cB = nB; ++ui;
        if constexpr (ALIGN_EPI) { if (wr == 1) PG8_BAR; }
    }
    PG8_WAIT_V(0);
    if constexpr (!ALIGN_EPI) { if (wr == 0) PG8_BAR; }
    PG8_BAR;
#undef PG8_SA
#undef PG8_SB
#undef PG8_STAGE
#undef PG8_LDA
#undef PG8_LDB
#undef PG8_MMA
#undef PG8_F8
#undef PG8_INS8
#undef PG8_GET8
#undef PG8_WAIT_V
#undef PG8_WAIT_L
#undef PG8_BAR
#undef PG8_SCHED
}
}

#ifndef FARFIELD
#define FARFIELD 1
#endif
#ifndef ZERO_MOE
#define ZERO_MOE 0
#endif
#ifndef ZERO_FFN
#define ZERO_FFN 0
#endif
#ifndef ZERO_A
#define ZERO_A 0
#endif
#ifndef ZERO_B
#define ZERO_B 0
#endif
#ifndef ZERO_C
#define ZERO_C 0
#endif
#ifndef ZERO_D
#define ZERO_D 0
#endif
constexpr int NWAVES = 8;
constexpr int NB = 16, SEQ = 2048, DM = 2048, M = NB * SEQ;
constexpr int NIN = 5328, NINP = 5376;
constexpr int C_QC = 0, C_KVC = 384, C_KPE = 640, C_RQ = 704, C_RK = 960, C_RV = 1216, C_RG = 1728, C_MZ = 2240, C_XBC = 2752, C_DT = 3776, C_HU = 3792;
constexpr int DFF = 5632, DFFE = 7168, NEXP = 8;
constexpr int CAP_ROWS = 2 * M + NEXP * 256, CAP_RB = CAP_ROWS / 256;
constexpr int MOE_CH = 1, MOE_CH_RB = CAP_RB / MOE_CH;
constexpr float ALPHA = 1.4142135623730951f;
constexpr int HY_OFF = 2055, HY_GLEN = 4112;

constexpr size_t al256(size_t x) { return (x + 255) / 256 * 256; }
constexpr size_t WS_CTL = 0, CTL_ZERO_BYTES = 1u << 20;
constexpr size_t SZ_WIN = (size_t)NINP * DM * 2, SZ_WUQ = (size_t)768 * 384 * 2, SZ_WUKV = (size_t)1024 * 256 * 2, SZ_WOUT = (size_t)DM * DM * 2;
constexpr size_t WS_WIN = CTL_ZERO_BYTES;
constexpr size_t WS_WUQ = WS_WIN + 2 * SZ_WIN;
constexpr size_t WS_WUKV = WS_WUQ + 2 * SZ_WUQ;
constexpr size_t WS_WOUT = WS_WUKV + 2 * SZ_WUKV;
constexpr size_t WS_WGU = WS_WOUT + 2 * SZ_WOUT;
constexpr size_t WS_WDN = WS_WGU + (size_t)2 * DFF * DM * 2;
constexpr size_t WS_HYG = WS_WDN + (size_t)DM * DFF * 2;
constexpr size_t WS_XB = al256(WS_HYG + (size_t)2 * 2 * 512 * HY_GLEN * 2);
constexpr size_t WS_XF8 = WS_XB + (size_t)M * DM * 2;
constexpr size_t WS_RT = WS_XF8 + (size_t)M * DM;
constexpr size_t WS_RTG = WS_RT + (size_t)M * 16;
constexpr size_t WS_SLOT = WS_RTG + (size_t)M * 8;
constexpr size_t WS_SLOTG = WS_SLOT + (size_t)CAP_ROWS * 4;
constexpr size_t WS_SCR = al256(WS_SLOTG + (size_t)CAP_ROWS * 4);
constexpr size_t WS_PROJ = WS_SCR;
constexpr size_t WS_DTF = WS_PROJ + (size_t)M * NINP * 2;
constexpr size_t WS_QN = WS_DTF + (size_t)M * 16 * 4;
constexpr size_t WS_KVN = WS_QN + (size_t)M * 384 * 2;
constexpr size_t WS_KPE = WS_KVN + (size_t)M * 256 * 2;
constexpr size_t WS_RQ = WS_KPE + (size_t)M * 64 * 2;
constexpr size_t WS_RK = WS_RQ + (size_t)M * 256 * 2;
constexpr size_t WS_XBC = WS_RK + (size_t)M * 256 * 2;
constexpr size_t WS_SSDP = WS_XBC + (size_t)M * 1024 * 2;
constexpr size_t WS_UT = WS_SSDP + (size_t)M * 8 * 16;
constexpr size_t WS_QB = WS_UT + (size_t)3 * 512 * M * 2;
constexpr size_t WS_KVB = WS_QB + (size_t)M * 768 * 2;
constexpr size_t WS_ATT = WS_KVB + (size_t)M * 1024 * 2;
constexpr size_t WS_YC = WS_ATT + (size_t)M * 512 * 2;
constexpr size_t WS_ZT = WS_YC + (size_t)M * 512 * 2;
constexpr size_t WS_MIX = WS_ZT + (size_t)512 * M * 2;
constexpr size_t WS_STR = WS_MIX + (size_t)M * DM * 2;
constexpr size_t WS_STS = WS_STR + (size_t)NB * 4 * 8 * 2 * 8192 * 2;
constexpr size_t WS_MIX_END = WS_STS + (size_t)NB * 8 * 8 * 2 * 8192 * 2;
constexpr size_t WS_HID = WS_SCR;
constexpr size_t WS_MGU = WS_SCR;
constexpr size_t WS_MDN = WS_MGU + (size_t)NEXP * 2 * DFFE * DM;
constexpr size_t WS_XS = WS_MDN + (size_t)NEXP * DM * DFFE;
constexpr size_t WS_HIDS = WS_XS + (size_t)CAP_ROWS * DM;
constexpr size_t WS_Y0 = WS_HIDS + (size_t)MOE_CH_RB * 256 * DFFE;
constexpr size_t WS_Y1 = WS_Y0 + (size_t)M * DM * 2;
constexpr size_t WS_END = WS_Y1 + (size_t)M * DM * 2;
static_assert(WS_MIX_END <= WS_END && WS_HID + (size_t)M * DFF * 2 <= WS_END, "d_ws map");
static_assert(WS_END <= 1942000000ull, "d_ws map exceeds the guaranteed workspace");
constexpr int CW_TMO = 0, CW_CODE = 1;
constexpr int CW_CNT = 64;
constexpr int CW_MIXQ = 1024;
constexpr int CW_BAR = 4096;

constexpr int RING_OFF = 0, RING_BYTES = 131072;
constexpr int LDSCTL_OFF = RING_BYTES, MISC_OFF = LDSCTL_OFF + 320;
constexpr int LDS_BYTES = 147456;

#define GAS __attribute__((address_space(1)))
#define LAS __attribute__((address_space(3)))
typedef unsigned short bf16;
typedef unsigned v4u __attribute__((ext_vector_type(4)));
typedef unsigned v2u __attribute__((ext_vector_type(2)));
typedef float f32x4 __attribute__((ext_vector_type(4)));
typedef float f32x2 __attribute__((ext_vector_type(2)));
typedef float f32x16 __attribute__((ext_vector_type(16)));
typedef short bf16x8 __attribute__((ext_vector_type(8)));
typedef short s16x4 __attribute__((ext_vector_type(4)));
typedef GAS unsigned gu32;
#define RLX_AGENT __ATOMIC_RELAXED, __HIP_MEMORY_SCOPE_AGENT
#define LDS_WAIT() asm volatile("s_waitcnt lgkmcnt(0)" ::: "memory")
#define VM_WAIT() asm volatile("s_waitcnt vmcnt(0)" ::: "memory")
__device__ __forceinline__ unsigned f2bf(float f) { unsigned u = __builtin_bit_cast(unsigned, f); return (u + 0x7fffu + ((u >> 16) & 1u)) >> 16; }
__device__ __forceinline__ unsigned pk2(float lo, float hi) { return f2bf(lo) | (f2bf(hi) << 16); }
__device__ __forceinline__ float bf2f(unsigned b) { return __builtin_bit_cast(float, b << 16); }
__device__ __forceinline__ float bflo(unsigned w) { return __builtin_bit_cast(float, w << 16); }
__device__ __forceinline__ float bfhi(unsigned w) { return __builtin_bit_cast(float, w & 0xffff0000u); }
__device__ __forceinline__ float silu(float v) { return v / (1.0f + __expf(-v)); }
template <int K> __device__ __forceinline__ float swz_xor(float v) { return __builtin_bit_cast(float, __builtin_amdgcn_ds_swizzle(__builtin_bit_cast(int, v), (K << 10) | 0x1f)); }
__device__ __forceinline__ float half_sum(float v) { v += swz_xor<1>(v); v += swz_xor<2>(v); v += swz_xor<4>(v); v += swz_xor<8>(v); v += swz_xor<16>(v); return v; }
__device__ __forceinline__ float wave_sum(float v) { v = half_sum(v);
    auto rr = __builtin_amdgcn_permlane32_swap(__builtin_bit_cast(unsigned, v), __builtin_bit_cast(unsigned, v), false, false);
    const unsigned r0 = rr[0], r1 = rr[1];
    return __uint_as_float(r0) + __uint_as_float(r1); }

#define XB_TMO      128
#define XB_XCNT(j)  (256  + 64 * (j))
#define XB_XSUB(j)  (1280 + 64 * (j))
#define XB_XGEN(j)  (2304 + 64 * (j))
#define XB_TOP      3328
#define XB_TOPGEN   3392
#define XCD_BAR_WORDS 3456
#define XB_SPIN_CAP (1u << 18)
__device__ __forceinline__ unsigned xb_ld(unsigned* p)              { return __hip_atomic_load(p, __ATOMIC_RELAXED, __HIP_MEMORY_SCOPE_AGENT); }
__device__ __forceinline__ unsigned xb_add(unsigned* p, unsigned v) { return __hip_atomic_fetch_add(p, v, __ATOMIC_RELAXED, __HIP_MEMORY_SCOPE_AGENT); }
__device__ __forceinline__ unsigned xb_xcc_id() { return (unsigned)__builtin_amdgcn_s_getreg((3 << 11) | 20) & 0xFu; }
#define XB_SPIN(cond, bar) do { unsigned _sp = 0; while (cond) { __builtin_amdgcn_s_sleep(1); \
    if ((++_sp & 255u) == 0u) { if (xb_ld(&(bar)[XB_TMO])) break; if (_sp > XB_SPIN_CAP) { atomicAdd(&(bar)[XB_TMO], 1u); break; } } } } while (0)
struct XcdBarrier { unsigned* bar; unsigned x; volatile LAS unsigned* st; };
__device__ __forceinline__ XcdBarrier xcd_barrier_post(unsigned* bar, volatile LAS unsigned* st) {
    XcdBarrier b; b.bar = bar; b.x = xb_xcc_id(); b.st = st;
    if (threadIdx.x == 0) (void)xb_add(&bar[XB_XCNT(b.x)], 1u);
    return b;
}
__device__ __forceinline__ void xcd_barrier_complete(unsigned* bar, unsigned x, unsigned& nloc, unsigned& nx) {
    const unsigned G = gridDim.x * gridDim.y * gridDim.z;
    unsigned sum, cnt, mine, sp = 0u;
    for (;;) {
        sum = 0u; cnt = 0u; mine = 0u;
#pragma unroll
        for (unsigned j = 0; j < 16; ++j) { const unsigned c = xb_ld(&bar[XB_XCNT(j)]); sum += c; cnt += (c > 0u) ? 1u : 0u; mine = (j == x) ? c : mine; }
        if (sum == G) break;
        __builtin_amdgcn_s_sleep(1);
        if ((++sp & 255u) == 0u) { if (xb_ld(&bar[XB_TMO])) break; if (sp > XB_SPIN_CAP) { atomicAdd(&bar[XB_TMO], 1u); break; } }
    }
    nloc = mine > 0u ? mine : 1u; nx = cnt > 0u ? cnt : 1u;
}
__device__ __forceinline__ void xcd_barrier(const XcdBarrier& b) {
    asm volatile("s_waitcnt vmcnt(0)" ::: "memory");
    __syncthreads();
    if (threadIdx.x == 0) {
        unsigned* bar = b.bar;
        __builtin_amdgcn_s_waitcnt(0);
        unsigned nloc = b.st[0], nx = b.st[1];
        if (nloc == 0u) { xcd_barrier_complete(bar, b.x, nloc, nx); b.st[0] = nloc; b.st[1] = nx; }
        const unsigned old = xb_add(&bar[XB_XSUB(b.x)], 1u);
        const unsigned gen = old / nloc;
        if (old + 1u == (gen + 1u) * nloc) {
            __builtin_amdgcn_fence(__ATOMIC_RELEASE, "agent");
            asm volatile("s_waitcnt vmcnt(0)" ::: "memory");
            const unsigned og = xb_add(&bar[XB_TOP], 1u);
            const unsigned tg = og / nx;
            if (og + 1u == (tg + 1u) * nx) xb_add(&bar[XB_TOPGEN], 1u);
            else XB_SPIN(xb_ld(&bar[XB_TOPGEN]) == tg, bar);
            __builtin_amdgcn_fence(__ATOMIC_ACQUIRE, "agent");
            xb_add(&bar[XB_XGEN(b.x)], 1u);
            asm volatile("s_waitcnt vmcnt(0)" ::: "memory");
        } else {
            XB_SPIN(xb_ld(&bar[XB_XGEN(b.x)]) == gen, bar);
            __builtin_amdgcn_fence(__ATOMIC_ACQUIRE, "agent");
            asm volatile("s_waitcnt vmcnt(0)" ::: "memory");
        }
    }
    __syncthreads();
}

struct Args {
    const float* in[35]; float* out; unsigned char* ws; int ph_lo, ph_hi;
};
enum { I_X = 0, I_WIN, I_QNORM, I_WUQ, I_KVNORM, I_WUKV, I_OUTNORM, I_CONVW, I_CONVB, I_DTBIAS, I_ALOG, I_SSDD, I_SSDNORM, I_HYCW, I_HYCB, I_HYW1, I_HYB1, I_HYW2, I_HYB2, I_HYW3, I_HYFREQ, I_HYBIAS, I_HYNORM,
       I_WOUT, I_LN1G, I_LN1B, I_LN2G, I_LN2B, I_FFG, I_FFU, I_FFD, I_ROUTER, I_MOEG, I_MOEU, I_MOED };

typedef __attribute__((address_space(4))) const Args CArgs;
struct AP { const CArgs* p;
    __device__ __forceinline__ const float* in(int i) const { return p->in[i]; }
    __device__ __forceinline__ float* out() const { return p->out; }
    __device__ __forceinline__ unsigned char* ws() const { return p->ws; } };
__device__ __forceinline__ AP kargs() { const CArgs* p = (const CArgs*)__builtin_amdgcn_kernarg_segment_ptr(); asm volatile("" : "+s"(p)); AP a; a.p = p; return a; }

__device__ __forceinline__ void transpose_item(const float* W, int K, int N, int nblk, bf16* WT, int GR, int GS, int off, LAS float* scr, int item, int lane) {
    const int kb = item / nblk, nb = item % nblk, k0 = 64 * kb, n0 = 32 * nb;
    const int nr = n0 + (lane & 31); const bool ok = nr < N;
    float tv[32]; const int nrc = ok ? nr : N - 1;
#pragma unroll
    for (int i = 0; i < 32; ++i) { const int kk = 2 * i + (lane >> 5); tv[i] = __builtin_nontemporal_load(W + (size_t)(k0 + kk) * N + nrc); }
#pragma unroll
    for (int i = 0; i < 32; ++i) { const int kk = 2 * i + (lane >> 5); scr[kk * 33 + (lane & 31)] = ok ? tv[i] : 0.f; }
    LDS_WAIT(); asm volatile("" ::: "memory");
    const int c = lane & 7;
#pragma unroll
    for (int j = 0; j < 4; ++j) { const int nl = (lane >> 3) + 8 * j; const int n = n0 + nl; const LAS float* s = scr + (8 * c) * 33 + nl;
        v4u o; o.x = pk2(s[0 * 33], s[1 * 33]); o.y = pk2(s[2 * 33], s[3 * 33]); o.z = pk2(s[4 * 33], s[5 * 33]); o.w = pk2(s[6 * 33], s[7 * 33]);
        const int dest = (n / GR) * GS + (n % GR) + off;
        *(GAS v4u*)(WT + (size_t)dest * K + k0 + 8 * c) = o; }
    LDS_WAIT(); asm volatile("" ::: "memory");
}
__device__ __forceinline__ unsigned pk4_fp8(float a, float b, float c, float d) { int w = 0; w = __builtin_amdgcn_cvt_pk_fp8_f32(a, b, w, false); w = __builtin_amdgcn_cvt_pk_fp8_f32(c, d, w, true); return (unsigned)w; }
struct TrF8 { const float* W; int K, N, nblk; unsigned char* WT; int GR, GS, off; float scl; };
__device__ __forceinline__ void tr_f8_load(const TrF8& j, int item, int lane, float (&tv)[32]) {
    const int kb = item / j.nblk, nb = item % j.nblk, k0 = 64 * kb, n0 = 32 * nb; const int nr = n0 + (lane & 31);
#pragma unroll
    for (int i = 0; i < 32; ++i) { const int kk = 2 * i + (lane >> 5); tv[i] = __builtin_nontemporal_load(j.W + (size_t)(k0 + kk) * j.N + nr); }
}
__device__ __forceinline__ void tr_f8_finish(const TrF8& j, int item, int lane, const float (&tv)[32], LAS float* scr) {
    const int kb = item / j.nblk, nb = item % j.nblk, k0 = 64 * kb, n0 = 32 * nb;
#pragma unroll
    for (int i = 0; i < 32; ++i) { const int kk = 2 * i + (lane >> 5); scr[kk * 33 + (lane & 31)] = tv[i] * j.scl; }
    LDS_WAIT(); asm volatile("" ::: "memory");
    const int nl = lane >> 1, hf = lane & 1, n = n0 + nl; const LAS float* sp = scr + (32 * hf) * 33 + nl;
    v4u o0, o1;
    o0.x = pk4_fp8(sp[0 * 33], sp[1 * 33], sp[2 * 33], sp[3 * 33]); o0.y = pk4_fp8(sp[4 * 33], sp[5 * 33], sp[6 * 33], sp[7 * 33]);
    o0.z = pk4_fp8(sp[8 * 33], sp[9 * 33], sp[10 * 33], sp[11 * 33]); o0.w = pk4_fp8(sp[12 * 33], sp[13 * 33], sp[14 * 33], sp[15 * 33]);
    o1.x = pk4_fp8(sp[16 * 33], sp[17 * 33], sp[18 * 33], sp[19 * 33]); o1.y = pk4_fp8(sp[20 * 33], sp[21 * 33], sp[22 * 33], sp[23 * 33]);
    o1.z = pk4_fp8(sp[24 * 33], sp[25 * 33], sp[26 * 33], sp[27 * 33]); o1.w = pk4_fp8(sp[28 * 33], sp[29 * 33], sp[30 * 33], sp[31 * 33]);
    const int dest = (n / j.GR) * j.GS + (n % j.GR) + j.off;
    GAS v4u* dp = (GAS v4u*)(j.WT + (size_t)dest * j.K + k0 + 32 * hf); dp[0] = o0; dp[1] = o1;
    LDS_WAIT(); asm volatile("" ::: "memory");
}
__device__ __forceinline__ void transpose_item_f8(const float* W, int K, int N, int nblk, unsigned char* WT, int GR, int GS, int off, float scl, LAS float* scr, int item, int lane) {
    TrF8 j{W, K, N, nblk, WT, GR, GS, off, scl}; float tv[32]; tr_f8_load(j, item, lane, tv); tr_f8_finish(j, item, lane, tv, scr);
}
struct TrJob { const float* W; int K, N, nblk; bf16* WT; int GR, GS, off; int items; };
__device__ __forceinline__ TrJob mk_job(const float* W, int K, int N, int Npad, bf16* WT, int GR, int GS, int off) { TrJob j; j.W = W; j.K = K; j.N = N; j.nblk = Npad / 32; j.WT = WT; j.GR = GR; j.GS = GS; j.off = off; j.items = (K / 64) * (Npad / 32); return j; }

__device__ __forceinline__ void hyena_filter_item(const AP& a, int layer, int pos, bf16* HYG, LAS float* scr, int lane) {
    const float* w1 = a.in(I_HYW1) + layer * 33 * 64; const float* b1 = a.in(I_HYB1) + layer * 64;
    const float* w2 = a.in(I_HYW2) + layer * 64 * 64; const float* b2 = a.in(I_HYB2) + layer * 64;
    const float* w3 = a.in(I_HYW3) + (size_t)layer * 64 * 2048; const float* fr = a.in(I_HYFREQ) + layer * 128;
    const float t = (float)pos / 2047.0f; const float ang = 6.283185307179586f * (float)pos / 2048.0f;
    if (lane < 33) { float z;
        if (lane == 0) z = t;
        else { const int k = (lane - 1) & 15; const float f = 1e-4f + (float)k * ((15.0f - 1e-4f) / 15.0f); z = (lane <= 16) ? cosf(f * ang) : -sinf(f * ang); }
        scr[lane] = z; }
    LDS_WAIT(); asm volatile("" ::: "memory");
    float s = b1[lane];
    for (int i = 0; i < 33; ++i) s += scr[i] * w1[i * 64 + lane];
    const float h1 = sinf(fr[lane] * s);
    scr[64 + lane] = h1;
    LDS_WAIT(); asm volatile("" ::: "memory");
    float s2 = b2[lane];
    for (int i = 0; i < 64; ++i) s2 += scr[64 + i] * w2[i * 64 + lane];
    const float h2 = sinf(fr[64 + lane] * s2);
    scr[128 + lane] = h2;
    LDS_WAIT(); asm volatile("" ::: "memory");
    for (int m = 0; m < 32; ++m) { const int col = lane + 64 * m; float v = 0.f;
        for (int i = 0; i < 64; ++i) v += scr[128 + i] * w3[(size_t)i * 2048 + col];
        const int o = col >> 10, dir = (col >> 9) & 1, c = col & 511;
        const float delta = fabsf(-3.0701134573253945f + (float)c * ((-15.350567286626973f + 3.0701134573253945f) / 511.0f));
        v *= expf(-t * delta);
        if (dir == 0 || pos > 0) { const int n = dir == 0 ? HY_OFF - pos : HY_OFF + pos;
            HYG[(((size_t)layer * 2 + o) * 512 + c) * HY_GLEN + n] = (bf16)f2bf(v); } }
    LDS_WAIT(); asm volatile("" ::: "memory");
}

__device__ __forceinline__ void ln_load(const float* xrow, int lane, f32x4 (&v)[8]) { const GAS f32x4* xr = (const GAS f32x4*)xrow + lane;
#pragma unroll
    for (int j = 0; j < 8; ++j) v[j] = xr[64 * j]; }
__device__ __forceinline__ void ln_row(float* xrow, bf16* brow, const float* g, const float* b, int lane, f32x4 (&v)[8], const bf16* y0, const bf16* y1, float* orow, unsigned char* frow = nullptr) {
    float s = 0.f; (void)xrow;
#pragma unroll
    for (int j = 0; j < 8; ++j) {
        if (y0) { v2u a0 = *((const GAS v2u*)y0 + lane + 64 * j), a1 = *((const GAS v2u*)y1 + lane + 64 * j); if (ZERO_MOE) { a0.x = a0.y = a1.x = a1.y = 0u; }
            v[j].x = ALPHA * v[j].x + bflo(a0.x) + bflo(a1.x); v[j].y = ALPHA * v[j].y + bfhi(a0.x) + bfhi(a1.x); v[j].z = ALPHA * v[j].z + bflo(a0.y) + bflo(a1.y); v[j].w = ALPHA * v[j].w + bfhi(a0.y) + bfhi(a1.y); }
        s += (v[j].x + v[j].y) + (v[j].z + v[j].w); }
    const float mean = wave_sum(s) * (1.f / DM); float s2 = 0.f;
#pragma unroll
    for (int j = 0; j < 8; ++j) { v[j] = v[j] - mean; s2 += (v[j].x * v[j].x + v[j].y * v[j].y) + (v[j].z * v[j].z + v[j].w * v[j].w); }
    const float rstd = 1.f / sqrtf(wave_sum(s2) * (1.f / DM) + 1e-5f);
    GAS f32x4* xo = (GAS f32x4*)orow + lane;
#pragma unroll
    for (int j = 0; j < 8; ++j) { const f32x4 gg = *((const GAS f32x4*)g + lane + 64 * j), bb = *((const GAS f32x4*)b + lane + 64 * j);
        v[j] = v[j] * rstd * gg + bb; xo[64 * j] = v[j];
        if (brow) { v2u w; w.x = pk2(v[j].x, v[j].y); w.y = pk2(v[j].z, v[j].w); *((GAS v2u*)brow + lane + 64 * j) = w; }
        if (frow) *((GAS unsigned*)frow + lane + 64 * j) = pk4_fp8(v[j].x, v[j].y, v[j].z, v[j].w); }
}

__device__ __forceinline__ void ld8bf(const bf16* p, float (&f)[8]) { const v4u w = *(const GAS v4u*)p; f[0] = bflo(w.x); f[1] = bfhi(w.x); f[2] = bflo(w.y); f[3] = bfhi(w.y); f[4] = bflo(w.z); f[5] = bfhi(w.z); f[6] = bflo(w.w); f[7] = bfhi(w.w); }
__device__ __forceinline__ void st8bf(bf16* p, const float (&f)[8]) { v4u w; w.x = pk2(f[0], f[1]); w.y = pk2(f[2], f[3]); w.z = pk2(f[4], f[5]); w.w = pk2(f[6], f[7]); *(GAS v4u*)p = w; }

__device__ __forceinline__ float sum8(float v) { v += swz_xor<1>(v); v += swz_xor<2>(v); v += swz_xor<4>(v); return v; }
__device__ __forceinline__ void prep_rows8(const AP& a, int layer, int item, int lane, unsigned char* ws, const LAS float* cwl) {
    const int rr = lane >> 3, sub = lane & 7, row = item * 8 + rr, t = row & (SEQ - 1);
    const bf16* pr = (const bf16*)(ws + WS_PROJ) + (size_t)row * NINP;
    { float f[6][8]; float ss = 0.f;
#pragma unroll
      for (int i = 0; i < 6; ++i) { ld8bf(pr + C_QC + (sub + 8 * i) * 8, f[i]);
#pragma unroll
          for (int j = 0; j < 8; ++j) ss += f[i][j] * f[i][j]; }
      const float rs = 1.0f / sqrtf(sum8(ss) * (1.f / 384.f) + 1e-6f);
#pragma unroll
      for (int i = 0; i < 6; ++i) { const float* w = a.in(I_QNORM) + layer * 384 + (sub + 8 * i) * 8;
#pragma unroll
          for (int j = 0; j < 8; ++j) f[i][j] = f[i][j] * rs * w[j];
          st8bf((bf16*)(ws + WS_QN) + (size_t)row * 384 + (sub + 8 * i) * 8, f[i]); } }
    { float f[4][8]; float ss = 0.f;
#pragma unroll
      for (int i = 0; i < 4; ++i) { ld8bf(pr + C_KVC + (sub + 8 * i) * 8, f[i]);
#pragma unroll
          for (int j = 0; j < 8; ++j) ss += f[i][j] * f[i][j]; }
      const float rs = 1.0f / sqrtf(sum8(ss) * (1.f / 256.f) + 1e-6f);
#pragma unroll
      for (int i = 0; i < 4; ++i) { const float* w = a.in(I_KVNORM) + layer * 256 + (sub + 8 * i) * 8;
#pragma unroll
          for (int j = 0; j < 8; ++j) f[i][j] = f[i][j] * rs * w[j];
          st8bf((bf16*)(ws + WS_KVN) + (size_t)row * 256 + (sub + 8 * i) * 8, f[i]); } }
    { float sn[4], cs[4];
#pragma unroll
      for (int j = 0; j < 4; ++j) { const float inv = exp2f(-(float)(4 * sub + j) * (13.287712379549449f / 32.0f)); sincosf((float)t * inv, &sn[j], &cs[j]); }
#pragma unroll
      for (int g = 0; g < 9; ++g) { int src; bf16* dst; float sc = 1.f;
          if (g == 0) { src = C_KPE; dst = (bf16*)(ws + WS_KPE) + (size_t)row * 64; }
          else if (g < 5) { src = C_RQ + (g - 1) * 64; dst = (bf16*)(ws + WS_RQ) + (size_t)row * 256 + (g - 1) * 64; }
          else { src = C_RK + (g - 5) * 64; dst = (bf16*)(ws + WS_RK) + (size_t)row * 256 + (g - 5) * 64; sc = 0.125f; }
          const v2u a1 = *(const GAS v2u*)(pr + src + 4 * sub), a2 = *(const GAS v2u*)(pr + src + 32 + 4 * sub);
          const float x1[4] = {bflo(a1.x), bfhi(a1.x), bflo(a1.y), bfhi(a1.y)}, x2[4] = {bflo(a2.x), bfhi(a2.x), bflo(a2.y), bfhi(a2.y)};
          float y1[4], y2[4];
#pragma unroll
          for (int j = 0; j < 4; ++j) { y1[j] = (x1[j] * cs[j] - x2[j] * sn[j]) * sc; y2[j] = (x2[j] * cs[j] + x1[j] * sn[j]) * sc; }
          v2u o1, o2; o1.x = pk2(y1[0], y1[1]); o1.y = pk2(y1[2], y1[3]); o2.x = pk2(y2[0], y2[1]); o2.y = pk2(y2[2], y2[3]);
          *(GAS v2u*)(dst + 4 * sub) = o1; *(GAS v2u*)(dst + 32 + 4 * sub) = o2; } }
#pragma unroll 4
    for (int i = 0; i < 16; ++i) { const int c0 = (sub + 8 * i) * 8; float acc[8];
        { const f32x4 b0 = *(const LAS f32x4*)(cwl + 5 * 1024 + c0), b1 = *(const LAS f32x4*)(cwl + 5 * 1024 + c0 + 4); acc[0] = b0.x; acc[1] = b0.y; acc[2] = b0.z; acc[3] = b0.w; acc[4] = b1.x; acc[5] = b1.y; acc[6] = b1.z; acc[7] = b1.w; }
#pragma unroll
        for (int k = 0; k < 5; ++k) { const int tt = t + k - 2;
            if (tt >= 0 && tt < SEQ) { float f[8]; ld8bf(pr + (long)(k - 2) * NINP + C_XBC + c0, f);
                const f32x4 w0 = *(const LAS f32x4*)(cwl + k * 1024 + c0), w1 = *(const LAS f32x4*)(cwl + k * 1024 + c0 + 4);
                acc[0] += w0.x * f[0]; acc[1] += w0.y * f[1]; acc[2] += w0.z * f[2]; acc[3] += w0.w * f[3]; acc[4] += w1.x * f[4]; acc[5] += w1.y * f[5]; acc[6] += w1.z * f[6]; acc[7] += w1.w * f[7]; } }
#pragma unroll
        for (int j = 0; j < 8; ++j) acc[j] = silu(acc[j]);
        st8bf((bf16*)(ws + WS_XBC) + (size_t)row * 1024 + c0, acc); }
}
__device__ __forceinline__ void prep_scan(const AP& a, int layer, int item, int lane, unsigned char* ws, LAS float* scr) {
    const int b = item >> 4, dir = (item >> 3) & 1, hh = item & 7;
    const float* DTF = (const float*)(ws + WS_DTF); float* SSDP = (float*)(ws + WS_SSDP);
    const float bias = a.in(I_DTBIAS)[layer * 16 + dir * 8 + hh]; const float av = -expf(a.in(I_ALOG)[layer * 16 + dir * 8 + hh]);
    float dt[32]; float tot = 0.f;
#pragma unroll
    for (int j = 0; j < 32; ++j) { const int row = b * SEQ + lane * 32 + j; const float x = DTF[(size_t)row * 16 + dir * 8 + hh] + bias;
        dt[j] = x > 20.f ? x : log1pf(expf(x)); tot += dt[j] * av; }
    scr[lane] = tot; LDS_WAIT(); asm volatile("" ::: "memory");
    float excl = 0.f, T = 0.f;
#pragma unroll 2
    for (int l = 0; l < 64; ++l) { const float v = scr[l]; T += v; excl += (l < lane) ? v : 0.f; }
    LDS_WAIT(); asm volatile("" ::: "memory");
    float run = excl;
#pragma unroll
    for (int j = 0; j < 32; ++j) { const int row = b * SEQ + lane * 32 + j; const float la = dt[j] * av; float c;
        if (dir == 0) { run += la; c = run; } else { c = T - run; run += la; }
        f32x2 o; o.x = c * 1.4426950408889634f; o.y = log2f(dt[j]) - o.x;
        *(GAS f32x2*)(SSDP + ((size_t)row * 8 + hh) * 4 + dir * 2) = o; }
}
__device__ __forceinline__ void prep_hyconv(const AP& a, int layer, int item, int lane, unsigned char* ws, LAS bf16* scr) {
    const int cg = item % 24, tt = (item / 24) & 31, b = item / (24 * 32);
    const int ch = cg * 64 + lane, part = ch >> 9, c = ch & 511, t0 = tt * 64;
    const bf16* PROJ = (const bf16*)(ws + WS_PROJ); const bf16* tile = PROJ + (size_t)(b * SEQ) * NINP + C_HU + cg * 64;
    v4u ld[9];
#pragma unroll
    for (int i = 0; i < 9; ++i) { const int id = lane + 64 * i, r = id >> 3, c8 = id & 7, t = t0 - 1 + r;
        ld[i] = (id < 66 * 8 && t >= 0 && t < SEQ) ? *(const GAS v4u*)(tile + (size_t)t * NINP + c8 * 8) : (v4u){0u, 0u, 0u, 0u}; }
#pragma unroll
    for (int i = 0; i < 9; ++i) { const int id = lane + 64 * i, r = id >> 3, c8 = id & 7; if (id < 66 * 8) *(LAS v4u*)(scr + r * 72 + c8 * 8) = ld[i]; }
    const float* cw = a.in(I_HYCW) + layer * 3 * 1536; const float w0 = cw[ch], w1 = cw[1536 + ch], w2 = cw[3072 + ch], bs = a.in(I_HYCB)[layer * 1536 + ch];
    LDS_WAIT(); asm volatile("" ::: "memory");
    float xm = bf2f(scr[lane]), x0 = bf2f(scr[72 + lane]);
    bf16* dst = (bf16*)(ws + WS_UT) + (((size_t)part * 512 + c) * NB + b) * SEQ + t0;
#pragma unroll
    for (int q = 0; q < 8; ++q) { float u[8];
#pragma unroll
        for (int j = 0; j < 8; ++j) { const float xp = bf2f(scr[(q * 8 + j + 2) * 72 + lane]);
            u[j] = bs + w0 * xm + w1 * x0 + w2 * xp; xm = x0; x0 = xp; }
        st8bf(dst + q * 8, u); }
    LDS_WAIT(); asm volatile("" ::: "memory");
}

__device__ __forceinline__ void post_row(const AP& a, int layer, int row, int lane, unsigned char* ws) {
    bf16* MIX = (bf16*)(ws + WS_MIX) + (size_t)row * DM;
    { float f[8]; ld8bf((const bf16*)(ws + WS_ATT) + (size_t)row * 512 + lane * 8, f); float ss = 0.f;
#pragma unroll
      for (int j = 0; j < 8; ++j) ss += f[j] * f[j];
      const float rs = 1.0f / sqrtf(wave_sum(ss) * (1.f / 512.f) + 1e-6f); const float* w = a.in(I_OUTNORM) + layer * 512 + lane * 8;
#pragma unroll
      for (int j = 0; j < 8; ++j) f[j] = ZERO_A ? 0.f : f[j] * rs * w[j];
      st8bf(MIX + lane * 8, f); }
    { float f[8], z[8]; ld8bf((const bf16*)(ws + WS_YC) + (size_t)row * 512 + lane * 8, f); ld8bf((const bf16*)(ws + WS_PROJ) + (size_t)row * NINP + C_MZ + lane * 8, z); float ss = 0.f;
#pragma unroll
      for (int j = 0; j < 8; ++j) { f[j] = f[j] * silu(z[j]); ss += f[j] * f[j]; }
      const float rs = 1.0f / sqrtf(wave_sum(ss) * (1.f / 512.f) + 1e-6f); const float* w = a.in(I_SSDNORM) + layer * 512 + lane * 8;
#pragma unroll
      for (int j = 0; j < 8; ++j) f[j] = ZERO_C ? 0.f : f[j] * rs * w[j];
      st8bf(MIX + 1024 + lane * 8, f); }
}
__device__ __forceinline__ void post_hy(const AP& a, int layer, int item, int lane, unsigned char* ws, LAS bf16* scr) {
    const int b = item >> 7, t0 = (item & 127) * 16, tl = lane & 15, cs = lane >> 4;
    const bf16* ZT = (const bf16*)(ws + WS_ZT) + (size_t)b * SEQ + t0 + tl; const float* w = a.in(I_HYNORM) + layer * 512;
    float ss = 0.f;
#pragma unroll 16
    for (int cc = 0; cc < 128; ++cc) { const float v = bf2f(ZT[(size_t)(cc * 4 + cs) * M]); ss += v * v; }
    ss += swz_xor<16>(ss);
    { auto rr = __builtin_amdgcn_permlane32_swap(__float_as_uint(ss), __float_as_uint(ss), false, false); const unsigned r0 = rr[0], r1 = rr[1]; ss = __uint_as_float(r0) + __uint_as_float(r1); }
    const float rs = 1.0f / sqrtf(ss * (1.f / 512.f) + 1e-6f);
    for (int cg = 0; cg < 8; ++cg) {
#pragma unroll
        for (int jj = 0; jj < 16; ++jj) { const int cl = jj * 4 + cs, c = cg * 64 + cl; scr[tl * 72 + cl] = (bf16)f2bf(ZERO_D ? 0.f : bf2f(ZT[(size_t)c * M]) * rs * w[c]); }
        LDS_WAIT(); asm volatile("" ::: "memory");
#pragma unroll
        for (int i = 0; i < 2; ++i) { const int t2 = (lane >> 3) + 8 * i, c8 = lane & 7; const v4u v = *(const LAS v4u*)(scr + t2 * 72 + c8 * 8);
            *(GAS v4u*)((bf16*)(ws + WS_MIX) + (size_t)(b * SEQ + t0 + t2) * DM + 1536 + cg * 64 + c8 * 8) = v; }
        LDS_WAIT(); asm volatile("" ::: "memory");
    }
}

namespace mixb {
#define SBAR() __builtin_amdgcn_sched_barrier(0)
__device__ __forceinline__ int crow(int r, int hi) { return (r & 3) + 8 * (r >> 2) + 4 * hi; }
__device__ __forceinline__ unsigned cvtpk(float lo, float hi) { unsigned r; asm volatile("v_cvt_pk_bf16_f32 %0, %1, %2" : "=v"(r) : "v"(lo), "v"(hi)); return r; }
__device__ __forceinline__ int v_st(int k, int c) { const int kk = (k & ~0xC) | ((k & 4) << 1) | ((k & 8) >> 1); return ((kk >> 3) * 4 + (c >> 5)) * 512 + ((kk & 7) * 32 + (c & 31)) * 2; }
__device__ __forceinline__ int v_rd_base(int lane) { return ((lane & 3) << 3) | (((lane >> 2) & 3) << 6) | (((lane >> 4) & 1) << 5) | (((lane >> 5) & 1) << 8); }
constexpr int v_rd_off(int d0, int ks, int half) { return d0 * 512 + ks * 4096 + half * 2048; }
template <int OFF> __device__ __forceinline__ s16x4 tr_read(int vb) { s16x4 r; asm volatile("ds_read_b64_tr_b16 %0, %1 offset:%2" : "=&v"(r) : "v"(vb), "i"(OFF) : "memory"); return r; }
template <int D0> __device__ __forceinline__ void pv_one(f32x16& od, int vb, bf16x8 pa0, bf16x8 pa1, bf16x8 pa2, bf16x8 pa3) {
    const s16x4 l0 = tr_read<v_rd_off(D0, 0, 0)>(vb), h0 = tr_read<v_rd_off(D0, 0, 1)>(vb), l1 = tr_read<v_rd_off(D0, 1, 0)>(vb), h1 = tr_read<v_rd_off(D0, 1, 1)>(vb);
    const s16x4 l2 = tr_read<v_rd_off(D0, 2, 0)>(vb), h2 = tr_read<v_rd_off(D0, 2, 1)>(vb), l3 = tr_read<v_rd_off(D0, 3, 0)>(vb), h3 = tr_read<v_rd_off(D0, 3, 1)>(vb);
    asm volatile("s_waitcnt lgkmcnt(0)" ::: "memory"); SBAR();
#define PKV(L, H) (bf16x8){L[0], L[1], L[2], L[3], H[0], H[1], H[2], H[3]}
    od = __builtin_amdgcn_mfma_f32_32x32x16_bf16(pa0, PKV(l0, h0), od, 0, 0, 0);
    od = __builtin_amdgcn_mfma_f32_32x32x16_bf16(pa1, PKV(l1, h1), od, 0, 0, 0);
    od = __builtin_amdgcn_mfma_f32_32x32x16_bf16(pa2, PKV(l2, h2), od, 0, 0, 0);
    od = __builtin_amdgcn_mfma_f32_32x32x16_bf16(pa3, PKV(l3, h3), od, 0, 0, 0);
#undef PKV
}
__device__ __forceinline__ void fast_sincos(float x, float& s, float& c) { float r = x * 0.15915494309189535f; r = r - floorf(r); s = __builtin_amdgcn_sinf(r); c = __builtin_amdgcn_cosf(r); }

struct MixP {
    const bf16* q; int ldq;
    const bf16* k0; int ldk0; const bf16* k1; int ldk1;
    const bf16* v; int ldv;
    bf16* o; int ldo;
    float lf, lb;
    const float* ssdp;
    const bf16* aux; int ldaux; float dh;
    const bf16* st;
};
constexpr int V_BYTES = 16384, V_OFF = 0, K_OFF = 2 * V_BYTES;
template <int DQK> struct KL { static constexpr int PITCH = DQK * 2, BYTES = 64 * PITCH, WK_OFF = K_OFF + 2 * BYTES, SCR_OFF = WK_OFF + 2176, END = SCR_OFF + NWAVES * 256; };

template <int MODE, int DQK, int DV>
__device__ __forceinline__ void mix_unit(const MixP& P, int q0, LAS unsigned char* lds, int tid) {
    typedef KL<DQK> L;
    constexpr int ND = DQK / 16, NV = DV / 32, CPR = DQK / 8, KCH = 64 * CPR / 512, VPR = DV / 8, VCH = (64 * VPR + 511) / 512;
    constexpr float SCALE = 0.07216878364870322f;
    constexpr float C = SCALE * 1.4426950408889634f, THR = 8.f;
    asm volatile("" : "+v"(tid));
    const int wid = tid >> 6, lane = tid & 63, r32 = lane & 31, hi = lane >> 5;
    const int qrow = q0 + wid * 32 + r32;
    LAS unsigned char* Vl = lds + V_OFF; LAS unsigned char* Kl = lds + K_OFF;
    LAS float* wsc = (LAS float*)(lds + L::SCR_OFF) + wid * 64; LAS float* li_l = wsc; LAS float* al_l = wsc + 32;
    LAS f32x4* wk_l = (LAS f32x4*)(lds + L::WK_OFF);
    LAS f32x2* wkref_l = (LAS f32x2*)(lds + L::WK_OFF + 2048);
    const int wq0 = q0 + __builtin_amdgcn_readfirstlane(wid) * 32;
    bf16x8 qr[ND];
    { const bf16* Qw = P.q + (long)qrow * P.ldq + hi * 8;
#pragma unroll
      for (int d0 = 0; d0 < ND; ++d0) qr[d0] = *(const GAS bf16x8*)(Qw + d0 * 16); }
    if constexpr (MODE == 0) {
#pragma unroll
        for (int dd = 0; dd < 2; ++dd)
#pragma unroll
            for (int j = 0; j < 8; ++j) { const int i = dd * 16 + hi * 8 + j; const float inv = exp2f(-(float)i * (13.287712379549449f / 32.0f)); float sn, cs; fast_sincos((float)qrow * inv, sn, cs);
                const float x1 = bf2f((unsigned short)qr[8 + dd][j]), x2 = bf2f((unsigned short)qr[10 + dd][j]);
                qr[8 + dd][j] = (short)f2bf(x1 * cs - x2 * sn); qr[10 + dd][j] = (short)f2bf(x2 * cs + x1 * sn); }
    }
    float cf_i = 0.f, rb_i = 0.f;
    if constexpr (MODE == 2) { const f32x4 w = *(const GAS f32x4*)(P.ssdp + (size_t)qrow * 32); cf_i = w.x; rb_i = w.z; }
    bf16x8 ks[KCH], vs[VCH]; f32x4 wkreg = {0.f, 0.f, 0.f, 0.f}; float crf = 0.f, rrf = 0.f;
#define MX_SLOAD(kr0) do { \
    _Pragma("unroll") for (int i = 0; i < KCH; ++i) { const int cid = tid + 512 * i, row = cid / CPR, c8 = cid % CPR; \
        const bf16* src = (MODE == 0 && c8 >= 16) ? P.k1 + (long)((kr0) + row) * P.ldk1 + (c8 - 16) * 8 : P.k0 + (long)((kr0) + row) * P.ldk0 + c8 * 8; \
        ks[i] = *(const GAS bf16x8*)src; } \
    _Pragma("unroll") for (int i = 0; i < VCH; ++i) { const int cid = tid + 512 * i, row = cid / VPR, c8 = cid % VPR; \
        if (VCH * 512 == 64 * VPR || cid < 64 * VPR) vs[i] = *(const GAS bf16x8*)(P.v + (long)((kr0) + row) * P.ldv + c8 * 8); } \
    if (MODE == 2) { if (tid < 64) { wkreg = *(const GAS f32x4*)(P.ssdp + (size_t)((kr0) + tid) * 32); crf = P.ssdp[(size_t)((kr0) + 63) * 32]; rrf = P.ssdp[(size_t)(kr0) * 32 + 2]; } } } while (0)
#define MX_SWRITE(b) do { \
    _Pragma("unroll") for (int i = 0; i < KCH; ++i) { const int cid = tid + 512 * i, row = cid / CPR, c8 = cid % CPR; \
        *(LAS bf16x8*)(Kl + (b) * L::BYTES + row * L::PITCH + ((c8 * 16) ^ ((row & 7) << 4))) = ks[i]; } \
    _Pragma("unroll") for (int i = 0; i < VCH; ++i) { const int cid = tid + 512 * i, row = cid / VPR, c8 = cid % VPR; \
        if (VCH * 512 == 64 * VPR || cid < 64 * VPR) *(LAS bf16x8*)(Vl + (b) * V_BYTES + v_st(row, c8 * 8)) = vs[i]; } \
    if (MODE == 2) { if (tid < 64) { wk_l[(b) * 64 + tid] = (f32x4){wkreg.y, wkreg.w, __builtin_amdgcn_exp2f(wkreg.y + crf), __builtin_amdgcn_exp2f(wkreg.w + rrf)}; if (tid == 0) wkref_l[(b)] = (f32x2){crf, rrf}; } } } while (0)
    float bfw0[16], bbw0[16]; float c32f = 1.f, c32b = 1.f;
    if constexpr (MODE == 1) {
#pragma unroll
        for (int r = 0; r < 16; ++r) { const int j0 = crow(r, hi);
            bfw0[r] = __builtin_amdgcn_exp2f((float)(63 - j0) * P.lf); bbw0[r] = __builtin_amdgcn_exp2f((float)j0 * P.lb); }
        c32f = __builtin_amdgcn_exp2f(-32.f * P.lf); c32b = __builtin_amdgcn_exp2f(32.f * P.lb);
    }
    float m_reg = -1e30f, l_reg = 0.f; f32x16 o[NV];
#pragma unroll
    for (int d = 0; d < NV; ++d) o[d] = f32x16{};
    const int vb0 = (int)(uintptr_t)(Vl) + v_rd_base(lane);
    constexpr int NT = SEQ / 64;
    int jlo = 0, jhi = NT - 1;
#if FARFIELD
    if constexpr (MODE != 0) {
        const int Bq = q0 >> 8; jlo = 4 * Bq; jhi = jlo + 3;
        float fv[7];
#pragma unroll
        for (int idx = 0; idx < 7; ++idx) { const int Bp = idx < Bq ? idx : idx + 1;
            if constexpr (MODE == 1) fv[idx] = (Bp < Bq) ? __builtin_amdgcn_exp2f((float)(qrow - 256 * (Bp + 1)) * P.lf) : __builtin_amdgcn_exp2f((float)(256 * Bp - qrow) * P.lb);
            else fv[idx] = (Bp < Bq) ? __builtin_amdgcn_exp2f(cf_i - P.ssdp[(size_t)(256 * Bp + 255) * 32 + 0]) : __builtin_amdgcn_exp2f(rb_i - P.ssdp[(size_t)(256 * Bp) * 32 + 2]); }
        constexpr int CPRS = DQK / 8;
        v4u stv[14];
#pragma unroll
        for (int i = 0; i < 14; ++i) { const int cid = tid + 512 * i, s = cid >> 10, w = cid & 1023; const int Bp = s < Bq ? s : s + 1;
            stv[i] = *(const GAS v4u*)(P.st + ((size_t)Bp * 2 + (Bp < Bq ? 0 : 1)) * (DV * DQK) + (size_t)w * 8); }
        MX_SLOAD(jlo * 64);
#pragma unroll
        for (int i = 0; i < 14; ++i) { const int cid = tid + 512 * i, s = cid >> 10, w = cid & 1023, row = w / CPRS, ch = w % CPRS;
            *(LAS v4u*)(lds + s * 16384 + row * (DQK * 2) + ((ch ^ (row & 7)) * 16)) = stv[i]; }
        __syncthreads();
#pragma unroll
        for (int s = 0; s < 7; ++s) { const float f = fv[s]; bf16x8 qs[ND];
#pragma unroll
            for (int d0 = 0; d0 < ND; ++d0) { v4u w;
                w.x = cvtpk(bf2f((unsigned short)qr[d0][0]) * f, bf2f((unsigned short)qr[d0][1]) * f); w.y = cvtpk(bf2f((unsigned short)qr[d0][2]) * f, bf2f((unsigned short)qr[d0][3]) * f);
                w.z = cvtpk(bf2f((unsigned short)qr[d0][4]) * f, bf2f((unsigned short)qr[d0][5]) * f); w.w = cvtpk(bf2f((unsigned short)qr[d0][6]) * f, bf2f((unsigned short)qr[d0][7]) * f);
                qs[d0] = __builtin_bit_cast(bf16x8, w); }
#pragma unroll
            for (int d0v = 0; d0v < NV; ++d0v)
#pragma unroll
                for (int ks = 0; ks < ND; ++ks) { const bf16x8 sf = *(const LAS bf16x8*)(lds + s * 16384 + (32 * d0v + r32) * (DQK * 2) + (((2 * ks + hi) ^ (r32 & 7)) * 16));
                    o[d0v] = __builtin_amdgcn_mfma_f32_32x32x16_bf16(qs[ks], sf, o[d0v], 0, 0, 0); }
            SBAR(); }
        __syncthreads();
#define FF_LOAD(a, b)
#undef FF_LOAD
    }
#else
    if constexpr (MODE == 2) {
        const int l = lane & 31, qt = q0 >> 6;
        const float cfq = P.ssdp[(size_t)q0 * 32 + 0], rbq = P.ssdp[(size_t)(q0 + 255) * 32 + 2];
        const float cfe = P.ssdp[(size_t)(64 * l + 63) * 32 + 0], rbs = P.ssdp[(size_t)(64 * l) * 32 + 2];
        const bool keep = (l < qt) ? (cfq - cfe > -24.f) : ((l > qt + 3) ? (rbq - rbs > -24.f) : true);
        const unsigned m32 = (unsigned)__ballot(keep);
        jlo = __builtin_amdgcn_readfirstlane(__builtin_ctz(m32)); jhi = __builtin_amdgcn_readfirstlane(31 - __builtin_clz(m32));
    } else if constexpr (MODE == 1) {
        const float dmf = 24.f / (-P.lf), dmb = 24.f / (-P.lb);
        int a = (int)floorf(((float)(q0 - 63) - dmf) * (1.f / 64.f)) + 1; int b = (int)ceilf(((float)(q0 + 255) + dmb) * (1.f / 64.f)) - 1;
        jlo = a < 0 ? 0 : a; jhi = b > NT - 1 ? NT - 1 : b;
        jlo = __builtin_amdgcn_readfirstlane(jlo); jhi = __builtin_amdgcn_readfirstlane(jhi);
    }
#endif
    if (!(FARFIELD && MODE != 0)) MX_SLOAD(jlo * 64);
    VM_WAIT(); MX_SWRITE(0); __syncthreads();
    for (int j = jlo; j <= jhi; ++j) {
        const int buf = (j - jlo) & 1; const int kr0 = j * 64;
        if (j < jhi) MX_SLOAD(kr0 + 64);
        f32x16 p0 = f32x16{}, p1 = f32x16{};
        { LAS unsigned char* Kb = Kl + buf * L::BYTES;
#pragma unroll
          for (int dg = 0; dg < ND / 4; ++dg) { bf16x8 kb0[4], kb1[4];
#pragma unroll
              for (int dd = 0; dd < 4; ++dd) { const int cb = ((dg * 4 + dd) * 16 + hi * 8) * 2;
                  kb0[dd] = *(const LAS bf16x8*)(Kb + r32 * L::PITCH + (cb ^ ((r32 & 7) << 4)));
                  kb1[dd] = *(const LAS bf16x8*)(Kb + (32 + r32) * L::PITCH + (cb ^ ((r32 & 7) << 4))); }
              LDS_WAIT(); SBAR();
#pragma unroll
              for (int dd = 0; dd < 4; ++dd) { p0 = __builtin_amdgcn_mfma_f32_32x32x16_bf16(kb0[dd], qr[dg * 4 + dd], p0, 0, 0, 0);
                  p1 = __builtin_amdgcn_mfma_f32_32x32x16_bf16(kb1[dd], qr[dg * 4 + dd], p1, 0, 0, 0); }
              SBAR(); } }
        if constexpr (MODE == 0) {
            float pmax = p0[0];
#pragma unroll
            for (int r = 1; r < 16; ++r) pmax = fmaxf(pmax, p0[r]);
#pragma unroll
            for (int r = 0; r < 16; ++r) pmax = fmaxf(pmax, p1[r]);
            { auto rr = __builtin_amdgcn_permlane32_swap(__float_as_uint(pmax), __float_as_uint(pmax), false, false); pmax = fmaxf(__uint_as_float(rr[0]), __uint_as_float(rr[1])); }
            float mn, alpha;
            if (__all(pmax - m_reg <= THR / SCALE)) { mn = m_reg; alpha = 1.f; }
            else { mn = fmaxf(m_reg, pmax); alpha = __builtin_amdgcn_exp2f((m_reg - mn) * C); m_reg = mn; }
            const float mnC = -mn * C;
#pragma unroll
            for (int r = 0; r < 16; ++r) { p0[r] = __builtin_amdgcn_exp2f(fmaf(p0[r], C, mnC)); p1[r] = __builtin_amdgcn_exp2f(fmaf(p1[r], C, mnC)); }
            if (__any(alpha < 1.f)) { if (hi == 0) al_l[r32] = alpha; LDS_WAIT();
#pragma unroll
                for (int r = 0; r < 16; ++r) { const float av = al_l[crow(r, hi)];
#pragma unroll
                    for (int d = 0; d < NV; ++d) o[d][r] *= av; } }
            float ps = 0.f;
#pragma unroll
            for (int r = 0; r < 16; ++r) ps += p0[r] + p1[r];
            { auto rr = __builtin_amdgcn_permlane32_swap(__float_as_uint(ps), __float_as_uint(ps), false, false); ps = __uint_as_float(rr[0]) + __uint_as_float(rr[1]); }
            l_reg = l_reg * alpha + ps;
        } else if constexpr (MODE == 1) {
            if (kr0 + 63 <= wq0) {
                const float ai = __builtin_amdgcn_exp2f((float)(qrow - kr0 - 63) * P.lf);
                const float ai1 = ai * c32f;
#pragma unroll
                for (int r = 0; r < 16; ++r) { p0[r] *= ai * bfw0[r]; p1[r] *= ai1 * bfw0[r]; }
            } else if (kr0 > wq0 + 31) {
                const float ai = __builtin_amdgcn_exp2f((float)(kr0 - qrow) * P.lb);
                const float ai1 = ai * c32b;
#pragma unroll
                for (int r = 0; r < 16; ++r) { p0[r] *= ai * bbw0[r]; p1[r] *= ai1 * bbw0[r]; }
            } else {
#pragma unroll
                for (int r = 0; r < 16; ++r) { const int k0 = kr0 + crow(r, hi), k1 = k0 + 32;
                    const float e0 = (k0 <= qrow) ? (float)(qrow - k0) * P.lf : (float)(k0 - qrow) * P.lb;
                    const float e1 = (k1 <= qrow) ? (float)(qrow - k1) * P.lf : (float)(k1 - qrow) * P.lb;
                    p0[r] *= __builtin_amdgcn_exp2f(e0); p1[r] *= __builtin_amdgcn_exp2f(e1); }
            }
        } else {
            if (kr0 + 63 <= wq0) {
                const float ai = __builtin_amdgcn_exp2f(cf_i - wkref_l[buf].x);
#pragma unroll
                for (int r = 0; r < 16; ++r) { const int kk = crow(r, hi); p0[r] *= ai * wk_l[buf * 64 + kk].z; p1[r] *= ai * wk_l[buf * 64 + 32 + kk].z; }
            } else if (kr0 > wq0 + 31) {
                const float ai = __builtin_amdgcn_exp2f(rb_i - wkref_l[buf].y);
#pragma unroll
                for (int r = 0; r < 16; ++r) { const int kk = crow(r, hi); p0[r] *= ai * wk_l[buf * 64 + kk].w; p1[r] *= ai * wk_l[buf * 64 + 32 + kk].w; }
            } else {
#pragma unroll
                for (int r = 0; r < 16; ++r) { const int kk = crow(r, hi); const f32x4 w0 = wk_l[buf * 64 + kk], w1 = wk_l[buf * 64 + 32 + kk];
                    const int k0 = kr0 + kk, k1 = k0 + 32;
                    const float e0 = (k0 <= qrow) ? cf_i + w0.x : rb_i + w0.y;
                    const float e1 = (k1 <= qrow) ? cf_i + w1.x : rb_i + w1.y;
                    p0[r] *= __builtin_amdgcn_exp2f(e0); p1[r] *= __builtin_amdgcn_exp2f(e1); }
            }
        }
        bf16x8 pa0, pa1, pa2, pa3;
#define MX_PK4(PP, BASE, OUT) do { const unsigned a0 = cvtpk(PP[BASE + 0], PP[BASE + 1]), a1 = cvtpk(PP[BASE + 2], PP[BASE + 3]); \
    const unsigned b0 = cvtpk(PP[BASE + 4], PP[BASE + 5]), b1 = cvtpk(PP[BASE + 6], PP[BASE + 7]); \
    auto r0 = __builtin_amdgcn_permlane32_swap(a0, b0, false, false); auto r1 = __builtin_amdgcn_permlane32_swap(a1, b1, false, false); \
    v4u w = {r0[0], r1[0], r0[1], r1[1]}; OUT = __builtin_bit_cast(bf16x8, w); } while (0)
        MX_PK4(p0, 0, pa0); MX_PK4(p0, 8, pa1); MX_PK4(p1, 0, pa2); MX_PK4(p1, 8, pa3);
#undef MX_PK4
        { const int vb = vb0 + buf * V_BYTES;
          pv_one<0>(o[0], vb, pa0, pa1, pa2, pa3); pv_one<1>(o[1], vb, pa0, pa1, pa2, pa3);
          if constexpr (NV == 4) { pv_one<2>(o[2], vb, pa0, pa1, pa2, pa3); pv_one<3>(o[3], vb, pa0, pa1, pa2, pa3); } }
        if (j < jhi) { VM_WAIT(); MX_SWRITE(buf ^ 1); }
        __syncthreads();
    }
#undef MX_SLOAD
#undef MX_SWRITE
    const int orow0 = q0 + wid * 32;
    if constexpr (MODE == 0) {
        if (hi == 0) li_l[r32] = l_reg; LDS_WAIT();
#pragma unroll
        for (int r = 0; r < 16; ++r) { const int rr = crow(r, hi); const float rl = __builtin_amdgcn_rcpf(li_l[rr]);
#pragma unroll
            for (int d0 = 0; d0 < NV; ++d0) P.o[(long)(orow0 + rr) * P.ldo + d0 * 32 + r32] = (bf16)f2bf(o[d0][r] * rl); }
    } else if constexpr (MODE == 1) {
#pragma unroll
        for (int r = 0; r < 16; ++r) { const int rr = crow(r, hi);
            float s = 0.f;
#pragma unroll
            for (int d0 = 0; d0 < NV; ++d0) s += o[d0][r];
            s = half_sum(s);
            const float mean = s * (1.f / 128.f); float qv = 0.f;
#pragma unroll
            for (int d0 = 0; d0 < NV; ++d0) { const float dlt = o[d0][r] - mean; qv += dlt * dlt; }
            qv = half_sum(qv);
            const float rs = 1.0f / sqrtf(qv * (1.f / 128.f) + 1e-6f);
#pragma unroll
            for (int d0 = 0; d0 < NV; ++d0) { const float gt = bf2f(P.aux[(long)(orow0 + rr) * P.ldaux + d0 * 32 + r32]);
                P.o[(long)(orow0 + rr) * P.ldo + d0 * 32 + r32] = (bf16)f2bf(ZERO_B ? 0.f : (o[d0][r] - mean) * rs * silu(gt)); } }
    } else {
#pragma unroll
        for (int r = 0; r < 16; ++r) { const int rr = crow(r, hi);
#pragma unroll
            for (int d0 = 0; d0 < NV; ++d0) { const float xv = bf2f(P.aux[(long)(orow0 + rr) * P.ldaux + d0 * 32 + r32]);
                P.o[(long)(orow0 + rr) * P.ldo + d0 * 32 + r32] = (bf16)f2bf(o[d0][r] + xv * P.dh); } }
    }
    __syncthreads();
}
template <int MODE, int DK, int DV>
__device__ __forceinline__ void state_unit(const MixP& P, int Bk, bf16* ST, LAS unsigned char* lds, int tid) {
    asm volatile("" : "+v"(tid));
    const int wid = __builtin_amdgcn_readfirstlane(tid >> 6), lane = tid & 63, r32 = lane & 31, hi = lane >> 5;
    constexpr int KPR = DK / 8, VPR = DV / 8, KCH = 64 * KPR / 512, VCH = 64 * VPR / 512;
    LAS unsigned char* Vt = lds; LAS unsigned char* Kf = lds + 16384; LAS unsigned char* Kb = lds + 32768;
    const int dvb = wid / (DK / 32), dkb = wid % (DK / 32); const int r0 = Bk * 256;
    float cfe = 0.f, rbs = 0.f;
    if constexpr (MODE == 2) { cfe = P.ssdp[(size_t)(r0 + 255) * 32 + 0]; rbs = P.ssdp[(size_t)r0 * 32 + 2]; }
    f32x16 accf = f32x16{}, accb = f32x16{};
    const int vbV = (int)(uintptr_t)Vt + v_rd_base(lane) + dvb * 512, vbF = (int)(uintptr_t)Kf + v_rd_base(lane) + dkb * 512, vbB = (int)(uintptr_t)Kb + v_rd_base(lane) + dkb * 512;
    bf16x8 kc[4][KCH], vc[4][VCH]; float sf[4][KCH], sb[4][KCH];
#pragma unroll
    for (int tl = 0; tl < 4; ++tl) { const int kr0 = r0 + tl * 64;
#pragma unroll
        for (int i = 0; i < KCH; ++i) { const int cid = tid + 512 * i, row = cid / KPR, c8 = cid % KPR; kc[tl][i] = *(const GAS bf16x8*)(P.k0 + (long)(kr0 + row) * P.ldk0 + c8 * 8);
            if constexpr (MODE == 1) { const int jj = tl * 64 + row; sf[tl][i] = __builtin_amdgcn_exp2f((float)(256 - jj) * P.lf); sb[tl][i] = __builtin_amdgcn_exp2f((float)jj * P.lb); }
            else { const f32x4 w = *(const GAS f32x4*)(P.ssdp + (size_t)(kr0 + row) * 32); sf[tl][i] = __builtin_amdgcn_exp2f(cfe + w.y); sb[tl][i] = __builtin_amdgcn_exp2f(rbs + w.w); } }
#pragma unroll
        for (int i = 0; i < VCH; ++i) { const int cid = tid + 512 * i, row = cid / VPR, c8 = cid % VPR; vc[tl][i] = *(const GAS bf16x8*)(P.v + (long)(kr0 + row) * P.ldv + c8 * 8); } }
#pragma unroll
    for (int tl = 0; tl < 4; ++tl) {
#pragma unroll
        for (int i = 0; i < KCH; ++i) { const int cid = tid + 512 * i, row = cid / KPR, c8 = cid % KPR; v4u wf, wb; const bf16x8 kk = kc[tl][i]; const float s1 = sf[tl][i], s2 = sb[tl][i];
            wf.x = cvtpk(bf2f((unsigned short)kk[0]) * s1, bf2f((unsigned short)kk[1]) * s1); wf.y = cvtpk(bf2f((unsigned short)kk[2]) * s1, bf2f((unsigned short)kk[3]) * s1);
            wf.z = cvtpk(bf2f((unsigned short)kk[4]) * s1, bf2f((unsigned short)kk[5]) * s1); wf.w = cvtpk(bf2f((unsigned short)kk[6]) * s1, bf2f((unsigned short)kk[7]) * s1);
            wb.x = cvtpk(bf2f((unsigned short)kk[0]) * s2, bf2f((unsigned short)kk[1]) * s2); wb.y = cvtpk(bf2f((unsigned short)kk[2]) * s2, bf2f((unsigned short)kk[3]) * s2);
            wb.z = cvtpk(bf2f((unsigned short)kk[4]) * s2, bf2f((unsigned short)kk[5]) * s2); wb.w = cvtpk(bf2f((unsigned short)kk[6]) * s2, bf2f((unsigned short)kk[7]) * s2);
            *(LAS v4u*)(Kf + v_st(row, c8 * 8)) = wf; *(LAS v4u*)(Kb + v_st(row, c8 * 8)) = wb; }
#pragma unroll
        for (int i = 0; i < VCH; ++i) { const int cid = tid + 512 * i, row = cid / VPR, c8 = cid % VPR; *(LAS bf16x8*)(Vt + v_st(row, c8 * 8)) = vc[tl][i]; }
        __syncthreads();
#define ST_FR(vb, ks) ({ const s16x4 l_ = tr_read<v_rd_off(0, ks, 0)>(vb), h_ = tr_read<v_rd_off(0, ks, 1)>(vb); (bf16x8){l_[0], l_[1], l_[2], l_[3], h_[0], h_[1], h_[2], h_[3]}; })
        { const bf16x8 a0 = ST_FR(vbV, 0), a1 = ST_FR(vbV, 1), a2 = ST_FR(vbV, 2), a3 = ST_FR(vbV, 3);
          const bf16x8 f0 = ST_FR(vbF, 0), f1 = ST_FR(vbF, 1), f2 = ST_FR(vbF, 2), f3 = ST_FR(vbF, 3);
          const bf16x8 b0 = ST_FR(vbB, 0), b1 = ST_FR(vbB, 1), b2 = ST_FR(vbB, 2), b3 = ST_FR(vbB, 3);
          asm volatile("s_waitcnt lgkmcnt(0)" ::: "memory"); SBAR();
          accf = __builtin_amdgcn_mfma_f32_32x32x16_bf16(a0, f0, accf, 0, 0, 0); accf = __builtin_amdgcn_mfma_f32_32x32x16_bf16(a1, f1, accf, 0, 0, 0);
          accf = __builtin_amdgcn_mfma_f32_32x32x16_bf16(a2, f2, accf, 0, 0, 0); accf = __builtin_amdgcn_mfma_f32_32x32x16_bf16(a3, f3, accf, 0, 0, 0);
          accb = __builtin_amdgcn_mfma_f32_32x32x16_bf16(a0, b0, accb, 0, 0, 0); accb = __builtin_amdgcn_mfma_f32_32x32x16_bf16(a1, b1, accb, 0, 0, 0);
          accb = __builtin_amdgcn_mfma_f32_32x32x16_bf16(a2, b2, accb, 0, 0, 0); accb = __builtin_amdgcn_mfma_f32_32x32x16_bf16(a3, b3, accb, 0, 0, 0); }
#undef ST_FR
        __syncthreads();
    }
#pragma unroll
    for (int r = 0; r < 16; ++r) { const size_t e = (size_t)(32 * dvb + crow(r, hi)) * DK + 32 * dkb + r32;
        ST[e] = (bf16)f2bf(accf[r]); ST[(size_t)DV * DK + e] = (bf16)f2bf(accb[r]); }
}
#undef SBAR
}

namespace hyb {
constexpr int U_PITCH = 4112, U_BYTES = 16 * U_PITCH, FC_OFF = U_BYTES, FC_PITCH = 8256;
typedef float f32x4v __attribute__((ext_vector_type(4)));
__device__ __forceinline__ void hyena_unit(const AP& a, int layer, int c, unsigned char* ws, LAS unsigned char* lds, int tid) {
    asm volatile("" : "+v"(tid));
    const int wid = tid >> 6, lane = tid & 63, fr = lane & 15, fq = lane >> 4;
    const bf16* UT = (const bf16*)(ws + WS_UT); bf16* ZT = (bf16*)(ws + WS_ZT);
    LAS unsigned char* Ul = lds; LAS unsigned char* FC = lds + FC_OFF;
    const int ksh = (3 - fr) & 3;
    for (int o = 0; o < 2; ++o) {
        const bf16* G = (const bf16*)(ws + WS_HYG) + (((size_t)layer * 2 + o) * 512 + c) * HY_GLEN;
        for (int id = tid; id < HY_GLEN / 8; id += 512) *(LAS v4u*)(FC + id * 16) = *(const GAS v4u*)(G + id * 8);
        if (o == 0) {
#pragma unroll
            for (int i = 0; i < 8; ++i) { const int id = tid + 512 * i, b = id >> 8, t8 = id & 255;
                *(LAS v4u*)(Ul + b * U_PITCH + t8 * 16) = *(const GAS v4u*)(UT + ((size_t)c * NB + b) * SEQ + t8 * 8); } }
        __syncthreads();
        for (int idx = tid; idx < 4104; idx += 512) { const LAS bf16* g0 = (const LAS bf16*)FC + idx;
#pragma unroll
            for (int k = 1; k < 4; ++k) *(LAS bf16*)(FC + k * FC_PITCH + idx * 2) = g0[k]; }
        const bf16* X = UT + (((size_t)(1 + o) * 512 + c) * NB + fr) * SEQ;
        v2u xg[16];
#pragma unroll
        for (int al = 0; al < 16; ++al) xg[al] = *(const GAS v2u*)(X + 16 * (16 * wid + al) + 4 * fq);
        __syncthreads();
        f32x4v acc[16];
#pragma unroll
        for (int i = 0; i < 16; ++i) acc[i] = (f32x4v){0.f, 0.f, 0.f, 0.f};
        for (int kb = 0; kb < 8; ++kb) {
            bf16x8 bfr[8];
#pragma unroll
            for (int kl = 0; kl < 8; ++kl) bfr[kl] = *(const LAS bf16x8*)(Ul + fr * U_PITCH + ((kb * 8 + kl) * 32 + fq * 8) * 2);
            const int n0 = HY_OFF - 16 * (16 * wid - 16 * kb + 15) - fr + 8 * fq;
            const LAS unsigned char* ab = FC + ksh * FC_PITCH + (n0 - ksh) * 2;
#pragma unroll
            for (int hb = 0; hb < 2; ++hb) {
                v2u alo[15], ahi[15];
#pragma unroll
                for (int d = 0; d < 15; ++d) { alo[d] = *(const LAS v2u*)(ab + (29 - (hb * 15 + d)) * 32); ahi[d] = *(const LAS v2u*)(ab + (29 - (hb * 15 + d)) * 32 + 8); }
                LDS_WAIT(); __builtin_amdgcn_sched_barrier(0);
#pragma unroll
                for (int d = 0; d < 15; ++d) { const int ddrel = hb * 15 + d - 14;
                    const v4u w = {alo[d].x, alo[d].y, ahi[d].x, ahi[d].y}; const bf16x8 af = __builtin_bit_cast(bf16x8, w);
#pragma unroll
                    for (int kl = 0; kl < 8; ++kl) { const int al = ddrel + 2 * kl; if (al >= 0 && al < 16) acc[al] = __builtin_amdgcn_mfma_f32_16x16x32_bf16(af, bfr[kl], acc[al], 0, 0, 0); }
                }
                __builtin_amdgcn_sched_barrier(0);
            }
        }
        __syncthreads();
        const float bias = a.in(I_HYBIAS)[(layer * 2 + o) * 512 + c];
#pragma unroll
        for (int al = 0; al < 16; ++al) { const int t = 16 * (16 * wid + al) + 4 * fq;
            const v2u uu = *(const LAS v2u*)(Ul + fr * U_PITCH + t * 2); const v2u xx = xg[al];
            const float r0 = bflo(xx.x) * (acc[al][0] + bflo(uu.x) * bias), r1 = bfhi(xx.x) * (acc[al][1] + bfhi(uu.x) * bias);
            const float r2 = bflo(xx.y) * (acc[al][2] + bflo(uu.y) * bias), r3 = bfhi(xx.y) * (acc[al][3] + bfhi(uu.y) * bias);
            v2u z; z.x = pk2(r0, r1); z.y = pk2(r2, r3);
            if (o == 0) *(LAS v2u*)(Ul + fr * U_PITCH + t * 2) = z;
            else *(GAS v2u*)(ZT + ((size_t)c * NB + fr) * SEQ + t) = z; }
        __syncthreads();
    }
}
}

constexpr int N_PHASES = 26;
#ifndef MK_CUTS
#define MK_CUTS 0
#endif
#ifndef MIXSKIP
#define MIXSKIP 0
#endif
#ifndef MOE_CHECK
#define MOE_CHECK 0
#endif
#ifndef ONLYKIND
#define ONLYKIND -1
#endif
#define KSEL(kind) (ONLYKIND < 0 || ONLYKIND == (kind))
#define IN(k) (LO <= (k) && (k) < HI)
#define INK(k, kind) (KSEL(kind) && LO <= (k) && (k) < HI)
struct Ids { int wave0, G0, bx0, vcu0; };
#define PH_LOCALS int wave = ids.wave0, G = ids.G0, bx = ids.bx0, vcu = ids.vcu0; asm volatile("" : "+s"(wave), "+s"(G), "+s"(bx), "+s"(vcu)); \
    int tid; asm volatile("v_mbcnt_lo_u32_b32 %0, -1, 0\n\tv_mbcnt_hi_u32_b32 %0, -1, %0" : "=v"(tid)); tid += wave * 64; \
    const int lane = tid & 63, gw = wave * G + vcu, NGW = G * NWAVES; LAS float* wscr = (LAS float*)(lds + RING_OFF + wave * 16384); (void)lane; (void)gw; (void)NGW; (void)wscr; (void)bx; \
    const AP args = kargs(); unsigned char* ws = args.ws(); float* XRES = args.out(); bf16* XB = (bf16*)(ws + WS_XB); gu32* ctl = (gu32*)(ws + WS_CTL); (void)XRES; (void)XB; (void)ctl;
#ifndef PROBE_SCALE
#define PROBE_SCALE 0.0025f
#endif
#ifndef TIMING_PROBE
#define TIMING_PROBE 0
#endif
#ifndef PROBE_A0
#define PROBE_A0 0
#define PROBE_A1 1
#define PROBE_B0 1
#define PROBE_B1 2
#endif
#if TIMING_PROBE
#define STAMP(idx) do { if (ids.bx0 == 0 && threadIdx.x == 0) ((volatile LAS unsigned*)(lds + MISC_OFF))[16 + (idx)] = (unsigned)wall_clock64(); } while (0)
#else
#define STAMP(idx) do { } while (0)
#endif
#define SEAM(k) do { if constexpr (IN(k) && IN((k) + 1)) { XcdBarrier bb_ = bar; asm volatile("" : "+s"(bb_.bar), "+s"(bb_.x)); xcd_barrier(bb_); } STAMP((k) + 1); } while (0)

template <int LAYER, int LO, int HI>
__device__ __forceinline__ void layer_phases(LAS unsigned char* lds, const XcdBarrier& bar, const Ids& ids) {
    constexpr int layer = LAYER, pb = 1 + LAYER * 10;
    if constexpr (INK(pb + 0, 1)) { PH_LOCALS
        pg8::Gemm g{XB, (const bf16*)(ws + WS_WIN + layer * SZ_WIN), M, NINP, DM}; pg8::StaticOrder S; S.init(M, NINP, G, bx);
        pg8::EpiBf16 E{(bf16*)(ws + WS_PROJ), NINP, (float*)(ws + WS_DTF), C_DT};
        pg8::gemm_phase<pg8::EpiBf16, pg8::StaticOrder, true, true>(lds + RING_OFF, g, S, E, tid);
    }
    SEAM(pb + 0);
    if constexpr (INK(pb + 1, 2)) { PH_LOCALS
        LAS float* cwl = (LAS float*)(lds + RING_OFF);
        for (int i = tid; i < 6 * 1024; i += NWAVES * 64) cwl[i] = i < 5 * 1024 ? args.in(I_CONVW)[layer * 5 * 1024 + i] : args.in(I_CONVB)[layer * 1024 + i - 5 * 1024];
        __syncthreads();
        LAS float* pscr = (LAS float*)(lds + RING_OFF + 32768 + wave * 12288);
        for (int it = gw; it < M / 8; it += NGW) prep_rows8(args, layer, it, lane, ws, cwl);
        for (int it = gw; it < 256; it += NGW) prep_scan(args, layer, it, lane, ws, pscr);
        for (int it = gw; it < NB * 32 * 24; it += NGW) prep_hyconv(args, layer, it, lane, ws, (LAS bf16*)pscr);
        __syncthreads();
    }
    SEAM(pb + 1);
    if constexpr (INK(pb + 2, 3)) {
        { PH_LOCALS pg8::Gemm g{(const bf16*)(ws + WS_QN), (const bf16*)(ws + WS_WUQ + layer * SZ_WUQ), M, 768, 384}; pg8::StaticOrder S; S.init(M, 768, G, bx);
          pg8::EpiBf16 E{(bf16*)(ws + WS_QB), 768, nullptr, 0};
          pg8::gemm_phase<pg8::EpiBf16, pg8::StaticOrder, true, true>(lds + RING_OFF, g, S, E, tid); }
        { PH_LOCALS pg8::Gemm g{(const bf16*)(ws + WS_KVN), (const bf16*)(ws + WS_WUKV + layer * SZ_WUKV), M, 1024, 256}; pg8::StaticOrder S; S.init(M, 1024, G, bx);
          pg8::EpiBf16 E{(bf16*)(ws + WS_KVB), 1024, nullptr, 0};
          pg8::gemm_phase<pg8::EpiBf16, pg8::StaticOrder, true, true>(lds + RING_OFF, g, S, E, tid); }
#if FARFIELD
        { PH_LOCALS for (int u = vcu; u < NB * 4 * 8; u += G) { const int b = u >> 5, h = (u >> 3) & 3, Bk = u & 7; const size_t r0 = (size_t)b * SEQ;
            mixb::MixP P{}; P.k0 = (const bf16*)(ws + WS_RK) + r0 * 256 + h * 64; P.ldk0 = 256; P.v = (const bf16*)(ws + WS_PROJ) + r0 * NINP + C_RV + h * 128; P.ldv = NINP;
            P.lf = log2f(1.0f - exp2f(-5.0f - (float)h)); P.lb = log2f(1.0f - exp2f(-5.5f - (float)h));
            mixb::state_unit<1, 64, 128>(P, Bk, (bf16*)(ws + WS_STR) + ((size_t)(b * 4 + h) * 8 + Bk) * 2 * 8192, lds + RING_OFF, tid); } }
        { PH_LOCALS for (int u = vcu; u < NB * 8 * 8; u += G) { const int b = u >> 6, hh = (u >> 3) & 7, Bk = u & 7, gq = hh >> 2; const size_t r0 = (size_t)b * SEQ;
            mixb::MixP P{}; const bf16* XBC = (const bf16*)(ws + WS_XBC) + r0 * 1024; P.k0 = XBC + 512 + gq * 128; P.ldk0 = 1024; P.v = XBC + hh * 64; P.ldv = 1024;
            P.ssdp = (const float*)(ws + WS_SSDP) + r0 * 32 + hh * 4;
            mixb::state_unit<2, 128, 64>(P, Bk, (bf16*)(ws + WS_STS) + ((size_t)(b * 8 + hh) * 8 + Bk) * 2 * 8192, lds + RING_OFF, tid); } }
#endif
    }
    SEAM(pb + 2);
    if constexpr (IN(pb + 3)) {
        if constexpr (KSEL(40)) { PH_LOCALS for (int u = vcu; u < NB * 4 * 8; u += G) { const int b = u >> 5, h = (u >> 3) & 3, qb = u & 7; const size_t r0 = (size_t)b * SEQ;
            mixb::MixP P{}; P.q = (const bf16*)(ws + WS_QB) + r0 * 768 + h * 192; P.ldq = 768; P.k0 = (const bf16*)(ws + WS_KVB) + r0 * 1024 + h * 256; P.ldk0 = 1024;
            P.k1 = (const bf16*)(ws + WS_KPE) + r0 * 64; P.ldk1 = 64; P.v = (const bf16*)(ws + WS_KVB) + r0 * 1024 + h * 256 + 128; P.ldv = 1024;
            P.o = (bf16*)(ws + WS_ATT) + r0 * 512 + h * 128; P.ldo = 512;
            mixb::mix_unit<0, 192, 128>(P, qb * 256, lds + RING_OFF, tid); } }
        STAMP(32 + LAYER * 4 + 0);
        if constexpr (KSEL(41)) { PH_LOCALS for (int u = vcu; u < NB * 4 * 8; u += G) { const int rnd = u / G; const int b = u >> 5, h0 = (u >> 3) & 3, h = (rnd & 1) ? 3 - h0 : h0, qb = u & 7; const size_t r0 = (size_t)b * SEQ;
            mixb::MixP P{}; P.q = (const bf16*)(ws + WS_RQ) + r0 * 256 + h * 64; P.ldq = 256; P.k0 = (const bf16*)(ws + WS_RK) + r0 * 256 + h * 64; P.ldk0 = 256; P.k1 = P.k0; P.ldk1 = 256;
            P.v = (const bf16*)(ws + WS_PROJ) + r0 * NINP + C_RV + h * 128; P.ldv = NINP; P.aux = (const bf16*)(ws + WS_PROJ) + r0 * NINP + C_RG + h * 128; P.ldaux = NINP;
            P.o = (bf16*)(ws + WS_MIX) + r0 * DM + 512 + h * 128; P.ldo = DM;
            P.lf = log2f(1.0f - exp2f(-5.0f - (float)h)); P.lb = log2f(1.0f - exp2f(-5.5f - (float)h)); P.st = (const bf16*)(ws + WS_STR) + (size_t)(b * 4 + h) * 8 * 2 * 8192;
            mixb::mix_unit<1, 64, 128>(P, qb * 256, lds + RING_OFF, tid); } }
        STAMP(32 + LAYER * 4 + 1);
        if constexpr (KSEL(42)) { PH_LOCALS for (int u = vcu; u < NB * 8 * 8; u += G) { const int rnd = u / G; const int b = u >> 6, hh = (((u >> 3) & 7) + 2 * rnd) & 7, qb = u & 7, gq = hh >> 2; const size_t r0 = (size_t)b * SEQ;
            mixb::MixP P{}; const bf16* XBC = (const bf16*)(ws + WS_XBC) + r0 * 1024;
            P.q = XBC + 768 + gq * 128; P.ldq = 1024; P.k0 = XBC + 512 + gq * 128; P.ldk0 = 1024; P.k1 = P.k0; P.ldk1 = 1024; P.v = XBC + hh * 64; P.ldv = 1024; P.aux = P.v; P.ldaux = 1024;
            P.ssdp = (const float*)(ws + WS_SSDP) + r0 * 32 + hh * 4; P.dh = args.in(I_SSDD)[layer * 8 + hh];
            P.o = (bf16*)(ws + WS_YC) + r0 * 512 + hh * 64; P.ldo = 512; P.st = (const bf16*)(ws + WS_STS) + (size_t)(b * 8 + hh) * 8 * 2 * 8192;
            mixb::mix_unit<2, 128, 64>(P, qb * 256, lds + RING_OFF, tid); } }
        STAMP(32 + LAYER * 4 + 2);
        if constexpr (KSEL(43)) { PH_LOCALS for (int u = vcu; u < 512; u += G) hyb::hyena_unit(args, layer, u, ws, lds + RING_OFF, tid); }
        STAMP(32 + LAYER * 4 + 3);
    }
    SEAM(pb + 3);
    if constexpr (INK(pb + 4, 5)) { PH_LOCALS
        for (int m = gw; m < M; m += NGW) post_row(args, layer, m, lane, ws);
        for (int it = gw; it < NB * 128; it += NGW) post_hy(args, layer, it, lane, ws, (LAS bf16*)wscr);
    }
    SEAM(pb + 4);
    if constexpr (INK(pb + 5, 6)) { PH_LOCALS
        pg8::Gemm g{(const bf16*)(ws + WS_MIX), (const bf16*)(ws + WS_WOUT + layer * SZ_WOUT), M, DM, DM}; pg8::StaticOrder S; S.init(M, DM, G, bx);
        pg8::EpiResF32 E{LAYER == 0 ? args.in(I_X) : (const float*)XRES, XRES, DM, ALPHA, 1.f};
        pg8::gemm_phase<pg8::EpiResF32, pg8::StaticOrder, true, true>(lds + RING_OFF, g, S, E, tid);
    }
    SEAM(pb + 5);
    if constexpr (INK(pb + 6, 7)) { PH_LOCALS
        const float* gG = args.in(I_LN1G) + layer * DM; const float* gB = args.in(I_LN1B) + layer * DM;
        if constexpr (LAYER == 1) {
            LAS float* WrT = (LAS float*)(lds + RING_OFF);
            for (int i = tid; i < DM * NEXP; i += NWAVES * 64) WrT[(i & 7) * DM + (i >> 3)] = args.in(I_ROUTER)[i];
            for (int i = bx * NWAVES * 64 + tid; i < CAP_ROWS; i += G * NWAVES * 64) ((int*)(ws + WS_SLOT))[i] = -1;
            LAS unsigned* lcnt = (LAS unsigned*)(lds + RING_OFF + 65536); LAS unsigned* lbase = lcnt + 8; LAS int* lrec = (LAS int*)(lcnt + 16);
            if (tid < 16) lcnt[tid] = 0u;
            __syncthreads();
            int nrow = 0;
            f32x4 nv[8]; if (gw < M) ln_load(XRES + (size_t)gw * DM, lane, nv);
            for (int m = gw; m < M; m += NGW) { f32x4 v[8];
#pragma unroll
                for (int j = 0; j < 8; ++j) v[j] = nv[j];
                if (m + NGW < M) ln_load(XRES + (size_t)(m + NGW) * DM, lane, nv);
                ln_row(XRES + (size_t)m * DM, XB + (size_t)m * DM, gG, gB, lane, v, nullptr, nullptr, XRES + (size_t)m * DM);
                float lg[8];
#pragma unroll
                for (int e = 0; e < 8; ++e) { float s = 0.f;
#pragma unroll
                    for (int j = 0; j < 8; ++j) { const f32x4 w = *((const LAS f32x4*)(WrT + e * DM) + lane + 64 * j); s += (v[j].x * w.x + v[j].y * w.y) + (v[j].z * w.z + v[j].w * w.w); }
                    lg[e] = wave_sum(s); __builtin_amdgcn_sched_barrier(0); }
                int e0 = 0; float v0 = lg[0];
#pragma unroll
                for (int e = 1; e < 8; ++e) if (lg[e] > v0) { v0 = lg[e]; e0 = e; }
                int e1 = -1; float v1 = -3.0e38f;
#pragma unroll
                for (int e = 0; e < 8; ++e) if (e != e0 && lg[e] > v1) { v1 = lg[e]; e1 = e; }
                if (lane == 0) { const float ex = __expf(v1 - v0); const float g0 = 1.0f / (1.0f + ex), g1 = ex / (1.0f + ex);
                    const int p0 = (int)__hip_atomic_fetch_add(lcnt + e0, 1u, __ATOMIC_RELAXED, __HIP_MEMORY_SCOPE_WORKGROUP), p1 = (int)__hip_atomic_fetch_add(lcnt + e1, 1u, __ATOMIC_RELAXED, __HIP_MEMORY_SCOPE_WORKGROUP);
                    LAS int* rec = lrec + (wave * 64 + nrow) * 4; rec[0] = e0; rec[1] = e1; rec[2] = p0; rec[3] = p1;
                    float* rg = (float*)(ws + WS_RTG) + (size_t)m * 2; rg[0] = g0; rg[1] = g1; }
                ++nrow; }
            __syncthreads();
            if (tid < NEXP) lbase[tid] = atomicAdd((unsigned*)(ctl + CW_CNT + tid), lcnt[tid]);
            __syncthreads();
            { int r = 0; for (int m = gw; m < M; m += NGW, ++r) if (lane == 0) { const LAS int* rec = lrec + (wave * 64 + r) * 4; const int e0 = rec[0], e1 = rec[1];
                int* rt = (int*)(ws + WS_RT) + (size_t)m * 4; rt[0] = e0; rt[1] = e1; rt[2] = rec[2] + (int)lbase[e0]; rt[3] = rec[3] + (int)lbase[e1]; } }
            __syncthreads();
        } else {
            f32x4 nv[8]; if (gw < M) ln_load(XRES + (size_t)gw * DM, lane, nv);
            for (int m = gw; m < M; m += NGW) { f32x4 v[8];
#pragma unroll
                for (int j = 0; j < 8; ++j) v[j] = nv[j];
                if (m + NGW < M) ln_load(XRES + (size_t)(m + NGW) * DM, lane, nv);
                ln_row(XRES + (size_t)m * DM, XB + (size_t)m * DM, gG, gB, lane, v, nullptr, nullptr, XRES + (size_t)m * DM, ws + WS_XF8 + (size_t)m * DM); }
        }
    }
    SEAM(pb + 6);
    if constexpr (LAYER == 0) {
        if constexpr (INK(8, 8)) { PH_LOCALS
            pg8::Gemm g{(const bf16*)(ws + WS_XF8), (const bf16*)(ws + WS_WGU), M, 2 * DFF, DM}; pg8::StaticOrder S; S.init(M, 2 * DFF, G, bx);
            pg8::EpiSwigluF8 E{ws + WS_HID, DFF};
            pg8::gemm_phase_f8<pg8::EpiSwigluF8, pg8::StaticOrder, true, true>(lds + RING_OFF, g, S, E, tid, 0x79797979, 0x7f7f7f7f);
        }
        SEAM(8);
        if constexpr (INK(9, 9)) { PH_LOCALS
            pg8::Gemm g{(const bf16*)(ws + WS_HID), (const bf16*)(ws + WS_WDN), M, DM, DFF}; pg8::StaticOrder S; S.init(M, DM, G, bx);
            pg8::EpiResF32 E{XRES, XRES, DM, ALPHA, ZERO_FFN ? 0.f : 1.f};
            pg8::gemm_phase_f8<pg8::EpiResF32, pg8::StaticOrder, true, true>(lds + RING_OFF, g, S, E, tid, 0x77777777, 0x7f7f7f7f);
        }
        SEAM(9);
        if constexpr (INK(10, 10)) { PH_LOCALS
            const float* gG = args.in(I_LN2G); const float* gB = args.in(I_LN2B);
            f32x4 nv[8]; if (gw < M) ln_load(XRES + (size_t)gw * DM, lane, nv);
            for (int m = gw; m < M; m += NGW) { f32x4 v[8];
#pragma unroll
                for (int j = 0; j < 8; ++j) v[j] = nv[j];
                if (m + NGW < M) ln_load(XRES + (size_t)(m + NGW) * DM, lane, nv);
                ln_row(XRES + (size_t)m * DM, XB + (size_t)m * DM, gG, gB, lane, v, nullptr, nullptr, XRES + (size_t)m * DM); }
        }
        SEAM(10);
    }
}

template <int CH, int LO, int HI>
__device__ __forceinline__ void moe_chunk(LAS unsigned char* lds, const XcdBarrier& bar, const Ids& ids) {
    if constexpr (INK(19 + 2 * CH, 19)) { PH_LOCALS
        pg8::MoeOrder S; int acc = 0;
#pragma unroll
        for (int e = 0; e < 8; ++e) { const int c = (int)__hip_atomic_load(ctl + CW_CNT + e, RLX_AGENT); acc += (c + 255) / 256 * 256; S.pend[e] = acc; }
        const int nrb = acc / 256; const int rb0 = CH * MOE_CH_RB; int nrbc = nrb - rb0; nrbc = nrbc < 0 ? 0 : (nrbc > MOE_CH_RB ? MOE_CH_RB : nrbc);
        pg8::Gemm g{(const bf16*)(ws + WS_XS + (size_t)rb0 * 256 * DM), (const bf16*)(ws + WS_MGU), nrbc * 256, 2 * DFFE, DM};
        S.so.init(nrbc * 256, 2 * DFFE, G, bx); S.rb0 = rb0; S.bstride = (long)2 * DFFE * DM;
        pg8::EpiSwigluF8 E{ws + WS_HIDS, DFFE};
        pg8::gemm_phase_f8<pg8::EpiSwigluF8, pg8::MoeOrder, true, true>(lds + RING_OFF, g, S, E, tid, 0x79797979, 0x7f7f7f7f);
    }
    SEAM(19 + 2 * CH);
    if constexpr (INK(20 + 2 * CH, 20)) { PH_LOCALS
        pg8::MoeOrder S; int acc = 0;
#pragma unroll
        for (int e = 0; e < 8; ++e) { const int c = (int)__hip_atomic_load(ctl + CW_CNT + e, RLX_AGENT); acc += (c + 255) / 256 * 256; S.pend[e] = acc; }
        const int nrb = acc / 256; const int rb0 = CH * MOE_CH_RB; int nrbc = nrb - rb0; nrbc = nrbc < 0 ? 0 : (nrbc > MOE_CH_RB ? MOE_CH_RB : nrbc);
        pg8::Gemm g{(const bf16*)(ws + WS_HIDS), (const bf16*)(ws + WS_MDN), nrbc * 256, DM, DFFE};
        S.so.init(nrbc * 256, DM, G, bx); S.rb0 = rb0; S.bstride = (long)DM * DFFE;
        pg8::EpiMoeDown E{(bf16*)(ws + WS_Y0), (long)((WS_Y1 - WS_Y0) / 2), DM, (const int*)(ws + WS_SLOT), (const float*)(ws + WS_SLOTG), rb0 * 256};
        pg8::gemm_phase_f8<pg8::EpiMoeDown, pg8::MoeOrder, true, true>(lds + RING_OFF, g, S, E, tid, 0x77777777, 0x7f7f7f7f);
    }
    SEAM(20 + 2 * CH);
}

template <int LO, int HI>
__global__ void __launch_bounds__(NWAVES * 64, 2) mk_fwd(Args args_unused, int li) {
    extern __shared__ __attribute__((aligned(16))) unsigned char lds_raw[];
    LAS unsigned char* lds = (LAS unsigned char*)lds_raw;
    volatile LAS unsigned* MISC = (volatile LAS unsigned*)(lds + MISC_OFF);
    Ids ids; { const int tid0 = threadIdx.x; ids.wave0 = __builtin_amdgcn_readfirstlane(tid0 >> 6); ids.G0 = gridDim.x; ids.bx0 = blockIdx.x;
        ids.vcu0 = (ids.G0 % 8 == 0) ? (ids.bx0 % 8) * (ids.G0 / 8) + ids.bx0 / 8 : ids.bx0;
        for (int u = tid0; u < (LDS_BYTES - LDSCTL_OFF) / 4; u += NWAVES * 64) ((LAS unsigned*)(lds + LDSCTL_OFF))[u] = 0u; }
    __syncthreads();
    XcdBarrier bar; bar.bar = nullptr; bar.x = 0; bar.st = nullptr;
    if constexpr (HI - LO > 1) { const AP a0 = kargs(); bar = xcd_barrier_post((unsigned*)((gu32*)(a0.ws() + WS_CTL) + CW_BAR) + li * XCD_BAR_WORDS, MISC + 8); }

    STAMP(0);
    if constexpr (INK(0, 0)) { PH_LOCALS
        constexpr int I_WIN_ = 32 * (NINP / 32), I_UQ = 6 * 24, I_UKV = 4 * 32, I_OUT = 32 * 64, I_GU = 32 * (DFF / 32), I_DN = (DFF / 64) * 64;
        constexpr int NIT = 2 * I_WIN_ + 2 * I_UQ + 2 * I_UKV + 2 * I_OUT + 2 * I_GU + I_DN;
        for (int it = gw; it < NIT; it += NGW) { int r = it;
#define TRJ(n, W, K, N, NP, WT, GR, GS, OFF) if (r < (n)) { transpose_item((W), (K), (N), (NP) / 32, (bf16*)(WT), (GR), (GS), (OFF), wscr, r, lane); continue; } r -= (n);
            TRJ(I_WIN_, args.in(I_WIN), DM, NIN, NINP, ws + WS_WIN, 1 << 30, 0, 0)
            TRJ(I_WIN_, args.in(I_WIN) + (size_t)DM * NIN, DM, NIN, NINP, ws + WS_WIN + SZ_WIN, 1 << 30, 0, 0)
            TRJ(I_UQ, args.in(I_WUQ), 384, 768, 768, ws + WS_WUQ, 1 << 30, 0, 0)
            TRJ(I_UQ, args.in(I_WUQ) + 384 * 768, 384, 768, 768, ws + WS_WUQ + SZ_WUQ, 1 << 30, 0, 0)
            TRJ(I_UKV, args.in(I_WUKV), 256, 1024, 1024, ws + WS_WUKV, 1 << 30, 0, 0)
            TRJ(I_UKV, args.in(I_WUKV) + 256 * 1024, 256, 1024, 1024, ws + WS_WUKV + SZ_WUKV, 1 << 30, 0, 0)
            TRJ(I_OUT, args.in(I_WOUT), DM, DM, DM, ws + WS_WOUT, 1 << 30, 0, 0)
            TRJ(I_OUT, args.in(I_WOUT) + (size_t)DM * DM, DM, DM, DM, ws + WS_WOUT + SZ_WOUT, 1 << 30, 0, 0)
            if (r < I_GU) { transpose_item_f8(args.in(I_FFG), DM, DFF, DFF / 32, ws + WS_WGU, 128, 256, 0, 64.0f, wscr, r, lane); continue; } r -= I_GU;
            if (r < I_GU) { transpose_item_f8(args.in(I_FFU), DM, DFF, DFF / 32, ws + WS_WGU, 128, 256, 128, 64.0f, wscr, r, lane); continue; } r -= I_GU;
            transpose_item_f8(args.in(I_FFD), DFF, DM, DM / 32, ws + WS_WDN, 1 << 30, 0, 0, 256.0f, wscr, r, lane);
#undef TRJ
        }
        for (int m = gw; m < M; m += NGW) { const GAS f32x4* xr = (const GAS f32x4*)(args.in(I_X) + (size_t)m * DM) + lane; GAS v2u* xb = (GAS v2u*)(XB + (size_t)m * DM) + lane;
#pragma unroll
            for (int j = 0; j < 8; ++j) { const f32x4 v = xr[64 * j]; v2u w; w.x = pk2(v.x, v.y); w.y = pk2(v.z, v.w); xb[64 * j] = w; } }
        for (int it = gw; it < 2 * SEQ; it += NGW) hyena_filter_item(args, it >> 11, it & (SEQ - 1), (bf16*)(ws + WS_HYG), wscr, lane);
    }
    SEAM(0);
    layer_phases<0, LO, HI>(lds, bar, ids);
    layer_phases<1, LO, HI>(lds, bar, ids);
    if constexpr (INK(18, 18)) { PH_LOCALS
        auto mkjob = [&](int it, TrF8& j, int& r) { const int job = it / 7168, e = job / 3, kind = job - e * 3; r = it - job * 7168;
            if (kind < 2) j = TrF8{args.in(kind == 0 ? I_MOEG : I_MOEU) + (size_t)e * DM * DFFE, DM, DFFE, DFFE / 32, ws + WS_MGU + (size_t)e * 2 * DFFE * DM, 128, 256, kind * 128, 64.0f};
            else j = TrF8{args.in(I_MOED) + (size_t)e * DFFE * DM, DFFE, DM, DM / 32, ws + WS_MDN + (size_t)e * DM * DFFE, 1 << 30, 0, 0, 256.0f}; };
        for (int it = gw; it < 24 * 7168; it += 2 * NGW) { TrF8 ja, jb; int ra, rb; float ta[32], tb[32]; const bool hb = it + NGW < 24 * 7168;
            mkjob(it, ja, ra); tr_f8_load(ja, ra, lane, ta);
            if (hb) { mkjob(it + NGW, jb, rb); tr_f8_load(jb, rb, lane, tb); }
            tr_f8_finish(ja, ra, lane, ta, wscr);
            if (hb) tr_f8_finish(jb, rb, lane, tb, wscr); }
        int pst[8]; { int acc = 0;
#pragma unroll
            for (int e = 0; e < 8; ++e) { pst[e] = acc; const int c = (int)__hip_atomic_load(ctl + CW_CNT + e, RLX_AGENT); acc += (c + 255) / 256 * 256; } }
        for (int it = gw; it < 2 * M; it += NGW) { const int tok = it >> 1, k = it & 1; const int* rt = (const int*)(ws + WS_RT) + (size_t)tok * 4; const int e = rt[k], pos = rt[2 + k];
            int base = 0;
#pragma unroll
            for (int j = 0; j < 8; ++j) base = (e == j) ? pst[j] : base;
            const int slot = base + pos;
            const GAS v4u* src = (const GAS v4u*)(XB + (size_t)tok * DM) + lane; GAS v2u* dst = (GAS v2u*)(ws + WS_XS + (size_t)slot * DM) + lane;
#pragma unroll
            for (int j = 0; j < 4; ++j) { const v4u w = src[64 * j]; v2u o; o.x = pk4_fp8(bflo(w.x), bfhi(w.x), bflo(w.y), bfhi(w.y)); o.y = pk4_fp8(bflo(w.z), bfhi(w.z), bflo(w.w), bfhi(w.w)); dst[64 * j] = o; }
            if (lane == 0) { ((int*)(ws + WS_SLOT))[slot] = tok * 2 + k; ((float*)(ws + WS_SLOTG))[slot] = ((const float*)(ws + WS_RTG))[(size_t)tok * 2 + k]; } }
    }
    SEAM(18);
    moe_chunk<0, LO, HI>(lds, bar, ids);
    SEAM(21); SEAM(22); SEAM(23); SEAM(24);
    if constexpr (INK(25, 25)) { PH_LOCALS
#if MOE_CHECK
        { LAS float* xs = (LAS float*)(lds + RING_OFF); LAS float* hid = xs + DM; LAS float* red = hid + DFFE;
          for (int smp = bx; smp < 48; smp += G) { const int tok = (smp * 683 + 5) % M;
            for (int d = tid; d < DM; d += 512) xs[d] = bf2f(XB[(size_t)tok * DM + d]);
            __syncthreads();
            float accv[4] = {0.f, 0.f, 0.f, 0.f};
            for (int kk = 0; kk < 2; ++kk) { const int e = ((const int*)(ws + WS_RT))[(size_t)tok * 4 + kk]; const float gt = ((const float*)(ws + WS_RTG))[(size_t)tok * 2 + kk];
                const float* Wg = args.in(I_MOEG) + (size_t)e * DM * DFFE; const float* Wu = args.in(I_MOEU) + (size_t)e * DM * DFFE; const float* Wd = args.in(I_MOED) + (size_t)e * DFFE * DM;
                for (int j = tid; j < DFFE; j += 512) { float a = 0.f, b = 0.f; for (int d = 0; d < DM; ++d) { const float xv = xs[d]; a += xv * Wg[(size_t)d * DFFE + j]; b += xv * Wu[(size_t)d * DFFE + j]; } hid[j] = (a / (1.0f + __expf(-a))) * b; }
                __syncthreads();
                for (int q = 0; q < 4; ++q) { const int c = tid + 512 * q; float o = 0.f; for (int j = 0; j < DFFE; ++j) o += hid[j] * Wd[(size_t)j * DM + c]; accv[q] += gt * o; }
                __syncthreads(); }
            float num = 0.f, den = 0.f;
            for (int q = 0; q < 4; ++q) { const int c = tid + 512 * q; const float mine = bf2f(((const bf16*)(ws + WS_Y0))[(size_t)tok * DM + c]) + bf2f(((const bf16*)(ws + WS_Y1))[(size_t)tok * DM + c]); const float df = accv[q] - mine; num += df * df; den += accv[q] * accv[q]; }
            num = wave_sum(num); den = wave_sum(den); if (lane == 0) { red[wave * 2] = num; red[wave * 2 + 1] = den; }
            __syncthreads();
            if (tid == 0) { float n = 0.f, dn = 0.f; for (int w = 0; w < 8; ++w) { n += red[w * 2]; dn += red[w * 2 + 1]; } const float rel = n / (dn + 1e-20f); atomicMax((unsigned*)(ctl + 80), __float_as_uint(rel)); }
            if (wave == 0) { float lg[8]; for (int e = 0; e < 8; ++e) { float s = 0.f; for (int d = lane; d < DM; d += 64) s += xs[d] * args.in(I_ROUTER)[d * 8 + e]; lg[e] = wave_sum(s); }
                int e0 = 0; for (int e = 1; e < 8; ++e) if (lg[e] > lg[e0]) e0 = e; int e1 = -1; for (int e = 0; e < 8; ++e) if (e != e0 && (e1 < 0 || lg[e] > lg[e1])) e1 = e;
                const float ex = __expf(lg[e1] - lg[e0]); const float g0 = 1.f / (1.f + ex);
                const int* rt = (const int*)(ws + WS_RT) + (size_t)tok * 4; const float* rg = (const float*)(ws + WS_RTG) + (size_t)tok * 2;
                const bool bad = (rt[0] != e0) || (rt[1] != e1) || fabsf(rg[0] - g0) > 0.03f || fabsf(rg[0] + rg[1] - 1.f) > 1e-3f;
                if (lane == 0 && bad) atomicAdd((unsigned*)(ctl + 81), 1u); }
            __syncthreads(); } }
        __syncthreads();
        { XcdBarrier bb_ = bar; (void)bb_; }
#endif
        const float* gG = args.in(I_LN2G) + DM; const float* gB = args.in(I_LN2B) + DM;
        f32x4 nv[8]; if (gw < M) ln_load(XRES + (size_t)gw * DM, lane, nv);
        for (int m = gw; m < M; m += NGW) { f32x4 v[8];
#pragma unroll
            for (int j = 0; j < 8; ++j) v[j] = nv[j];
            if (m + NGW < M) ln_load(XRES + (size_t)(m + NGW) * DM, lane, nv);
            ln_row(XRES + (size_t)m * DM, nullptr, gG, gB, lane, v, (const bf16*)(ws + WS_Y0) + (size_t)m * DM, (const bf16*)(ws + WS_Y1) + (size_t)m * DM, XRES + (size_t)m * DM); }
#if TIMING_PROBE
        { XcdBarrier bb_ = bar; asm volatile("" : "+s"(bb_.bar), "+s"(bb_.x)); xcd_barrier(bb_); }
        STAMP(26);
        __syncthreads();
        if (bx == 0) { volatile LAS unsigned* T = (volatile LAS unsigned*)(lds + MISC_OFF) + 16;
            const float t1 = (float)(T[PROBE_A1] - T[PROBE_A0]) * 0.01f, t2 = (float)(T[PROBE_B1] - T[PROBE_B0]) * 0.01f;
            if (tid == 0) XRES[12345] = t1 * PROBE_SCALE + 0.f * t2; }
#endif
#if MOE_CHECK
        __syncthreads(); VM_WAIT();
        if (tid == 0) { __builtin_amdgcn_fence(__ATOMIC_RELEASE, "agent"); const unsigned old_ = atomicAdd((unsigned*)(ctl + 82), 1u); ((volatile LAS unsigned*)(lds + MISC_OFF))[12] = (old_ + 1u == (unsigned)G) ? 1u : 0u; }
        __syncthreads();
        if (((volatile LAS unsigned*)(lds + MISC_OFF))[12]) { __builtin_amdgcn_fence(__ATOMIC_ACQUIRE, "agent");
            const float rel = __uint_as_float(__hip_atomic_load(ctl + 80, RLX_AGENT)); const unsigned nbad = __hip_atomic_load(ctl + 81, RLX_AGENT);
            float code = 0.f; if (rel > 0.03f) code += 10.f; if (rel > 0.3f) code += 10.f; if (nbad > 2u) code += 40.f; if (nbad > 8u) code += 40.f;
            if (code > 0.f) for (size_t i = tid; i < (size_t)M * DM; i += 512) XRES[i] = code; }
#endif
    }
}
#undef IN
#undef INK
#undef SEAM
#undef STAMP

template <int LO, int HI> static void launch_range(int grid, const Args& a, int li, hipStream_t stream) {
    static bool attr = false;
    if (!attr) { if (hipFuncSetAttribute((const void*)mk_fwd<LO, HI>, hipFuncAttributeMaxDynamicSharedMemorySize, LDS_BYTES) != hipSuccess) fprintf(stderr, "kernel_launch: hipFuncSetAttribute failed\n"); attr = true; }
    hipLaunchKernelGGL((mk_fwd<LO, HI>), dim3(grid), dim3(NWAVES * 64), LDS_BYTES, stream, a, li);
}
template <int P> struct PerPhase { static void go(int grid, const Args& a, hipStream_t s) { PerPhase<P - 1>::go(grid, a, s); launch_range<P, P + 1>(grid, a, P, s); } };
template <> struct PerPhase<-1> { static void go(int, const Args&, hipStream_t) {} };

extern "C" void kernel_launch(void* const* d_in, const int* in_sizes, int n_in, void* d_out, int out_size, void* d_ws, size_t ws_size, hipStream_t stream) {
    static int grid = 0;
    if (grid == 0) {
        if (n_in != 35 || out_size != M * DM || ws_size < WS_END) { fprintf(stderr, "kernel_launch: built for 35 inputs, out %d floats, >= %zu bytes of workspace; got n_in %d, out %d, ws %zu; nothing launched\n", M * DM, (size_t)WS_END, n_in, out_size, ws_size); grid = -1; return; }
        int dev = 0, cus = 0;
        if (hipGetDevice(&dev) != hipSuccess || hipDeviceGetAttribute(&cus, hipDeviceAttributeMultiprocessorCount, dev) != hipSuccess) { grid = -1; return; }
        grid = cus;
    }
    if (grid < 0) return;
    if (hipMemsetAsync((char*)d_ws + WS_CTL, 0, CTL_ZERO_BYTES, stream) != hipSuccess) return;
    Args a{};
    for (int i = 0; i < 35; ++i) a.in[i] = (const float*)d_in[i];
    a.out = (float*)d_out; a.ws = (unsigned char*)d_ws; a.ph_lo = 0; a.ph_hi = N_PHASES;
#if MK_CUTS
    PerPhase<N_PHASES - 1>::go(grid, a, stream);
#else
    launch_range<0, N_PHASES>(grid, a, 0, stream);
#endif
    const hipError_t le = hipPeekAtLastError();
    if (le != hipSuccess) fprintf(stderr, "kernel_launch: launch failed: %s\n", hipGetErrorName(le));
}
```

```cpp
#include <hip/hip_runtime.h>
#include <cstdio>
#include <cstdint>
namespace pg8 {
#define PG8_LAS __attribute__((address_space(3)))
typedef unsigned short bf16_t;
typedef short bf16x8 __attribute__((ext_vector_type(8)));
typedef float f32x4 __attribute__((ext_vector_type(4)));
typedef unsigned u32x4 __attribute__((ext_vector_type(4)));
constexpr int BM = 256, BK = 64, HALF = 128, HTB = HALF * BK * 2  , STAGE_BYTES = 8 * HTB, NXCD = 8, WGM = 8;

__host__ __device__ __forceinline__ int lds_byte(int r, int c) { const int st = (r >> 4) * 2 + (c >> 5), rr = r & 15, cc = c & 31, ob = rr * 64 + cc * 2; return st * 1024 + (ob ^ (((ob >> 9) & 1) << 5)); }
__host__ __device__ __forceinline__ void stage_rc(int b, int& R, int& C) { const int st = b / 1024, sb = b % 1024, swz = sb ^ (((sb >> 9) & 1) << 5); R = (st >> 1) * 16 + swz / 64; C = (st & 1) * 32 + (swz % 64) / 2; }
__host__ __device__ __forceinline__ int perm32(int rho) { const int n = rho >> 4, i = rho & 15; return 8 * (i >> 2) + 4 * n + (i & 3); }

struct Unit { int pm, pn; long aoff, boff; int aux; };
struct Gemm { const bf16_t* A; const bf16_t* Bt; int M, N, K; };
__device__ __forceinline__ long rfl64(long v) { const unsigned lo = __builtin_amdgcn_readfirstlane((unsigned)v), hi = __builtin_amdgcn_readfirstlane((unsigned)((unsigned long)v >> 32)); return (long)(((unsigned long)hi << 32) | lo); }
__device__ __forceinline__ void unit_uniform(Unit& u) { u.pm = __builtin_amdgcn_readfirstlane(u.pm); u.pn = __builtin_amdgcn_readfirstlane(u.pn); u.aux = __builtin_amdgcn_readfirstlane(u.aux); u.aoff = rfl64(u.aoff); u.boff = rfl64(u.boff); }

struct StaticOrder {
    int nM, nN, nwg, G, c;
    __host__ __device__ void init(int M, int N, int G_, int c_) { nM = M / BM; nN = N / BM; nwg = nM * nN; G = G_; c = c_; }
    __host__ __device__ bool next(int i, Unit& u) const {
        const long L = (long)i * G + c; if (L >= nwg) return false;
        int wgid = (int)L; { const int q = nwg / NXCD, r = nwg % NXCD, xcd = wgid % NXCD, off = wgid / NXCD; wgid = (xcd < r ? xcd * (q + 1) : r * (q + 1) + (xcd - r) * q) + off; }
        const int nig = WGM * nN, gid = wgid / nig, fm = gid * WGM, gsz = (nM - fm) < WGM ? (nM - fm) : WGM;
        u.pm = fm + ((wgid % nig) % gsz); u.pn = (wgid % nig) / gsz; u.aoff = 0; u.boff = 0; u.aux = 0; return true;
    }
    __device__ __forceinline__ void a_ready(const Unit&) const {}
    __device__ __forceinline__ void done(const Unit&) const {}
};
struct MoeOrder {
    StaticOrder so; int rb0; int pend[8]; long bstride;
    __device__ bool next(int i, Unit& u) const {
        if (!so.next(i, u)) return false;
        const int row = (rb0 + u.pm) * BM; int e = 0;
#pragma unroll
        for (int j = 0; j < 7; ++j) e += (row >= pend[j]) ? 1 : 0;
        u.boff = (long)e * bstride; u.aux = rb0 + u.pm; return true;
    }
    __device__ __forceinline__ void a_ready(const Unit&) const {}
    __device__ __forceinline__ void done(const Unit&) const {}
};

__device__ __forceinline__ unsigned cvt_pk_bf16(float lo, float hi) { unsigned r; asm volatile("v_cvt_pk_bf16_f32 %0, %1, %2" : "=v"(r) : "v"(lo), "v"(hi)); return r; }
__device__ __forceinline__ float silu_f(float v) { return v * __builtin_amdgcn_rcpf(1.0f + __builtin_amdgcn_exp2f(-1.4426950408889634f * v)); }

struct EpiBf16 {
    static constexpr bool PERM = true, AFTER_DRAIN = false;
    bf16_t* O; int ldc; float* F; int fcol0;
    __device__ __forceinline__ void operator()(const f32x4 (&acc)[2][2][4][2], const Unit& u, int wr, int wc, int fr, int fq) const {
        const int row0 = u.pm * BM + wr * 64 + fr; const int col0 = u.pn * BM + wc * 32 + 8 * fq;
#pragma unroll
        for (int ai = 0; ai < 2; ++ai)
#pragma unroll
            for (int m = 0; m < 4; ++m) { bf16_t* rowp = O + (size_t)(row0 + ai * HALF + m * 16) * ldc + col0;
#pragma unroll
                for (int bj = 0; bj < 2; ++bj) { const f32x4 v0 = acc[ai][bj][m][0], v1 = acc[ai][bj][m][1];
                    u32x4 w; w.x = cvt_pk_bf16(v0[0], v0[1]); w.y = cvt_pk_bf16(v0[2], v0[3]); w.z = cvt_pk_bf16(v1[0], v1[1]); w.w = cvt_pk_bf16(v1[2], v1[3]);
                    *(u32x4*)(rowp + bj * HALF) = w;
                    if (F) { const int c = col0 + bj * HALF - fcol0; if (c >= 0 && c < 16) { float* fp = F + (size_t)(row0 + ai * HALF + m * 16) * 16 + c; *(f32x4*)fp = v0; *(f32x4*)(fp + 4) = v1; } }
                } }
    }
};
struct EpiResF32 {
    static constexpr bool PERM = false, AFTER_DRAIN = false;
    const float* Xin; float* X; int ldc; float alpha; float bscale;
    __device__ __forceinline__ void operator()(const f32x4 (&acc)[2][2][4][2], const Unit& u, int wr, int wc, int fr, int fq) const {
        const int row0 = u.pm * BM + wr * 64 + fr, col0 = u.pn * BM + wc * 32 + 4 * fq;
#pragma unroll
        for (int ai = 0; ai < 2; ++ai)
#pragma unroll
            for (int m = 0; m < 4; ++m) { float* rowp = X + (size_t)(row0 + ai * HALF + m * 16) * ldc + col0;
#pragma unroll
                for (int bj = 0; bj < 2; ++bj)
#pragma unroll
                    for (int n = 0; n < 2; ++n) { f32x4* p = (f32x4*)(rowp + bj * HALF + n * 16); const f32x4 x = *(const f32x4*)(Xin + (p - (f32x4*)X) * 4); *p = x * alpha + acc[ai][bj][m][n] * bscale; } }
    }
};
struct EpiSwiglu {
    static constexpr bool PERM = true, AFTER_DRAIN = false;
    bf16_t* H; int ldc;
    __device__ __forceinline__ void operator()(const f32x4 (&acc)[2][2][4][2], const Unit& u, int wr, int wc, int fr, int fq) const {
        const int row0 = u.pm * BM + wr * 64 + fr; const int col0 = u.pn * HALF + wc * 32 + 8 * fq;
#pragma unroll
        for (int ai = 0; ai < 2; ++ai)
#pragma unroll
            for (int m = 0; m < 4; ++m) { bf16_t* rowp = H + (size_t)(row0 + ai * HALF + m * 16) * ldc + col0;
                const f32x4 g0 = acc[ai][0][m][0], g1 = acc[ai][0][m][1], u0 = acc[ai][1][m][0], u1 = acc[ai][1][m][1];
                f32x4 h0, h1;
#pragma unroll
                for (int j = 0; j < 4; ++j) { h0[j] = silu_f(g0[j]) * u0[j]; h1[j] = silu_f(g1[j]) * u1[j]; }
                u32x4 w; w.x = cvt_pk_bf16(h0[0], h0[1]); w.y = cvt_pk_bf16(h0[2], h0[3]); w.z = cvt_pk_bf16(h1[0], h1[1]); w.w = cvt_pk_bf16(h1[2], h1[3]);
                *(u32x4*)rowp = w; }
    }
};
struct EpiSwigluF8 {
    static constexpr bool PERM = true, AFTER_DRAIN = false;
    unsigned char* H; int ldc;
    __device__ __forceinline__ void operator()(const f32x4 (&acc)[2][2][4][2], const Unit& u, int wr, int wc, int fr, int fq) const {
        const int row0 = u.pm * BM + wr * 64 + fr; const int col0 = u.pn * HALF + wc * 32 + 8 * fq;
#pragma unroll
        for (int ai = 0; ai < 2; ++ai)
#pragma unroll
            for (int m = 0; m < 4; ++m) { unsigned char* rowp = H + (size_t)(row0 + ai * HALF + m * 16) * ldc + col0;
                const f32x4 g0 = acc[ai][0][m][0], g1 = acc[ai][0][m][1], u0 = acc[ai][1][m][0], u1 = acc[ai][1][m][1];
                f32x4 h0, h1;
#pragma unroll
                for (int j = 0; j < 4; ++j) { h0[j] = silu_f(g0[j]) * u0[j]; h1[j] = silu_f(g1[j]) * u1[j]; }
                int w0 = 0, w1 = 0;
                w0 = __builtin_amdgcn_cvt_pk_fp8_f32(h0[0], h0[1], w0, false); w0 = __builtin_amdgcn_cvt_pk_fp8_f32(h0[2], h0[3], w0, true);
                w1 = __builtin_amdgcn_cvt_pk_fp8_f32(h1[0], h1[1], w1, false); w1 = __builtin_amdgcn_cvt_pk_fp8_f32(h1[2], h1[3], w1, true);
                typedef int i32x2 __attribute__((ext_vector_type(2))); *(i32x2*)rowp = (i32x2){w0, w1}; __builtin_amdgcn_sched_barrier(0); }
    }
};
struct EpiMoeDown {
    static constexpr bool PERM = true, AFTER_DRAIN = false;
    bf16_t* Y0; long ystride; int ldc; const int* slot_tok2; const float* slot_gate; int rbase;
    __device__ __forceinline__ void operator()(const f32x4 (&acc)[2][2][4][2], const Unit& u, int wr, int wc, int fr, int fq) const {
        const int row0 = rbase + u.pm * BM + wr * 64 + fr; const int col0 = u.pn * BM + wc * 32 + 8 * fq;
#pragma unroll
        for (int ai = 0; ai < 2; ++ai)
#pragma unroll
            for (int m = 0; m < 4; ++m) { const int slot = row0 + ai * HALF + m * 16; const int t2 = slot_tok2[slot]; const float gt = slot_gate[slot];
                if (t2 >= 0) { bf16_t* rowp = Y0 + (size_t)(t2 & 1) * ystride + (size_t)(t2 >> 1) * ldc + col0;
#pragma unroll
                    for (int bj = 0; bj < 2; ++bj) { const f32x4 v0 = acc[ai][bj][m][0] * gt, v1 = acc[ai][bj][m][1] * gt;
                        u32x4 w; w.x = cvt_pk_bf16(v0[0], v0[1]); w.y = cvt_pk_bf16(v0[2], v0[3]); w.z = cvt_pk_bf16(v1[0], v1[1]); w.w = cvt_pk_bf16(v1[2], v1[3]);
                        *(u32x4*)(rowp + bj * HALF) = w; } } __builtin_amdgcn_sched_barrier(0); }
    }
};

template <class Epi, class Sched, bool ALIGN_EPI = false, bool SP2 = false>
__device__ __forceinline__ void gemm_phase(PG8_LAS unsigned char* lds, const Gemm g, const Sched& S, const Epi& E, int tid) {
    asm volatile("" : "+v"(tid));
    const int wid = __builtin_amdgcn_readfirstlane(tid >> 6), lane = tid & 63, wr = wid >> 2, wc = wid & 3, fr = lane & 15, fq = lane >> 4;
    const int K = g.K, nt = K / BK;
    unsigned voffA[2], voffB[2];
#pragma unroll
    for (int i = 0; i < 2; ++i) { int R, C; stage_rc(tid * 16 + i * 8192, R, C); const int Rb = Epi::PERM ? ((R & ~31) + perm32(R & 31)) : R;
        voffA[i] = (unsigned)(R * K + C) * 2u; voffB[i] = (unsigned)(Rb * K + C) * 2u; }
    const size_t kstep = (size_t)(BK * 2);
    const size_t hstep = (size_t)HALF * K * 2;
    const size_t tstep = 2 * hstep;
    const unsigned ldsw = (unsigned)wid * 1024u;
    const int aoff = lds_byte(wr * 64 + fr, fq * 8), boff = lds_byte(wc * 32 + fr, fq * 8);
#define PG8_SA(b, h) (((b) * 2 + (h)) * HTB)
#define PG8_SB(b, h) ((4 + (b) * 2 + (h)) * HTB)
#define PG8_STAGE(bufoff, gbase, voff) do { _Pragma("unroll") for (int _i = 0; _i < 2; ++_i) \
        __builtin_amdgcn_global_load_lds((const unsigned*)((const char*)(gbase) + (voff)[_i]), (PG8_LAS unsigned*)(lds + (bufoff) + ldsw + _i * 8192), 16, 0, 0); } while (0)
#define PG8_LDA(dst, b, h) do { _Pragma("unroll") for (int m = 0; m < 4; ++m) _Pragma("unroll") for (int k = 0; k < 2; ++k) dst[m][k] = *(const PG8_LAS bf16x8*)(lds + PG8_SA(b, h) + aoff + m * 2048 + k * 1024); } while (0)
#define PG8_LDB(dst, b, h) do { _Pragma("unroll") for (int n = 0; n < 2; ++n) _Pragma("unroll") for (int k = 0; k < 2; ++k) dst[n][k] = *(const PG8_LAS bf16x8*)(lds + PG8_SB(b, h) + boff + n * 2048 + k * 1024); } while (0)
#define PG8_MMA(ai, bj, At, Bt) do { __builtin_amdgcn_s_setprio(1); _Pragma("unroll") for (int m = 0; m < 4; ++m) _Pragma("unroll") for (int n = 0; n < 2; ++n) _Pragma("unroll") for (int k = 0; k < 2; ++k) \
        acc[ai][bj][m][n] = __builtin_amdgcn_mfma_f32_16x16x32_bf16(Bt[n][k], At[m][k], acc[ai][bj][m][n], 0, 0, 0); __builtin_amdgcn_s_setprio(0); } while (0)
#define PG8_WAIT_V(n) asm volatile("s_waitcnt vmcnt(" #n ")" ::: "memory")
#define PG8_WAIT_L(n) asm volatile("s_waitcnt lgkmcnt(" #n ")" ::: "memory")
#define PG8_BAR __builtin_amdgcn_s_barrier()
#define PG8_SCHED __builtin_amdgcn_sched_barrier(0)
    Unit cur, nxt; int ui = 0;
    if (!S.next(0, cur)) return;
    f32x4 acc[2][2][4][2];
#pragma unroll
    for (int a = 0; a < 2; ++a)
#pragma unroll
        for (int b = 0; b < 2; ++b)
#pragma unroll
            for (int m = 0; m < 4; ++m)
#pragma unroll
                for (int n = 0; n < 2; ++n) acc[a][b][m][n] = (f32x4){0.f, 0.f, 0.f, 0.f};
    bf16x8 At[4][2], B0[2][2], B1[2][2];
    const char* cA = (const char*)g.A + cur.aoff + (size_t)cur.pm * tstep; const char* cB = (const char*)g.Bt + cur.boff + (size_t)cur.pn * tstep;
    S.a_ready(cur);
    if constexpr (SP2) {
        PG8_STAGE(PG8_SB(0, 0), cB, voffB); PG8_STAGE(PG8_SB(0, 1), cB + hstep, voffB); PG8_STAGE(PG8_SA(0, 0), cA, voffA); PG8_STAGE(PG8_SA(0, 1), cA + hstep, voffA);
        if (wr == 1) PG8_BAR;
        PG8_WAIT_V(2); PG8_BAR;
        PG8_STAGE(PG8_SB(1, 0), cB + kstep, voffB); PG8_STAGE(PG8_SA(1, 0), cA + kstep, voffA); PG8_STAGE(PG8_SB(1, 1), cB + hstep + kstep, voffB);
        PG8_WAIT_V(6); PG8_BAR;
    } else {
        PG8_STAGE(PG8_SB(0, 0), cB, voffB); PG8_STAGE(PG8_SA(0, 0), cA, voffA); PG8_STAGE(PG8_SB(0, 1), cB + hstep, voffB); PG8_STAGE(PG8_SA(0, 1), cA + hstep, voffA);
        if (wr == 1) PG8_BAR;
        PG8_WAIT_V(4); PG8_BAR;
        PG8_STAGE(PG8_SB(1, 0), cB + kstep, voffB); PG8_STAGE(PG8_SA(1, 0), cA + kstep, voffA); PG8_STAGE(PG8_SB(1, 1), cB + hstep + kstep, voffB);
        PG8_WAIT_V(6); PG8_BAR;
    }
    for (;;) {
        const bool has_next = S.next(ui + 1, nxt);
        const char* nA = has_next ? (const char*)g.A + nxt.aoff + (size_t)nxt.pm * tstep : cA; const char* nB = has_next ? (const char*)g.Bt + nxt.boff + (size_t)nxt.pn * tstep : cB;
        for (int t = 0; t < nt; t += 2) {
            const bool last = (t == nt - 2);
            const char* a1 = cA + (size_t)(t + 1) * kstep;
            const char* a2 = last ? nA : cA + (size_t)(t + 2) * kstep; const char* b2 = last ? nB : cB + (size_t)(t + 2) * kstep;
            const char* a3 = a2 + kstep; const char* b3 = b2 + kstep;
            if (last && has_next) S.a_ready(nxt);
            if constexpr (SP2) {
            PG8_LDB(B0, 0, 0); PG8_LDB(B1, 0, 1); PG8_SCHED; PG8_LDA(At, 0, 0); PG8_STAGE(PG8_SA(1, 1), a1 + hstep, voffA);
            PG8_WAIT_V(8); PG8_WAIT_L(0); PG8_BAR; PG8_MMA(0, 0, At, B0); PG8_MMA(0, 1, At, B1); PG8_BAR; PG8_SCHED;
            PG8_LDA(At, 0, 1); PG8_STAGE(PG8_SB(0, 0), b2, voffB); PG8_STAGE(PG8_SB(0, 1), b2 + hstep, voffB); PG8_STAGE(PG8_SA(0, 0), a2, voffA);
            PG8_WAIT_V(8); PG8_WAIT_L(0); PG8_BAR; PG8_MMA(1, 0, At, B0); PG8_MMA(1, 1, At, B1); PG8_BAR; PG8_SCHED;
            PG8_LDB(B0, 1, 0); PG8_LDB(B1, 1, 1); PG8_SCHED; PG8_LDA(At, 1, 0); PG8_STAGE(PG8_SA(0, 1), a2 + hstep, voffA);
            PG8_WAIT_V(8); PG8_WAIT_L(0); PG8_BAR; PG8_MMA(0, 0, At, B0); PG8_MMA(0, 1, At, B1); PG8_BAR; PG8_SCHED;
            PG8_LDA(At, 1, 1); PG8_STAGE(PG8_SB(1, 0), b3, voffB); PG8_STAGE(PG8_SB(1, 1), b3 + hstep, voffB); PG8_STAGE(PG8_SA(1, 0), a3, voffA);
            PG8_WAIT_V(8); PG8_WAIT_L(0); PG8_BAR; PG8_MMA(1, 0, At, B0); PG8_MMA(1, 1, At, B1); PG8_BAR; PG8_SCHED;
            } else {
            PG8_LDB(B0, 0, 0); PG8_SCHED; PG8_LDA(At, 0, 0); PG8_STAGE(PG8_SA(1, 1), a1 + hstep, voffA);
            PG8_WAIT_L(8); PG8_BAR; PG8_WAIT_L(0); PG8_MMA(0, 0, At, B0); PG8_BAR; PG8_SCHED;
            PG8_LDB(B1, 0, 1); PG8_STAGE(PG8_SB(0, 0), b2, voffB);
            PG8_BAR; PG8_WAIT_L(0); PG8_MMA(0, 1, At, B1); PG8_BAR;
            PG8_LDA(At, 0, 1); PG8_STAGE(PG8_SA(0, 0), a2, voffA);
            PG8_BAR; PG8_WAIT_L(0); PG8_MMA(1, 0, At, B0); PG8_BAR; PG8_SCHED;
            PG8_STAGE(PG8_SB(0, 1), b2 + hstep, voffB);
            PG8_WAIT_V(6); PG8_BAR; PG8_MMA(1, 1, At, B1); PG8_BAR;
            PG8_LDB(B0, 1, 0); PG8_SCHED; PG8_LDA(At, 1, 0); PG8_STAGE(PG8_SA(0, 1), a2 + hstep, voffA);
            PG8_WAIT_L(8); PG8_BAR; PG8_WAIT_L(0); PG8_MMA(0, 0, At, B0); PG8_BAR; PG8_SCHED;
            PG8_LDB(B1, 1, 1); PG8_STAGE(PG8_SB(1, 0), b3, voffB);
            PG8_BAR; PG8_WAIT_L(0); PG8_MMA(0, 1, At, B1); PG8_BAR;
            PG8_LDA(At, 1, 1); PG8_STAGE(PG8_SA(1, 0), a3, voffA);
            PG8_BAR; PG8_WAIT_L(0); PG8_MMA(1, 0, At, B0); PG8_BAR; PG8_SCHED;
            PG8_STAGE(PG8_SB(1, 1), b3 + hstep, voffB);
            PG8_WAIT_V(6); PG8_BAR; PG8_MMA(1, 1, At, B1); PG8_BAR;
            }
        }
        if constexpr (ALIGN_EPI) { if (wr == 0) PG8_BAR; }
        if constexpr (!Epi::AFTER_DRAIN) { E(acc, cur, wr, wc, fr, fq); S.done(cur); }
        if (!has_next) break;
#pragma unroll
        for (int a = 0; a < 2; ++a)
#pragma unroll
            for (int b = 0; b < 2; ++b)
#pragma unroll
                for (int m = 0; m < 4; ++m)
#pragma unroll
                    for (int n = 0; n < 2; ++n) acc[a][b][m][n] = (f32x4){0.f, 0.f, 0.f, 0.f};
        cur = nxt; cA = nA; cB = nB; ++ui;
        if constexpr (ALIGN_EPI) { if (wr == 1) PG8_BAR; }
    }
    PG8_WAIT_V(0);
    if constexpr (!ALIGN_EPI) { if (wr == 0) PG8_BAR; }
    PG8_BAR;
#undef PG8_SA
#undef PG8_SB
#undef PG8_STAGE
#undef PG8_LDA
#undef PG8_LDB
#undef PG8_MMA
#undef PG8_WAIT_V
#undef PG8_WAIT_L
#undef PG8_BAR
#undef PG8_SCHED
}
typedef int v8i __attribute__((ext_vector_type(8)));
typedef int v4i __attribute__((ext_vector_type(4)));
typedef int v32i __attribute__((ext_vector_type(32)));
template <class Epi, class Sched, bool ALIGN_EPI = false, bool SP2 = false>
__device__ __forceinline__ void gemm_phase_f8(PG8_LAS unsigned char* lds, const Gemm g, const Sched& S, const Epi& E, int tid, int scaleBt, int scaleA) {
    asm volatile("" : "+v"(tid));
    const int wid = __builtin_amdgcn_readfirstlane(tid >> 6), lane = tid & 63, wr = wid >> 2, wc = wid & 3, fr = lane & 15, fq = lane >> 4;
    const int K = g.K, nt = K / 128;
    unsigned voffA[2], voffB[2];
#pragma unroll
    for (int i = 0; i < 2; ++i) { int R, C; stage_rc(tid * 16 + i * 8192, R, C); const int Rb = Epi::PERM ? ((R & ~31) + perm32(R & 31)) : R;
        voffA[i] = (unsigned)(R * K + C * 2); voffB[i] = (unsigned)(Rb * K + C * 2); }
    const size_t kstep = (size_t)(BK * 2);
    const size_t hstep = (size_t)HALF * K;
    const size_t tstep = 2 * hstep;
    const unsigned ldsw = (unsigned)wid * 1024u;
    const int aoff0 = lds_byte(wr * 64 + fr, fq * 16), aoff1 = lds_byte(wr * 64 + fr, fq * 16 + 8), boff0 = lds_byte(wc * 32 + fr, fq * 16), boff1 = lds_byte(wc * 32 + fr, fq * 16 + 8);
#define PG8_SA(b, h) (((b) * 2 + (h)) * HTB)
#define PG8_SB(b, h) ((4 + (b) * 2 + (h)) * HTB)
#define PG8_STAGE(bufoff, gbase, voff) do { _Pragma("unroll") for (int _i = 0; _i < 2; ++_i) \
        __builtin_amdgcn_global_load_lds((const unsigned*)((const char*)(gbase) + (voff)[_i]), (PG8_LAS unsigned*)(lds + (bufoff) + ldsw + _i * 8192), 16, 0, 0); } while (0)
#define PG8_INS8(big, slot, lo_, hi_) do { const v8i f_ = __builtin_shufflevector(lo_, hi_, 0, 1, 2, 3, 4, 5, 6, 7); \
        const v32i e_ = __builtin_shufflevector(f_, f_, 0, 1, 2, 3, 4, 5, 6, 7, 0, 1, 2, 3, 4, 5, 6, 7, 0, 1, 2, 3, 4, 5, 6, 7, 0, 1, 2, 3, 4, 5, 6, 7); \
        if ((slot) == 0) big = __builtin_shufflevector(big, e_, 32, 33, 34, 35, 36, 37, 38, 39, 8, 9, 10, 11, 12, 13, 14, 15, 16, 17, 18, 19, 20, 21, 22, 23, 24, 25, 26, 27, 28, 29, 30, 31); \
        else if ((slot) == 1) big = __builtin_shufflevector(big, e_, 0, 1, 2, 3, 4, 5, 6, 7, 32, 33, 34, 35, 36, 37, 38, 39, 16, 17, 18, 19, 20, 21, 22, 23, 24, 25, 26, 27, 28, 29, 30, 31); \
        else if ((slot) == 2) big = __builtin_shufflevector(big, e_, 0, 1, 2, 3, 4, 5, 6, 7, 8, 9, 10, 11, 12, 13, 14, 15, 32, 33, 34, 35, 36, 37, 38, 39, 24, 25, 26, 27, 28, 29, 30, 31); \
        else big = __builtin_shufflevector(big, e_, 0, 1, 2, 3, 4, 5, 6, 7, 8, 9, 10, 11, 12, 13, 14, 15, 16, 17, 18, 19, 20, 21, 22, 23, 32, 33, 34, 35, 36, 37, 38, 39); } while (0)
#define PG8_GET8(big, slot) ((slot) == 0 ? __builtin_shufflevector(big, big, 0, 1, 2, 3, 4, 5, 6, 7) : (slot) == 1 ? __builtin_shufflevector(big, big, 8, 9, 10, 11, 12, 13, 14, 15) : (slot) == 2 ? __builtin_shufflevector(big, big, 16, 17, 18, 19, 20, 21, 22, 23) : __builtin_shufflevector(big, big, 24, 25, 26, 27, 28, 29, 30, 31))
#define PG8_LDA(dst, b, h) do { _Pragma("unroll") for (int m = 0; m < 4; ++m) { const v4i lo_ = *(const PG8_LAS v4i*)(lds + PG8_SA(b, h) + aoff0 + m * 2048), hi_ = *(const PG8_LAS v4i*)(lds + PG8_SA(b, h) + aoff1 + m * 2048); PG8_INS8(Afr, m, lo_, hi_); } } while (0)
#define PG8_LDB(dst, b, h) do { _Pragma("unroll") for (int n = 0; n < 2; ++n) { const v4i lo_ = *(const PG8_LAS v4i*)(lds + PG8_SB(b, h) + boff0 + n * 2048), hi_ = *(const PG8_LAS v4i*)(lds + PG8_SB(b, h) + boff1 + n * 2048); PG8_INS8(Bfr, (dst) * 2 + n, lo_, hi_); } } while (0)
#define PG8_F8(x) __builtin_bit_cast(v8i, x)
#define PG8_MMA(ai, bj, At, Bt) do { __builtin_amdgcn_s_setprio(1); _Pragma("unroll") for (int m = 0; m < 4; ++m) _Pragma("unroll") for (int n = 0; n < 2; ++n) { const v8i bop_ = PG8_GET8(Bfr, (Bt) * 2 + n), aop_ = PG8_GET8(Afr, m); \
        asm volatile("v_mfma_scale_f32_16x16x128_f8f6f4 %0, %1, %2, %0, %3, %4 op_sel_hi:[0,0,0]" : "+v"(acc[ai][bj][m][n]) : "v"(bop_), "v"(aop_), "v"(scaleBt), "v"(scaleA)); } __builtin_amdgcn_s_setprio(0); } while (0)
#define PG8_WAIT_V(n) asm volatile("s_waitcnt vmcnt(" #n ")" ::: "memory")
#define PG8_WAIT_L(n) asm volatile("s_waitcnt lgkmcnt(" #n ")" ::: "memory")
#define PG8_BAR __builtin_amdgcn_s_barrier()
#define PG8_SCHED __builtin_amdgcn_sched_barrier(0)
    Unit cur, nxt; int ui = 0;
    if (!S.next(0, cur)) return;
    unit_uniform(cur);
    f32x4 acc[2][2][4][2];
#pragma unroll
    for (int a = 0; a < 2; ++a)
#pragma unroll
        for (int b = 0; b < 2; ++b)
#pragma unroll
            for (int m = 0; m < 4; ++m)
#pragma unroll
                for (int n = 0; n < 2; ++n) acc[a][b][m][n] = (f32x4){0.f, 0.f, 0.f, 0.f};
    v32i Afr, Bfr;
    const char* cA = (const char*)g.A + cur.aoff + (size_t)cur.pm * tstep; const char* cB = (const char*)g.Bt + cur.boff + (size_t)cur.pn * tstep;
    S.a_ready(cur);
    if constexpr (SP2) {
        PG8_STAGE(PG8_SB(0, 0), cB, voffB); PG8_STAGE(PG8_SB(0, 1), cB + hstep, voffB); PG8_STAGE(PG8_SA(0, 0), cA, voffA); PG8_STAGE(PG8_SA(0, 1), cA + hstep, voffA);
        if (wr == 1) PG8_BAR;
        PG8_WAIT_V(2); PG8_BAR;
        PG8_STAGE(PG8_SB(1, 0), cB + kstep, voffB); PG8_STAGE(PG8_SA(1, 0), cA + kstep, voffA); PG8_STAGE(PG8_SB(1, 1), cB + hstep + kstep, voffB);
        PG8_WAIT_V(6); PG8_BAR;
    } else {
        PG8_STAGE(PG8_SB(0, 0), cB, voffB); PG8_STAGE(PG8_SA(0, 0), cA, voffA); PG8_STAGE(PG8_SB(0, 1), cB + hstep, voffB); PG8_STAGE(PG8_SA(0, 1), cA + hstep, voffA);
        if (wr == 1) PG8_BAR;
        PG8_WAIT_V(4); PG8_BAR;
        PG8_STAGE(PG8_SB(1, 0), cB + kstep, voffB); PG8_STAGE(PG8_SA(1, 0), cA + kstep, voffA); PG8_STAGE(PG8_SB(1, 1), cB + hstep + kstep, voffB);
        PG8_WAIT_V(6); PG8_BAR;
    }
    for (;;) {
        const bool has_next = __builtin_amdgcn_readfirstlane((int)S.next(ui + 1, nxt)) != 0; unit_uniform(nxt);
        const char* nA = has_next ? (const char*)g.A + nxt.aoff + (size_t)nxt.pm * tstep : cA; const char* nB = has_next ? (const char*)g.Bt + nxt.boff + (size_t)nxt.pn * tstep : cB;
        for (int t = 0; t < nt; t += 2) {
            const bool last = (t == nt - 2);
            const char* a1 = cA + (size_t)(t + 1) * kstep;
            const char* a2 = last ? nA : cA + (size_t)(t + 2) * kstep; const char* b2 = last ? nB : cB + (size_t)(t + 2) * kstep;
            const char* a3 = a2 + kstep; const char* b3 = b2 + kstep;
            if (last && has_next) S.a_ready(nxt);
            if constexpr (SP2) {
            PG8_LDB(0, 0, 0); PG8_LDB(1, 0, 1); PG8_SCHED; PG8_LDA(0, 0, 0); PG8_STAGE(PG8_SA(1, 1), a1 + hstep, voffA);
            PG8_WAIT_V(8); PG8_WAIT_L(0); PG8_BAR; PG8_MMA(0, 0, 0, 0); PG8_MMA(0, 1, 0, 1); PG8_BAR; PG8_SCHED;
            PG8_LDA(0, 0, 1); PG8_STAGE(PG8_SB(0, 0), b2, voffB); PG8_STAGE(PG8_SB(0, 1), b2 + hstep, voffB); PG8_STAGE(PG8_SA(0, 0), a2, voffA);
            PG8_WAIT_V(8); PG8_WAIT_L(0); PG8_BAR; PG8_MMA(1, 0, 0, 0); PG8_MMA(1, 1, 0, 1); PG8_BAR; PG8_SCHED;
            PG8_LDB(0, 1, 0); PG8_LDB(1, 1, 1); PG8_SCHED; PG8_LDA(0, 1, 0); PG8_STAGE(PG8_SA(0, 1), a2 + hstep, voffA);
            PG8_WAIT_V(8); PG8_WAIT_L(0); PG8_BAR; PG8_MMA(0, 0, 0, 0); PG8_MMA(0, 1, 0, 1); PG8_BAR; PG8_SCHED;
            PG8_LDA(0, 1, 1); PG8_STAGE(PG8_SB(1, 0), b3, voffB); PG8_STAGE(PG8_SB(1, 1), b3 + hstep, voffB); PG8_STAGE(PG8_SA(1, 0), a3, voffA);
            PG8_WAIT_V(8); PG8_WAIT_L(0); PG8_BAR; PG8_MMA(1, 0, 0, 0); PG8_MMA(1, 1, 0, 1); PG8_BAR; PG8_SCHED;
            } else {
            PG8_LDB(0, 0, 0); PG8_SCHED; PG8_LDA(0, 0, 0); PG8_STAGE(PG8_SA(1, 1), a1 + hstep, voffA);
            PG8_WAIT_L(8); PG8_BAR; PG8_WAIT_L(0); PG8_MMA(0, 0, 0, 0); PG8_BAR; PG8_SCHED;
            PG8_LDB(1, 0, 1); PG8_STAGE(PG8_SB(0, 0), b2, voffB);
            PG8_BAR; PG8_WAIT_L(0); PG8_MMA(0, 1, 0, 1); PG8_BAR;
            PG8_LDA(0, 0, 1); PG8_STAGE(PG8_SA(0, 0), a2, voffA);
            PG8_BAR; PG8_WAIT_L(0); PG8_MMA(1, 0, 0, 0); PG8_BAR; PG8_SCHED;
            PG8_STAGE(PG8_SB(0, 1), b2 + hstep, voffB);
            PG8_WAIT_V(6); PG8_BAR; PG8_MMA(1, 1, 0, 1); PG8_BAR;
            PG8_LDB(0, 1, 0); PG8_SCHED; PG8_LDA(0, 1, 0); PG8_STAGE(PG8_SA(0, 1), a2 + hstep, voffA);
            PG8_WAIT_L(8); PG8_BAR; PG8_WAIT_L(0); PG8_MMA(0, 0, 0, 0); PG8_BAR; PG8_SCHED;
            PG8_LDB(1, 1, 1); PG8_STAGE(PG8_SB(1, 0), b3, voffB);
            PG8_BAR; PG8_WAIT_L(0); PG8_MMA(0, 1, 0, 1); PG8_BAR;
            PG8_LDA(0, 1, 1); PG8_STAGE(PG8_SA(1, 0), a3, voffA);
            PG8_BAR; PG8_WAIT_L(0); PG8_MMA(1, 0, 0, 0); PG8_BAR; PG8_SCHED;
            PG8_STAGE(PG8_SB(1, 1), b3 + hstep, voffB);
            PG8_WAIT_V(6); PG8_BAR; PG8_MMA(1, 1, 0, 1); PG8_BAR;
            }
        }
        asm volatile("s_nop 15\n\ts_nop 15" ::: "memory");
        if constexpr (ALIGN_EPI) { if (wr == 0) PG8_BAR; }
        if constexpr (!Epi::AFTER_DRAIN) { E(acc, cur, wr, wc, fr, fq); S.done(cur); }
        if (!has_next) break;
#pragma unroll
        for (int a = 0; a < 2; ++a)
#pragma unroll
            for (int b = 0; b < 2; ++b)
#pragma unroll
                for (int m = 0; m < 4; ++m)
#pragma unroll
                    for (int n = 0; n < 2; ++n) acc[a][b][m][n] = (f32x4){0.f, 0.f, 0.f, 0.f};
        cur = nxt; cA = nA; cB = nB; ++ui;
        if constexpr (ALIGN_EPI) { if (wr == 1) PG8_BAR; }
    }
    PG8_WAIT_V(0);
    if constexpr (!ALIGN_EPI) { if (wr == 0) PG8_BAR; }
    PG8_BAR;
#undef PG8_SA
#undef PG8_SB
#undef PG8_STAGE
#undef PG8_LDA
#undef PG8_LDB
#undef PG8_MMA
#undef PG8_F8
#undef PG8_INS8
#undef PG8_GET8
#undef PG8_WAIT_V
#undef PG8_WAIT_L
#undef PG8_BAR
#undef PG8_SCHED
}
}

#ifndef FARFIELD
#define FARFIELD 1
#endif
#ifndef ZERO_MOE
#define ZERO_MOE 0
#endif
#ifndef ZERO_FFN
#define ZERO_FFN 0
#endif
#ifndef ZERO_A
#define ZERO_A 0
#endif
#ifndef ZERO_B
#define ZERO_B 0
#endif
#ifndef ZERO_C
#define ZERO_C 0
#endif
#ifndef ZERO_D
#define ZERO_D 0
#endif
constexpr int NWAVES = 8;
constexpr int NB = 16, SEQ = 2048, DM = 2048, M = NB * SEQ;
constexpr int NIN = 5328, NINP = 5376;
constexpr int C_QC = 0, C_KVC = 384, C_KPE = 640, C_RQ = 704, C_RK = 960, C_RV = 1216, C_RG = 1728, C_MZ = 2240, C_XBC = 2752, C_DT = 3776, C_HU = 3792;
constexpr int DFF = 5632, DFFE = 7168, NEXP = 8;
constexpr int CAP_ROWS = 2 * M + NEXP * 256, CAP_RB = CAP_ROWS / 256;
constexpr int MOE_CH = 1, MOE_CH_RB = CAP_RB / MOE_CH;
constexpr float ALPHA = 1.4142135623730951f;
constexpr int HY_OFF = 2055, HY_GLEN = 4112;

constexpr size_t al256(size_t x) { return (x + 255) / 256 * 256; }
constexpr size_t WS_CTL = 0, CTL_ZERO_BYTES = 1u << 20;
constexpr size_t SZ_WIN = (size_t)NINP * DM * 2, SZ_WUQ = (size_t)768 * 384 * 2, SZ_WUKV = (size_t)1024 * 256 * 2, SZ_WOUT = (size_t)DM * DM * 2;
constexpr size_t WS_WIN = CTL_ZERO_BYTES;
constexpr size_t WS_WUQ = WS_WIN + 2 * SZ_WIN;
constexpr size_t WS_WUKV = WS_WUQ + 2 * SZ_WUQ;
constexpr size_t WS_WOUT = WS_WUKV + 2 * SZ_WUKV;
constexpr size_t WS_WGU = WS_WOUT + 2 * SZ_WOUT;
constexpr size_t WS_WDN = WS_WGU + (size_t)2 * DFF * DM;
constexpr size_t WS_HYG = WS_WDN + (size_t)DM * DFF;
constexpr size_t WS_XB = al256(WS_HYG + (size_t)2 * 2 * 512 * HY_GLEN * 2);
constexpr size_t WS_XF8 = WS_XB + (size_t)M * DM * 2;
constexpr size_t WS_RT = WS_XF8 + (size_t)M * DM;
constexpr size_t WS_RTG = WS_RT + (size_t)M * 16;
constexpr size_t WS_SLOT = WS_RTG + (size_t)M * 8;
constexpr size_t WS_SLOTG = WS_SLOT + (size_t)CAP_ROWS * 4;
constexpr size_t WS_SCR = al256(WS_SLOTG + (size_t)CAP_ROWS * 4);
constexpr size_t WS_PROJ = WS_SCR;
constexpr size_t WS_DTF = WS_PROJ + (size_t)M * NINP * 2;
constexpr size_t WS_QN = WS_DTF + (size_t)M * 16 * 4;
constexpr size_t WS_KVN = WS_QN + (size_t)M * 384 * 2;
constexpr size_t WS_KPE = WS_KVN + (size_t)M * 256 * 2;
constexpr size_t WS_RQ = WS_KPE + (size_t)M * 64 * 2;
constexpr size_t WS_RK = WS_RQ + (size_t)M * 256 * 2;
constexpr size_t WS_XBC = WS_RK + (size_t)M * 256 * 2;
constexpr size_t WS_SSDP = WS_XBC + (size_t)M * 1024 * 2;
constexpr size_t WS_UT = WS_SSDP + (size_t)M * 8 * 16;
constexpr size_t WS_QB = WS_UT + (size_t)3 * 512 * M * 2;
constexpr size_t WS_KVB = WS_QB + (size_t)M * 768 * 2;
constexpr size_t WS_ATT = WS_KVB + (size_t)M * 1024 * 2;
constexpr size_t WS_YC = WS_ATT + (size_t)M * 512 * 2;
constexpr size_t WS_ZT = WS_YC + (size_t)M * 512 * 2;
constexpr size_t WS_MIX = WS_ZT + (size_t)512 * M * 2;
constexpr size_t WS_STR = WS_MIX + (size_t)M * DM * 2;
constexpr size_t WS_STS = WS_STR + (size_t)NB * 4 * 8 * 2 * 8192 * 2;
constexpr size_t WS_MIX_END = WS_STS + (size_t)NB * 8 * 8 * 2 * 8192 * 2;
constexpr size_t WS_HID = WS_SCR;
constexpr size_t WS_XS = WS_SCR + (size_t)NEXP * 3 * DFFE * DM;
constexpr size_t WS_HIDS = WS_XS + (size_t)CAP_ROWS * DM;
constexpr size_t WS_Y0 = WS_HIDS + (size_t)MOE_CH_RB * 256 * DFFE;
constexpr size_t WS_Y1 = WS_Y0 + (size_t)M * DM * 2;
constexpr size_t WS_MGU = WS_Y1 + (size_t)M * DM * 2;
constexpr size_t WS_MDN = WS_MGU + (size_t)NEXP * 2 * DFFE * DM;
constexpr size_t WS_END = WS_MDN + (size_t)NEXP * DM * DFFE;
static_assert(WS_MIX_END <= WS_END && WS_HID + (size_t)M * DFF * 2 <= WS_END, "d_ws map");
static_assert(WS_END <= 1942000000ull, "d_ws map exceeds the guaranteed workspace");
constexpr int CW_TMO = 0, CW_CODE = 1;
constexpr int CW_CNT = 64;
constexpr int CW_MIXQ = 1024;
constexpr int CW_BAR = 4096;

constexpr int RING_OFF = 0, RING_BYTES = 131072;
constexpr int LDSCTL_OFF = RING_BYTES, MISC_OFF = LDSCTL_OFF + 320;
constexpr int LDS_BYTES = 147456;

#define GAS __attribute__((address_space(1)))
#define LAS __attribute__((address_space(3)))
typedef unsigned short bf16;
typedef unsigned v4u __attribute__((ext_vector_type(4)));
typedef unsigned v2u __attribute__((ext_vector_type(2)));
typedef float f32x4 __attribute__((ext_vector_type(4)));
typedef float f32x2 __attribute__((ext_vector_type(2)));
typedef float f32x16 __attribute__((ext_vector_type(16)));
typedef short bf16x8 __attribute__((ext_vector_type(8)));
typedef short s16x4 __attribute__((ext_vector_type(4)));
typedef GAS unsigned gu32;
#define RLX_AGENT __ATOMIC_RELAXED, __HIP_MEMORY_SCOPE_AGENT
#define LDS_WAIT() asm volatile("s_waitcnt lgkmcnt(0)" ::: "memory")
#define VM_WAIT() asm volatile("s_waitcnt vmcnt(0)" ::: "memory")
__device__ __forceinline__ unsigned f2bf(float f) { unsigned u = __builtin_bit_cast(unsigned, f); return (u + 0x7fffu + ((u >> 16) & 1u)) >> 16; }
__device__ __forceinline__ unsigned pk2(float lo, float hi) { return f2bf(lo) | (f2bf(hi) << 16); }
__device__ __forceinline__ float bf2f(unsigned b) { return __builtin_bit_cast(float, b << 16); }
__device__ __forceinline__ float bflo(unsigned w) { return __builtin_bit_cast(float, w << 16); }
__device__ __forceinline__ float bfhi(unsigned w) { return __builtin_bit_cast(float, w & 0xffff0000u); }
__device__ __forceinline__ float silu(float v) { return v / (1.0f + __expf(-v)); }
template <int K> __device__ __forceinline__ float swz_xor(float v) { return __builtin_bit_cast(float, __builtin_amdgcn_ds_swizzle(__builtin_bit_cast(int, v), (K << 10) | 0x1f)); }
__device__ __forceinline__ float half_sum(float v) { v += swz_xor<1>(v); v += swz_xor<2>(v); v += swz_xor<4>(v); v += swz_xor<8>(v); v += swz_xor<16>(v); return v; }
__device__ __forceinline__ float wave_sum(float v) { v = half_sum(v);
    auto rr = __builtin_amdgcn_permlane32_swap(__builtin_bit_cast(unsigned, v), __builtin_bit_cast(unsigned, v), false, false);
    const unsigned r0 = rr[0], r1 = rr[1];
    return __uint_as_float(r0) + __uint_as_float(r1); }

#define XB_TMO      128
#define XB_XCNT(j)  (256  + 64 * (j))
#define XB_XSUB(j)  (1280 + 64 * (j))
#define XB_XGEN(j)  (2304 + 64 * (j))
#define XB_TOP      3328
#define XB_TOPGEN   3392
#define XCD_BAR_WORDS 3456
#define XB_SPIN_CAP (1u << 18)
__device__ __forceinline__ unsigned xb_ld(unsigned* p)              { return __hip_atomic_load(p, __ATOMIC_RELAXED, __HIP_MEMORY_SCOPE_AGENT); }
__device__ __forceinline__ unsigned xb_add(unsigned* p, unsigned v) { return __hip_atomic_fetch_add(p, v, __ATOMIC_RELAXED, __HIP_MEMORY_SCOPE_AGENT); }
__device__ __forceinline__ unsigned xb_xcc_id() { return (unsigned)__builtin_amdgcn_s_getreg((3 << 11) | 20) & 0xFu; }
#define XB_SPIN(cond, bar) do { unsigned _sp = 0; while (cond) { __builtin_amdgcn_s_sleep(1); \
    if ((++_sp & 255u) == 0u) { if (xb_ld(&(bar)[XB_TMO])) break; if (_sp > XB_SPIN_CAP) { atomicAdd(&(bar)[XB_TMO], 1u); break; } } } } while (0)
struct XcdBarrier { unsigned* bar; unsigned x; volatile LAS unsigned* st; };
__device__ __forceinline__ XcdBarrier xcd_barrier_post(unsigned* bar, volatile LAS unsigned* st) {
    XcdBarrier b; b.bar = bar; b.x = xb_xcc_id(); b.st = st;
    if (threadIdx.x == 0) (void)xb_add(&bar[XB_XCNT(b.x)], 1u);
    return b;
}
__device__ __forceinline__ void xcd_barrier_complete(unsigned* bar, unsigned x, unsigned& nloc, unsigned& nx) {
    const unsigned G = gridDim.x * gridDim.y * gridDim.z;
    unsigned sum, cnt, mine, sp = 0u;
    for (;;) {
        sum = 0u; cnt = 0u; mine = 0u;
#pragma unroll
        for (unsigned j = 0; j < 16; ++j) { const unsigned c = xb_ld(&bar[XB_XCNT(j)]); sum += c; cnt += (c > 0u) ? 1u : 0u; mine = (j == x) ? c : mine; }
        if (sum == G) break;
        __builtin_amdgcn_s_sleep(1);
        if ((++sp & 255u) == 0u) { if (xb_ld(&bar[XB_TMO])) break; if (sp > XB_SPIN_CAP) { atomicAdd(&bar[XB_TMO], 1u); break; } }
    }
    nloc = mine > 0u ? mine : 1u; nx = cnt > 0u ? cnt : 1u;
}
__device__ __forceinline__ void xcd_barrier(const XcdBarrier& b) {
    asm volatile("s_waitcnt vmcnt(0)" ::: "memory");
    __syncthreads();
    if (threadIdx.x == 0) {
        unsigned* bar = b.bar;
        __builtin_amdgcn_s_waitcnt(0);
        unsigned nloc = b.st[0], nx = b.st[1];
        if (nloc == 0u) { xcd_barrier_complete(bar, b.x, nloc, nx); b.st[0] = nloc; b.st[1] = nx; }
        const unsigned old = xb_add(&bar[XB_XSUB(b.x)], 1u);
        const unsigned gen = old / nloc;
        if (old + 1u == (gen + 1u) * nloc) {
            __builtin_amdgcn_fence(__ATOMIC_RELEASE, "agent");
            asm volatile("s_waitcnt vmcnt(0)" ::: "memory");
            const unsigned og = xb_add(&bar[XB_TOP], 1u);
            const unsigned tg = og / nx;
            if (og + 1u == (tg + 1u) * nx) xb_add(&bar[XB_TOPGEN], 1u);
            else XB_SPIN(xb_ld(&bar[XB_TOPGEN]) == tg, bar);
            __builtin_amdgcn_fence(__ATOMIC_ACQUIRE, "agent");
            xb_add(&bar[XB_XGEN(b.x)], 1u);
            asm volatile("s_waitcnt vmcnt(0)" ::: "memory");
        } else {
            XB_SPIN(xb_ld(&bar[XB_XGEN(b.x)]) == gen, bar);
            __builtin_amdgcn_fence(__ATOMIC_ACQUIRE, "agent");
            asm volatile("s_waitcnt vmcnt(0)" ::: "memory");
        }
    }
    __syncthreads();
}

struct Args {
    const float* in[35]; float* out; unsigned char* ws; int ph_lo, ph_hi;
};
enum { I_X = 0, I_WIN, I_QNORM, I_WUQ, I_KVNORM, I_WUKV, I_OUTNORM, I_CONVW, I_CONVB, I_DTBIAS, I_ALOG, I_SSDD, I_SSDNORM, I_HYCW, I_HYCB, I_HYW1, I_HYB1, I_HYW2, I_HYB2, I_HYW3, I_HYFREQ, I_HYBIAS, I_HYNORM,
       I_WOUT, I_LN1G, I_LN1B, I_LN2G, I_LN2B, I_FFG, I_FFU, I_FFD, I_ROUTER, I_MOEG, I_MOEU, I_MOED };

typedef __attribute__((address_space(4))) const Args CArgs;
struct AP { const CArgs* p;
    __device__ __forceinline__ const float* in(int i) const { return p->in[i]; }
    __device__ __forceinline__ float* out() const { return p->out; }
    __device__ __forceinline__ unsigned char* ws() const { return p->ws; } };
__device__ __forceinline__ AP kargs() { const CArgs* p = (const CArgs*)__builtin_amdgcn_kernarg_segment_ptr(); asm volatile("" : "+s"(p)); AP a; a.p = p; return a; }

__device__ __forceinline__ void transpose_item(const float* W, int K, int N, int nblk, bf16* WT, int GR, int GS, int off, LAS float* scr, int item, int lane) {
    const int kb = item / nblk, nb = item % nblk, k0 = 64 * kb, n0 = 32 * nb;
    const int nr = n0 + (lane & 31); const bool ok = nr < N;
    float tv[32]; const int nrc = ok ? nr : N - 1;
#pragma unroll
    for (int i = 0; i < 32; ++i) { const int kk = 2 * i + (lane >> 5); tv[i] = __builtin_nontemporal_load(W + (size_t)(k0 + kk) * N + nrc); }
#pragma unroll
    for (int i = 0; i < 32; ++i) { const int kk = 2 * i + (lane >> 5); scr[kk * 33 + (lane & 31)] = ok ? tv[i] : 0.f; }
    LDS_WAIT(); asm volatile("" ::: "memory");
    const int c = lane & 7;
#pragma unroll
    for (int j = 0; j < 4; ++j) { const int nl = (lane >> 3) + 8 * j; const int n = n0 + nl; const LAS float* s = scr + (8 * c) * 33 + nl;
        v4u o; o.x = pk2(s[0 * 33], s[1 * 33]); o.y = pk2(s[2 * 33], s[3 * 33]); o.z = pk2(s[4 * 33], s[5 * 33]); o.w = pk2(s[6 * 33], s[7 * 33]);
        const int dest = (n / GR) * GS + (n % GR) + off;
        *(GAS v4u*)(WT + (size_t)dest * K + k0 + 8 * c) = o; }
    LDS_WAIT(); asm volatile("" ::: "memory");
}
__device__ __forceinline__ unsigned pk4_fp8(float a, float b, float c, float d) { int w = 0; w = __builtin_amdgcn_cvt_pk_fp8_f32(a, b, w, false); w = __builtin_amdgcn_cvt_pk_fp8_f32(c, d, w, true); return (unsigned)w; }
struct TrF8 { const float* W; int K, N, nblk; unsigned char* WT; int GR, GS, off; float scl; };
__device__ __forceinline__ void tr_f8_load(const TrF8& j, int item, int lane, float (&tv)[32]) {
    const int kb = item / j.nblk, nb = item % j.nblk, k0 = 64 * kb, n0 = 32 * nb; const int nr = n0 + (lane & 31);
#pragma unroll
    for (int i = 0; i < 32; ++i) { const int kk = 2 * i + (lane >> 5); tv[i] = __builtin_nontemporal_load(j.W + (size_t)(k0 + kk) * j.N + nr); }
}
__device__ __forceinline__ void tr_f8_finish(const TrF8& j, int item, int lane, const float (&tv)[32], LAS float* scr) {
    const int kb = item / j.nblk, nb = item % j.nblk, k0 = 64 * kb, n0 = 32 * nb;
#pragma unroll
    for (int i = 0; i < 32; ++i) { const int kk = 2 * i + (lane >> 5); scr[kk * 33 + (lane & 31)] = tv[i] * j.scl; }
    LDS_WAIT(); asm volatile("" ::: "memory");
    const int nl = lane >> 1, hf = lane & 1, n = n0 + nl; const LAS float* sp = scr + (32 * hf) * 33 + nl;
    v4u o0, o1;
    o0.x = pk4_fp8(sp[0 * 33], sp[1 * 33], sp[2 * 33], sp[3 * 33]); o0.y = pk4_fp8(sp[4 * 33], sp[5 * 33], sp[6 * 33], sp[7 * 33]);
    o0.z = pk4_fp8(sp[8 * 33], sp[9 * 33], sp[10 * 33], sp[11 * 33]); o0.w = pk4_fp8(sp[12 * 33], sp[13 * 33], sp[14 * 33], sp[15 * 33]);
    o1.x = pk4_fp8(sp[16 * 33], sp[17 * 33], sp[18 * 33], sp[19 * 33]); o1.y = pk4_fp8(sp[20 * 33], sp[21 * 33], sp[22 * 33], sp[23 * 33]);
    o1.z = pk4_fp8(sp[24 * 33], sp[25 * 33], sp[26 * 33], sp[27 * 33]); o1.w = pk4_fp8(sp[28 * 33], sp[29 * 33], sp[30 * 33], sp[31 * 33]);
    const int dest = (n / j.GR) * j.GS + (n % j.GR) + j.off;
    GAS v4u* dp = (GAS v4u*)(j.WT + (size_t)dest * j.K + k0 + 32 * hf); dp[0] = o0; dp[1] = o1;
    LDS_WAIT(); asm volatile("" ::: "memory");
}
__device__ __forceinline__ void transpose_item_f8(const float* W, int K, int N, int nblk, unsigned char* WT, int GR, int GS, int off, float scl, LAS float* scr, int item, int lane) {
    TrF8 j{W, K, N, nblk, WT, GR, GS, off, scl}; float tv[32]; tr_f8_load(j, item, lane, tv); tr_f8_finish(j, item, lane, tv, scr);
}
struct TrJob { const float* W; int K, N, nblk; bf16* WT; int GR, GS, off; int items; };
__device__ __forceinline__ TrJob mk_job(const float* W, int K, int N, int Npad, bf16* WT, int GR, int GS, int off) { TrJob j; j.W = W; j.K = K; j.N = N; j.nblk = Npad / 32; j.WT = WT; j.GR = GR; j.GS = GS; j.off = off; j.items = (K / 64) * (Npad / 32); return j; }

__device__ __forceinline__ void hyena_filter_block(const AP& a, int item, bf16* HYG, LAS float* scr, int lane) {
    asm volatile("" : "+v"(lane));
    const int layer = item >> 10, pos0 = ((item & 1023) >> 3) * 16, mg = item & 7;
    const float* w1 = a.in(I_HYW1) + layer * 33 * 64; const float* b1 = a.in(I_HYB1) + layer * 64;
    const float* w2 = a.in(I_HYW2) + layer * 64 * 64; const float* b2 = a.in(I_HYB2) + layer * 64;
    const float* w3 = a.in(I_HYW3) + (size_t)layer * 64 * 2048; const float* fr = a.in(I_HYFREQ) + layer * 128;
    LAS float* Z = scr; LAS float* H1 = scr + 544; LAS float* H2 = scr + 544 + 1024;
#pragma unroll 1
    for (int idx = lane; idx < 33 * 16; idx += 64) { const int j = idx >> 4, p = idx & 15, pos = pos0 + p; float z;
        const float t = (float)pos / 2047.0f; const float ang = 6.283185307179586f * (float)pos / 2048.0f;
        if (j == 0) z = t;
        else { const int k = (j - 1) & 15; const float f = 1e-4f + (float)k * ((15.0f - 1e-4f) / 15.0f); z = (j <= 16) ? cosf(f * ang) : -sinf(f * ang); }
        Z[idx] = z; }
    LDS_WAIT(); asm volatile("" ::: "memory");
#define HYF_FMA16(S, SRC, W) do { _Pragma("unroll") for (int q = 0; q < 4; ++q) { const f32x4 z_ = *(const LAS f32x4*)((SRC) + 4 * q); S[4 * q] += z_.x * (W); S[4 * q + 1] += z_.y * (W); S[4 * q + 2] += z_.z * (W); S[4 * q + 3] += z_.w * (W); } } while (0)
    { float s[16]; const float bb = b1[lane];
#pragma unroll
      for (int p = 0; p < 16; ++p) s[p] = bb;
#pragma unroll 1
      for (int c0 = 0; c0 < 33; c0 += 11) { float w[11];
#pragma unroll
          for (int ii = 0; ii < 11; ++ii) w[ii] = w1[(c0 + ii) * 64 + lane];
          __builtin_amdgcn_sched_barrier(0);
#pragma unroll
          for (int ii = 0; ii < 11; ++ii) HYF_FMA16(s, Z + (c0 + ii) * 16, w[ii]); }
      const float f = fr[lane];
#pragma unroll
      for (int p = 0; p < 16; ++p) H1[lane * 16 + p] = f * s[p]; }
    LDS_WAIT(); asm volatile("" ::: "memory");
#pragma unroll 1
    for (int p = 0; p < 16; ++p) { const float x = H1[lane * 16 + p]; H1[lane * 16 + p] = sinf(x); }
    LDS_WAIT(); asm volatile("" ::: "memory");
    { float s[16]; const float bb = b2[lane];
#pragma unroll
      for (int p = 0; p < 16; ++p) s[p] = bb;
#pragma unroll 1
      for (int c0 = 0; c0 < 64; c0 += 8) { float w[8];
#pragma unroll
          for (int ii = 0; ii < 8; ++ii) w[ii] = w2[(c0 + ii) * 64 + lane];
          __builtin_amdgcn_sched_barrier(0);
#pragma unroll
          for (int ii = 0; ii < 8; ++ii) HYF_FMA16(s, H1 + (c0 + ii) * 16, w[ii]); }
      const float f = fr[64 + lane];
#pragma unroll
      for (int p = 0; p < 16; ++p) H2[lane * 16 + p] = f * s[p]; }
    LDS_WAIT(); asm volatile("" ::: "memory");
#pragma unroll 1
    for (int p = 0; p < 16; ++p) { const float x = H2[lane * 16 + p]; H2[lane * 16 + p] = sinf(x); }
    LDS_WAIT(); asm volatile("" ::: "memory");
#pragma unroll 1
    for (int hh = 0; hh < 2; ++hh) {
    float v[2][16];
#pragma unroll
    for (int mm = 0; mm < 2; ++mm)
#pragma unroll
        for (int p = 0; p < 16; ++p) v[mm][p] = 0.f;
#pragma unroll 1
    for (int c0 = 0; c0 < 64; c0 += 8) { float w[2][8];
#pragma unroll
        for (int mm = 0; mm < 2; ++mm)
#pragma unroll
            for (int ii = 0; ii < 8; ++ii) w[mm][ii] = w3[(size_t)(c0 + ii) * 2048 + lane + 64 * (4 * mg + 2 * hh + mm)];
        __builtin_amdgcn_sched_barrier(0);
#pragma unroll
        for (int ii = 0; ii < 8; ++ii)
#pragma unroll
            for (int q = 0; q < 4; ++q) { const f32x4 z_ = *(const LAS f32x4*)(H2 + (c0 + ii) * 16 + 4 * q);
#pragma unroll
                for (int mm = 0; mm < 2; ++mm) { v[mm][4 * q] += z_.x * w[mm][ii]; v[mm][4 * q + 1] += z_.y * w[mm][ii]; v[mm][4 * q + 2] += z_.z * w[mm][ii]; v[mm][4 * q + 3] += z_.w * w[mm][ii]; } } }
    __builtin_amdgcn_sched_barrier(0);
#pragma unroll
    for (int mm = 0; mm < 2; ++mm) { const int col = lane + 64 * (4 * mg + 2 * hh + mm);
        const int o = col >> 10, dir = (col >> 9) & 1, c = col & 511;
        const float delta = fabsf(-3.0701134573253945f + (float)c * ((-15.350567286626973f + 3.0701134573253945f) / 511.0f));
        bf16* base = HYG + (((size_t)layer * 2 + o) * 512 + c) * HY_GLEN;
#pragma unroll
        for (int p = 0; p < 16; ++p) { const int pos = pos0 + p; const float t = (float)pos / 2047.0f; const float r = v[mm][p] * expf(-t * delta);
            if (dir == 0 || pos > 0) { const int n = dir == 0 ? HY_OFF - pos : HY_OFF + pos; base[n] = (bf16)f2bf(r); } } }
    }
#undef HYF_FMA16
    LDS_WAIT(); asm volatile("" ::: "memory");
}
__device__ __forceinline__ void hyena_filter_item(const AP& a, int layer, int pos, bf16* HYG, LAS float* scr, int lane) {
    const float* w1 = a.in(I_HYW1) + layer * 33 * 64; const float* b1 = a.in(I_HYB1) + layer * 64;
    const float* w2 = a.in(I_HYW2) + layer * 64 * 64; const float* b2 = a.in(I_HYB2) + layer * 64;
    const float* w3 = a.in(I_HYW3) + (size_t)layer * 64 * 2048; const float* fr = a.in(I_HYFREQ) + layer * 128;
    const float t = (float)pos / 2047.0f; const float ang = 6.283185307179586f * (float)pos / 2048.0f;
    if (lane < 33) { float z;
        if (lane == 0) z = t;
        else { const int k = (lane - 1) & 15; const float f = 1e-4f + (float)k * ((15.0f - 1e-4f) / 15.0f); z = (lane <= 16) ? cosf(f * ang) : -sinf(f * ang); }
        scr[lane] = z; }
    LDS_WAIT(); asm volatile("" ::: "memory");
    float s = b1[lane];
    for (int i = 0; i < 33; ++i) s += scr[i] * w1[i * 64 + lane];
    const float h1 = sinf(fr[lane] * s);
    scr[64 + lane] = h1;
    LDS_WAIT(); asm volatile("" ::: "memory");
    float s2 = b2[lane];
    for (int i = 0; i < 64; ++i) s2 += scr[64 + i] * w2[i * 64 + lane];
    const float h2 = sinf(fr[64 + lane] * s2);
    scr[128 + lane] = h2;
    LDS_WAIT(); asm volatile("" ::: "memory");
    for (int m = 0; m < 32; ++m) { const int col = lane + 64 * m; float v = 0.f;
        for (int i = 0; i < 64; ++i) v += scr[128 + i] * w3[(size_t)i * 2048 + col];
        const int o = col >> 10, dir = (col >> 9) & 1, c = col & 511;
        const float delta = fabsf(-3.0701134573253945f + (float)c * ((-15.350567286626973f + 3.0701134573253945f) / 511.0f));
        v *= expf(-t * delta);
        if (dir == 0 || pos > 0) { const int n = dir == 0 ? HY_OFF - pos : HY_OFF + pos;
            HYG[(((size_t)layer * 2 + o) * 512 + c) * HY_GLEN + n] = (bf16)f2bf(v); } }
    LDS_WAIT(); asm volatile("" ::: "memory");
}

__device__ __forceinline__ void ln_load(const float* xrow, int lane, f32x4 (&v)[8]) { const GAS f32x4* xr = (const GAS f32x4*)xrow + lane;
#pragma unroll
    for (int j = 0; j < 8; ++j) v[j] = xr[64 * j]; }
__device__ __forceinline__ void ln_load_b(const bf16* xrow, int lane, v2u (&x)[8]) { const GAS v2u* xr = (const GAS v2u*)xrow + lane;
#pragma unroll
    for (int j = 0; j < 8; ++j) x[j] = xr[64 * j]; }
__device__ __forceinline__ void ln_row_b(const v2u (&xb)[8], f32x4 (&v)[8], bf16* brow, const float* g, const float* b, int lane, const bf16* y0, const bf16* y1, float* orow, unsigned char* frow = nullptr) {
    float s = 0.f;
#pragma unroll
    for (int j = 0; j < 8; ++j) { const v2u a0 = *((const GAS v2u*)y0 + lane + 64 * j);
        v[j].x = ALPHA * bflo(xb[j].x) + bflo(a0.x); v[j].y = ALPHA * bfhi(xb[j].x) + bfhi(a0.x); v[j].z = ALPHA * bflo(xb[j].y) + bflo(a0.y); v[j].w = ALPHA * bfhi(xb[j].y) + bfhi(a0.y);
        if (y1) { const v2u a1 = *((const GAS v2u*)y1 + lane + 64 * j); v[j].x += bflo(a1.x); v[j].y += bfhi(a1.x); v[j].z += bflo(a1.y); v[j].w += bfhi(a1.y); }
        s += (v[j].x + v[j].y) + (v[j].z + v[j].w); }
    const float mean = wave_sum(s) * (1.f / DM); float s2 = 0.f;
#pragma unroll
    for (int j = 0; j < 8; ++j) { v[j] = v[j] - mean; s2 += (v[j].x * v[j].x + v[j].y * v[j].y) + (v[j].z * v[j].z + v[j].w * v[j].w); }
    const float rstd = 1.f / sqrtf(wave_sum(s2) * (1.f / DM) + 1e-5f);
#pragma unroll
    for (int j = 0; j < 8; ++j) { const f32x4 gg = *((const GAS f32x4*)g + lane + 64 * j), bb = *((const GAS f32x4*)b + lane + 64 * j);
        v[j] = v[j] * rstd * gg + bb;
        if (orow) *((GAS f32x4*)orow + lane + 64 * j) = v[j];
        if (brow) { v2u w; w.x = pk2(v[j].x, v[j].y); w.y = pk2(v[j].z, v[j].w); *((GAS v2u*)brow + lane + 64 * j) = w; }
        if (frow) *((GAS unsigned*)frow + lane + 64 * j) = pk4_fp8(v[j].x, v[j].y, v[j].z, v[j].w); }
}
__device__ __forceinline__ void ln_row(float* xrow, bf16* brow, const float* g, const float* b, int lane, f32x4 (&v)[8], const bf16* y0, const bf16* y1, float* orow, unsigned char* frow = nullptr) {
    float s = 0.f; (void)xrow;
#pragma unroll
    for (int j = 0; j < 8; ++j) {
        if (y0) { v2u a0 = *((const GAS v2u*)y0 + lane + 64 * j), a1 = *((const GAS v2u*)y1 + lane + 64 * j); if (ZERO_MOE) { a0.x = a0.y = a1.x = a1.y = 0u; }
            v[j].x = ALPHA * v[j].x + bflo(a0.x) + bflo(a1.x); v[j].y = ALPHA * v[j].y + bfhi(a0.x) + bfhi(a1.x); v[j].z = ALPHA * v[j].z + bflo(a0.y) + bflo(a1.y); v[j].w = ALPHA * v[j].w + bfhi(a0.y) + bfhi(a1.y); }
        s += (v[j].x + v[j].y) + (v[j].z + v[j].w); }
    const float mean = wave_sum(s) * (1.f / DM); float s2 = 0.f;
#pragma unroll
    for (int j = 0; j < 8; ++j) { v[j] = v[j] - mean; s2 += (v[j].x * v[j].x + v[j].y * v[j].y) + (v[j].z * v[j].z + v[j].w * v[j].w); }
    const float rstd = 1.f / sqrtf(wave_sum(s2) * (1.f / DM) + 1e-5f);
    GAS f32x4* xo = (GAS f32x4*)orow + lane;
#pragma unroll
    for (int j = 0; j < 8; ++j) { const f32x4 gg = *((const GAS f32x4*)g + lane + 64 * j), bb = *((const GAS f32x4*)b + lane + 64 * j);
        v[j] = v[j] * rstd * gg + bb; xo[64 * j] = v[j];
        if (brow) { v2u w; w.x = pk2(v[j].x, v[j].y); w.y = pk2(v[j].z, v[j].w); *((GAS v2u*)brow + lane + 64 * j) = w; }
        if (frow) *((GAS unsigned*)frow + lane + 64 * j) = pk4_fp8(v[j].x, v[j].y, v[j].z, v[j].w); }
}

__device__ __forceinline__ void ld8bf(const bf16* p, float (&f)[8]) { const v4u w = *(const GAS v4u*)p; f[0] = bflo(w.x); f[1] = bfhi(w.x); f[2] = bflo(w.y); f[3] = bfhi(w.y); f[4] = bflo(w.z); f[5] = bfhi(w.z); f[6] = bflo(w.w); f[7] = bfhi(w.w); }
__device__ __forceinline__ void st8bf(bf16* p, const float (&f)[8]) { v4u w; w.x = pk2(f[0], f[1]); w.y = pk2(f[2], f[3]); w.z = pk2(f[4], f[5]); w.w = pk2(f[6], f[7]); *(GAS v4u*)p = w; }

__device__ __forceinline__ float sum8(float v) { v += swz_xor<1>(v); v += swz_xor<2>(v); v += swz_xor<4>(v); return v; }
__device__ __forceinline__ void prep_rows8(const AP& a, int layer, int item, int lane, unsigned char* ws, const LAS float* cwl) {
    const int rr = lane >> 3, sub = lane & 7, row = item * 8 + rr, t = row & (SEQ - 1);
    const bf16* pr = (const bf16*)(ws + WS_PROJ) + (size_t)row * NINP;
    { float f[6][8]; float ss = 0.f;
#pragma unroll
      for (int i = 0; i < 6; ++i) { ld8bf(pr + C_QC + (sub + 8 * i) * 8, f[i]);
#pragma unroll
          for (int j = 0; j < 8; ++j) ss += f[i][j] * f[i][j]; }
      const float rs = 1.0f / sqrtf(sum8(ss) * (1.f / 384.f) + 1e-6f);
#pragma unroll
      for (int i = 0; i < 6; ++i) { const float* w = a.in(I_QNORM) + layer * 384 + (sub + 8 * i) * 8;
#pragma unroll
          for (int j = 0; j < 8; ++j) f[i][j] = f[i][j] * rs * w[j];
          st8bf((bf16*)(ws + WS_QN) + (size_t)row * 384 + (sub + 8 * i) * 8, f[i]); } }
    { float f[4][8]; float ss = 0.f;
#pragma unroll
      for (int i = 0; i < 4; ++i) { ld8bf(pr + C_KVC + (sub + 8 * i) * 8, f[i]);
#pragma unroll
          for (int j = 0; j < 8; ++j) ss += f[i][j] * f[i][j]; }
      const float rs = 1.0f / sqrtf(sum8(ss) * (1.f / 256.f) + 1e-6f);
#pragma unroll
      for (int i = 0; i < 4; ++i) { const float* w = a.in(I_KVNORM) + layer * 256 + (sub + 8 * i) * 8;
#pragma unroll
          for (int j = 0; j < 8; ++j) f[i][j] = f[i][j] * rs * w[j];
          st8bf((bf16*)(ws + WS_KVN) + (size_t)row * 256 + (sub + 8 * i) * 8, f[i]); } }
    { float sn[4], cs[4];
#pragma unroll
      for (int j = 0; j < 4; ++j) { const float inv = exp2f(-(float)(4 * sub + j) * (13.287712379549449f / 32.0f)); sincosf((float)t * inv, &sn[j], &cs[j]); }
#pragma unroll
      for (int g = 0; g < 9; ++g) { int src; bf16* dst; float sc = 1.f;
          if (g == 0) { src = C_KPE; dst = (bf16*)(ws + WS_KPE) + (size_t)row * 64; }
          else if (g < 5) { src = C_RQ + (g - 1) * 64; dst = (bf16*)(ws + WS_RQ) + (size_t)row * 256 + (g - 1) * 64; }
          else { src = C_RK + (g - 5) * 64; dst = (bf16*)(ws + WS_RK) + (size_t)row * 256 + (g - 5) * 64; sc = 0.125f; }
          const v2u a1 = *(const GAS v2u*)(pr + src + 4 * sub), a2 = *(const GAS v2u*)(pr + src + 32 + 4 * sub);
          const float x1[4] = {bflo(a1.x), bfhi(a1.x), bflo(a1.y), bfhi(a1.y)}, x2[4] = {bflo(a2.x), bfhi(a2.x), bflo(a2.y), bfhi(a2.y)};
          float y1[4], y2[4];
#pragma unroll
          for (int j = 0; j < 4; ++j) { y1[j] = (x1[j] * cs[j] - x2[j] * sn[j]) * sc; y2[j] = (x2[j] * cs[j] + x1[j] * sn[j]) * sc; }
          v2u o1, o2; o1.x = pk2(y1[0], y1[1]); o1.y = pk2(y1[2], y1[3]); o2.x = pk2(y2[0], y2[1]); o2.y = pk2(y2[2], y2[3]);
          *(GAS v2u*)(dst + 4 * sub) = o1; *(GAS v2u*)(dst + 32 + 4 * sub) = o2; } }
#pragma unroll 4
    for (int i = 0; i < 16; ++i) { const int c0 = (sub + 8 * i) * 8; float acc[8];
        { const f32x4 b0 = *(const LAS f32x4*)(cwl + 5 * 1024 + c0), b1 = *(const LAS f32x4*)(cwl + 5 * 1024 + c0 + 4); acc[0] = b0.x; acc[1] = b0.y; acc[2] = b0.z; acc[3] = b0.w; acc[4] = b1.x; acc[5] = b1.y; acc[6] = b1.z; acc[7] = b1.w; }
        v4u raw[5];
#pragma unroll
        for (int k = 0; k < 5; ++k) { const int tt = t + k - 2; const bool ok = tt >= 0 && tt < SEQ; raw[k] = *(const GAS v4u*)(pr + (ok ? (long)(k - 2) * NINP : 0l) + C_XBC + c0); }
#pragma unroll
        for (int k = 0; k < 5; ++k) { const int tt = t + k - 2; const float mk = (tt >= 0 && tt < SEQ) ? 1.f : 0.f;
            const f32x4 w0 = *(const LAS f32x4*)(cwl + k * 1024 + c0) * mk, w1 = *(const LAS f32x4*)(cwl + k * 1024 + c0 + 4) * mk;
            acc[0] += w0.x * bflo(raw[k].x); acc[1] += w0.y * bfhi(raw[k].x); acc[2] += w0.z * bflo(raw[k].y); acc[3] += w0.w * bfhi(raw[k].y);
            acc[4] += w1.x * bflo(raw[k].z); acc[5] += w1.y * bfhi(raw[k].z); acc[6] += w1.z * bflo(raw[k].w); acc[7] += w1.w * bfhi(raw[k].w); }
#pragma unroll
        for (int j = 0; j < 8; ++j) acc[j] = silu(acc[j]);
        st8bf((bf16*)(ws + WS_XBC) + (size_t)row * 1024 + c0, acc); }
}
__device__ __forceinline__ void prep_scan(const AP& a, int layer, int item, int lane, unsigned char* ws, LAS float* scr) {
    const int b = item >> 4, dir = (item >> 3) & 1, hh = item & 7;
    const float* DTF = (const float*)(ws + WS_DTF); float* SSDP = (float*)(ws + WS_SSDP);
    const float bias = a.in(I_DTBIAS)[layer * 16 + dir * 8 + hh]; const float av = -expf(a.in(I_ALOG)[layer * 16 + dir * 8 + hh]);
    float dt[32]; float tot = 0.f;
#pragma unroll
    for (int j = 0; j < 32; ++j) { const int row = b * SEQ + lane * 32 + j; const float x = DTF[(size_t)row * 16 + dir * 8 + hh] + bias;
        dt[j] = x > 20.f ? x : log1pf(expf(x)); tot += dt[j] * av; }
    scr[lane] = tot; LDS_WAIT(); asm volatile("" ::: "memory");
    float excl = 0.f, T = 0.f;
#pragma unroll 2
    for (int l = 0; l < 64; ++l) { const float v = scr[l]; T += v; excl += (l < lane) ? v : 0.f; }
    LDS_WAIT(); asm volatile("" ::: "memory");
    float run = excl;
#pragma unroll
    for (int j = 0; j < 32; ++j) { const int row = b * SEQ + lane * 32 + j; const float la = dt[j] * av; float c;
        if (dir == 0) { run += la; c = run; } else { c = T - run; run += la; }
        f32x2 o; o.x = c * 1.4426950408889634f; o.y = log2f(dt[j]) - o.x;
        *(GAS f32x2*)(SSDP + ((size_t)row * 8 + hh) * 4 + dir * 2) = o; }
}
__device__ __forceinline__ void prep_scan_wg(const AP& a, int layer, int item, int wave, int lane, unsigned char* ws, LAS float* scr, LAS float* wg) {
    const int b = item >> 4, dir = (item >> 3) & 1, hh = item & 7;
    const float* DTF = (const float*)(ws + WS_DTF); float* SSDP = (float*)(ws + WS_SSDP);
    const float bias = a.in(I_DTBIAS)[layer * 16 + dir * 8 + hh]; const float av = -expf(a.in(I_ALOG)[layer * 16 + dir * 8 + hh]);
    const int row0 = b * SEQ + wave * 256 + lane * 4;
    float dt[4]; float tot = 0.f;
#pragma unroll
    for (int j = 0; j < 4; ++j) { const float x = DTF[(size_t)(row0 + j) * 16 + dir * 8 + hh] + bias; dt[j] = x > 20.f ? x : log1pf(expf(x)); tot += dt[j] * av; }
    scr[lane] = tot; LDS_WAIT(); asm volatile("" ::: "memory");
    float excl = 0.f, Tw = 0.f;
#pragma unroll 2
    for (int l = 0; l < 64; ++l) { const float v = scr[l]; Tw += v; excl += (l < lane) ? v : 0.f; }
    if (lane == 0) wg[wave] = Tw;
    __syncthreads();
    float wpre = 0.f, T = 0.f;
#pragma unroll
    for (int w2 = 0; w2 < 8; ++w2) { const float v = wg[w2]; T += v; wpre += (w2 < wave) ? v : 0.f; }
    float run = wpre + excl;
#pragma unroll
    for (int j = 0; j < 4; ++j) { const float la = dt[j] * av; float c;
        if (dir == 0) { run += la; c = run; } else { c = T - run; run += la; }
        f32x2 o; o.x = c * 1.4426950408889634f; o.y = log2f(dt[j]) - o.x;
        *(GAS f32x2*)(SSDP + ((size_t)(row0 + j) * 8 + hh) * 4 + dir * 2) = o; }
    __syncthreads();
}
__device__ __forceinline__ void prep_hyconv(const AP& a, int layer, int item, int lane, unsigned char* ws, LAS bf16* scr) {
    const int cg = item % 24, tt = (item / 24) & 31, b = item / (24 * 32);
    const int ch = cg * 64 + lane, part = ch >> 9, c = ch & 511, t0 = tt * 64;
    const bf16* PROJ = (const bf16*)(ws + WS_PROJ); const bf16* tile = PROJ + (size_t)(b * SEQ) * NINP + C_HU + cg * 64;
    v4u ld[9];
#pragma unroll
    for (int i = 0; i < 9; ++i) { const int id = lane + 64 * i, r = id >> 3, c8 = id & 7, t = t0 - 1 + r; const bool ok = id < 66 * 8 && t >= 0 && t < SEQ;
        const int tc = t < 0 ? 0 : (t > SEQ - 1 ? SEQ - 1 : t);
        const v4u w = *(const GAS v4u*)(tile + (size_t)tc * NINP + c8 * 8); ld[i] = ok ? w : (v4u){0u, 0u, 0u, 0u}; }
#pragma unroll
    for (int i = 0; i < 9; ++i) { const int id = lane + 64 * i, r = id >> 3, c8 = id & 7; if (id < 66 * 8) *(LAS v4u*)(scr + r * 72 + c8 * 8) = ld[i]; }
    const float* cw = a.in(I_HYCW) + layer * 3 * 1536; const float w0 = cw[ch], w1 = cw[1536 + ch], w2 = cw[3072 + ch], bs = a.in(I_HYCB)[layer * 1536 + ch];
    LDS_WAIT(); asm volatile("" ::: "memory");
    float xm = bf2f(scr[lane]), x0 = bf2f(scr[72 + lane]);
    bf16* dst = (bf16*)(ws + WS_UT) + (((size_t)part * 512 + c) * NB + b) * SEQ + t0;
    v4u ou[8];
#pragma unroll
    for (int q = 0; q < 8; ++q) { float u[8];
#pragma unroll
        for (int j = 0; j < 8; ++j) { const float xp = bf2f(scr[(q * 8 + j + 2) * 72 + lane]);
            u[j] = bs + w0 * xm + w1 * x0 + w2 * xp; xm = x0; x0 = xp; }
        ou[q].x = pk2(u[0], u[1]); ou[q].y = pk2(u[2], u[3]); ou[q].z = pk2(u[4], u[5]); ou[q].w = pk2(u[6], u[7]); }
    LDS_WAIT(); asm volatile("" ::: "memory");
#pragma unroll
    for (int q = 0; q < 8; ++q) *(LAS v4u*)(scr + lane * 72 + q * 8) = ou[q];
    LDS_WAIT(); asm volatile("" ::: "memory");
    (void)dst;
    bf16* dstb = (bf16*)(ws + WS_UT) + (((size_t)part * 512 + ((cg * 64) & 511)) * NB + b) * SEQ + t0;
#pragma unroll
    for (int i = 0; i < 8; ++i) { const int chl = (lane >> 3) + 8 * i, k8 = lane & 7; const v4u v = *(const LAS v4u*)(scr + chl * 72 + k8 * 8);
        *(GAS v4u*)(dstb + (size_t)chl * NB * SEQ + k8 * 8) = v; }
    LDS_WAIT(); asm volatile("" ::: "memory");
}

__device__ __forceinline__ void unpk8(const v4u w, float (&f)[8]) { f[0] = bflo(w.x); f[1] = bfhi(w.x); f[2] = bflo(w.y); f[3] = bfhi(w.y); f[4] = bflo(w.z); f[5] = bfhi(w.z); f[6] = bflo(w.w); f[7] = bfhi(w.w); }
__device__ __forceinline__ void post_rows4(const AP& a, int layer, int row0, int lane, unsigned char* ws) {
    v4u att[4], yc[4], zz[4];
#pragma unroll
    for (int r = 0; r < 4; ++r) { const size_t row = (size_t)(row0 + r);
        att[r] = *(const GAS v4u*)((const bf16*)(ws + WS_ATT) + row * 512 + lane * 8); yc[r] = *(const GAS v4u*)((const bf16*)(ws + WS_YC) + row * 512 + lane * 8);
        zz[r] = *(const GAS v4u*)((const bf16*)(ws + WS_PROJ) + row * NINP + C_MZ + lane * 8); }
    const float* wa = a.in(I_OUTNORM) + layer * 512 + lane * 8; const float* wsn = a.in(I_SSDNORM) + layer * 512 + lane * 8;
#pragma unroll
    for (int r = 0; r < 4; ++r) { bf16* MIX = (bf16*)(ws + WS_MIX) + (size_t)(row0 + r) * DM;
        { float f[8]; unpk8(att[r], f); float ss = 0.f;
#pragma unroll
          for (int j = 0; j < 8; ++j) ss += f[j] * f[j];
          const float rs = 1.0f / sqrtf(wave_sum(ss) * (1.f / 512.f) + 1e-6f);
#pragma unroll
          for (int j = 0; j < 8; ++j) f[j] = ZERO_A ? 0.f : f[j] * rs * wa[j];
          st8bf(MIX + lane * 8, f); }
        { float f[8], z[8]; unpk8(yc[r], f); unpk8(zz[r], z); float ss = 0.f;
#pragma unroll
          for (int j = 0; j < 8; ++j) { f[j] = f[j] * silu(z[j]); ss += f[j] * f[j]; }
          const float rs = 1.0f / sqrtf(wave_sum(ss) * (1.f / 512.f) + 1e-6f);
#pragma unroll
          for (int j = 0; j < 8; ++j) f[j] = ZERO_C ? 0.f : f[j] * rs * wsn[j];
          st8bf(MIX + 1024 + lane * 8, f); } }
}
__device__ __forceinline__ void post_row(const AP& a, int layer, int row, int lane, unsigned char* ws) {
    bf16* MIX = (bf16*)(ws + WS_MIX) + (size_t)row * DM;
    { float f[8]; ld8bf((const bf16*)(ws + WS_ATT) + (size_t)row * 512 + lane * 8, f); float ss = 0.f;
#pragma unroll
      for (int j = 0; j < 8; ++j) ss += f[j] * f[j];
      const float rs = 1.0f / sqrtf(wave_sum(ss) * (1.f / 512.f) + 1e-6f); const float* w = a.in(I_OUTNORM) + layer * 512 + lane * 8;
#pragma unroll
      for (int j = 0; j < 8; ++j) f[j] = ZERO_A ? 0.f : f[j] * rs * w[j];
      st8bf(MIX + lane * 8, f); }
    { float f[8], z[8]; ld8bf((const bf16*)(ws + WS_YC) + (size_t)row * 512 + lane * 8, f); ld8bf((const bf16*)(ws + WS_PROJ) + (size_t)row * NINP + C_MZ + lane * 8, z); float ss = 0.f;
#pragma unroll
      for (int j = 0; j < 8; ++j) { f[j] = f[j] * silu(z[j]); ss += f[j] * f[j]; }
      const float rs = 1.0f / sqrtf(wave_sum(ss) * (1.f / 512.f) + 1e-6f); const float* w = a.in(I_SSDNORM) + layer * 512 + lane * 8;
#pragma unroll
      for (int j = 0; j < 8; ++j) f[j] = ZERO_C ? 0.f : f[j] * rs * w[j];
      st8bf(MIX + 1024 + lane * 8, f); }
}
__device__ __forceinline__ void post_hy(const AP& a, int layer, int item, int lane, unsigned char* ws, LAS bf16* scr) {
    const int b = item >> 7, t0 = (item & 127) * 16, tp = lane & 7, cs = lane >> 3;
    const bf16* ZT = (const bf16*)(ws + WS_ZT) + (size_t)b * SEQ + t0 + 2 * tp; const float* w = a.in(I_HYNORM) + layer * 512;
    float s0 = 0.f, s1 = 0.f;
#pragma unroll 16
    for (int cc = 0; cc < 64; ++cc) { const unsigned v = *(const GAS unsigned*)(ZT + (size_t)(cc * 8 + cs) * M); const float v0 = bflo(v), v1 = bfhi(v); s0 += v0 * v0; s1 += v1 * v1; }
    s0 += swz_xor<8>(s0); s0 += swz_xor<16>(s0); s1 += swz_xor<8>(s1); s1 += swz_xor<16>(s1);
    { auto rr = __builtin_amdgcn_permlane32_swap(__float_as_uint(s0), __float_as_uint(s0), false, false); const unsigned r0 = rr[0], r1 = rr[1]; s0 = __uint_as_float(r0) + __uint_as_float(r1); }
    { auto rr = __builtin_amdgcn_permlane32_swap(__float_as_uint(s1), __float_as_uint(s1), false, false); const unsigned r0 = rr[0], r1 = rr[1]; s1 = __uint_as_float(r0) + __uint_as_float(r1); }
    const float rs0 = 1.0f / sqrtf(s0 * (1.f / 512.f) + 1e-6f), rs1 = 1.0f / sqrtf(s1 * (1.f / 512.f) + 1e-6f);
    for (int cg = 0; cg < 8; ++cg) {
#pragma unroll
        for (int jj = 0; jj < 8; ++jj) { const int cl = jj * 8 + cs, c = cg * 64 + cl; const unsigned v = *(const GAS unsigned*)(ZT + (size_t)c * M); const float wc = w[c];
            scr[(2 * tp) * 72 + cl] = (bf16)f2bf(ZERO_D ? 0.f : bflo(v) * rs0 * wc); scr[(2 * tp + 1) * 72 + cl] = (bf16)f2bf(ZERO_D ? 0.f : bfhi(v) * rs1 * wc); }
        LDS_WAIT(); asm volatile("" ::: "memory");
#pragma unroll
        for (int i = 0; i < 2; ++i) { const int t2 = (lane >> 3) + 8 * i, c8 = lane & 7; const v4u v = *(const LAS v4u*)(scr + t2 * 72 + c8 * 8);
            *(GAS v4u*)((bf16*)(ws + WS_MIX) + (size_t)(b * SEQ + t0 + t2) * DM + 1536 + cg * 64 + c8 * 8) = v; }
        LDS_WAIT(); asm volatile("" ::: "memory");
    }
}

namespace mixb {
#define SBAR() __builtin_amdgcn_sched_barrier(0)
__device__ __forceinline__ int crow(int r, int hi) { return (r & 3) + 8 * (r >> 2) + 4 * hi; }
__device__ __forceinline__ unsigned cvtpk(float lo, float hi) { unsigned r; asm volatile("v_cvt_pk_bf16_f32 %0, %1, %2" : "=v"(r) : "v"(lo), "v"(hi)); return r; }
__device__ __forceinline__ int v_st(int k, int c) { const int kk = (k & ~0xC) | ((k & 4) << 1) | ((k & 8) >> 1); return ((kk >> 3) * 4 + (c >> 5)) * 512 + ((kk & 7) * 32 + (c & 31)) * 2; }
__device__ __forceinline__ int v_rd_base(int lane) { return ((lane & 3) << 3) | (((lane >> 2) & 3) << 6) | (((lane >> 4) & 1) << 5) | (((lane >> 5) & 1) << 8); }
constexpr int v_rd_off(int d0, int ks, int half) { return d0 * 512 + ks * 4096 + half * 2048; }
template <int OFF> __device__ __forceinline__ s16x4 tr_read(int vb) { s16x4 r; asm volatile("ds_read_b64_tr_b16 %0, %1 offset:%2" : "=&v"(r) : "v"(vb), "i"(OFF) : "memory"); return r; }
template <int D0> __device__ __forceinline__ void pv_one(f32x16& od, int vb, bf16x8 pa0, bf16x8 pa1, bf16x8 pa2, bf16x8 pa3) {
    const s16x4 l0 = tr_read<v_rd_off(D0, 0, 0)>(vb), h0 = tr_read<v_rd_off(D0, 0, 1)>(vb), l1 = tr_read<v_rd_off(D0, 1, 0)>(vb), h1 = tr_read<v_rd_off(D0, 1, 1)>(vb);
    const s16x4 l2 = tr_read<v_rd_off(D0, 2, 0)>(vb), h2 = tr_read<v_rd_off(D0, 2, 1)>(vb), l3 = tr_read<v_rd_off(D0, 3, 0)>(vb), h3 = tr_read<v_rd_off(D0, 3, 1)>(vb);
    asm volatile("s_waitcnt lgkmcnt(0)" ::: "memory"); SBAR();
#define PKV(L, H) (bf16x8){L[0], L[1], L[2], L[3], H[0], H[1], H[2], H[3]}
    od = __builtin_amdgcn_mfma_f32_32x32x16_bf16(pa0, PKV(l0, h0), od, 0, 0, 0);
    od = __builtin_amdgcn_mfma_f32_32x32x16_bf16(pa1, PKV(l1, h1), od, 0, 0, 0);
    od = __builtin_amdgcn_mfma_f32_32x32x16_bf16(pa2, PKV(l2, h2), od, 0, 0, 0);
    od = __builtin_amdgcn_mfma_f32_32x32x16_bf16(pa3, PKV(l3, h3), od, 0, 0, 0);
#undef PKV
}
__device__ __forceinline__ void fast_sincos(float x, float& s, float& c) { float r = x * 0.15915494309189535f; r = r - floorf(r); s = __builtin_amdgcn_sinf(r); c = __builtin_amdgcn_cosf(r); }

struct MixP {
    const bf16* q; int ldq;
    const bf16* k0; int ldk0; const bf16* k1; int ldk1;
    const bf16* v; int ldv;
    bf16* o; int ldo;
    float lf, lb;
    const float* ssdp;
    const bf16* aux; int ldaux; float dh;
    const bf16* st;
};
constexpr int V_BYTES = 16384, V_OFF = 0, K_OFF = 2 * V_BYTES;
template <int DQK> struct KL { static constexpr int PITCH = DQK * 2, BYTES = 64 * PITCH, WK_OFF = K_OFF + 2 * BYTES, SCR_OFF = WK_OFF + 2176, END = SCR_OFF + NWAVES * 256; };

template <int MODE, int DQK, int DV>
__device__ __forceinline__ void mix_unit(const MixP& P, int q0, LAS unsigned char* lds, int tid) {
    typedef KL<DQK> L;
    constexpr int ND = DQK / 16, NV = DV / 32, CPR = DQK / 8, KCH = 64 * CPR / 512, VPR = DV / 8, VCH = (64 * VPR + 511) / 512;
    constexpr float SCALE = 0.07216878364870322f;
    constexpr float C = SCALE * 1.4426950408889634f, THR = 8.f;
    asm volatile("" : "+v"(tid));
    const int wid = tid >> 6, lane = tid & 63, r32 = lane & 31, hi = lane >> 5;
    const int qrow = q0 + wid * 32 + r32;
    LAS unsigned char* Vl = lds + V_OFF; LAS unsigned char* Kl = lds + K_OFF;
    LAS float* wsc = (LAS float*)(lds + L::SCR_OFF) + wid * 64; LAS float* li_l = wsc; LAS float* al_l = wsc + 32;
    LAS f32x4* wk_l = (LAS f32x4*)(lds + L::WK_OFF);
    LAS f32x2* wkref_l = (LAS f32x2*)(lds + L::WK_OFF + 2048);
    const int wq0 = q0 + __builtin_amdgcn_readfirstlane(wid) * 32;
    bf16x8 qr[ND];
    { const bf16* Qw = P.q + (long)qrow * P.ldq + hi * 8;
#pragma unroll
      for (int d0 = 0; d0 < ND; ++d0) qr[d0] = *(const GAS bf16x8*)(Qw + d0 * 16); }
    if constexpr (MODE == 0) {
#pragma unroll
        for (int dd = 0; dd < 2; ++dd)
#pragma unroll
            for (int j = 0; j < 8; ++j) { const int i = dd * 16 + hi * 8 + j; const float inv = exp2f(-(float)i * (13.287712379549449f / 32.0f)); float sn, cs; fast_sincos((float)qrow * inv, sn, cs);
                const float x1 = bf2f((unsigned short)qr[8 + dd][j]), x2 = bf2f((unsigned short)qr[10 + dd][j]);
                qr[8 + dd][j] = (short)f2bf(x1 * cs - x2 * sn); qr[10 + dd][j] = (short)f2bf(x2 * cs + x1 * sn); }
    }
    float cf_i = 0.f, rb_i = 0.f;
    if constexpr (MODE == 2) { const f32x4 w = *(const GAS f32x4*)(P.ssdp + (size_t)qrow * 32); cf_i = w.x; rb_i = w.z; }
    bf16x8 ks[KCH], vs[VCH]; f32x4 wkreg = {0.f, 0.f, 0.f, 0.f}; float crf = 0.f, rrf = 0.f;
#define MX_SLOAD(kr0) do { \
    _Pragma("unroll") for (int i = 0; i < KCH; ++i) { const int cid = tid + 512 * i, row = cid / CPR, c8 = cid % CPR; \
        const bf16* src = (MODE == 0 && c8 >= 16) ? P.k1 + (long)((kr0) + row) * P.ldk1 + (c8 - 16) * 8 : P.k0 + (long)((kr0) + row) * P.ldk0 + c8 * 8; \
        ks[i] = *(const GAS bf16x8*)src; } \
    _Pragma("unroll") for (int i = 0; i < VCH; ++i) { const int cid = tid + 512 * i, row = cid / VPR, c8 = cid % VPR; \
        if (VCH * 512 == 64 * VPR || cid < 64 * VPR) vs[i] = *(const GAS bf16x8*)(P.v + (long)((kr0) + row) * P.ldv + c8 * 8); } \
    if (MODE == 2) { if (tid < 64) { wkreg = *(const GAS f32x4*)(P.ssdp + (size_t)((kr0) + tid) * 32); crf = P.ssdp[(size_t)((kr0) + 63) * 32]; rrf = P.ssdp[(size_t)(kr0) * 32 + 2]; } } } while (0)
#define MX_SWRITE(b) do { \
    _Pragma("unroll") for (int i = 0; i < KCH; ++i) { const int cid = tid + 512 * i, row = cid / CPR, c8 = cid % CPR; \
        *(LAS bf16x8*)(Kl + (b) * L::BYTES + row * L::PITCH + ((c8 * 16) ^ ((row & 7) << 4))) = ks[i]; } \
    _Pragma("unroll") for (int i = 0; i < VCH; ++i) { const int cid = tid + 512 * i, row = cid / VPR, c8 = cid % VPR; \
        if (VCH * 512 == 64 * VPR || cid < 64 * VPR) *(LAS bf16x8*)(Vl + (b) * V_BYTES + v_st(row, c8 * 8)) = vs[i]; } \
    if (MODE == 2) { if (tid < 64) { wk_l[(b) * 64 + tid] = (f32x4){wkreg.y, wkreg.w, __builtin_amdgcn_exp2f(wkreg.y + crf), __builtin_amdgcn_exp2f(wkreg.w + rrf)}; if (tid == 0) wkref_l[(b)] = (f32x2){crf, rrf}; } } } while (0)
    float bfw0[16], bbw0[16]; float c32f = 1.f, c32b = 1.f;
    if constexpr (MODE == 1) {
#pragma unroll
        for (int r = 0; r < 16; ++r) { const int j0 = crow(r, hi);
            bfw0[r] = __builtin_amdgcn_exp2f((float)(63 - j0) * P.lf); bbw0[r] = __builtin_amdgcn_exp2f((float)j0 * P.lb); }
        c32f = __builtin_amdgcn_exp2f(-32.f * P.lf); c32b = __builtin_amdgcn_exp2f(32.f * P.lb);
    }
    float m_reg = -1e30f, l_reg = 0.f; f32x16 o[NV];
#pragma unroll
    for (int d = 0; d < NV; ++d) o[d] = f32x16{};
    const int vb0 = (int)(uintptr_t)(Vl) + v_rd_base(lane);
    constexpr int NT = SEQ / 64;
    int jlo = 0, jhi = NT - 1;
#if FARFIELD
    if constexpr (MODE != 0) {
        const int Bq = q0 >> 8; jlo = 4 * Bq; jhi = jlo + 3;
        float fv[7];
#pragma unroll
        for (int idx = 0; idx < 7; ++idx) { const int Bp = idx < Bq ? idx : idx + 1;
            if constexpr (MODE == 1) fv[idx] = (Bp < Bq) ? __builtin_amdgcn_exp2f((float)(qrow - 256 * (Bp + 1)) * P.lf) : __builtin_amdgcn_exp2f((float)(256 * Bp - qrow) * P.lb);
            else fv[idx] = (Bp < Bq) ? __builtin_amdgcn_exp2f(cf_i - P.ssdp[(size_t)(256 * Bp + 255) * 32 + 0]) : __builtin_amdgcn_exp2f(rb_i - P.ssdp[(size_t)(256 * Bp) * 32 + 2]); }
        constexpr int CPRS = DQK / 8;
        v4u stv[14];
#pragma unroll
        for (int i = 0; i < 14; ++i) { const int cid = tid + 512 * i, s = cid >> 10, w = cid & 1023; const int Bp = s < Bq ? s : s + 1;
            stv[i] = *(const GAS v4u*)(P.st + ((size_t)Bp * 2 + (Bp < Bq ? 0 : 1)) * (DV * DQK) + (size_t)w * 8); }
        MX_SLOAD(jlo * 64);
#pragma unroll
        for (int i = 0; i < 14; ++i) { const int cid = tid + 512 * i, s = cid >> 10, w = cid & 1023, row = w / CPRS, ch = w % CPRS;
            *(LAS v4u*)(lds + s * 16384 + row * (DQK * 2) + ((ch ^ (row & 7)) * 16)) = stv[i]; }
        __syncthreads();
#pragma unroll
        for (int s = 0; s < 7; ++s) { const float f = fv[s]; bf16x8 qs[ND];
#pragma unroll
            for (int d0 = 0; d0 < ND; ++d0) { v4u w;
                w.x = cvtpk(bf2f((unsigned short)qr[d0][0]) * f, bf2f((unsigned short)qr[d0][1]) * f); w.y = cvtpk(bf2f((unsigned short)qr[d0][2]) * f, bf2f((unsigned short)qr[d0][3]) * f);
                w.z = cvtpk(bf2f((unsigned short)qr[d0][4]) * f, bf2f((unsigned short)qr[d0][5]) * f); w.w = cvtpk(bf2f((unsigned short)qr[d0][6]) * f, bf2f((unsigned short)qr[d0][7]) * f);
                qs[d0] = __builtin_bit_cast(bf16x8, w); }
#pragma unroll
            for (int d0v = 0; d0v < NV; ++d0v)
#pragma unroll
                for (int ks = 0; ks < ND; ++ks) { const bf16x8 sf = *(const LAS bf16x8*)(lds + s * 16384 + (32 * d0v + r32) * (DQK * 2) + (((2 * ks + hi) ^ (r32 & 7)) * 16));
                    o[d0v] = __builtin_amdgcn_mfma_f32_32x32x16_bf16(qs[ks], sf, o[d0v], 0, 0, 0); }
            SBAR(); }
        __syncthreads();
#define FF_LOAD(a, b)
#undef FF_LOAD
    }
#else
    if constexpr (MODE == 2) {
        const int l = lane & 31, qt = q0 >> 6;
        const float cfq = P.ssdp[(size_t)q0 * 32 + 0], rbq = P.ssdp[(size_t)(q0 + 255) * 32 + 2];
        const float cfe = P.ssdp[(size_t)(64 * l + 63) * 32 + 0], rbs = P.ssdp[(size_t)(64 * l) * 32 + 2];
        const bool keep = (l < qt) ? (cfq - cfe > -24.f) : ((l > qt + 3) ? (rbq - rbs > -24.f) : true);
        const unsigned m32 = (unsigned)__ballot(keep);
        jlo = __builtin_amdgcn_readfirstlane(__builtin_ctz(m32)); jhi = __builtin_amdgcn_readfirstlane(31 - __builtin_clz(m32));
    } else if constexpr (MODE == 1) {
        const float dmf = 24.f / (-P.lf), dmb = 24.f / (-P.lb);
        int a = (int)floorf(((float)(q0 - 63) - dmf) * (1.f / 64.f)) + 1; int b = (int)ceilf(((float)(q0 + 255) + dmb) * (1.f / 64.f)) - 1;
        jlo = a < 0 ? 0 : a; jhi = b > NT - 1 ? NT - 1 : b;
        jlo = __builtin_amdgcn_readfirstlane(jlo); jhi = __builtin_amdgcn_readfirstlane(jhi);
    }
#endif
    if (!(FARFIELD && MODE != 0)) MX_SLOAD(jlo * 64);
    VM_WAIT(); MX_SWRITE(0); __syncthreads();
    for (int j = jlo; j <= jhi; ++j) {
        const int buf = (j - jlo) & 1; const int kr0 = j * 64;
        if (j < jhi) MX_SLOAD(kr0 + 64);
        f32x16 p0 = f32x16{}, p1 = f32x16{};
        { LAS unsigned char* Kb = Kl + buf * L::BYTES;
#pragma unroll
          for (int dg = 0; dg < ND / 4; ++dg) { bf16x8 kb0[4], kb1[4];
#pragma unroll
              for (int dd = 0; dd < 4; ++dd) { const int cb = ((dg * 4 + dd) * 16 + hi * 8) * 2;
                  kb0[dd] = *(const LAS bf16x8*)(Kb + r32 * L::PITCH + (cb ^ ((r32 & 7) << 4)));
                  kb1[dd] = *(const LAS bf16x8*)(Kb + (32 + r32) * L::PITCH + (cb ^ ((r32 & 7) << 4))); }
              LDS_WAIT(); SBAR();
#pragma unroll
              for (int dd = 0; dd < 4; ++dd) { p0 = __builtin_amdgcn_mfma_f32_32x32x16_bf16(kb0[dd], qr[dg * 4 + dd], p0, 0, 0, 0);
                  p1 = __builtin_amdgcn_mfma_f32_32x32x16_bf16(kb1[dd], qr[dg * 4 + dd], p1, 0, 0, 0); }
              SBAR(); } }
        if constexpr (MODE == 0) {
            float pmax = p0[0];
#pragma unroll
            for (int r = 1; r < 16; ++r) pmax = fmaxf(pmax, p0[r]);
#pragma unroll
            for (int r = 0; r < 16; ++r) pmax = fmaxf(pmax, p1[r]);
            { auto rr = __builtin_amdgcn_permlane32_swap(__float_as_uint(pmax), __float_as_uint(pmax), false, false); pmax = fmaxf(__uint_as_float(rr[0]), __uint_as_float(rr[1])); }
            float mn, alpha;
            if (__all(pmax - m_reg <= THR / SCALE)) { mn = m_reg; alpha = 1.f; }
            else { mn = fmaxf(m_reg, pmax); alpha = __builtin_amdgcn_exp2f((m_reg - mn) * C); m_reg = mn; }
            const float mnC = -mn * C;
#pragma unroll
            for (int r = 0; r < 16; ++r) { p0[r] = __builtin_amdgcn_exp2f(fmaf(p0[r], C, mnC)); p1[r] = __builtin_amdgcn_exp2f(fmaf(p1[r], C, mnC)); }
            if (__any(alpha < 1.f)) { if (hi == 0) al_l[r32] = alpha; LDS_WAIT();
#pragma unroll
                for (int r = 0; r < 16; ++r) { const float av = al_l[crow(r, hi)];
#pragma unroll
                    for (int d = 0; d < NV; ++d) o[d][r] *= av; } }
            float ps = 0.f;
#pragma unroll
            for (int r = 0; r < 16; ++r) ps += p0[r] + p1[r];
            { auto rr = __builtin_amdgcn_permlane32_swap(__float_as_uint(ps), __float_as_uint(ps), false, false); ps = __uint_as_float(rr[0]) + __uint_as_float(rr[1]); }
            l_reg = l_reg * alpha + ps;
        } else if constexpr (MODE == 1) {
            if (kr0 + 63 <= wq0) {
                const float ai = __builtin_amdgcn_exp2f((float)(qrow - kr0 - 63) * P.lf);
                const float ai1 = ai * c32f;
#pragma unroll
                for (int r = 0; r < 16; ++r) { p0[r] *= ai * bfw0[r]; p1[r] *= ai1 * bfw0[r]; }
            } else if (kr0 > wq0 + 31) {
                const float ai = __builtin_amdgcn_exp2f((float)(kr0 - qrow) * P.lb);
                const float ai1 = ai * c32b;
#pragma unroll
                for (int r = 0; r < 16; ++r) { p0[r] *= ai * bbw0[r]; p1[r] *= ai1 * bbw0[r]; }
            } else {
#pragma unroll
                for (int r = 0; r < 16; ++r) { const int k0 = kr0 + crow(r, hi), k1 = k0 + 32;
                    const float e0 = (k0 <= qrow) ? (float)(qrow - k0) * P.lf : (float)(k0 - qrow) * P.lb;
                    const float e1 = (k1 <= qrow) ? (float)(qrow - k1) * P.lf : (float)(k1 - qrow) * P.lb;
                    p0[r] *= __builtin_amdgcn_exp2f(e0); p1[r] *= __builtin_amdgcn_exp2f(e1); }
            }
        } else {
            if (kr0 + 63 <= wq0) {
                const float ai = __builtin_amdgcn_exp2f(cf_i - wkref_l[buf].x);
#pragma unroll
                for (int r = 0; r < 16; ++r) { const int kk = crow(r, hi); p0[r] *= ai * wk_l[buf * 64 + kk].z; p1[r] *= ai * wk_l[buf * 64 + 32 + kk].z; }
            } else if (kr0 > wq0 + 31) {
                const float ai = __builtin_amdgcn_exp2f(rb_i - wkref_l[buf].y);
#pragma unroll
                for (int r = 0; r < 16; ++r) { const int kk = crow(r, hi); p0[r] *= ai * wk_l[buf * 64 + kk].w; p1[r] *= ai * wk_l[buf * 64 + 32 + kk].w; }
            } else {
#pragma unroll
                for (int r = 0; r < 16; ++r) { const int kk = crow(r, hi); const f32x4 w0 = wk_l[buf * 64 + kk], w1 = wk_l[buf * 64 + 32 + kk];
                    const int k0 = kr0 + kk, k1 = k0 + 32;
                    const float e0 = (k0 <= qrow) ? cf_i + w0.x : rb_i + w0.y;
                    const float e1 = (k1 <= qrow) ? cf_i + w1.x : rb_i + w1.y;
                    p0[r] *= __builtin_amdgcn_exp2f(e0); p1[r] *= __builtin_amdgcn_exp2f(e1); }
            }
        }
        bf16x8 pa0, pa1, pa2, pa3;
#define MX_PK4(PP, BASE, OUT) do { const unsigned a0 = cvtpk(PP[BASE + 0], PP[BASE + 1]), a1 = cvtpk(PP[BASE + 2], PP[BASE + 3]); \
    const unsigned b0 = cvtpk(PP[BASE + 4], PP[BASE + 5]), b1 = cvtpk(PP[BASE + 6], PP[BASE + 7]); \
    auto r0 = __builtin_amdgcn_permlane32_swap(a0, b0, false, false); auto r1 = __builtin_amdgcn_permlane32_swap(a1, b1, false, false); \
    v4u w = {r0[0], r1[0], r0[1], r1[1]}; OUT = __builtin_bit_cast(bf16x8, w); } while (0)
        MX_PK4(p0, 0, pa0); MX_PK4(p0, 8, pa1); MX_PK4(p1, 0, pa2); MX_PK4(p1, 8, pa3);
#undef MX_PK4
        { const int vb = vb0 + buf * V_BYTES;
          pv_one<0>(o[0], vb, pa0, pa1, pa2, pa3); pv_one<1>(o[1], vb, pa0, pa1, pa2, pa3);
          if constexpr (NV == 4) { pv_one<2>(o[2], vb, pa0, pa1, pa2, pa3); pv_one<3>(o[3], vb, pa0, pa1, pa2, pa3); } }
        if (j < jhi) { VM_WAIT(); MX_SWRITE(buf ^ 1); }
        __syncthreads();
    }
#undef MX_SLOAD
#undef MX_SWRITE
    const int orow0 = q0 + wid * 32;
    if constexpr (MODE == 0) {
        if (hi == 0) li_l[r32] = l_reg; LDS_WAIT();
#pragma unroll
        for (int r = 0; r < 16; ++r) { const int rr = crow(r, hi); const float rl = __builtin_amdgcn_rcpf(li_l[rr]);
#pragma unroll
            for (int d0 = 0; d0 < NV; ++d0) P.o[(long)(orow0 + rr) * P.ldo + d0 * 32 + r32] = (bf16)f2bf(o[d0][r] * rl); }
    } else if constexpr (MODE == 1) {
#pragma unroll
        for (int r = 0; r < 16; ++r) { const int rr = crow(r, hi);
            float s = 0.f;
#pragma unroll
            for (int d0 = 0; d0 < NV; ++d0) s += o[d0][r];
            s = half_sum(s);
            const float mean = s * (1.f / 128.f); float qv = 0.f;
#pragma unroll
            for (int d0 = 0; d0 < NV; ++d0) { const float dlt = o[d0][r] - mean; qv += dlt * dlt; }
            qv = half_sum(qv);
            const float rs = 1.0f / sqrtf(qv * (1.f / 128.f) + 1e-6f);
#pragma unroll
            for (int d0 = 0; d0 < NV; ++d0) { const float gt = bf2f(P.aux[(long)(orow0 + rr) * P.ldaux + d0 * 32 + r32]);
                P.o[(long)(orow0 + rr) * P.ldo + d0 * 32 + r32] = (bf16)f2bf(ZERO_B ? 0.f : (o[d0][r] - mean) * rs * silu(gt)); } }
    } else {
#pragma unroll
        for (int r = 0; r < 16; ++r) { const int rr = crow(r, hi);
#pragma unroll
            for (int d0 = 0; d0 < NV; ++d0) { const float xv = bf2f(P.aux[(long)(orow0 + rr) * P.ldaux + d0 * 32 + r32]);
                P.o[(long)(orow0 + rr) * P.ldo + d0 * 32 + r32] = (bf16)f2bf(o[d0][r] + xv * P.dh); } }
    }
    __syncthreads();
}
template <int MODE, int DK, int DV>
__device__ __forceinline__ void state_unit(const MixP& P, int Bk, bf16* ST, LAS unsigned char* lds, int tid) {
    asm volatile("" : "+v"(tid));
    const int wid = __builtin_amdgcn_readfirstlane(tid >> 6), lane = tid & 63, r32 = lane & 31, hi = lane >> 5;
    constexpr int KPR = DK / 8, VPR = DV / 8, KCH = 64 * KPR / 512, VCH = 64 * VPR / 512;
    LAS unsigned char* Vt = lds; LAS unsigned char* Kf = lds + 16384; LAS unsigned char* Kb = lds + 32768;
    const int dvb = wid / (DK / 32), dkb = wid % (DK / 32); const int r0 = Bk * 256;
    float cfe = 0.f, rbs = 0.f;
    if constexpr (MODE == 2) { cfe = P.ssdp[(size_t)(r0 + 255) * 32 + 0]; rbs = P.ssdp[(size_t)r0 * 32 + 2]; }
    f32x16 accf = f32x16{}, accb = f32x16{};
    const int vbV = (int)(uintptr_t)Vt + v_rd_base(lane) + dvb * 512, vbF = (int)(uintptr_t)Kf + v_rd_base(lane) + dkb * 512, vbB = (int)(uintptr_t)Kb + v_rd_base(lane) + dkb * 512;
    bf16x8 kc[4][KCH], vc[4][VCH]; float sf[4][KCH], sb[4][KCH];
#pragma unroll
    for (int tl = 0; tl < 4; ++tl) { const int kr0 = r0 + tl * 64;
#pragma unroll
        for (int i = 0; i < KCH; ++i) { const int cid = tid + 512 * i, row = cid / KPR, c8 = cid % KPR; kc[tl][i] = *(const GAS bf16x8*)(P.k0 + (long)(kr0 + row) * P.ldk0 + c8 * 8);
            if constexpr (MODE == 1) { const int jj = tl * 64 + row; sf[tl][i] = __builtin_amdgcn_exp2f((float)(256 - jj) * P.lf); sb[tl][i] = __builtin_amdgcn_exp2f((float)jj * P.lb); }
            else { const f32x4 w = *(const GAS f32x4*)(P.ssdp + (size_t)(kr0 + row) * 32); sf[tl][i] = __builtin_amdgcn_exp2f(cfe + w.y); sb[tl][i] = __builtin_amdgcn_exp2f(rbs + w.w); } }
#pragma unroll
        for (int i = 0; i < VCH; ++i) { const int cid = tid + 512 * i, row = cid / VPR, c8 = cid % VPR; vc[tl][i] = *(const GAS bf16x8*)(P.v + (long)(kr0 + row) * P.ldv + c8 * 8); } }
#pragma unroll
    for (int tl = 0; tl < 4; ++tl) {
#pragma unroll
        for (int i = 0; i < KCH; ++i) { const int cid = tid + 512 * i, row = cid / KPR, c8 = cid % KPR; v4u wf, wb; const bf16x8 kk = kc[tl][i]; const float s1 = sf[tl][i], s2 = sb[tl][i];
            wf.x = cvtpk(bf2f((unsigned short)kk[0]) * s1, bf2f((unsigned short)kk[1]) * s1); wf.y = cvtpk(bf2f((unsigned short)kk[2]) * s1, bf2f((unsigned short)kk[3]) * s1);
            wf.z = cvtpk(bf2f((unsigned short)kk[4]) * s1, bf2f((unsigned short)kk[5]) * s1); wf.w = cvtpk(bf2f((unsigned short)kk[6]) * s1, bf2f((unsigned short)kk[7]) * s1);
            wb.x = cvtpk(bf2f((unsigned short)kk[0]) * s2, bf2f((unsigned short)kk[1]) * s2); wb.y = cvtpk(bf2f((unsigned short)kk[2]) * s2, bf2f((unsigned short)kk[3]) * s2);
            wb.z = cvtpk(bf2f((unsigned short)kk[4]) * s2, bf2f((unsigned short)kk[5]) * s2); wb.w = cvtpk(bf2f((unsigned short)kk[6]) * s2, bf2f((unsigned short)kk[7]) * s2);
            *(LAS v4u*)(Kf + v_st(row, c8 * 8)) = wf; *(LAS v4u*)(Kb + v_st(row, c8 * 8)) = wb; }
#pragma unroll
        for (int i = 0; i < VCH; ++i) { const int cid = tid + 512 * i, row = cid / VPR, c8 = cid % VPR; *(LAS bf16x8*)(Vt + v_st(row, c8 * 8)) = vc[tl][i]; }
        __syncthreads();
#define ST_FR(vb, ks) ({ const s16x4 l_ = tr_read<v_rd_off(0, ks, 0)>(vb), h_ = tr_read<v_rd_off(0, ks, 1)>(vb); (bf16x8){l_[0], l_[1], l_[2], l_[3], h_[0], h_[1], h_[2], h_[3]}; })
        { const bf16x8 a0 = ST_FR(vbV, 0), a1 = ST_FR(vbV, 1), a2 = ST_FR(vbV, 2), a3 = ST_FR(vbV, 3);
          const bf16x8 f0 = ST_FR(vbF, 0), f1 = ST_FR(vbF, 1), f2 = ST_FR(vbF, 2), f3 = ST_FR(vbF, 3);
          const bf16x8 b0 = ST_FR(vbB, 0), b1 = ST_FR(vbB, 1), b2 = ST_FR(vbB, 2), b3 = ST_FR(vbB, 3);
          asm volatile("s_waitcnt lgkmcnt(0)" ::: "memory"); SBAR();
          accf = __builtin_amdgcn_mfma_f32_32x32x16_bf16(a0, f0, accf, 0, 0, 0); accf = __builtin_amdgcn_mfma_f32_32x32x16_bf16(a1, f1, accf, 0, 0, 0);
          accf = __builtin_amdgcn_mfma_f32_32x32x16_bf16(a2, f2, accf, 0, 0, 0); accf = __builtin_amdgcn_mfma_f32_32x32x16_bf16(a3, f3, accf, 0, 0, 0);
          accb = __builtin_amdgcn_mfma_f32_32x32x16_bf16(a0, b0, accb, 0, 0, 0); accb = __builtin_amdgcn_mfma_f32_32x32x16_bf16(a1, b1, accb, 0, 0, 0);
          accb = __builtin_amdgcn_mfma_f32_32x32x16_bf16(a2, b2, accb, 0, 0, 0); accb = __builtin_amdgcn_mfma_f32_32x32x16_bf16(a3, b3, accb, 0, 0, 0); }
#undef ST_FR
        __syncthreads();
    }
#pragma unroll
    for (int r = 0; r < 16; ++r) { const size_t e = (size_t)(32 * dvb + crow(r, hi)) * DK + 32 * dkb + r32;
        ST[e] = (bf16)f2bf(accf[r]); ST[(size_t)DV * DK + e] = (bf16)f2bf(accb[r]); }
}
#undef SBAR
}

namespace hyb {
constexpr int U_PITCH = 4112, U_BYTES = 16 * U_PITCH, FC_OFF = U_BYTES, FC_PITCH = 8256;
typedef float f32x4v __attribute__((ext_vector_type(4)));
__device__ __forceinline__ void hyena_unit(const AP& a, int layer, int c, unsigned char* ws, LAS unsigned char* lds, int tid) {
    asm volatile("" : "+v"(tid));
    const int wid = tid >> 6, lane = tid & 63, fr = lane & 15, fq = lane >> 4;
    const bf16* UT = (const bf16*)(ws + WS_UT); bf16* ZT = (bf16*)(ws + WS_ZT);
    LAS unsigned char* Ul = lds; LAS unsigned char* FC = lds + FC_OFF;
    const int ksh = (3 - fr) & 3;
    for (int o = 0; o < 2; ++o) {
        const bf16* G = (const bf16*)(ws + WS_HYG) + (((size_t)layer * 2 + o) * 512 + c) * HY_GLEN;
        for (int id = tid; id < HY_GLEN / 8; id += 512) *(LAS v4u*)(FC + id * 16) = *(const GAS v4u*)(G + id * 8);
        if (o == 0) {
#pragma unroll
            for (int i = 0; i < 8; ++i) { const int id = tid + 512 * i, b = id >> 8, t8 = id & 255;
                *(LAS v4u*)(Ul + b * U_PITCH + t8 * 16) = *(const GAS v4u*)(UT + ((size_t)c * NB + b) * SEQ + t8 * 8); } }
        __syncthreads();
        for (int idx = tid; idx < 4104; idx += 512) { const LAS bf16* g0 = (const LAS bf16*)FC + idx;
#pragma unroll
            for (int k = 1; k < 4; ++k) *(LAS bf16*)(FC + k * FC_PITCH + idx * 2) = g0[k]; }
        const bf16* X = UT + (((size_t)(1 + o) * 512 + c) * NB + fr) * SEQ;
        v2u xg[16];
#pragma unroll
        for (int al = 0; al < 16; ++al) xg[al] = *(const GAS v2u*)(X + 16 * (16 * wid + al) + 4 * fq);
        __syncthreads();
        f32x4v acc[16];
#pragma unroll
        for (int i = 0; i < 16; ++i) acc[i] = (f32x4v){0.f, 0.f, 0.f, 0.f};
        for (int kb = 0; kb < 8; ++kb) {
            bf16x8 bfr[8];
#pragma unroll
            for (int kl = 0; kl < 8; ++kl) bfr[kl] = *(const LAS bf16x8*)(Ul + fr * U_PITCH + ((kb * 8 + kl) * 32 + fq * 8) * 2);
            const int n0 = HY_OFF - 16 * (16 * wid - 16 * kb + 15) - fr + 8 * fq;
            const LAS unsigned char* ab = FC + ksh * FC_PITCH + (n0 - ksh) * 2;
#pragma unroll
            for (int hb = 0; hb < 2; ++hb) {
                v2u alo[15], ahi[15];
#pragma unroll
                for (int d = 0; d < 15; ++d) { alo[d] = *(const LAS v2u*)(ab + (29 - (hb * 15 + d)) * 32); ahi[d] = *(const LAS v2u*)(ab + (29 - (hb * 15 + d)) * 32 + 8); }
                LDS_WAIT(); __builtin_amdgcn_sched_barrier(0);
#pragma unroll
                for (int d = 0; d < 15; ++d) { const int ddrel = hb * 15 + d - 14;
                    const v4u w = {alo[d].x, alo[d].y, ahi[d].x, ahi[d].y}; const bf16x8 af = __builtin_bit_cast(bf16x8, w);
#pragma unroll
                    for (int kl = 0; kl < 8; ++kl) { const int al = ddrel + 2 * kl; if (al >= 0 && al < 16) acc[al] = __builtin_amdgcn_mfma_f32_16x16x32_bf16(af, bfr[kl], acc[al], 0, 0, 0); }
                }
                __builtin_amdgcn_sched_barrier(0);
            }
        }
        __syncthreads();
        const float bias = a.in(I_HYBIAS)[(layer * 2 + o) * 512 + c];
#pragma unroll
        for (int al = 0; al < 16; ++al) { const int t = 16 * (16 * wid + al) + 4 * fq;
            const v2u uu = *(const LAS v2u*)(Ul + fr * U_PITCH + t * 2); const v2u xx = xg[al];
            const float r0 = bflo(xx.x) * (acc[al][0] + bflo(uu.x) * bias), r1 = bfhi(xx.x) * (acc[al][1] + bfhi(uu.x) * bias);
            const float r2 = bflo(xx.y) * (acc[al][2] + bflo(uu.y) * bias), r3 = bfhi(xx.y) * (acc[al][3] + bfhi(uu.y) * bias);
            v2u z; z.x = pk2(r0, r1); z.y = pk2(r2, r3);
            if (o == 0) *(LAS v2u*)(Ul + fr * U_PITCH + t * 2) = z;
            else *(GAS v2u*)(ZT + ((size_t)c * NB + fr) * SEQ + t) = z; }
        __syncthreads();
    }
}
}

constexpr int N_PHASES = 26;
#ifndef MK_CUTS
#define MK_CUTS 0
#endif
#ifndef MIXSKIP
#define MIXSKIP 0
#endif
#ifndef MOE_CHECK
#define MOE_CHECK 0
#endif
#ifndef ONLYKIND
#define ONLYKIND -1
#endif
#define KSEL(kind) (ONLYKIND < 0 || ONLYKIND == (kind))
#define IN(k) (LO <= (k) && (k) < HI)
#define INK(k, kind) (KSEL(kind) && LO <= (k) && (k) < HI)
struct Ids { int wave0, G0, bx0, vcu0; };
#define PH_LOCALS int wave = ids.wave0, G = ids.G0, bx = ids.bx0, vcu = ids.vcu0; asm volatile("" : "+s"(wave), "+s"(G), "+s"(bx), "+s"(vcu)); \
    int tid; asm volatile("v_mbcnt_lo_u32_b32 %0, -1, 0\n\tv_mbcnt_hi_u32_b32 %0, -1, %0" : "=v"(tid)); tid += wave * 64; \
    const int lane = tid & 63, gw = wave * G + vcu, NGW = G * NWAVES; LAS float* wscr = (LAS float*)(lds + RING_OFF + wave * 16384); (void)lane; (void)gw; (void)NGW; (void)wscr; (void)bx; \
    const AP args = kargs(); unsigned char* ws = args.ws(); float* XRES = args.out(); bf16* XB = (bf16*)(ws + WS_XB); gu32* ctl = (gu32*)(ws + WS_CTL); (void)XRES; (void)XB; (void)ctl;
#ifndef PROBE_SCALE
#define PROBE_SCALE 0.0025f
#endif
#ifndef TIMING_PROBE
#define TIMING_PROBE 0
#endif
#ifndef PROBE_A0
#define PROBE_A0 0
#define PROBE_A1 1
#define PROBE_B0 1
#define PROBE_B1 2
#endif
#if TIMING_PROBE
#ifndef PROBE_BLK
#define PROBE_BLK 0
#endif
#ifndef PROBE_BIAS
#define PROBE_BIAS 0
#endif
#define STAMP(idx) do { if (ids.bx0 == PROBE_BLK && threadIdx.x == 0) ((volatile LAS unsigned*)(lds + MISC_OFF))[16 + (idx)] = (unsigned)wall_clock64(); } while (0)
#else
#define STAMP(idx) do { } while (0)
#endif
#define SEAM(k) do { STAMP(64 + (k)); if constexpr (IN(k) && IN((k) + 1)) { XcdBarrier bb_ = bar; asm volatile("" : "+s"(bb_.bar), "+s"(bb_.x)); xcd_barrier(bb_); } STAMP((k) + 1); } while (0)

constexpr int MOE_ITEMS = 24 * 7168, MOE_FILL = 14336;
__device__ __forceinline__ void moe_conv_items(const AP& args, unsigned char* ws, LAS float* wscr, int lane, int it0, int it1, int wi, int nw) {
    auto mkjob = [&](int it, TrF8& j, int& r) { const int job = it / 7168, e = job / 3, kind = job - e * 3; r = it - job * 7168;
        if (kind < 2) j = TrF8{args.in(kind == 0 ? I_MOEG : I_MOEU) + (size_t)e * DM * DFFE, DM, DFFE, DFFE / 32, ws + WS_MGU + (size_t)e * 2 * DFFE * DM, 128, 256, kind * 128, 64.0f};
        else j = TrF8{args.in(I_MOED) + (size_t)e * DFFE * DM, DFFE, DM, DM / 32, ws + WS_MDN + (size_t)e * DM * DFFE, 1 << 30, 0, 0, 256.0f}; };
    for (int it = it0 + wi; it < it1; it += 2 * nw) { TrF8 ja, jb; int ra, rb; float ta[32], tb[32]; const bool hb = it + nw < it1;
        mkjob(it, ja, ra); tr_f8_load(ja, ra, lane, ta);
        if (hb) { mkjob(it + nw, jb, rb); tr_f8_load(jb, rb, lane, tb); }
        tr_f8_finish(ja, ra, lane, ta, wscr);
        if (hb) tr_f8_finish(jb, rb, lane, tb, wscr); }
}

template <int LAYER, int LO, int HI>
__device__ __forceinline__ void layer_phases(LAS unsigned char* lds, const XcdBarrier& bar, const Ids& ids) {
    constexpr int layer = LAYER, pb = 1 + LAYER * 10;
    if constexpr (INK(pb + 0, 1)) { PH_LOCALS
        pg8::Gemm g{XB, (const bf16*)(ws + WS_WIN + layer * SZ_WIN), M, NINP, DM}; pg8::StaticOrder S; S.init(M, NINP, G, bx);
        pg8::EpiBf16 E{(bf16*)(ws + WS_PROJ), NINP, (float*)(ws + WS_DTF), C_DT};
        pg8::gemm_phase<pg8::EpiBf16, pg8::StaticOrder, true, true>(lds + RING_OFF, g, S, E, tid);
        { const int nwg = (M / 256) * (NINP / 256), rounds = (nwg + G - 1) / G, first_idle = nwg - (rounds - 1) * G, nidle = G - first_idle;
          if (nidle <= 0 || bx >= first_idle) { __syncthreads();
              moe_conv_items(args, ws, wscr, lane, layer * MOE_FILL, (layer + 1) * MOE_FILL, nidle > 0 ? (bx - first_idle) * NWAVES + wave : bx * NWAVES + wave, (nidle > 0 ? nidle : G) * NWAVES);
              __syncthreads(); } }
    }
    SEAM(pb + 0);
    if constexpr (INK(pb + 1, 2)) { PH_LOCALS
        LAS float* cwl = (LAS float*)(lds + RING_OFF);
        for (int i = tid; i < 6 * 1024; i += NWAVES * 64) cwl[i] = i < 5 * 1024 ? args.in(I_CONVW)[layer * 5 * 1024 + i] : args.in(I_CONVB)[layer * 1024 + i - 5 * 1024];
        LAS unsigned* hyq = (LAS unsigned*)(lds + RING_OFF + 24576 + 64);
        if (tid == 0) *hyq = 0u;
        __syncthreads();
        LAS float* pscr = (LAS float*)(lds + RING_OFF + 32768 + wave * 12288);
        for (int it = vcu; it < 256; it += G) prep_scan_wg(args, layer, it, wave, lane, ws, pscr, (LAS float*)(lds + RING_OFF + 24576 + 128));
        if constexpr (LAYER == 0) STAMP(90);
        for (int it = gw; it < M / 8; it += NGW) prep_rows8(args, layer, it, lane, ws, cwl);
        if constexpr (LAYER == 0) STAMP(91);
        for (;;) { unsigned k = 0; if (lane == 0) k = __hip_atomic_fetch_add(hyq, 1u, __ATOMIC_RELAXED, __HIP_MEMORY_SCOPE_WORKGROUP);
            const int it = __builtin_amdgcn_readfirstlane((int)k) * G + vcu; if (it >= NB * 32 * 24) break;
            prep_hyconv(args, layer, it, lane, ws, (LAS bf16*)pscr); }
        __syncthreads();
    }
    SEAM(pb + 1);
    if constexpr (INK(pb + 2, 3)) {
        { PH_LOCALS pg8::Gemm g{(const bf16*)(ws + WS_QN), (const bf16*)(ws + WS_WUQ + layer * SZ_WUQ), M, 768, 384}; pg8::StaticOrder S; S.init(M, 768, G, bx);
          pg8::EpiBf16 E{(bf16*)(ws + WS_QB), 768, nullptr, 0};
          pg8::gemm_phase<pg8::EpiBf16, pg8::StaticOrder, true, true>(lds + RING_OFF, g, S, E, tid); }
        { PH_LOCALS pg8::Gemm g{(const bf16*)(ws + WS_KVN), (const bf16*)(ws + WS_WUKV + layer * SZ_WUKV), M, 1024, 256}; pg8::StaticOrder S; S.init(M, 1024, G, bx);
          pg8::EpiBf16 E{(bf16*)(ws + WS_KVB), 1024, nullptr, 0};
          pg8::gemm_phase<pg8::EpiBf16, pg8::StaticOrder, true, true>(lds + RING_OFF, g, S, E, tid); }
#if FARFIELD
        { PH_LOCALS for (int u = vcu; u < NB * 4 * 8; u += G) { const int b = u >> 5, h = (u >> 3) & 3, Bk = u & 7; const size_t r0 = (size_t)b * SEQ;
            mixb::MixP P{}; P.k0 = (const bf16*)(ws + WS_RK) + r0 * 256 + h * 64; P.ldk0 = 256; P.v = (const bf16*)(ws + WS_PROJ) + r0 * NINP + C_RV + h * 128; P.ldv = NINP;
            P.lf = log2f(1.0f - exp2f(-5.0f - (float)h)); P.lb = log2f(1.0f - exp2f(-5.5f - (float)h));
            mixb::state_unit<1, 64, 128>(P, Bk, (bf16*)(ws + WS_STR) + ((size_t)(b * 4 + h) * 8 + Bk) * 2 * 8192, lds + RING_OFF, tid); } }
        { PH_LOCALS for (int u = vcu; u < NB * 8 * 8; u += G) { const int b = u >> 6, hh = (u >> 3) & 7, Bk = u & 7, gq = hh >> 2; const size_t r0 = (size_t)b * SEQ;
            mixb::MixP P{}; const bf16* XBC = (const bf16*)(ws + WS_XBC) + r0 * 1024; P.k0 = XBC + 512 + gq * 128; P.ldk0 = 1024; P.v = XBC + hh * 64; P.ldv = 1024;
            P.ssdp = (const float*)(ws + WS_SSDP) + r0 * 32 + hh * 4;
            mixb::state_unit<2, 128, 64>(P, Bk, (bf16*)(ws + WS_STS) + ((size_t)(b * 8 + hh) * 8 + Bk) * 2 * 8192, lds + RING_OFF, tid); } }
#endif
    }
    SEAM(pb + 2);
    if constexpr (IN(pb + 3)) {
        if constexpr (KSEL(40)) { PH_LOCALS for (int u = vcu; u < NB * 4 * 8; u += G) { const int b = u >> 5, h = (u >> 3) & 3, qb = u & 7; const size_t r0 = (size_t)b * SEQ;
            mixb::MixP P{}; P.q = (const bf16*)(ws + WS_QB) + r0 * 768 + h * 192; P.ldq = 768; P.k0 = (const bf16*)(ws + WS_KVB) + r0 * 1024 + h * 256; P.ldk0 = 1024;
            P.k1 = (const bf16*)(ws + WS_KPE) + r0 * 64; P.ldk1 = 64; P.v = (const bf16*)(ws + WS_KVB) + r0 * 1024 + h * 256 + 128; P.ldv = 1024;
            P.o = (bf16*)(ws + WS_ATT) + r0 * 512 + h * 128; P.ldo = 512;
            mixb::mix_unit<0, 192, 128>(P, qb * 256, lds + RING_OFF, tid); } }
        STAMP(32 + LAYER * 4 + 0);
        if constexpr (KSEL(41)) { PH_LOCALS for (int u = vcu; u < NB * 4 * 8; u += G) { const int rnd = u / G; const int b = u >> 5, h0 = (u >> 3) & 3, h = (rnd & 1) ? 3 - h0 : h0, qb = u & 7; const size_t r0 = (size_t)b * SEQ;
            mixb::MixP P{}; P.q = (const bf16*)(ws + WS_RQ) + r0 * 256 + h * 64; P.ldq = 256; P.k0 = (const bf16*)(ws + WS_RK) + r0 * 256 + h * 64; P.ldk0 = 256; P.k1 = P.k0; P.ldk1 = 256;
            P.v = (const bf16*)(ws + WS_PROJ) + r0 * NINP + C_RV + h * 128; P.ldv = NINP; P.aux = (const bf16*)(ws + WS_PROJ) + r0 * NINP + C_RG + h * 128; P.ldaux = NINP;
            P.o = (bf16*)(ws + WS_MIX) + r0 * DM + 512 + h * 128; P.ldo = DM;
            P.lf = log2f(1.0f - exp2f(-5.0f - (float)h)); P.lb = log2f(1.0f - exp2f(-5.5f - (float)h)); P.st = (const bf16*)(ws + WS_STR) + (size_t)(b * 4 + h) * 8 * 2 * 8192;
            mixb::mix_unit<1, 64, 128>(P, qb * 256, lds + RING_OFF, tid); } }
        STAMP(32 + LAYER * 4 + 1);
        if constexpr (KSEL(42)) { PH_LOCALS for (int u = vcu; u < NB * 8 * 8; u += G) { const int rnd = u / G; const int b = u >> 6, hh = (((u >> 3) & 7) + 2 * rnd) & 7, qb = u & 7, gq = hh >> 2; const size_t r0 = (size_t)b * SEQ;
            mixb::MixP P{}; const bf16* XBC = (const bf16*)(ws + WS_XBC) + r0 * 1024;
            P.q = XBC + 768 + gq * 128; P.ldq = 1024; P.k0 = XBC + 512 + gq * 128; P.ldk0 = 1024; P.k1 = P.k0; P.ldk1 = 1024; P.v = XBC + hh * 64; P.ldv = 1024; P.aux = P.v; P.ldaux = 1024;
            P.ssdp = (const float*)(ws + WS_SSDP) + r0 * 32 + hh * 4; P.dh = args.in(I_SSDD)[layer * 8 + hh];
            P.o = (bf16*)(ws + WS_YC) + r0 * 512 + hh * 64; P.ldo = 512; P.st = (const bf16*)(ws + WS_STS) + (size_t)(b * 8 + hh) * 8 * 2 * 8192;
            mixb::mix_unit<2, 128, 64>(P, qb * 256, lds + RING_OFF, tid); } }
        STAMP(32 + LAYER * 4 + 2);
        if constexpr (KSEL(43)) { PH_LOCALS for (int u = vcu; u < 512; u += G) hyb::hyena_unit(args, layer, u, ws, lds + RING_OFF, tid); }
        STAMP(32 + LAYER * 4 + 3);
    }
    SEAM(pb + 3);
    if constexpr (INK(pb + 4, 5)) { PH_LOCALS
        for (int m = gw * 4; m < M; m += NGW * 4) post_rows4(args, layer, m, lane, ws);
        for (int it = gw; it < NB * 128; it += NGW) post_hy(args, layer, it, lane, ws, (LAS bf16*)wscr);
    }
    SEAM(pb + 4);
    if constexpr (INK(pb + 5, 6)) { PH_LOCALS
        pg8::Gemm g{(const bf16*)(ws + WS_MIX), (const bf16*)(ws + WS_WOUT + layer * SZ_WOUT), M, DM, DM}; pg8::StaticOrder S; S.init(M, DM, G, bx);
        pg8::EpiBf16 E{(bf16*)(ws + WS_Y0), DM, nullptr, 0};
        pg8::gemm_phase<pg8::EpiBf16, pg8::StaticOrder, true, true>(lds + RING_OFF, g, S, E, tid);
    }
    SEAM(pb + 5);
    if constexpr (INK(pb + 6, 7)) { PH_LOCALS
        const float* gG = args.in(I_LN1G) + layer * DM; const float* gB = args.in(I_LN1B) + layer * DM;
        if constexpr (LAYER == 1) {
            LAS float* WrT = (LAS float*)(lds + RING_OFF);
            for (int i = tid; i < DM * NEXP; i += NWAVES * 64) WrT[(i & 7) * DM + (i >> 3)] = args.in(I_ROUTER)[i];
            for (int i = bx * NWAVES * 64 + tid; i < CAP_ROWS; i += G * NWAVES * 64) ((int*)(ws + WS_SLOT))[i] = -1;
            LAS unsigned* lcnt = (LAS unsigned*)(lds + RING_OFF + 65536); LAS unsigned* lbase = lcnt + 8; LAS int* lrec = (LAS int*)(lcnt + 16);
            if (tid < 16) lcnt[tid] = 0u;
            __syncthreads();
            int nrow = 0;
            v2u nv[8]; if (gw < M) ln_load_b(XB + (size_t)gw * DM, lane, nv);
            for (int m = gw; m < M; m += NGW) { f32x4 v[8]; v2u xv[8];
#pragma unroll
                for (int j = 0; j < 8; ++j) xv[j] = nv[j];
                if (m + NGW < M) ln_load_b(XB + (size_t)(m + NGW) * DM, lane, nv);
                ln_row_b(xv, v, XB + (size_t)m * DM, gG, gB, lane, (const bf16*)(ws + WS_Y0) + (size_t)m * DM, nullptr, nullptr);
                float lg[8];
#pragma unroll
                for (int e = 0; e < 8; ++e) { float s = 0.f;
#pragma unroll
                    for (int j = 0; j < 8; ++j) { const f32x4 w = *((const LAS f32x4*)(WrT + e * DM) + lane + 64 * j); s += (v[j].x * w.x + v[j].y * w.y) + (v[j].z * w.z + v[j].w * w.w); }
                    lg[e] = wave_sum(s); __builtin_amdgcn_sched_barrier(0); }
                int e0 = 0; float v0 = lg[0];
#pragma unroll
                for (int e = 1; e < 8; ++e) if (lg[e] > v0) { v0 = lg[e]; e0 = e; }
                int e1 = -1; float v1 = -3.0e38f;
#pragma unroll
                for (int e = 0; e < 8; ++e) if (e != e0 && lg[e] > v1) { v1 = lg[e]; e1 = e; }
                if (lane == 0) { const float ex = __expf(v1 - v0); const float g0 = 1.0f / (1.0f + ex), g1 = ex / (1.0f + ex);
                    const int p0 = (int)__hip_atomic_fetch_add(lcnt + e0, 1u, __ATOMIC_RELAXED, __HIP_MEMORY_SCOPE_WORKGROUP), p1 = (int)__hip_atomic_fetch_add(lcnt + e1, 1u, __ATOMIC_RELAXED, __HIP_MEMORY_SCOPE_WORKGROUP);
                    LAS int* rec = lrec + (wave * 64 + nrow) * 4; rec[0] = e0; rec[1] = e1; rec[2] = p0; rec[3] = p1;
                    float* rg = (float*)(ws + WS_RTG) + (size_t)m * 2; rg[0] = g0; rg[1] = g1; }
                ++nrow; }
            __syncthreads();
            if (tid < NEXP) lbase[tid] = atomicAdd((unsigned*)(ctl + CW_CNT + tid), lcnt[tid]);
            __syncthreads();
            { int r = 0; for (int m = gw; m < M; m += NGW, ++r) if (lane == 0) { const LAS int* rec = lrec + (wave * 64 + r) * 4; const int e0 = rec[0], e1 = rec[1];
                int* rt = (int*)(ws + WS_RT) + (size_t)m * 4; rt[0] = e0; rt[1] = e1; rt[2] = rec[2] + (int)lbase[e0]; rt[3] = rec[3] + (int)lbase[e1]; } }
            __syncthreads();
        } else {
            v2u nv[8]; if (gw < M) ln_load_b(XB + (size_t)gw * DM, lane, nv);
            for (int m = gw; m < M; m += NGW) { f32x4 v[8]; v2u xv[8];
#pragma unroll
                for (int j = 0; j < 8; ++j) xv[j] = nv[j];
                if (m + NGW < M) ln_load_b(XB + (size_t)(m + NGW) * DM, lane, nv);
                ln_row_b(xv, v, XB + (size_t)m * DM, gG, gB, lane, (const bf16*)(ws + WS_Y0) + (size_t)m * DM, nullptr, nullptr, ws + WS_XF8 + (size_t)m * DM); }
        }
    }
    SEAM(pb + 6);
    if constexpr (LAYER == 0) {
        if constexpr (INK(8, 8)) { PH_LOCALS
            pg8::Gemm g{(const bf16*)(ws + WS_XF8), (const bf16*)(ws + WS_WGU), M, 2 * DFF, DM}; pg8::StaticOrder S; S.init(M, 2 * DFF, G, bx);
            pg8::EpiSwigluF8 E{ws + WS_HID, DFF};
            pg8::gemm_phase_f8<pg8::EpiSwigluF8, pg8::StaticOrder, true, true>(lds + RING_OFF, g, S, E, tid, 0x79797979, 0x7f7f7f7f);
        }
        SEAM(8);
        if constexpr (INK(9, 9)) { PH_LOCALS
            pg8::Gemm g{(const bf16*)(ws + WS_HID), (const bf16*)(ws + WS_WDN), M, DM, DFF}; pg8::StaticOrder S; S.init(M, DM, G, bx);
            pg8::EpiBf16 E{(bf16*)(ws + WS_Y0), DM, nullptr, 0};
            pg8::gemm_phase_f8<pg8::EpiBf16, pg8::StaticOrder, true, true>(lds + RING_OFF, g, S, E, tid, 0x77777777, 0x7f7f7f7f);
        }
        SEAM(9);
        if constexpr (INK(10, 10)) { PH_LOCALS
            const float* gG = args.in(I_LN2G); const float* gB = args.in(I_LN2B);
            v2u nv[8]; if (gw < M) ln_load_b(XB + (size_t)gw * DM, lane, nv);
            for (int m = gw; m < M; m += NGW) { f32x4 v[8]; v2u xv[8];
#pragma unroll
                for (int j = 0; j < 8; ++j) xv[j] = nv[j];
                if (m + NGW < M) ln_load_b(XB + (size_t)(m + NGW) * DM, lane, nv);
                ln_row_b(xv, v, XB + (size_t)m * DM, gG, gB, lane, (const bf16*)(ws + WS_Y0) + (size_t)m * DM, nullptr, nullptr); }
        }
        SEAM(10);
    }
}

template <int CH, int LO, int HI>
__device__ __forceinline__ void moe_chunk(LAS unsigned char* lds, const XcdBarrier& bar, const Ids& ids) {
    if constexpr (INK(19 + 2 * CH, 19)) { PH_LOCALS
        pg8::MoeOrder S; int acc = 0;
#pragma unroll
        for (int e = 0; e < 8; ++e) { const int c = (int)__hip_atomic_load(ctl + CW_CNT + e, RLX_AGENT); acc += (c + 255) / 256 * 256; S.pend[e] = acc; }
        const int nrb = acc / 256; const int rb0 = CH * MOE_CH_RB; int nrbc = nrb - rb0; nrbc = nrbc < 0 ? 0 : (nrbc > MOE_CH_RB ? MOE_CH_RB : nrbc);
        pg8::Gemm g{(const bf16*)(ws + WS_XS + (size_t)rb0 * 256 * DM), (const bf16*)(ws + WS_MGU), nrbc * 256, 2 * DFFE, DM};
        S.so.init(nrbc * 256, 2 * DFFE, G, bx); S.rb0 = rb0; S.bstride = (long)2 * DFFE * DM;
        pg8::EpiSwigluF8 E{ws + WS_HIDS, DFFE};
        pg8::gemm_phase_f8<pg8::EpiSwigluF8, pg8::MoeOrder, true, true>(lds + RING_OFF, g, S, E, tid, 0x79797979, 0x7f7f7f7f);
    }
    SEAM(19 + 2 * CH);
    if constexpr (INK(20 + 2 * CH, 20)) { PH_LOCALS
        pg8::MoeOrder S; int acc = 0;
#pragma unroll
        for (int e = 0; e < 8; ++e) { const int c = (int)__hip_atomic_load(ctl + CW_CNT + e, RLX_AGENT); acc += (c + 255) / 256 * 256; S.pend[e] = acc; }
        const int nrb = acc / 256; const int rb0 = CH * MOE_CH_RB; int nrbc = nrb - rb0; nrbc = nrbc < 0 ? 0 : (nrbc > MOE_CH_RB ? MOE_CH_RB : nrbc);
        pg8::Gemm g{(const bf16*)(ws + WS_HIDS), (const bf16*)(ws + WS_MDN), nrbc * 256, DM, DFFE};
        S.so.init(nrbc * 256, DM, G, bx); S.rb0 = rb0; S.bstride = (long)DM * DFFE;
        pg8::EpiMoeDown E{(bf16*)(ws + WS_Y0), (long)((WS_Y1 - WS_Y0) / 2), DM, (const int*)(ws + WS_SLOT), (const float*)(ws + WS_SLOTG), rb0 * 256};
        pg8::gemm_phase_f8<pg8::EpiMoeDown, pg8::MoeOrder, true, true>(lds + RING_OFF, g, S, E, tid, 0x77777777, 0x7f7f7f7f);
    }
    SEAM(20 + 2 * CH);
}

template <int LO, int HI>
__global__ void __launch_bounds__(NWAVES * 64, 2) mk_fwd(Args args_unused, int li) {
    extern __shared__ __attribute__((aligned(16))) unsigned char lds_raw[];
    LAS unsigned char* lds = (LAS unsigned char*)lds_raw;
    volatile LAS unsigned* MISC = (volatile LAS unsigned*)(lds + MISC_OFF);
    Ids ids; { const int tid0 = threadIdx.x; ids.wave0 = __builtin_amdgcn_readfirstlane(tid0 >> 6); ids.G0 = gridDim.x; ids.bx0 = blockIdx.x;
        ids.vcu0 = (ids.G0 % 8 == 0) ? (ids.bx0 % 8) * (ids.G0 / 8) + ids.bx0 / 8 : ids.bx0;
        for (int u = tid0; u < (LDS_BYTES - LDSCTL_OFF) / 4; u += NWAVES * 64) ((LAS unsigned*)(lds + LDSCTL_OFF))[u] = 0u; }
    __syncthreads();
    XcdBarrier bar; bar.bar = nullptr; bar.x = 0; bar.st = nullptr;
    if constexpr (HI - LO > 1) { const AP a0 = kargs(); bar = xcd_barrier_post((unsigned*)((gu32*)(a0.ws() + WS_CTL) + CW_BAR) + li * XCD_BAR_WORDS, MISC + 8); }

    STAMP(0);
    if constexpr (INK(0, 0)) { PH_LOCALS
        constexpr int I_WIN_ = 32 * (NINP / 32), I_UQ = 6 * 24, I_UKV = 4 * 32, I_OUT = 32 * 64, I_GU = 32 * (DFF / 32), I_DN = (DFF / 64) * 64;
        constexpr int NIT = 2 * I_WIN_ + 2 * I_UQ + 2 * I_UKV + 2 * I_OUT + 2 * I_GU + I_DN;
        for (int it = gw; it < NIT; it += NGW) { int r = it;
#define TRJ(n, W, K, N, NP, WT, GR, GS, OFF) if (r < (n)) { transpose_item((W), (K), (N), (NP) / 32, (bf16*)(WT), (GR), (GS), (OFF), wscr, r, lane); continue; } r -= (n);
            TRJ(I_WIN_, args.in(I_WIN), DM, NIN, NINP, ws + WS_WIN, 1 << 30, 0, 0)
            TRJ(I_WIN_, args.in(I_WIN) + (size_t)DM * NIN, DM, NIN, NINP, ws + WS_WIN + SZ_WIN, 1 << 30, 0, 0)
            TRJ(I_UQ, args.in(I_WUQ), 384, 768, 768, ws + WS_WUQ, 1 << 30, 0, 0)
            TRJ(I_UQ, args.in(I_WUQ) + 384 * 768, 384, 768, 768, ws + WS_WUQ + SZ_WUQ, 1 << 30, 0, 0)
            TRJ(I_UKV, args.in(I_WUKV), 256, 1024, 1024, ws + WS_WUKV, 1 << 30, 0, 0)
            TRJ(I_UKV, args.in(I_WUKV) + 256 * 1024, 256, 1024, 1024, ws + WS_WUKV + SZ_WUKV, 1 << 30, 0, 0)
            TRJ(I_OUT, args.in(I_WOUT), DM, DM, DM, ws + WS_WOUT, 1 << 30, 0, 0)
            TRJ(I_OUT, args.in(I_WOUT) + (size_t)DM * DM, DM, DM, DM, ws + WS_WOUT + SZ_WOUT, 1 << 30, 0, 0)
            if (r < I_GU) { transpose_item_f8(args.in(I_FFG), DM, DFF, DFF / 32, ws + WS_WGU, 128, 256, 0, 64.0f, wscr, r, lane); continue; } r -= I_GU;
            if (r < I_GU) { transpose_item_f8(args.in(I_FFU), DM, DFF, DFF / 32, ws + WS_WGU, 128, 256, 128, 64.0f, wscr, r, lane); continue; } r -= I_GU;
            transpose_item_f8(args.in(I_FFD), DFF, DM, DM / 32, ws + WS_WDN, 1 << 30, 0, 0, 256.0f, wscr, r, lane);
#undef TRJ
        }
        STAMP(92);
        for (int m = gw; m < M; m += NGW) { const GAS f32x4* xr = (const GAS f32x4*)(args.in(I_X) + (size_t)m * DM) + lane; GAS v2u* xb = (GAS v2u*)(XB + (size_t)m * DM) + lane;
#pragma unroll
            for (int j = 0; j < 8; ++j) { const f32x4 v = xr[64 * j]; v2u w; w.x = pk2(v.x, v.y); w.y = pk2(v.z, v.w); xb[64 * j] = w; } }
        STAMP(93);
        for (int it = gw; it < 2048; it += NGW) hyena_filter_block(args, it, (bf16*)(ws + WS_HYG), wscr, lane);
    }
    SEAM(0);
    layer_phases<0, LO, HI>(lds, bar, ids);
    layer_phases<1, LO, HI>(lds, bar, ids);
    if constexpr (INK(18, 18)) { PH_LOCALS
        moe_conv_items(args, ws, wscr, lane, 2 * MOE_FILL, MOE_ITEMS, gw, NGW);
        int pst[8]; { int acc = 0;
#pragma unroll
            for (int e = 0; e < 8; ++e) { pst[e] = acc; const int c = (int)__hip_atomic_load(ctl + CW_CNT + e, RLX_AGENT); acc += (c + 255) / 256 * 256; } }
        for (int it = gw; it < 2 * M; it += 4 * NGW) {
            int tk[4], sl[4]; bool ok[4];
#pragma unroll
            for (int u = 0; u < 4; ++u) { const int iu = it + u * NGW; ok[u] = iu < 2 * M; const int ic = ok[u] ? iu : it; tk[u] = ic;
                const int* rt = (const int*)(ws + WS_RT) + (size_t)(ic >> 1) * 4; const int e = rt[ic & 1], pos = rt[2 + (ic & 1)];
                int base = 0;
#pragma unroll
                for (int j = 0; j < 8; ++j) base = (e == j) ? pst[j] : base;
                sl[u] = base + pos; }
            v4u rw[4][4];
#pragma unroll
            for (int u = 0; u < 4; ++u) { const GAS v4u* src = (const GAS v4u*)(XB + (size_t)(tk[u] >> 1) * DM) + lane;
#pragma unroll
                for (int j = 0; j < 4; ++j) rw[u][j] = src[64 * j]; }
#pragma unroll
            for (int u = 0; u < 4; ++u) if (ok[u]) { GAS v2u* dst = (GAS v2u*)(ws + WS_XS + (size_t)sl[u] * DM) + lane;
#pragma unroll
                for (int j = 0; j < 4; ++j) { const v4u w = rw[u][j]; v2u o; o.x = pk4_fp8(bflo(w.x), bfhi(w.x), bflo(w.y), bfhi(w.y)); o.y = pk4_fp8(bflo(w.z), bfhi(w.z), bflo(w.w), bfhi(w.w)); dst[64 * j] = o; }
                if (lane == 0) { ((int*)(ws + WS_SLOT))[sl[u]] = tk[u]; ((float*)(ws + WS_SLOTG))[sl[u]] = ((const float*)(ws + WS_RTG))[(size_t)tk[u]]; } } }
    }
    SEAM(18);
    moe_chunk<0, LO, HI>(lds, bar, ids);
    if constexpr (INK(25, 25)) { PH_LOCALS
#if MOE_CHECK
        { LAS float* xs = (LAS float*)(lds + RING_OFF); LAS float* hid = xs + DM; LAS float* red = hid + DFFE;
          for (int smp = bx; smp < 48; smp += G) { const int tok = (smp * 683 + 5) % M;
            for (int d = tid; d < DM; d += 512) xs[d] = bf2f(XB[(size_t)tok * DM + d]);
            __syncthreads();
            float accv[4] = {0.f, 0.f, 0.f, 0.f};
            for (int kk = 0; kk < 2; ++kk) { const int e = ((const int*)(ws + WS_RT))[(size_t)tok * 4 + kk]; const float gt = ((const float*)(ws + WS_RTG))[(size_t)tok * 2 + kk];
                const float* Wg = args.in(I_MOEG) + (size_t)e * DM * DFFE; const float* Wu = args.in(I_MOEU) + (size_t)e * DM * DFFE; const float* Wd = args.in(I_MOED) + (size_t)e * DFFE * DM;
                for (int j = tid; j < DFFE; j += 512) { float a = 0.f, b = 0.f; for (int d = 0; d < DM; ++d) { const float xv = xs[d]; a += xv * Wg[(size_t)d * DFFE + j]; b += xv * Wu[(size_t)d * DFFE + j]; } hid[j] = (a / (1.0f + __expf(-a))) * b; }
                __syncthreads();
                for (int q = 0; q < 4; ++q) { const int c = tid + 512 * q; float o = 0.f; for (int j = 0; j < DFFE; ++j) o += hid[j] * Wd[(size_t)j * DM + c]; accv[q] += gt * o; }
                __syncthreads(); }
            float num = 0.f, den = 0.f;
            for (int q = 0; q < 4; ++q) { const int c = tid + 512 * q; const float mine = bf2f(((const bf16*)(ws + WS_Y0))[(size_t)tok * DM + c]) + bf2f(((const bf16*)(ws + WS_Y1))[(size_t)tok * DM + c]); const float df = accv[q] - mine; num += df * df; den += accv[q] * accv[q]; }
            num = wave_sum(num); den = wave_sum(den); if (lane == 0) { red[wave * 2] = num; red[wave * 2 + 1] = den; }
            __syncthreads();
            if (tid == 0) { float n = 0.f, dn = 0.f; for (int w = 0; w < 8; ++w) { n += red[w * 2]; dn += red[w * 2 + 1]; } const float rel = n / (dn + 1e-20f); atomicMax((unsigned*)(ctl + 80), __float_as_uint(rel)); }
            if (wave == 0) { float lg[8]; for (int e = 0; e < 8; ++e) { float s = 0.f; for (int d = lane; d < DM; d += 64) s += xs[d] * args.in(I_ROUTER)[d * 8 + e]; lg[e] = wave_sum(s); }
                int e0 = 0; for (int e = 1; e < 8; ++e) if (lg[e] > lg[e0]) e0 = e; int e1 = -1; for (int e = 0; e < 8; ++e) if (e != e0 && (e1 < 0 || lg[e] > lg[e1])) e1 = e;
                const float ex = __expf(lg[e1] - lg[e0]); const float g0 = 1.f / (1.f + ex);
                const int* rt = (const int*)(ws + WS_RT) + (size_t)tok * 4; const float* rg = (const float*)(ws + WS_RTG) + (size_t)tok * 2;
                const bool bad = (rt[0] != e0) || (rt[1] != e1) || fabsf(rg[0] - g0) > 0.03f || fabsf(rg[0] + rg[1] - 1.f) > 1e-3f;
                if (lane == 0 && bad) atomicAdd((unsigned*)(ctl + 81), 1u); }
            __syncthreads(); } }
        __syncthreads();
        { XcdBarrier bb_ = bar; (void)bb_; }
#endif
        const float* gG = args.in(I_LN2G) + DM; const float* gB = args.in(I_LN2B) + DM;
        v2u nv[8]; if (gw < M) ln_load_b(XB + (size_t)gw * DM, lane, nv);
        for (int m = gw; m < M; m += NGW) { f32x4 v[8]; v2u xv[8];
#pragma unroll
            for (int j = 0; j < 8; ++j) xv[j] = nv[j];
            if (m + NGW < M) ln_load_b(XB + (size_t)(m + NGW) * DM, lane, nv);
            ln_row_b(xv, v, nullptr, gG, gB, lane, (const bf16*)(ws + WS_Y0) + (size_t)m * DM, (const bf16*)(ws + WS_Y1) + (size_t)m * DM, XRES + (size_t)m * DM); }
#if TIMING_PROBE
        { XcdBarrier bb_ = bar; asm volatile("" : "+s"(bb_.bar), "+s"(bb_.x)); xcd_barrier(bb_); }
        STAMP(26);
        __syncthreads();
        if (bx == PROBE_BLK) { volatile LAS unsigned* T = (volatile LAS unsigned*)(lds + MISC_OFF) + 16;
            const float t1 = (float)(T[PROBE_A1] - T[PROBE_A0]) * 0.01f + (float)PROBE_BIAS, t2 = (float)(T[PROBE_B1] - T[PROBE_B0]) * 0.01f;
            if (tid == 0) XRES[12345] = t1 * PROBE_SCALE + 1.66f + 0.f * t2; }
#endif
#if MOE_CHECK
        __syncthreads(); VM_WAIT();
        if (tid == 0) { __builtin_amdgcn_fence(__ATOMIC_RELEASE, "agent"); const unsigned old_ = atomicAdd((unsigned*)(ctl + 82), 1u); ((volatile LAS unsigned*)(lds + MISC_OFF))[12] = (old_ + 1u == (unsigned)G) ? 1u : 0u; }
        __syncthreads();
        if (((volatile LAS unsigned*)(lds + MISC_OFF))[12]) { __builtin_amdgcn_fence(__ATOMIC_ACQUIRE, "agent");
            const float rel = __uint_as_float(__hip_atomic_load(ctl + 80, RLX_AGENT)); const unsigned nbad = __hip_atomic_load(ctl + 81, RLX_AGENT);
            float code = 0.f; if (rel > 0.03f) code += 10.f; if (rel > 0.3f) code += 10.f; if (nbad > 2u) code += 40.f; if (nbad > 8u) code += 40.f;
            if (code > 0.f) for (size_t i = tid; i < (size_t)M * DM; i += 512) XRES[i] = code; }
#endif
    }
}
#undef IN
#undef INK
#undef SEAM
#undef STAMP

template <int LO, int HI> static void launch_range(int grid, const Args& a, int li, hipStream_t stream) {
    static bool attr = false;
    if (!attr) { if (hipFuncSetAttribute((const void*)mk_fwd<LO, HI>, hipFuncAttributeMaxDynamicSharedMemorySize, LDS_BYTES) != hipSuccess) fprintf(stderr, "kernel_launch: hipFuncSetAttribute failed\n"); attr = true; }
    hipLaunchKernelGGL((mk_fwd<LO, HI>), dim3(grid), dim3(NWAVES * 64), LDS_BYTES, stream, a, li);
}
template <int P> struct PerPhase { static void go(int grid, const Args& a, hipStream_t s) { PerPhase<P - 1>::go(grid, a, s); launch_range<P, P + 1>(grid, a, P, s); } };
template <> struct PerPhase<-1> { static void go(int, const Args&, hipStream_t) {} };

extern "C" void kernel_launch(void* const* d_in, const int* in_sizes, int n_in, void* d_out, int out_size, void* d_ws, size_t ws_size, hipStream_t stream) {
    static int grid = 0;
    if (grid == 0) {
        if (n_in != 35 || out_size != M * DM || ws_size < WS_END) { fprintf(stderr, "kernel_launch: built for 35 inputs, out %d floats, >= %zu bytes of workspace; got n_in %d, out %d, ws %zu; nothing launched\n", M * DM, (size_t)WS_END, n_in, out_size, ws_size); grid = -1; return; }
        int dev = 0, cus = 0;
        if (hipGetDevice(&dev) != hipSuccess || hipDeviceGetAttribute(&cus, hipDeviceAttributeMultiprocessorCount, dev) != hipSuccess) { grid = -1; return; }
        grid = cus;
    }
    if (grid < 0) return;
    if (hipMemsetAsync((char*)d_ws + WS_CTL, 0, CTL_ZERO_BYTES, stream) != hipSuccess) return;
    Args a{};
    for (int i = 0; i < 35; ++i) a.in[i] = (const float*)d_in[i];
    a.out = (float*)d_out; a.ws = (unsigned char*)d_ws; a.ph_lo = 0; a.ph_hi = N_PHASES;
#if MK_CUTS
    PerPhase<N_PHASES - 1>::go(grid, a, stream);
#else
    launch_range<0, N_PHASES>(grid, a, 0, stream);
#endif
    const hipError_t le = hipPeekAtLastError();
    if (le != hipSuccess) fprintf(stderr, "kernel_launch: launch failed: %s\n", hipGetErrorName(le));
}
```
